# Optimizing an MI355X kernel written in HIP

```python
import math
import jax
import jax.numpy as jnp
from jax import lax
import numpy as np

D_MODEL = 1024
BATCH = 8
SEQ = 2048
DEPTH = 2
DEC_BATCH = 128
DEC_SEQ = 4
PAST_LEN = 16384
PAGE_SIZE = 128

GROUP_W = D_MODEL // 4
SSD_HD = 64
SSD_H = GROUP_W // SSD_HD
SSD_G = 2
SSD_N = 128
SSD_CONV = 4
SSD_CONV_CH = GROUP_W + 2 * SSD_G * SSD_N
SSD_CHUNK = 64
RET_HD = 64
RET_H = GROUP_W // RET_HD
RET_CHUNK = 64
ROPE_BASE = 10000.0
RG_BLOCKS = 4
RG_BD = GROUP_W // RG_BLOCKS
RG_CONV = 4
RG_C = 8.0
HG_HD = 64
HG_H = GROUP_W // HG_HD
HG_CHUNK = 16
N_MEM = 256
XA_H = 4
XA_HD = D_MODEL // XA_H
D_FF = -(-8 * D_MODEL // (3 * 256)) * 256
IN_SIZES = (GROUP_W, SSD_CONV_CH, SSD_H, GROUP_W, GROUP_W, GROUP_W, GROUP_W, GROUP_W, GROUP_W, GROUP_W, GROUP_W, GROUP_W, GROUP_W)
D_IN = sum(IN_SIZES)
EPS = 1e-6

kernel_name = 'hybrid_ssd_ret_rglru_hgrn2_decode_step'


def _rmsnorm(x, g):
    xf = x.astype(jnp.float32)
    y = xf * lax.rsqrt(jnp.mean(xf * xf, axis=-1, keepdims=True) + EPS)
    return (y * g).astype(x.dtype)


def _headnorm(y, g, center):
    yf = y.astype(jnp.float32)
    if center:
        yf = yf - jnp.mean(yf, axis=-1, keepdims=True)
    yf = yf * lax.rsqrt(jnp.mean(yf * yf, axis=-1, keepdims=True) + EPS)
    return (yf.reshape(y.shape[:-2] + (-1,)) * g).astype(y.dtype)


def _causal_conv(x, buf, w, b):
    W = w.shape[0]
    T = x.shape[1]
    xx = jnp.concatenate([buf, x], axis=1)
    y = b + sum(xx[:, j:j + T] * w[j] for j in range(W))
    return y, xx[:, T:]


def _rope(x, pos):
    half = x.shape[-1] // 2
    inv = ROPE_BASE ** (-jnp.arange(half, dtype=jnp.float32) / half)
    ang = pos[:, None] * inv
    cos = jnp.cos(ang)[None, :, None, :]
    sin = jnp.sin(ang)[None, :, None, :]
    xf = x.astype(jnp.float32)
    x1, x2 = xf[..., :half], xf[..., half:]
    return jnp.concatenate([x1 * cos - x2 * sin, x2 * cos + x1 * sin], axis=-1).astype(x.dtype)


def _chunked_scalar_decay(q, k, v, log_a, s0, chunk):
    B, T, H, K = q.shape
    V = v.shape[-1]
    C = math.gcd(T, chunk)
    N = T // C
    f32 = jnp.float32
    qc = q.reshape(B, N, C, H, K).astype(f32)
    kc = k.reshape(B, N, C, H, K).astype(f32)
    vc = v.reshape(B, N, C, H, V).astype(f32)
    cum = jnp.cumsum(log_a.astype(f32).reshape(B, N, C, H), axis=2)
    cum_h = jnp.moveaxis(cum, 3, 2)
    mask = jnp.tril(jnp.ones((C, C), dtype=bool))
    dec = jnp.exp(jnp.where(mask, cum_h[..., :, None] - cum_h[..., None, :], -jnp.inf))
    scores = jnp.einsum('bnthk,bnshk->bnhts', qc, kc) * dec
    y = jnp.einsum('bnhts,bnshv->bnthv', scores, vc)
    last = cum[:, :, -1]
    k_end = kc * jnp.exp(last[:, :, None] - cum)[..., None]
    ds = jnp.einsum('bnshk,bnshv->bnhkv', k_end, vc)

    def step(S, inp):
        a, d = inp
        return a[..., None, None] * S + d, S

    s_fin, s_in = lax.scan(step, s0.astype(f32), (jnp.moveaxis(jnp.exp(last), 1, 0), jnp.moveaxis(ds, 1, 0)))
    s_in = jnp.moveaxis(s_in, 0, 1)
    y = y + jnp.einsum('bnthk,bnhkv->bnthv', qc * jnp.exp(cum)[..., None], s_in)
    return y.reshape(B, T, H, V).astype(v.dtype), s_fin.astype(s0.dtype)


def _chunked_vector_decay(q, k, v, log_f, s0, chunk):
    B, T, H, K = q.shape
    V = v.shape[-1]
    C = math.gcd(T, chunk)
    N = T // C
    f32 = jnp.float32
    qc = q.reshape(B, N, C, H, K).astype(f32)
    kc = k.reshape(B, N, C, H, K).astype(f32)
    vc = v.reshape(B, N, C, H, V).astype(f32)
    cum = jnp.cumsum(log_f.astype(f32).reshape(B, N, C, H, K), axis=2)
    cum_h = jnp.moveaxis(cum, 3, 2)
    mask = jnp.tril(jnp.ones((C, C), dtype=bool))[:, :, None]
    dec = jnp.exp(jnp.where(mask, cum_h[:, :, :, :, None, :] - cum_h[:, :, :, None, :, :], -jnp.inf))
    A = jnp.einsum('bnthk,bnhtsk,bnshk->bnhts', qc, dec, kc)
    y = jnp.einsum('bnhts,bnshv->bnthv', A, vc)
    last = cum[:, :, -1]
    k_end = kc * jnp.exp(last[:, :, None] - cum)
    ds = jnp.einsum('bnshk,bnshv->bnhkv', k_end, vc)

    def step(S, inp):
        a, d = inp
        return a[..., None] * S + d, S

    s_fin, s_in = lax.scan(step, s0.astype(f32), (jnp.moveaxis(jnp.exp(last), 1, 0), jnp.moveaxis(ds, 1, 0)))
    s_in = jnp.moveaxis(s_in, 0, 1)
    y = y + jnp.einsum('bnthk,bnhkv->bnthv', qc * jnp.exp(cum), s_in)
    return y.reshape(B, T, H, V).astype(v.dtype), s_fin.astype(s0.dtype)


def _linear_scan(a, b, h0):
    b = b.at[:, 0].add(a[:, 0] * h0)

    def comb(l, r):
        return (l[0] * r[0], r[0] * l[1] + r[1])

    _, h = lax.associative_scan(comb, (a, b), axis=1)
    return h


def _mixer(h, st, P, l, pos0):
    ssd_s, ssd_buf, ret_s, rg_h, rg_buf, hg_s = st
    B, T, _ = h.shape
    f32 = jnp.float32
    u = h @ P['w_in'][l]
    offs = np.cumsum(IN_SIZES)[:-1].tolist()
    (s_z, s_xbc, s_dt, r_q, r_k, r_v, r_g, g_x, g_y, h_q, h_f, h_i, h_g) = jnp.split(u, offs, axis=-1)

    xbc, ssd_buf_new = _causal_conv(s_xbc, ssd_buf, P['ssd_conv_w'][l], P['ssd_conv_b'][l])
    xbc = jax.nn.silu(xbc)
    xs, bm, cm = jnp.split(xbc, [GROUP_W, GROUP_W + SSD_G * SSD_N], axis=-1)
    xs = xs.reshape(B, T, SSD_H, SSD_HD)
    rep = SSD_H // SSD_G
    bm = jnp.repeat(bm.reshape(B, T, SSD_G, SSD_N), rep, axis=2)
    cm = jnp.repeat(cm.reshape(B, T, SSD_G, SSD_N), rep, axis=2)
    dt = jax.nn.softplus(s_dt + P['ssd_dt_bias'][l])
    log_a = -jnp.exp(P['ssd_A_log'][l]) * dt
    y, ssd_s_new = _chunked_scalar_decay(cm, bm, xs * dt[..., None], log_a, ssd_s, SSD_CHUNK)
    y = y + P['ssd_D'][l][:, None] * xs
    y_ssd = _rmsnorm(y.reshape(B, T, GROUP_W) * jax.nn.silu(s_z), P['ssd_norm'][l])

    pos = pos0 + jnp.arange(T, dtype=f32)
    rq = _rope(r_q.reshape(B, T, RET_H, RET_HD), pos)
    rk = _rope(r_k.reshape(B, T, RET_H, RET_HD), pos) * RET_HD ** -0.5
    rv = r_v.reshape(B, T, RET_H, RET_HD)
    log_gamma = jnp.log(1.0 - jnp.exp2(-5.0 - jnp.arange(RET_H, dtype=f32)))
    y, ret_s_new = _chunked_scalar_decay(rq, rk, rv, jnp.broadcast_to(log_gamma, (B, T, RET_H)), ret_s, RET_CHUNK)
    y_ret = jax.nn.silu(r_g) * _headnorm(y, P['ret_norm'][l], True)

    xr, rg_buf_new = _causal_conv(g_x, rg_buf, P['rg_conv_w'][l], P['rg_conv_b'][l])
    xb = xr.reshape(B, T, RG_BLOCKS, RG_BD)
    r_gate = jax.nn.sigmoid(jnp.einsum('bthi,hij->bthj', xb, P['rg_wa'][l]).reshape(B, T, GROUP_W) + P['rg_ba'][l])
    i_gate = jax.nn.sigmoid(jnp.einsum('bthi,hij->bthj', xb, P['rg_wx'][l]).reshape(B, T, GROUP_W) + P['rg_bx'][l])
    log_ar = (-RG_C * jax.nn.softplus(-P['rg_lambda'][l]) * r_gate).astype(f32)
    a_r = jnp.exp(log_ar)
    b_r = jnp.sqrt(-jnp.expm1(2.0 * log_ar)) * (i_gate * xr).astype(f32)
    hseq = _linear_scan(a_r, b_r, rg_h.astype(f32))
    rg_h_new = hseq[:, -1].astype(rg_h.dtype)
    y_rg = (jax.nn.gelu(g_y) * hseq).astype(h.dtype)

    lb_sm = jax.nn.softmax(P['hg_lb'].astype(f32), axis=0)
    lb = (jnp.cumsum(lb_sm, axis=0) - lb_sm[0])[l]
    fg = lb + (1.0 - lb) * jax.nn.sigmoid(h_f.astype(f32))
    shp = (B, T, HG_H, HG_HD)
    y, hg_s_new = _chunked_vector_decay(jax.nn.silu(h_q).reshape(shp), (1.0 - fg).reshape(shp),
                                        h_i.reshape(shp), jnp.log(fg).reshape(shp), hg_s, HG_CHUNK)
    y_hg = jax.nn.silu(h_g) * _headnorm(y, P['hg_norm'][l], False)

    mix = jnp.concatenate([y_ssd, y_ret, y_rg, y_hg], axis=-1) @ P['w_out'][l]
    return mix, (ssd_s_new, ssd_buf_new, ret_s_new, rg_h_new, rg_buf_new, hg_s_new)


def _mem_kv(mem, P, l):
    B, M, _ = mem.shape
    kv = _rmsnorm(mem, P['ln_mem'][l]) @ P['w_xkv'][l]
    k, v = jnp.split(kv, 2, axis=-1)
    return k.reshape(B, M, XA_H, XA_HD), v.reshape(B, M, XA_H, XA_HD)


def _xattn(h, k, v, P, l):
    B, T, _ = h.shape
    q = (h @ P['w_xq'][l]).reshape(B, T, XA_H, XA_HD)
    s = jnp.einsum('bthd,bmhd->bhtm', q, k).astype(jnp.float32) * XA_HD ** -0.5
    p = jax.nn.softmax(s, axis=-1).astype(v.dtype)
    o = jnp.einsum('bhtm,bmhd->bthd', p, v).reshape(B, T, D_MODEL)
    return o @ P['w_xo'][l]


def _ffn(h, P, l):
    g, u = jnp.split(h @ P['w_gu'][l], 2, axis=-1)
    return (jax.nn.silu(g) * u) @ P['w_down'][l]


def _layer(x, st, k_mem, v_mem, P, l, pos0):
    m, st_new = _mixer(_rmsnorm(x, P['ln_mix_pre'][l]), st, P, l, pos0)
    x = x + _rmsnorm(m, P['ln_mix_post'][l])
    a = _xattn(_rmsnorm(x, P['ln_xa_pre'][l]), k_mem, v_mem, P, l)
    x = x + _rmsnorm(a, P['ln_xa_post'][l])
    f = _ffn(_rmsnorm(x, P['ln_ffn_pre'][l]), P, l)
    x = x + _rmsnorm(f, P['ln_ffn_post'][l])
    return x, st_new


def _stack_field(states, i):
    return jnp.stack([s[i] for s in states], axis=0)


def setup_inputs(seed: int = 0) -> dict:
    key = jax.random.key(seed)
    keys = iter(jax.random.split(key, 64))
    f32 = jnp.float32
    L = DEPTH
    D = D_MODEL

    def nrm(shape, scale=1.0):
        return scale * jax.random.normal(next(keys), shape, f32)

    def gain(shape):
        return 1.0 + 0.02 * nrm(shape)

    def unif(shape, lo, hi):
        return jax.random.uniform(next(keys), shape, f32, lo, hi)

    dt0 = jnp.exp(unif((L, SSD_H), math.log(1e-3), math.log(1e-1)))
    a_rg = unif((L, GROUP_W), 0.9, 0.999) ** (1.0 / RG_C)
    return {
        'x_prompt': nrm((BATCH, SEQ, D)),
        'x_sample': nrm((DEC_BATCH, DEC_SEQ, D)),
        'state_ssd': nrm((L, DEC_BATCH, SSD_H, SSD_N, SSD_HD), 0.1),
        'state_ssd_conv': nrm((L, DEC_BATCH, SSD_CONV - 1, SSD_CONV_CH)),
        'state_ret': nrm((L, DEC_BATCH, RET_H, RET_HD, RET_HD)),
        'state_rglru': nrm((L, DEC_BATCH, GROUP_W), 0.5),
        'state_rglru_conv': nrm((L, DEC_BATCH, RG_CONV - 1, GROUP_W)),
        'state_hgrn': nrm((L, DEC_BATCH, HG_H, HG_HD, HG_HD), 0.5),
        'cache_mem_k': nrm((L, DEC_BATCH, N_MEM, XA_H, XA_HD)),
        'cache_mem_v': nrm((L, DEC_BATCH, N_MEM, XA_H, XA_HD)),
        'mem_prompt': nrm((BATCH, N_MEM, D)),
        'ln_mix_pre': gain((L, D)),
        'ln_mix_post': gain((L, D)),
        'ln_xa_pre': gain((L, D)),
        'ln_xa_post': gain((L, D)),
        'ln_ffn_pre': gain((L, D)),
        'ln_ffn_post': gain((L, D)),
        'w_in': nrm((L, D, D_IN), D ** -0.5),
        'ssd_conv_w': nrm((L, SSD_CONV, SSD_CONV_CH), SSD_CONV ** -0.5),
        'ssd_conv_b': nrm((L, SSD_CONV_CH), 0.01),
        'ssd_dt_bias': dt0 + jnp.log(-jnp.expm1(-dt0)),
        'ssd_A_log': jnp.log(unif((L, SSD_H), 1.0, 16.0)),
        'ssd_D': gain((L, SSD_H)),
        'ssd_norm': gain((L, GROUP_W)),
        'ret_norm': gain((L, GROUP_W)),
        'rg_conv_w': nrm((L, RG_CONV, GROUP_W), RG_CONV ** -0.5),
        'rg_conv_b': nrm((L, GROUP_W), 0.01),
        'rg_wa': nrm((L, RG_BLOCKS, RG_BD, RG_BD), RG_BD ** -0.5),
        'rg_ba': nrm((L, GROUP_W), 0.01),
        'rg_wx': nrm((L, RG_BLOCKS, RG_BD, RG_BD), RG_BD ** -0.5),
        'rg_bx': nrm((L, GROUP_W), 0.01),
        'rg_lambda': jnp.log(a_rg) - jnp.log1p(-a_rg),
        'hg_lb': nrm((L, GROUP_W), 0.5),
        'hg_norm': gain((L, GROUP_W)),
        'w_out': nrm((L, D, D), D ** -0.5),
        'ln_mem': gain((L, D)),
        'w_xq': nrm((L, D, D), D ** -0.5),
        'w_xkv': nrm((L, D, 2 * D), D ** -0.5),
        'w_xo': nrm((L, D, D), D ** -0.5),
        'w_gu': nrm((L, D, 2 * D_FF), D ** -0.5),
        'w_down': nrm((L, D_FF, D), D_FF ** -0.5),
    }


def reference(x_prompt, x_sample, state_ssd, state_ssd_conv, state_ret, state_rglru, state_rglru_conv,
              state_hgrn, cache_mem_k, cache_mem_v, mem_prompt, ln_mix_pre, ln_mix_post, ln_xa_pre,
              ln_xa_post, ln_ffn_pre, ln_ffn_post, w_in, ssd_conv_w, ssd_conv_b, ssd_dt_bias, ssd_A_log,
              ssd_D, ssd_norm, ret_norm, rg_conv_w, rg_conv_b, rg_wa, rg_ba, rg_wx, rg_bx, rg_lambda,
              hg_lb, hg_norm, w_out, ln_mem, w_xq, w_xkv, w_xo, w_gu, w_down):
    P = dict(ln_mix_pre=ln_mix_pre, ln_mix_post=ln_mix_post, ln_xa_pre=ln_xa_pre, ln_xa_post=ln_xa_post,
             ln_ffn_pre=ln_ffn_pre, ln_ffn_post=ln_ffn_post, w_in=w_in, ssd_conv_w=ssd_conv_w,
             ssd_conv_b=ssd_conv_b, ssd_dt_bias=ssd_dt_bias, ssd_A_log=ssd_A_log, ssd_D=ssd_D,
             ssd_norm=ssd_norm, ret_norm=ret_norm, rg_conv_w=rg_conv_w, rg_conv_b=rg_conv_b,
             rg_wa=rg_wa, rg_ba=rg_ba, rg_wx=rg_wx, rg_bx=rg_bx, rg_lambda=rg_lambda, hg_lb=hg_lb,
             hg_norm=hg_norm, w_out=w_out, ln_mem=ln_mem, w_xq=w_xq, w_xkv=w_xkv, w_xo=w_xo,
             w_gu=w_gu, w_down=w_down)
    B = x_prompt.shape[0]
    dt = x_prompt.dtype
    zero_state = (jnp.zeros((B, SSD_H, SSD_N, SSD_HD), dt), jnp.zeros((B, SSD_CONV - 1, SSD_CONV_CH), dt),
                  jnp.zeros((B, RET_H, RET_HD, RET_HD), dt), jnp.zeros((B, GROUP_W), dt),
                  jnp.zeros((B, RG_CONV - 1, GROUP_W), dt), jnp.zeros((B, HG_H, HG_HD, HG_HD), dt))
    y_p = x_prompt
    y_s = x_sample
    p_st, s_st, p_mk, p_mv = [], [], [], []
    for l in range(DEPTH):
        mk, mv = _mem_kv(mem_prompt, P, l)
        y_p, st_p = _layer(y_p, zero_state, mk, mv, P, l, 0)
        p_st.append(st_p)
        p_mk.append(mk)
        p_mv.append(mv)
        st_l = (state_ssd[l], state_ssd_conv[l], state_ret[l], state_rglru[l], state_rglru_conv[l], state_hgrn[l])
        y_s, st_s = _layer(y_s, st_l, cache_mem_k[l], cache_mem_v[l], P, l, PAST_LEN)
        s_st.append(st_s)
    return (y_p, y_s,
            _stack_field(p_st, 0), _stack_field(p_st, 1), _stack_field(p_st, 2),
            _stack_field(p_st, 3), _stack_field(p_st, 4), _stack_field(p_st, 5),
            jnp.stack(p_mk, axis=0), jnp.stack(p_mv, axis=0),
            _stack_field(s_st, 0), _stack_field(s_st, 1), _stack_field(s_st, 2),
            _stack_field(s_st, 3), _stack_field(s_st, 4), _stack_field(s_st, 5))
```

```cpp
#include <hip/hip_runtime.h>
#include <hip/hip_cooperative_groups.h>
#include <cstdio>
#include <cstdint>
namespace cg = cooperative_groups;
__device__ __forceinline__ int tidx() { int t = threadIdx.x; asm volatile("" : "+v"(t)); return t; }
namespace pg8 {
#define PG8_LAS __attribute__((address_space(3)))
typedef unsigned short bf16_t;
typedef short bf16x8 __attribute__((ext_vector_type(8)));
typedef float f32x4 __attribute__((ext_vector_type(4)));
typedef unsigned u32x4 __attribute__((ext_vector_type(4)));
constexpr int BM = 256, BK = 64, HALF = 128, HTB = HALF * BK * 2  , STAGE_BYTES = 8 * HTB, NXCD = 8, WGM = 8;

__host__ __device__ __forceinline__ int lds_byte(int r, int c) { const int st = (r >> 4) * 2 + (c >> 5), rr = r & 15, cc = c & 31, ob = rr * 64 + cc * 2; return st * 1024 + (ob ^ (((ob >> 9) & 1) << 5)); }
__host__ __device__ __forceinline__ void stage_rc(int b, int& R, int& C) { const int st = b / 1024, sb = b % 1024, swz = sb ^ (((sb >> 9) & 1) << 5); R = (st >> 1) * 16 + swz / 64; C = (st & 1) * 32 + (swz % 64) / 2; }
__host__ __device__ __forceinline__ int perm32(int rho) { const int n = rho >> 4, i = rho & 15; return 8 * (i >> 2) + 4 * n + (i & 3); }

struct Unit { int pm, pn; };
struct Gemm { const bf16_t* A; const bf16_t* Bt; int M, N, K; };

struct StaticOrder {
    int nM, nN, nwg, G, c;
    __host__ __device__ void init(int M, int N, int G_, int c_) { nM = M / BM; nN = N / BM; nwg = nM * nN; G = G_; c = c_; }
    __host__ __device__ bool next(int i, Unit& u) const {
        const long L = (long)i * G + c; if (L >= nwg) return false;
        int wgid = (int)L; { const int q = nwg / NXCD, r = nwg % NXCD, xcd = wgid % NXCD, off = wgid / NXCD; wgid = (xcd < r ? xcd * (q + 1) : r * (q + 1) + (xcd - r) * q) + off; }
        const int nig = WGM * nN, gid = wgid / nig, fm = gid * WGM, gsz = (nM - fm) < WGM ? (nM - fm) : WGM;
        u.pm = fm + ((wgid % nig) % gsz); u.pn = (wgid % nig) / gsz; return true;
    }
    __device__ __forceinline__ void a_ready(const Unit&) const {}
    __device__ __forceinline__ void done(const Unit&) const {}
};
}
namespace pg8 {
template <class Epi, class Sched, bool STAMP = false>
__device__ __forceinline__ void gemm_phase(PG8_LAS unsigned char* lds, const Gemm g, const Sched& S, const Epi& E, unsigned long long* stamps) {
    const int tid = tidx(), wid = __builtin_amdgcn_readfirstlane(tid >> 6), lane = tid & 63, wr = wid >> 2, wc = wid & 3, fr = lane & 15, fq = lane >> 4;
    const int K = g.K, nt = K / BK;
    int ts_lo = 0, ts_hi = 0, nts = 0; const unsigned long long rt_entry = STAMP ? (unsigned long long)wall_clock64() : 0ull;
#define PG8_STAMP() do { if (STAMP && wid == 0 && nts < 64) { const unsigned long long _c = (unsigned long long)clock64(); \
        ts_lo = (lane == nts) ? (int)(unsigned)_c : ts_lo; ts_hi = (lane == nts) ? (int)(unsigned)(_c >> 32) : ts_hi; ++nts; } } while (0)
    PG8_STAMP();
    unsigned voffA[2], voffB[2];
#pragma unroll
    for (int i = 0; i < 2; ++i) { int R, C; stage_rc(tid * 16 + i * 8192, R, C); const int Rb = Epi::PERM ? ((R & ~31) + perm32(R & 31)) : R;
        voffA[i] = (unsigned)(R * K + C) * 2u; voffB[i] = (unsigned)(Rb * K + C) * 2u; }
    const size_t kstep = (size_t)(BK * 2);
    const size_t hstep = (size_t)HALF * K * 2;
    const size_t tstep = 2 * hstep;
    const unsigned ldsw = (unsigned)wid * 1024u;
    const int aoff = lds_byte(wr * 64 + fr, fq * 8), boff = lds_byte(wc * 32 + fr, fq * 8);
#define PG8_SA(b, h) (((b) * 2 + (h)) * HTB)
#define PG8_SB(b, h) ((4 + (b) * 2 + (h)) * HTB)
#define PG8_STAGE(bufoff, gbase, voff) do { _Pragma("unroll") for (int _i = 0; _i < 2; ++_i) \
        __builtin_amdgcn_global_load_lds((const unsigned*)((const char*)(gbase) + (voff)[_i]), (PG8_LAS unsigned*)(lds + (bufoff) + ldsw + _i * 8192), 16, 0, 0); } while (0)
#define PG8_LDA(dst, b, h) do { _Pragma("unroll") for (int m = 0; m < 4; ++m) _Pragma("unroll") for (int k = 0; k < 2; ++k) dst[m][k] = *(const PG8_LAS bf16x8*)(lds + PG8_SA(b, h) + aoff + m * 2048 + k * 1024); } while (0)
#define PG8_LDB(dst, b, h) do { _Pragma("unroll") for (int n = 0; n < 2; ++n) _Pragma("unroll") for (int k = 0; k < 2; ++k) dst[n][k] = *(const PG8_LAS bf16x8*)(lds + PG8_SB(b, h) + boff + n * 2048 + k * 1024); } while (0)
#define PG8_MMA(ai, bj, At, Bt) do { __builtin_amdgcn_s_setprio(1); _Pragma("unroll") for (int m = 0; m < 4; ++m) _Pragma("unroll") for (int n = 0; n < 2; ++n) _Pragma("unroll") for (int k = 0; k < 2; ++k) \
        acc[ai][bj][m][n] = __builtin_amdgcn_mfma_f32_16x16x32_bf16(Bt[n][k], At[m][k], acc[ai][bj][m][n], 0, 0, 0); __builtin_amdgcn_s_setprio(0); } while (0)
#define PG8_WAIT_V(n) asm volatile("s_waitcnt vmcnt(" #n ")" ::: "memory")
#define PG8_WAIT_L(n) asm volatile("s_waitcnt lgkmcnt(" #n ")" ::: "memory")
#define PG8_BAR __builtin_amdgcn_s_barrier()
#define PG8_SCHED __builtin_amdgcn_sched_barrier(0)
    Unit cur, nxt; int ui = 0;
    if (!S.next(0, cur)) return;
    f32x4 acc[2][2][4][2];
#pragma unroll
    for (int a = 0; a < 2; ++a)
#pragma unroll
        for (int b = 0; b < 2; ++b)
#pragma unroll
            for (int m = 0; m < 4; ++m)
#pragma unroll
                for (int n = 0; n < 2; ++n) acc[a][b][m][n] = (f32x4){0.f, 0.f, 0.f, 0.f};
    bf16x8 At[4][2], B0[2][2], B1[2][2];
    const char* cA = (const char*)g.A + (size_t)cur.pm * tstep; const char* cB = (const char*)g.Bt + (size_t)cur.pn * tstep;
    S.a_ready(cur);
    PG8_STAGE(PG8_SB(0, 0), cB, voffB); PG8_STAGE(PG8_SA(0, 0), cA, voffA); PG8_STAGE(PG8_SB(0, 1), cB + hstep, voffB); PG8_STAGE(PG8_SA(0, 1), cA + hstep, voffA);
    if (wr == 1) PG8_BAR;
    PG8_WAIT_V(4); PG8_BAR;
    PG8_STAGE(PG8_SB(1, 0), cB + kstep, voffB); PG8_STAGE(PG8_SA(1, 0), cA + kstep, voffA); PG8_STAGE(PG8_SB(1, 1), cB + hstep + kstep, voffB);
    PG8_WAIT_V(6); PG8_BAR;
    PG8_STAMP();
    for (;;) {
        const bool has_next = S.next(ui + 1, nxt);
        const char* nA = has_next ? (const char*)g.A + (size_t)nxt.pm * tstep : cA; const char* nB = has_next ? (const char*)g.Bt + (size_t)nxt.pn * tstep : cB;
        for (int t = 0; t < nt; t += 2) {
            const bool last = (t == nt - 2);
            const char* a1 = cA + (size_t)(t + 1) * kstep;
            const char* a2 = last ? nA : cA + (size_t)(t + 2) * kstep; const char* b2 = last ? nB : cB + (size_t)(t + 2) * kstep;
            const char* a3 = a2 + kstep; const char* b3 = b2 + kstep;
            if (last && has_next) S.a_ready(nxt);
            PG8_LDB(B0, 0, 0); PG8_SCHED; PG8_LDA(At, 0, 0); PG8_STAGE(PG8_SA(1, 1), a1 + hstep, voffA);
            PG8_WAIT_L(8); PG8_BAR; PG8_WAIT_L(0); PG8_MMA(0, 0, At, B0); PG8_BAR; PG8_SCHED;
            PG8_LDB(B1, 0, 1); PG8_STAGE(PG8_SB(0, 0), b2, voffB);
            PG8_BAR; PG8_WAIT_L(0); PG8_MMA(0, 1, At, B1); PG8_BAR;
            PG8_LDA(At, 0, 1); PG8_STAGE(PG8_SA(0, 0), a2, voffA);
            PG8_BAR; PG8_WAIT_L(0); PG8_MMA(1, 0, At, B0); PG8_BAR; PG8_SCHED;
            PG8_STAGE(PG8_SB(0, 1), b2 + hstep, voffB);
            PG8_WAIT_V(6); PG8_BAR; PG8_MMA(1, 1, At, B1); PG8_BAR;
            PG8_LDB(B0, 1, 0); PG8_SCHED; PG8_LDA(At, 1, 0); PG8_STAGE(PG8_SA(0, 1), a2 + hstep, voffA);
            PG8_WAIT_L(8); PG8_BAR; PG8_WAIT_L(0); PG8_MMA(0, 0, At, B0); PG8_BAR; PG8_SCHED;
            PG8_LDB(B1, 1, 1); PG8_STAGE(PG8_SB(1, 0), b3, voffB);
            PG8_BAR; PG8_WAIT_L(0); PG8_MMA(0, 1, At, B1); PG8_BAR;
            PG8_LDA(At, 1, 1); PG8_STAGE(PG8_SA(1, 0), a3, voffA);
            PG8_BAR; PG8_WAIT_L(0); PG8_MMA(1, 0, At, B0); PG8_BAR; PG8_SCHED;
            PG8_STAGE(PG8_SB(1, 1), b3 + hstep, voffB);
            PG8_WAIT_V(6); PG8_BAR; PG8_MMA(1, 1, At, B1); PG8_BAR;
        }
        PG8_STAMP();
        if constexpr (!Epi::AFTER_DRAIN) { E(acc, cur, wr, wc, fr, fq); S.done(cur); }
        PG8_STAMP();
        if (!has_next) break;
#pragma unroll
        for (int a = 0; a < 2; ++a)
#pragma unroll
            for (int b = 0; b < 2; ++b)
#pragma unroll
                for (int m = 0; m < 4; ++m)
#pragma unroll
                    for (int n = 0; n < 2; ++n) acc[a][b][m][n] = (f32x4){0.f, 0.f, 0.f, 0.f};
        cur = nxt; cA = nA; cB = nB; ++ui;
    }
    PG8_WAIT_V(0);
    if (wr == 0) PG8_BAR;
    PG8_BAR;
    if constexpr (Epi::AFTER_DRAIN) { E.fused(acc, cur, wr, wc, fr, fq, lds, wid, lane); S.done(cur); }
    PG8_STAMP();
    if (STAMP && wid == 0) { stamps[lane] = lane < nts ? (((unsigned long long)(unsigned)ts_hi << 32) | (unsigned)ts_lo) : 0ull;
        if (lane == 62) stamps[62] = rt_entry; if (lane == 63) stamps[63] = (unsigned long long)wall_clock64(); }
#undef PG8_STAMP
#undef PG8_SA
#undef PG8_SB
#undef PG8_STAGE
#undef PG8_LDA
#undef PG8_LDB
#undef PG8_MMA
#undef PG8_WAIT_V
#undef PG8_WAIT_L
#undef PG8_BAR
#undef PG8_SCHED
}
}

#define LAS __attribute__((address_space(3)))
using pg8::bf16_t; using pg8::bf16x8; using pg8::f32x4; using pg8::u32x4;
typedef unsigned u32x2 __attribute__((ext_vector_type(2)));
typedef float f32x2 __attribute__((ext_vector_type(2)));

constexpr int D = 1024, TP = 16384, TS = 512, TT = TP + TS, NU = 3584, DIN = 3588, DFF = 2816, NL = 2;
constexpr int NTHR = 512;
constexpr float EPS = 1e-6f;
constexpr int UZ = 0, UXBC = 256, URQ = 1024, URK = 1280, URV = 1536, URG = 1792, UGX = 2048, UGY = 2304, UHQ = 2560, UHF = 2816, UHI = 3072, UHG = 3328;
constexpr size_t O_YP = 0, O_YS = O_YP + (size_t)8 * 2048 * 1024, O_PSSD = O_YS + (size_t)128 * 4 * 1024, O_PSSDC = O_PSSD + (size_t)2 * 8 * 4 * 128 * 64,
    O_PRET = O_PSSDC + (size_t)2 * 8 * 3 * 768, O_PRG = O_PRET + (size_t)2 * 8 * 4 * 64 * 64, O_PRGC = O_PRG + (size_t)2 * 8 * 256, O_PHG = O_PRGC + (size_t)2 * 8 * 3 * 256,
    O_PMK = O_PHG + (size_t)2 * 8 * 4 * 64 * 64, O_PMV = O_PMK + (size_t)2 * 8 * 256 * 1024, O_SSSD = O_PMV + (size_t)2 * 8 * 256 * 1024, O_SSSDC = O_SSSD + (size_t)2 * 128 * 4 * 128 * 64,
    O_SRET = O_SSSDC + (size_t)2 * 128 * 3 * 768, O_SRG = O_SRET + (size_t)2 * 128 * 4 * 64 * 64, O_SRGC = O_SRG + (size_t)2 * 128 * 256, O_SHG = O_SRGC + (size_t)2 * 128 * 3 * 256,
    O_END = O_SHG + (size_t)2 * 128 * 4 * 64 * 64;
constexpr size_t OFF_WIN = 0, OFF_WOUT = OFF_WIN + (size_t)NL * NU * D * 2, OFF_WXQ = OFF_WOUT + (size_t)NL * D * D * 2, OFF_WXO = OFF_WXQ + (size_t)NL * D * D * 2,
    OFF_WXKV = OFF_WXO + (size_t)NL * D * D * 2, OFF_WGU = OFF_WXKV + (size_t)NL * 2048 * D * 2, OFF_WDN = OFF_WGU + (size_t)NL * 5632 * D * 2, OFF_WRG = OFF_WDN + (size_t)NL * D * DFF * 2,
    OFF_ROPE = OFF_WRG + (size_t)NL * 2 * 4 * 64 * 64 * 2, OFF_H = OFF_ROPE + (size_t)2052 * 32 * 2 * 4, OFF_HM = OFF_H + (size_t)TT * D * 2, OFF_U = OFF_HM + (size_t)NL * 2048 * D * 2,
    OFF_SDT = OFF_U + (size_t)TT * NU * 2, OFF_YC = OFF_SDT + (size_t)TT * 4 * 4, OFF_M = OFF_YC + (size_t)TT * D * 2, OFF_Q = OFF_M + (size_t)TT * D * 4, OFF_ACT = OFF_Q + (size_t)TT * D * 2,
    OFF_KB = OFF_ACT + (size_t)TT * DFF * 2, OFF_VTB = OFF_KB + (size_t)8 * 4 * 256 * 256 * 2, OFF_DSS = OFF_VTB + (size_t)8 * 4 * 256 * 256 * 2, OFF_DECS = OFF_DSS + (size_t)8 * 4 * 32 * 8192 * 4,
    OFF_DSR = OFF_DECS + 4096, OFF_DSH = OFF_DSR + (size_t)8 * 4 * 32 * 4096 * 4, OFF_DECH = OFF_DSH + (size_t)8 * 4 * 32 * 4096 * 4, OFF_RGH = OFF_DECH + (size_t)8 * 4 * 32 * 64 * 4,
    OFF_RGA = OFF_RGH + (size_t)8 * 32 * 256 * 4, OFF_RGC = OFF_RGA + (size_t)8 * 32 * 256 * 4, WS_END = OFF_RGC + (size_t)8 * 32 * 256 * 4;

struct Params { const float* in[41]; float* out; unsigned char* ws; };

__device__ __forceinline__ float bf2f(bf16_t b) { return __uint_as_float(((unsigned)b) << 16); }
__device__ __forceinline__ unsigned pk2(float lo, float hi) { unsigned r; asm volatile("v_cvt_pk_bf16_f32 %0, %1, %2" : "=v"(r) : "v"(lo), "v"(hi)); return r; }
__device__ __forceinline__ bf16_t f2bf(float f) { return (bf16_t)(pk2(f, f) & 0xffffu); }
__device__ __forceinline__ float sigmoidf_(float x) { return 1.0f / (1.0f + __expf(-x)); }
__device__ __forceinline__ float siluf_(float x) { return x / (1.0f + __expf(-x)); }
__device__ __forceinline__ float softplusf_(float x) { return fmaxf(x, 0.0f) + log1pf(__expf(-fabsf(x))); }
__device__ __forceinline__ float geluf_(float x) { const float u = 0.7978845608028654f * (x + 0.044715f * x * x * x); return 0.5f * x * (1.0f + tanhf(u)); }
__device__ __forceinline__ float wave_sum(float v) {
#pragma unroll
    for (int o = 1; o < 64; o <<= 1) v += __shfl_xor(v, o);
    return v;
}
__device__ __forceinline__ float wave_max(float v) {
#pragma unroll
    for (int o = 1; o < 64; o <<= 1) v = fmaxf(v, __shfl_xor(v, o));
    return v;
}
template <int NT, int KS>
__device__ __forceinline__ void mm_nt(f32x4 (&acc)[NT], const LAS bf16_t* A, int lda, const LAS bf16_t* B, int ldb, int lane) {
    const int r = lane & 15, q = (lane >> 4) * 8;
#pragma unroll
    for (int ks = 0; ks < KS; ++ks) {
        const bf16x8 a = *(const LAS bf16x8*)(A + r * lda + ks * 32 + q);
#pragma unroll
        for (int j = 0; j < NT; ++j) {
            const bf16x8 b = *(const LAS bf16x8*)(B + (16 * j + r) * ldb + ks * 32 + q);
            acc[j] = __builtin_amdgcn_mfma_f32_16x16x32_bf16(a, b, acc[j], 0, 0, 0);
        }
    }
}

struct EpiBf16 {
    static constexpr bool PERM = true, AFTER_DRAIN = false;
    bf16_t* O; int ldc;
    __device__ __forceinline__ void operator()(const f32x4 (&acc)[2][2][4][2], const pg8::Unit& u, int wr, int wc, int fr, int fq) const {
        const int row0 = u.pm * 256 + wr * 64 + fr, col0 = u.pn * 256 + wc * 32 + 8 * fq;
#pragma unroll
        for (int ai = 0; ai < 2; ++ai)
#pragma unroll
            for (int m = 0; m < 4; ++m) {
                bf16_t* rowp = O + (size_t)(row0 + ai * 128 + m * 16) * ldc + col0;
#pragma unroll
                for (int bj = 0; bj < 2; ++bj) {
                    const f32x4 v0 = acc[ai][bj][m][0], v1 = acc[ai][bj][m][1];
                    u32x4 w; w.x = pk2(v0[0], v0[1]); w.y = pk2(v0[2], v0[3]); w.z = pk2(v1[0], v1[1]); w.w = pk2(v1[2], v1[3]);
                    *(u32x4*)(rowp + bj * 128) = w;
                }
            }
    }
};
struct EpiF32 {
    static constexpr bool PERM = false, AFTER_DRAIN = false;
    float* C; int ldc;
    __device__ __forceinline__ void operator()(const f32x4 (&acc)[2][2][4][2], const pg8::Unit& u, int wr, int wc, int fr, int fq) const {
        const int row0 = u.pm * 256 + wr * 64 + fr, col0 = u.pn * 256 + wc * 32 + 4 * fq;
#pragma unroll
        for (int ai = 0; ai < 2; ++ai)
#pragma unroll
            for (int m = 0; m < 4; ++m) {
                float* rowp = C + (size_t)(row0 + ai * 128 + m * 16) * ldc + col0;
#pragma unroll
                for (int bj = 0; bj < 2; ++bj)
#pragma unroll
                    for (int n = 0; n < 2; ++n) *(f32x4*)(rowp + bj * 128 + n * 16) = acc[ai][bj][m][n];
            }
    }
};
struct EpiSwiGLU {
    static constexpr bool PERM = true, AFTER_DRAIN = false;
    bf16_t* O;
    __device__ __forceinline__ void operator()(const f32x4 (&acc)[2][2][4][2], const pg8::Unit& u, int wr, int wc, int fr, int fq) const {
        const int row0 = u.pm * 256 + wr * 64 + fr, col0 = u.pn * 128 + wc * 32 + 8 * fq;
#pragma unroll
        for (int ai = 0; ai < 2; ++ai)
#pragma unroll
            for (int m = 0; m < 4; ++m) {
                bf16_t* rowp = O + (size_t)(row0 + ai * 128 + m * 16) * DFF + col0;
                const f32x4 g0 = acc[ai][0][m][0], g1 = acc[ai][0][m][1], u0 = acc[ai][1][m][0], u1 = acc[ai][1][m][1];
                u32x4 w;
                w.x = pk2(siluf_(g0[0]) * u0[0], siluf_(g0[1]) * u0[1]); w.y = pk2(siluf_(g0[2]) * u0[2], siluf_(g0[3]) * u0[3]);
                w.z = pk2(siluf_(g1[0]) * u1[0], siluf_(g1[1]) * u1[1]); w.w = pk2(siluf_(g1[2]) * u1[2], siluf_(g1[3]) * u1[3]);
                *(u32x4*)rowp = w;
            }
    }
};
struct EpiMemKV {
    static constexpr bool PERM = false, AFTER_DRAIN = false;
    float* kout; float* vout; bf16_t* KB; bf16_t* VTB;
    __device__ __forceinline__ void operator()(const f32x4 (&acc)[2][2][4][2], const pg8::Unit& u, int wr, int wc, int fr, int fq) const {
        const int row0 = u.pm * 256 + wr * 64 + fr, col0 = u.pn * 256 + wc * 32 + 4 * fq;
#pragma unroll
        for (int ai = 0; ai < 2; ++ai)
#pragma unroll
            for (int m = 0; m < 4; ++m) {
                const int row = row0 + ai * 128 + m * 16, b = row >> 8, key = row & 255;
#pragma unroll
                for (int bj = 0; bj < 2; ++bj)
#pragma unroll
                    for (int n = 0; n < 2; ++n) {
                        const int col = col0 + bj * 128 + n * 16; const f32x4 v = acc[ai][bj][m][n];
                        if (col < 1024) {
                            *(f32x4*)(kout + (size_t)row * 1024 + col) = v;
                            u32x2 w; w.x = pk2(v[0], v[1]); w.y = pk2(v[2], v[3]);
                            *(u32x2*)(KB + ((size_t)(b * 4 + (col >> 8)) * 256 + key) * 256 + (col & 255)) = w;
                        } else {
                            const int c2 = col - 1024;
                            *(f32x4*)(vout + (size_t)row * 1024 + c2) = v;
                            bf16_t* vp = VTB + ((size_t)(b * 4 + (c2 >> 8)) * 256 + (c2 & 255)) * 256 + key;
                            vp[0] = f2bf(v[0]); vp[256] = f2bf(v[1]); vp[512] = f2bf(v[2]); vp[768] = f2bf(v[3]);
                        }
                    }
            }
    }
};
template <class Epi>
__device__ __forceinline__ void run_gemm(LAS unsigned char* lds, const bf16_t* A, const bf16_t* Bt, int M, int N, int K, const Epi& E, int cshift) {
    asm volatile("" : "+s"(M), "+s"(N), "+s"(K));
    pg8::Gemm g{A, Bt, M, N, K};
    pg8::StaticOrder S; S.init(M, N, (int)gridDim.x, (int)((blockIdx.x + cshift) % gridDim.x));
    pg8::gemm_phase<Epi, pg8::StaticOrder, false>(lds, g, S, E, nullptr);
}

struct TItem { const float* src; bf16_t* dst; int ldw, K, k0, srcc, dstr; };
constexpr int I_IN = 16 * 112, I_SQ = 16 * 32, I_KV = 16 * 64, I_GU = 16 * 176, I_DN = 44 * 32, I_RG = 16;
constexpr int I_PER = I_IN + 3 * I_SQ + I_KV + I_GU + I_DN + I_RG;
__device__ __forceinline__ bool titem(const Params& p, int it, TItem& T) {
    if (it >= NL * I_PER) return false;
    const int l = it / I_PER; int r = it % I_PER;
    unsigned char* ws = p.ws;
    if (r < I_IN) { const int kb = r / 112, n0 = (r % 112) * 32; T.src = p.in[17] + (size_t)l * D * DIN; T.ldw = DIN; T.K = D; T.k0 = kb * 64; T.srcc = n0 < 1024 ? n0 : n0 + 4;
        T.dst = (bf16_t*)(ws + OFF_WIN) + (size_t)l * NU * D; T.dstr = n0; return true; }
    r -= I_IN;
    if (r < 3 * I_SQ) { const int which = r / I_SQ; r %= I_SQ; const int kb = r / 32, n0 = (r % 32) * 32;
        T.src = p.in[which == 0 ? 34 : (which == 1 ? 36 : 38)] + (size_t)l * D * D; T.ldw = D; T.K = D; T.k0 = kb * 64; T.srcc = n0;
        T.dst = (bf16_t*)(ws + (which == 0 ? OFF_WOUT : (which == 1 ? OFF_WXQ : OFF_WXO))) + (size_t)l * D * D; T.dstr = n0; return true; }
    r -= 3 * I_SQ;
    if (r < I_KV) { const int kb = r / 64, n0 = (r % 64) * 32; T.src = p.in[37] + (size_t)l * D * 2048; T.ldw = 2048; T.K = D; T.k0 = kb * 64; T.srcc = n0;
        T.dst = (bf16_t*)(ws + OFF_WXKV) + (size_t)l * 2048 * D; T.dstr = n0; return true; }
    r -= I_KV;
    if (r < I_GU) { const int kb = r / 176, n0 = (r % 176) * 32; const int pn = n0 >> 8, bj = (n0 & 255) >> 7, j = n0 & 127;
        T.src = p.in[39] + (size_t)l * D * 5632; T.ldw = 5632; T.K = D; T.k0 = kb * 64; T.srcc = bj * DFF + pn * 128 + j;
        T.dst = (bf16_t*)(ws + OFF_WGU) + (size_t)l * 5632 * D; T.dstr = n0; return true; }
    r -= I_GU;
    if (r < I_DN) { const int kb = r / 32, n0 = (r % 32) * 32; T.src = p.in[40] + (size_t)l * DFF * D; T.ldw = D; T.K = DFF; T.k0 = kb * 64; T.srcc = n0;
        T.dst = (bf16_t*)(ws + OFF_WDN) + (size_t)l * D * DFF; T.dstr = n0; return true; }
    r -= I_DN;
    { const int gate = r >> 3, blk = (r & 7) >> 1, nb = r & 1;
        T.src = p.in[gate ? 29 : 27] + (size_t)(l * 4 + blk) * 4096; T.ldw = 64; T.K = 64; T.k0 = 0; T.srcc = nb * 32;
        T.dst = (bf16_t*)(ws + OFF_WRG) + (size_t)((l * 2 + gate) * 4 + blk) * 4096; T.dstr = nb * 32; return true; }
}

__device__ __forceinline__ void rows_phase(LAS unsigned char* lds, int nrows, const float* xp, const float* xs, float* X, const float* M, const float* gpost,
                                           const float* gpre, bf16_t* H, const float* wdt, float* SDT) {
    const int tid = tidx(), lane = tid & 63, wave = tid >> 6;
    const int gw = blockIdx.x * 8 + wave, NGW = gridDim.x * 8;
    LAS float* wl = (LAS float*)lds;
    if (wdt) { for (int i = tid; i < 4096; i += NTHR) wl[i] = wdt[(size_t)(i >> 2) * DIN + 1024 + (i & 3)]; __syncthreads(); }
    for (int row = gw; row < nrows; row += NGW) {
        const float* xr = xp ? (row < TP ? xp + (size_t)row * D : xs + (size_t)(row - TP) * D) : X + (size_t)row * D;
        f32x4 v[4];
#pragma unroll
        for (int j = 0; j < 4; ++j) v[j] = ((const f32x4*)xr)[lane + 64 * j];
        if (M) {
            f32x4 m[4]; float ss = 0.f;
#pragma unroll
            for (int j = 0; j < 4; ++j) { m[j] = ((const f32x4*)(M + (size_t)row * D))[lane + 64 * j]; ss += m[j].x * m[j].x + m[j].y * m[j].y + m[j].z * m[j].z + m[j].w * m[j].w; }
            const float rstd = 1.0f / sqrtf(wave_sum(ss) * (1.0f / D) + EPS);
#pragma unroll
            for (int j = 0; j < 4; ++j) { const f32x4 g = ((const f32x4*)gpost)[lane + 64 * j]; v[j] = v[j] + m[j] * rstd * g; }
        }
        if (X && (M || xp)) {
#pragma unroll
            for (int j = 0; j < 4; ++j) ((f32x4*)(X + (size_t)row * D))[lane + 64 * j] = v[j];
        }
        if (gpre) {
            float ss = 0.f;
#pragma unroll
            for (int j = 0; j < 4; ++j) ss += v[j].x * v[j].x + v[j].y * v[j].y + v[j].z * v[j].z + v[j].w * v[j].w;
            const float rstd = 1.0f / sqrtf(wave_sum(ss) * (1.0f / D) + EPS);
            float d0 = 0.f, d1 = 0.f, d2 = 0.f, d3 = 0.f;
#pragma unroll
            for (int j = 0; j < 4; ++j) {
                const f32x4 g = ((const f32x4*)gpre)[lane + 64 * j]; const f32x4 h = v[j] * rstd * g;
                u32x2 w; w.x = pk2(h.x, h.y); w.y = pk2(h.z, h.w);
                ((u32x2*)(H + (size_t)row * D))[lane + 64 * j] = w;
                if (wdt) {
#pragma unroll
                    for (int e = 0; e < 4; ++e) { const f32x4 wv = *(const LAS f32x4*)(wl + 4 * (4 * (lane + 64 * j) + e)); const float he = h[e];
                        d0 += he * wv.x; d1 += he * wv.y; d2 += he * wv.z; d3 += he * wv.w; }
                }
            }
            if (wdt) { d0 = wave_sum(d0); d1 = wave_sum(d1); d2 = wave_sum(d2); d3 = wave_sum(d3);
                if (lane == 0) { f32x4 o; o.x = d0; o.y = d1; o.z = d2; o.w = d3; *(f32x4*)(SDT + (size_t)row * 4) = o; } }
        }
    }
    if (wdt) __syncthreads();
}

__device__ __forceinline__ void phase0(const Params& p, LAS unsigned char* lds) {
    const int tid = tidx(), lane = tid & 63, wave = tid >> 6;
    const int gw = blockIdx.x * 8 + wave, NGW = gridDim.x * 8;
    LAS float* scr = (LAS float*)lds + wave * (64 * 33);
    for (int base = 0; base < NL * I_PER; base += NGW) {
        TItem T; const bool ok = titem(p, base + gw, T);
        if (ok) {
#pragma unroll 8
            for (int i = 0; i < 32; ++i) { const int kk = 2 * i + (lane >> 5); scr[kk * 33 + (lane & 31)] = T.src[(size_t)(T.k0 + kk) * T.ldw + T.srcc + (lane & 31)]; }
        }
        __syncthreads();
        if (ok) {
            const int c = lane & 7;
#pragma unroll
            for (int j = 0; j < 4; ++j) { const int n = (lane >> 3) + 8 * j; const LAS float* s = scr + (8 * c) * 33 + n;
                u32x4 o; o.x = pk2(s[0 * 33], s[1 * 33]); o.y = pk2(s[2 * 33], s[3 * 33]); o.z = pk2(s[4 * 33], s[5 * 33]); o.w = pk2(s[6 * 33], s[7 * 33]);
                *(u32x4*)(T.dst + (size_t)(T.dstr + n) * T.K + T.k0 + 8 * c) = o; }
        }
        __syncthreads();
    }
    float* RC = (float*)(p.ws + OFF_ROPE); float* RS = RC + 2052 * 32;
    for (int i = blockIdx.x * NTHR + tid; i < 2052 * 32; i += gridDim.x * NTHR) {
        const int pi = i >> 5, j = i & 31;
        const double pos = pi < 2048 ? (double)pi : (double)(16384 + pi - 2048);
        const double inv = exp2(-(double)j * (13.287712379549449 / 32.0));
        const double ang = pos * inv;
        const double r = ang - 6.283185307179586 * rint(ang * 0.15915494309189535);
        const float rf = (float)r;
        RC[i] = cosf(rf); RS[i] = sinf(rf);
    }
    rows_phase(lds, TT, p.in[0], p.in[1], p.out, nullptr, nullptr, p.in[11], (bf16_t*)(p.ws + OFF_H), p.in[17], (float*)(p.ws + OFF_SDT));
    for (int l = 0; l < NL; ++l)
        rows_phase(lds, 2048, p.in[10], nullptr, nullptr, nullptr, nullptr, p.in[35] + l * D, (bf16_t*)(p.ws + OFF_HM) + (size_t)l * 2048 * D, nullptr, nullptr);
}

template <int NTOK>
__device__ __forceinline__ void conv_run(const bf16_t* Ucol, bool hist_ok, float w0, float w1, float w2, float w3, float bias, float (&out)[NTOK]) {
    float x3 = 0.f, x2 = 0.f, x1 = 0.f;
    if (hist_ok) { x3 = bf2f(Ucol[-3 * NU]); x2 = bf2f(Ucol[-2 * NU]); x1 = bf2f(Ucol[-NU]); }
#pragma unroll
    for (int i = 0; i < NTOK; ++i) { const float x0 = bf2f(Ucol[i * NU]); out[i] = bias + w0 * x3 + w1 * x2 + w2 * x1 + w3 * x0; x3 = x2; x2 = x1; x1 = x0; }
}
__device__ __forceinline__ float scan64_add(float v, int lane) {
#pragma unroll
    for (int d = 1; d < 64; d <<= 1) { const float t = __shfl_up(v, d); if (lane >= d) v += t; }
    return v;
}

__device__ __forceinline__ void ssd_passA(const Params& p, LAS unsigned char* lds, int l, int u) {
    const int tid = tidx(), lane = tid & 63, wave = tid >> 6;
    const int c = u & 31, g = (u >> 5) & 1, b = u >> 6, row0 = b * 2048 + c * 64;
    const bf16_t* U = (const bf16_t*)(p.ws + OFF_U); const float* SDT = (const float*)(p.ws + OFF_SDT);
    LAS float* DT = (LAS float*)lds; LAS float* CU = DT + 128;
    LAS bf16_t* BT = (LAS bf16_t*)(lds + 1024); LAS bf16_t* VT = (LAS bf16_t*)(lds + 1024 + 18432);
    if (wave < 2) {
        const int h = 2 * g + wave;
        const float dt = softplusf_(SDT[(size_t)(row0 + lane) * 4 + h] + p.in[20][l * 4 + h]);
        const float cum = scan64_add(-expf(p.in[21][l * 4 + h]) * dt, lane);
        DT[wave * 64 + lane] = dt; CU[wave * 64 + lane] = cum;
    }
    __syncthreads();
    for (int idx = tid; idx < 2048; idx += NTHR) {
        const int chl = idx & 255, t0 = (idx >> 8) * 8;
        const int xc = chl < 128 ? g * 128 + chl : 256 + g * 128 + (chl - 128);
        const float* cw = p.in[18] + (size_t)l * 4 * 768 + xc;
        float o[8]; conv_run<8>(U + (size_t)(row0 + t0) * NU + UXBC + xc, (c > 0) || (t0 > 0), cw[0], cw[768], cw[1536], cw[2304], p.in[19][l * 768 + xc], o);
        if (chl < 128) { const int hh = chl >> 6; const float last = CU[hh * 64 + 63];
#pragma unroll
            for (int i = 0; i < 8; ++i) { const int t = t0 + i; VT[chl * 72 + t] = f2bf(siluf_(o[i]) * DT[hh * 64 + t] * __expf(last - CU[hh * 64 + t])); }
        } else { const int n = chl - 128;
#pragma unroll
            for (int i = 0; i < 8; ++i) BT[n * 72 + t0 + i] = f2bf(siluf_(o[i]));
        }
    }
    __syncthreads();
    f32x4 acc[8];
#pragma unroll
    for (int j = 0; j < 8; ++j) acc[j] = (f32x4){0.f, 0.f, 0.f, 0.f};
    mm_nt<8, 2>(acc, BT + 16 * wave * 72, 72, VT, 72, lane);
    float* DS = (float*)(p.ws + OFF_DSS);
#pragma unroll
    for (int jj = 0; jj < 8; ++jj) { const int h = 2 * g + (jj >> 2), pc = (jj & 3) * 16 + (lane & 15);
#pragma unroll
        for (int e = 0; e < 4; ++e) { const int n = 16 * wave + (lane >> 4) * 4 + e; DS[(((size_t)(b * 4 + h) * 32 + c) * 128 + n) * 64 + pc] = acc[jj][e]; } }
    if (tid < 2) ((float*)(p.ws + OFF_DECS))[(b * 4 + 2 * g + tid) * 32 + c] = __expf(CU[tid * 64 + 63]);
    __syncthreads();
}

__device__ __forceinline__ void ssd_passC(const Params& p, LAS unsigned char* lds, int l, int u) {
    const int tid = tidx(), lane = tid & 63, wave = tid >> 6;
    const int c = u & 31, b = u >> 5, row0 = b * 2048 + c * 64;
    const bf16_t* U = (const bf16_t*)(p.ws + OFF_U); const float* SDT = (const float*)(p.ws + OFF_SDT);
    const float* DS = (const float*)(p.ws + OFF_DSS);
    bf16_t* YC = (bf16_t*)(p.ws + OFF_YC);
    LAS float* DT = (LAS float*)lds; LAS float* CU = (LAS float*)(lds + 1024); LAS float* SSQ = (LAS float*)(lds + 2048);
    LAS bf16_t* CM = (LAS bf16_t*)(lds + 3072); LAS bf16_t* BM = (LAS bf16_t*)(lds + 20480); LAS bf16_t* VT = (LAS bf16_t*)(lds + 37888);
    LAS bf16_t* PP = (LAS bf16_t*)(lds + 56320); LAS bf16_t* SINT = (LAS bf16_t*)(lds + 74752);
    if (wave < 4) {
        const int h = wave;
        const float dt = softplusf_(SDT[(size_t)(row0 + lane) * 4 + h] + p.in[20][l * 4 + h]);
        const float cum = scan64_add(-expf(p.in[21][l * 4 + h]) * dt, lane);
        DT[h * 64 + lane] = dt; CU[h * 64 + lane] = cum;
    }
    __syncthreads();
    f32x4 yv[2][4];
#pragma unroll
    for (int g = 0; g < 2; ++g) {
        for (int idx = tid; idx < 3072; idx += NTHR) {
            const int chl = idx % 384, t0 = (idx / 384) * 8, which = chl >> 7, n = chl & 127;
            const int xc = which * 256 + g * 128 + n;
            const float* cw = p.in[18] + (size_t)l * 4 * 768 + xc;
            float o[8]; conv_run<8>(U + (size_t)(row0 + t0) * NU + UXBC + xc, (c > 0) || (t0 > 0), cw[0], cw[768], cw[1536], cw[2304], p.in[19][l * 768 + xc], o);
            if (which == 0) {
#pragma unroll
                for (int i = 0; i < 8; ++i) VT[n * 72 + t0 + i] = f2bf(siluf_(o[i]));
            } else { LAS bf16_t* dstp = which == 1 ? BM : CM;
#pragma unroll
                for (int i = 0; i < 8; ++i) dstp[(t0 + i) * 136 + n] = f2bf(siluf_(o[i]));
            }
        }
        for (int idx = tid; idx < 16384; idx += NTHR) {
            const int hh = idx >> 13, rem = idx & 8191, n = rem >> 6, pc = rem & 63;
            SINT[(hh * 64 + pc) * 136 + n] = f2bf(DS[(((size_t)(b * 4 + 2 * g + hh) * 32 + c) * 128 + n) * 64 + pc]);
        }
        __syncthreads();
        {
            const int rt = wave & 3, ct0 = (wave >> 2) * 2;
            f32x4 sc[2]; sc[0] = (f32x4){0.f, 0.f, 0.f, 0.f}; sc[1] = sc[0];
            mm_nt<2, 4>(sc, CM + 16 * rt * 136, 136, BM + 16 * ct0 * 136, 136, lane);
#pragma unroll
            for (int hh = 0; hh < 2; ++hh) { const int h = 2 * g + hh;
#pragma unroll
                for (int jj = 0; jj < 2; ++jj)
#pragma unroll
                    for (int e = 0; e < 4; ++e) { const int t = 16 * rt + (lane >> 4) * 4 + e, s = 16 * (ct0 + jj) + (lane & 15);
                        const float val = s <= t ? sc[jj][e] * __expf(CU[h * 64 + t] - CU[h * 64 + s]) * DT[h * 64 + s] : 0.f;
                        PP[(hh * 64 + t) * 72 + s] = f2bf(val); } }
        }
        __syncthreads();
        {
            const int hh = wave >> 2, rt = wave & 3, h = 2 * g + hh;
#pragma unroll
            for (int j = 0; j < 4; ++j) yv[g][j] = (f32x4){0.f, 0.f, 0.f, 0.f};
            mm_nt<4, 4>(yv[g], CM + 16 * rt * 136, 136, SINT + hh * 64 * 136, 136, lane);
#pragma unroll
            for (int e = 0; e < 4; ++e) { const float sc = __expf(CU[h * 64 + 16 * rt + (lane >> 4) * 4 + e]);
#pragma unroll
                for (int j = 0; j < 4; ++j) yv[g][j][e] *= sc; }
            mm_nt<4, 2>(yv[g], PP + (hh * 64 + 16 * rt) * 72, 72, VT + hh * 64 * 72, 72, lane);
            const float Dh = p.in[22][l * 4 + h];
#pragma unroll
            for (int e = 0; e < 4; ++e) { const int t = 16 * rt + (lane >> 4) * 4 + e; float s2 = 0.f;
#pragma unroll
                for (int j = 0; j < 4; ++j) { const int pc = 16 * j + (lane & 15);
                    const float xs = bf2f(VT[(hh * 64 + pc) * 72 + t]); const float z = bf2f(U[(size_t)(row0 + t) * NU + UZ + h * 64 + pc]);
                    const float v = (yv[g][j][e] + Dh * xs) * siluf_(z); yv[g][j][e] = v; s2 += v * v; }
                s2 += __shfl_xor(s2, 1); s2 += __shfl_xor(s2, 2); s2 += __shfl_xor(s2, 4); s2 += __shfl_xor(s2, 8);
                if ((lane & 15) == 0) SSQ[t * 4 + h] = s2; }
        }
        __syncthreads();
    }
#pragma unroll
    for (int g = 0; g < 2; ++g) { const int hh = wave >> 2, rt = wave & 3, h = 2 * g + hh;
#pragma unroll
        for (int e = 0; e < 4; ++e) { const int t = 16 * rt + (lane >> 4) * 4 + e;
            const float tot = SSQ[t * 4 + 0] + SSQ[t * 4 + 1] + SSQ[t * 4 + 2] + SSQ[t * 4 + 3];
            const float rstd = 1.0f / sqrtf(tot * (1.0f / 256.0f) + EPS);
#pragma unroll
            for (int j = 0; j < 4; ++j) { const int pc = 16 * j + (lane & 15);
                YC[(size_t)(row0 + t) * D + h * 64 + pc] = f2bf(yv[g][j][e] * rstd * p.in[23][l * 256 + h * 64 + pc]); } } }
    if (c == 31) for (int idx = tid; idx < 2304; idx += NTHR) { const int r = idx / 768, ch = idx % 768;
        p.out[O_PSSDC + ((size_t)(l * 8 + b) * 3 + r) * 768 + ch] = bf2f(U[(size_t)(b * 2048 + 2045 + r) * NU + UXBC + ch]); }
    __syncthreads();
}

constexpr int E_CUM = 0, E_QS = 16640, E_QD = 25856, E_KV = 35072, E_VT = 71936, E_SINT = 81152, E_PP = 90368, E_KWT = 99584, E_RSC = 108800, E_SSQ = 109056;
__device__ __forceinline__ void engineA(LAS unsigned char* lds, float* DS, int wave, int lane) {
    const LAS bf16_t* KWT = (const LAS bf16_t*)(lds + E_KWT); const LAS bf16_t* VT = (const LAS bf16_t*)(lds + E_VT);
    const int rt = wave >> 1, ct0 = (wave & 1) * 2;
    f32x4 acc[2]; acc[0] = (f32x4){0.f, 0.f, 0.f, 0.f}; acc[1] = acc[0];
    mm_nt<2, 2>(acc, KWT + 16 * rt * 72, 72, VT + 16 * ct0 * 72, 72, lane);
#pragma unroll
    for (int jj = 0; jj < 2; ++jj)
#pragma unroll
        for (int e = 0; e < 4; ++e) DS[(16 * rt + (lane >> 4) * 4 + e) * 64 + 16 * (ct0 + jj) + (lane & 15)] = acc[jj][e];
}
template <bool RET>
__device__ __forceinline__ void engineC(LAS unsigned char* lds, int qd_off, int kvstride, float lg, f32x4 (&y)[2], int wave, int lane) {
    const LAS bf16_t* QS = (const LAS bf16_t*)(lds + E_QS); const LAS bf16_t* QD = (const LAS bf16_t*)(lds + qd_off);
    const LAS bf16_t* KV = (const LAS bf16_t*)(lds + E_KV); const LAS bf16_t* VT = (const LAS bf16_t*)(lds + E_VT);
    const LAS bf16_t* SINT = (const LAS bf16_t*)(lds + E_SINT); LAS bf16_t* PP = (LAS bf16_t*)(lds + E_PP); const LAS float* RSC = (const LAS float*)(lds + E_RSC);
    const int rt = wave >> 1, ct0 = (wave & 1) * 2;
    f32x4 sc[2]; sc[0] = (f32x4){0.f, 0.f, 0.f, 0.f}; sc[1] = sc[0];
    mm_nt<2, 2>(sc, QS + 16 * rt * 72, 72, KV + kvstride * rt + 16 * ct0 * 72, 72, lane);
#pragma unroll
    for (int jj = 0; jj < 2; ++jj)
#pragma unroll
        for (int e = 0; e < 4; ++e) { const int t = 16 * rt + (lane >> 4) * 4 + e, s = 16 * (ct0 + jj) + (lane & 15);
            float val = 0.f; if (s <= t) val = RET ? sc[jj][e] * __expf((float)(t - s) * lg) : sc[jj][e];
            PP[t * 72 + s] = f2bf(val); }
    __syncthreads();
    y[0] = (f32x4){0.f, 0.f, 0.f, 0.f}; y[1] = y[0];
    mm_nt<2, 2>(y, QD + 16 * rt * 72, 72, SINT + 16 * ct0 * 72, 72, lane);
#pragma unroll
    for (int e = 0; e < 4; ++e) { const float r = RSC[16 * rt + (lane >> 4) * 4 + e]; y[0][e] *= r; y[1][e] *= r; }
    mm_nt<2, 2>(y, PP + 16 * rt * 72, 72, VT + 16 * ct0 * 72, 72, lane);
}
template <bool CENTER>
__device__ __forceinline__ void headnorm_store(LAS unsigned char* lds, const f32x4 (&y)[2], int wave, int lane, const bf16_t* Ugate, const float* gain, bf16_t* outp) {
    LAS f32x2* SSQ = (LAS f32x2*)(lds + E_SSQ);
    const int rt = wave >> 1, half = wave & 1, ct0 = half * 2;
#pragma unroll
    for (int e = 0; e < 4; ++e) { float s1 = y[0][e] + y[1][e], s2 = y[0][e] * y[0][e] + y[1][e] * y[1][e];
#pragma unroll
        for (int o = 1; o < 16; o <<= 1) { s1 += __shfl_xor(s1, o); s2 += __shfl_xor(s2, o); }
        if ((lane & 15) == 0) SSQ[(16 * rt + (lane >> 4) * 4 + e) * 2 + half] = (f32x2){s1, s2}; }
    __syncthreads();
#pragma unroll
    for (int e = 0; e < 4; ++e) { const int t = 16 * rt + (lane >> 4) * 4 + e;
        const f32x2 a = SSQ[t * 2], b2 = SSQ[t * 2 + 1];
        const float mean = CENTER ? (a.x + b2.x) * (1.0f / 64.0f) : 0.f;
        const float var = (a.y + b2.y) * (1.0f / 64.0f) - mean * mean;
        const float rstd = 1.0f / sqrtf(fmaxf(var, 0.f) + EPS);
#pragma unroll
        for (int jj = 0; jj < 2; ++jj) { const int pc = 16 * (ct0 + jj) + (lane & 15);
            outp[(size_t)t * D + pc] = f2bf((y[jj][e] - mean) * rstd * gain[pc] * siluf_(bf2f(Ugate[(size_t)t * NU + pc]))); } }
}

template <bool PASSC>
__device__ __forceinline__ void ret_unit(const Params& p, LAS unsigned char* lds, int l, int u) {
    const int tid = tidx(), lane = tid & 63, wave = tid >> 6;
    const int h = u & 3, c = (u >> 2) & 31, b = u >> 7, row0 = b * 2048 + c * 64;
    const bf16_t* U = (const bf16_t*)(p.ws + OFF_U);
    const float* RC = (const float*)(p.ws + OFF_ROPE); const float* RS = RC + 2052 * 32;
    const float lg = logf(1.0f - exp2f(-5.0f - (float)h));
    LAS bf16_t* QS = (LAS bf16_t*)(lds + E_QS); LAS bf16_t* KV = (LAS bf16_t*)(lds + E_KV); LAS bf16_t* VT = (LAS bf16_t*)(lds + E_VT);
    LAS bf16_t* SINT = (LAS bf16_t*)(lds + E_SINT); LAS bf16_t* KWT = (LAS bf16_t*)(lds + E_KWT); LAS float* RSC = (LAS float*)(lds + E_RSC);
    float* DS = (float*)(p.ws + OFF_DSR) + ((size_t)(b * 4 + h) * 32 + c) * 4096;
    for (int idx = tid; idx < 2048; idx += NTHR) {
        const int t = idx >> 5, j = idx & 31; const bf16_t* ur = U + (size_t)(row0 + t) * NU;
        const float cs = RC[(c * 64 + t) * 32 + j], sn = RS[(c * 64 + t) * 32 + j];
        const float k1 = bf2f(ur[URK + h * 64 + j]), k2 = bf2f(ur[URK + h * 64 + j + 32]);
        const float ka = (k1 * cs - k2 * sn) * 0.125f, kb = (k2 * cs + k1 * sn) * 0.125f;
        if (PASSC) {
            const float q1 = bf2f(ur[URQ + h * 64 + j]), q2 = bf2f(ur[URQ + h * 64 + j + 32]);
            QS[t * 72 + j] = f2bf(q1 * cs - q2 * sn); QS[t * 72 + j + 32] = f2bf(q2 * cs + q1 * sn);
            KV[t * 72 + j] = f2bf(ka); KV[t * 72 + j + 32] = f2bf(kb);
        } else {
            const float w = __expf((float)(63 - t) * lg);
            KWT[j * 72 + t] = f2bf(ka * w); KWT[(j + 32) * 72 + t] = f2bf(kb * w);
        }
    }
    for (int idx = tid; idx < 4096; idx += NTHR) { const int s = idx >> 6, pc = idx & 63; VT[pc * 72 + s] = U[(size_t)(row0 + s) * NU + URV + h * 64 + pc]; }
    if (PASSC) {
        for (int idx = tid; idx < 4096; idx += NTHR) { const int k = idx >> 6, pc = idx & 63; SINT[pc * 72 + k] = f2bf(DS[idx]); }
        if (tid < 64) RSC[tid] = __expf((float)(tid + 1) * lg);
    }
    __syncthreads();
    if (PASSC) {
        f32x4 y[2]; engineC<true>(lds, E_QS, 0, lg, y, wave, lane);
        headnorm_store<true>(lds, y, wave, lane, U + (size_t)row0 * NU + URG + h * 64, p.in[24] + l * 256 + h * 64, (bf16_t*)(p.ws + OFF_YC) + (size_t)row0 * D + 256 + h * 64);
    } else engineA(lds, DS, wave, lane);
    __syncthreads();
}

template <bool PASSC>
__device__ __forceinline__ void hg_unit(const Params& p, LAS unsigned char* lds, int l, int u) {
    const int tid = tidx(), lane = tid & 63, wave = tid >> 6;
    const int h = u & 3, c = (u >> 2) & 31, b = u >> 7, row0 = b * 2048 + c * 64;
    const bf16_t* U = (const bf16_t*)(p.ws + OFF_U);
    LAS float* CUM = (LAS float*)(lds + E_CUM);
    LAS bf16_t* QS = (LAS bf16_t*)(lds + E_QS); LAS bf16_t* QD = (LAS bf16_t*)(lds + E_QD); LAS bf16_t* KV = (LAS bf16_t*)(lds + E_KV); LAS bf16_t* VT = (LAS bf16_t*)(lds + E_VT);
    LAS bf16_t* SINT = (LAS bf16_t*)(lds + E_SINT); LAS bf16_t* KWT = (LAS bf16_t*)(lds + E_KWT); LAS float* RSC = (LAS float*)(lds + E_RSC);
    float* DS = (float*)(p.ws + OFF_DSH) + ((size_t)(b * 4 + h) * 32 + c) * 4096;
    const int kme = tid & 63;
    float lbk = 0.f;
    if (l > 0) { const float a0 = p.in[32][h * 64 + kme], a1 = p.in[32][256 + h * 64 + kme]; const float mx = fmaxf(a0, a1), e0 = expf(a0 - mx), e1 = expf(a1 - mx); lbk = e1 / (e0 + e1); }
    for (int idx = tid; idx < 4096; idx += NTHR) { const int t = idx >> 6, k = idx & 63;
        const float hf = bf2f(U[(size_t)(row0 + t) * NU + UHF + h * 64 + k]);
        CUM[t * 65 + k] = logf(lbk + (1.0f - lbk) * sigmoidf_(hf)); }
    __syncthreads();
#pragma unroll
    for (int kk = 0; kk < 8; ++kk) { const int k = wave * 8 + kk; const float v = scan64_add(CUM[lane * 65 + k], lane); CUM[lane * 65 + k] = v; }
    __syncthreads();
    for (int idx = tid; idx < 4096; idx += NTHR) { const int t = idx >> 6, k = idx & 63;
        const bf16_t* ur = U + (size_t)(row0 + t) * NU;
        const float hf = bf2f(ur[UHF + h * 64 + k]); const float kk_ = (1.0f - lbk) * sigmoidf_(-hf);
        const float cum = CUM[t * 65 + k];
        if (PASSC) {
            const float q = siluf_(bf2f(ur[UHQ + h * 64 + k])); const int i = t >> 4;
            const float ci0 = i ? CUM[(16 * i - 1) * 65 + k] : 0.f;
            QD[t * 72 + k] = f2bf(q * __expf(cum)); QS[t * 72 + k] = f2bf(q * __expf(cum - ci0));
#pragma unroll
            for (int i2 = 0; i2 < 4; ++i2) { float val = 0.f;
                if (i2 >= i) { const float c0 = i2 ? CUM[(16 * i2 - 1) * 65 + k] : 0.f; val = kk_ * __expf(fminf(c0 - cum, 60.f)); }
                KV[i2 * 4608 + t * 72 + k] = f2bf(val); }
        } else {
            KWT[k * 72 + t] = f2bf(kk_ * __expf(CUM[63 * 65 + k] - cum));
        }
    }
    for (int idx = tid; idx < 4096; idx += NTHR) { const int s = idx >> 6, pc = idx & 63; VT[pc * 72 + s] = U[(size_t)(row0 + s) * NU + UHI + h * 64 + pc]; }
    if (PASSC) {
        for (int idx = tid; idx < 4096; idx += NTHR) { const int k = idx >> 6, pc = idx & 63; SINT[pc * 72 + k] = f2bf(DS[idx]); }
        if (tid < 64) RSC[tid] = 1.0f;
    } else if (tid < 64) ((float*)(p.ws + OFF_DECH))[((size_t)(b * 4 + h) * 32 + c) * 64 + tid] = __expf(CUM[63 * 65 + tid]);
    __syncthreads();
    if (PASSC) {
        f32x4 y[2]; engineC<false>(lds, E_QD, 4608, 0.f, y, wave, lane);
        headnorm_store<false>(lds, y, wave, lane, U + (size_t)row0 * NU + UHG + h * 64, p.in[33] + l * 256 + h * 64, (bf16_t*)(p.ws + OFF_YC) + (size_t)row0 * D + 768 + h * 64);
    } else engineA(lds, DS, wave, lane);
    __syncthreads();
}

template <bool PASSC>
__device__ __forceinline__ void rg_unit(const Params& p, LAS unsigned char* lds, int l, int u) {
    const int tid = tidx(), lane = tid & 63, wave = tid >> 6;
    const int blk = u & 3, c = (u >> 2) & 31, b = u >> 7, row0 = b * 2048 + c * 64;
    const bf16_t* U = (const bf16_t*)(p.ws + OFF_U);
    LAS float* XR = (LAS float*)lds; LAS bf16_t* XRB = (LAS bf16_t*)(lds + 16640); LAS bf16_t* WT = (LAS bf16_t*)(lds + 25856);
    LAS float* AA = (LAS float*)(lds + 44288); LAS float* BB = (LAS float*)(lds + 60928); LAS float* HL = (LAS float*)(lds + 77568);
    {
        const int j = tid & 63, tg = tid >> 6, ch = blk * 64 + j;
        const float* cw = p.in[25] + (size_t)l * 4 * 256 + ch;
        float o[8]; conv_run<8>(U + (size_t)(row0 + tg * 8) * NU + UGX + ch, (c > 0) || (tg > 0), cw[0], cw[256], cw[512], cw[768], p.in[26][l * 256 + ch], o);
#pragma unroll
        for (int i = 0; i < 8; ++i) { XR[(tg * 8 + i) * 65 + j] = o[i]; XRB[(tg * 8 + i) * 72 + j] = f2bf(o[i]); }
    }
    const bf16_t* WRG = (const bf16_t*)(p.ws + OFF_WRG);
    for (int idx = tid; idx < 1024; idx += NTHR) { const int gate = idx >> 9, rem = idx & 511, j = rem >> 3, c8 = rem & 7;
        *(LAS u32x4*)(WT + gate * 4608 + j * 72 + c8 * 8) = *(const u32x4*)(WRG + (size_t)((l * 2 + gate) * 4 + blk) * 4096 + j * 64 + c8 * 8); }
    __syncthreads();
    {
        const int rt = wave & 3, ct0 = (wave >> 2) * 2;
        f32x4 aA[2], aX[2]; aA[0] = (f32x4){0.f, 0.f, 0.f, 0.f}; aA[1] = aA[0]; aX[0] = aA[0]; aX[1] = aA[0];
        mm_nt<2, 2>(aA, XRB + 16 * rt * 72, 72, WT + 16 * ct0 * 72, 72, lane);
        mm_nt<2, 2>(aX, XRB + 16 * rt * 72, 72, WT + 4608 + 16 * ct0 * 72, 72, lane);
#pragma unroll
        for (int jj = 0; jj < 2; ++jj) { const int j = 16 * (ct0 + jj) + (lane & 15), ch = blk * 64 + j;
            const float ba = p.in[28][l * 256 + ch], bx = p.in[30][l * 256 + ch], sp = -8.0f * softplusf_(-p.in[31][l * 256 + ch]);
#pragma unroll
            for (int e = 0; e < 4; ++e) { const int t = 16 * rt + (lane >> 4) * 4 + e;
                const float r = sigmoidf_(aA[jj][e] + ba), ig = sigmoidf_(aX[jj][e] + bx);
                const float la = sp * r; AA[t * 65 + j] = __expf(la); BB[t * 65 + j] = sqrtf(-expm1f(2.0f * la)) * ig * XR[t * 65 + j]; } }
    }
    __syncthreads();
#pragma unroll
    for (int kk = 0; kk < 8; ++kk) { const int j = wave * 8 + kk, ch = blk * 64 + j;
        float A = AA[lane * 65 + j], B = BB[lane * 65 + j];
#pragma unroll
        for (int d = 1; d < 64; d <<= 1) { const float Ap = __shfl_up(A, d), Bp = __shfl_up(B, d); if (lane >= d) { B = A * Bp + B; A = A * Ap; } }
        if (PASSC) { const float hin = ((const float*)(p.ws + OFF_RGC))[(size_t)(b * 32 + c) * 256 + ch]; HL[lane * 65 + j] = B + A * hin; }
        else if (lane == 63) { ((float*)(p.ws + OFF_RGH))[(size_t)(b * 32 + c) * 256 + ch] = B; ((float*)(p.ws + OFF_RGA))[(size_t)(b * 32 + c) * 256 + ch] = A; }
    }
    if (PASSC) {
        __syncthreads();
        bf16_t* YC = (bf16_t*)(p.ws + OFF_YC);
        for (int idx = tid; idx < 4096; idx += NTHR) { const int t = idx >> 6, j = idx & 63, ch = blk * 64 + j;
            YC[(size_t)(row0 + t) * D + 512 + ch] = f2bf(geluf_(bf2f(U[(size_t)(row0 + t) * NU + UGY + ch])) * HL[t * 65 + j]); }
        if (c == 31 && tid < 192) { const int r = tid >> 6, j = tid & 63;
            p.out[O_PRGC + ((size_t)(l * 8 + b) * 3 + r) * 256 + blk * 64 + j] = bf2f(U[(size_t)(b * 2048 + 2045 + r) * NU + UGX + blk * 64 + j]); }
    }
    __syncthreads();
}

__device__ __forceinline__ void carry_phase(const Params& p, int l) {
    const int gt = blockIdx.x * NTHR + tidx(), NG = gridDim.x * NTHR;
    constexpr int N_SSD = 8 * 4 * 8192, N_RET = 8 * 4 * 4096, N_HG = N_RET, N_RG = 8 * 256;
    for (int i = gt; i < N_SSD + N_RET + N_HG + N_RG; i += NG) {
        float tmp[32], dec[32];
        if (i < N_SSD) {
            const int bh = i >> 13, e = i & 8191; float* base = (float*)(p.ws + OFF_DSS) + (size_t)bh * 32 * 8192 + e; const float* dc = (const float*)(p.ws + OFF_DECS) + bh * 32;
#pragma unroll
            for (int c = 0; c < 32; ++c) { tmp[c] = base[(size_t)c * 8192]; dec[c] = dc[c]; }
            float s = 0.f;
#pragma unroll
            for (int c = 0; c < 32; ++c) { base[(size_t)c * 8192] = s; s = dec[c] * s + tmp[c]; }
            p.out[O_PSSD + (size_t)l * 8 * 32768 + (size_t)bh * 8192 + e] = s;
        } else if (i < N_SSD + N_RET) {
            const int j = i - N_SSD, bh = j >> 12, e = j & 4095; float* base = (float*)(p.ws + OFF_DSR) + (size_t)bh * 32 * 4096 + e;
            const float d = expf(64.0f * logf(1.0f - exp2f(-5.0f - (float)(bh & 3))));
#pragma unroll
            for (int c = 0; c < 32; ++c) tmp[c] = base[(size_t)c * 4096];
            float s = 0.f;
#pragma unroll
            for (int c = 0; c < 32; ++c) { base[(size_t)c * 4096] = s; s = d * s + tmp[c]; }
            p.out[O_PRET + (size_t)l * 8 * 16384 + (size_t)bh * 4096 + e] = s;
        } else if (i < N_SSD + N_RET + N_HG) {
            const int j = i - N_SSD - N_RET, bh = j >> 12, e = j & 4095; float* base = (float*)(p.ws + OFF_DSH) + (size_t)bh * 32 * 4096 + e;
            const float* dc = (const float*)(p.ws + OFF_DECH) + (size_t)bh * 32 * 64 + (e >> 6);
#pragma unroll
            for (int c = 0; c < 32; ++c) { tmp[c] = base[(size_t)c * 4096]; dec[c] = dc[c * 64]; }
            float s = 0.f;
#pragma unroll
            for (int c = 0; c < 32; ++c) { base[(size_t)c * 4096] = s; s = dec[c] * s + tmp[c]; }
            p.out[O_PHG + (size_t)l * 8 * 16384 + (size_t)bh * 4096 + e] = s;
        } else {
            const int j = i - N_SSD - N_RET - N_HG, b = j >> 8, ch = j & 255;
            const float* hl = (const float*)(p.ws + OFF_RGH) + (size_t)b * 32 * 256 + ch; const float* at = (const float*)(p.ws + OFF_RGA) + (size_t)b * 32 * 256 + ch;
            float* cr = (float*)(p.ws + OFF_RGC) + (size_t)b * 32 * 256 + ch;
#pragma unroll
            for (int c = 0; c < 32; ++c) { tmp[c] = hl[c * 256]; dec[c] = at[c * 256]; }
            float s = 0.f;
#pragma unroll
            for (int c = 0; c < 32; ++c) { cr[c * 256] = s; s = dec[c] * s + tmp[c]; }
            p.out[O_PRG + (size_t)l * 8 * 256 + b * 256 + ch] = s;
        }
    }
}

constexpr int S_QD = 0, S_KW = 8192, S_V = 16384, S_DEC = 20480, S_P = 22528, S_Y = 22784, S_RED = 26880, S_SCR = 59648;
template <int KD>
__device__ __forceinline__ void dec_engine(const float* S0, float* S1, LAS unsigned char* lds) {
    const int tid = tidx(), p_ = tid & 63, kq = tid >> 6; constexpr int KPER = KD / 8;
    const LAS float* QDs = (const LAS float*)(lds + S_QD); const LAS float* KWs = (const LAS float*)(lds + S_KW); const LAS float* Vs = (const LAS float*)(lds + S_V);
    const LAS float* DECs = (const LAS float*)(lds + S_DEC); const LAS float* Ps = (const LAS float*)(lds + S_P); LAS float* Ys = (LAS float*)(lds + S_Y); LAS float* RED = (LAS float*)(lds + S_RED);
    float v[4][4], yp[4][4];
#pragma unroll
    for (int h = 0; h < 4; ++h)
#pragma unroll
        for (int s = 0; s < 4; ++s) { v[h][s] = Vs[s * 256 + h * 64 + p_]; yp[h][s] = 0.f; }
#pragma unroll
    for (int h = 0; h < 4; ++h) {
#pragma unroll
        for (int kk = 0; kk < KPER; ++kk) { const int k = kq * KPER + kk;
            const float s0 = S0[(size_t)(h * KD + k) * 64 + p_];
            float acc = DECs[h * 128 + k] * s0;
#pragma unroll
            for (int s = 0; s < 4; ++s) acc += KWs[(h * 4 + s) * 128 + k] * v[h][s];
            S1[(size_t)(h * KD + k) * 64 + p_] = acc;
#pragma unroll
            for (int t = 0; t < 4; ++t) yp[h][t] += QDs[(h * 4 + t) * 128 + k] * s0;
        }
    }
#pragma unroll
    for (int h = 0; h < 4; ++h)
#pragma unroll
        for (int t = 0; t < 4; ++t) RED[(kq * 16 + h * 4 + t) * 64 + p_] = yp[h][t];
    __syncthreads();
    for (int idx = tid; idx < 1024; idx += NTHR) { const int p2 = idx & 63, ht = idx >> 6, h = ht >> 2, t = ht & 3;
        float sum = 0.f;
#pragma unroll
        for (int q = 0; q < 8; ++q) sum += RED[(q * 16 + ht) * 64 + p2];
        for (int s = 0; s <= t; ++s) sum += Ps[ht * 4 + s] * Vs[s * 256 + h * 64 + p2];
        Ys[t * 256 + h * 64 + p2] = sum; }
    __syncthreads();
}

__device__ __forceinline__ void sample_ssd(const Params& p, LAS unsigned char* lds, int l, int b) {
    const int tid = tidx(), lane = tid & 63, wave = tid >> 6, R0 = TP + b * 4;
    const bf16_t* U = (const bf16_t*)(p.ws + OFF_U); const float* SDT = (const float*)(p.ws + OFF_SDT);
    LAS float* QDs = (LAS float*)(lds + S_QD); LAS float* KWs = (LAS float*)(lds + S_KW); LAS float* Vs = (LAS float*)(lds + S_V);
    LAS float* DECs = (LAS float*)(lds + S_DEC); LAS float* Ps = (LAS float*)(lds + S_P); LAS float* Ys = (LAS float*)(lds + S_Y);
    LAS float* XB = (LAS float*)(lds + S_SCR); LAS float* DTs = (LAS float*)(lds + S_SCR + 12288); LAS float* CUs = DTs + 16;
    for (int ch = tid; ch < 768; ch += NTHR) {
        float xx[7];
#pragma unroll
        for (int r = 0; r < 3; ++r) xx[r] = p.in[3][((size_t)(l * 128 + b) * 3 + r) * 768 + ch];
#pragma unroll
        for (int t = 0; t < 4; ++t) xx[3 + t] = bf2f(U[(size_t)(R0 + t) * NU + UXBC + ch]);
        const float* cw = p.in[18] + (size_t)l * 4 * 768 + ch; const float w0 = cw[0], w1 = cw[768], w2 = cw[1536], w3 = cw[2304], bias = p.in[19][l * 768 + ch];
#pragma unroll
        for (int t = 0; t < 4; ++t) XB[t * 768 + ch] = siluf_(bias + w0 * xx[t] + w1 * xx[t + 1] + w2 * xx[t + 2] + w3 * xx[t + 3]);
#pragma unroll
        for (int r = 0; r < 3; ++r) p.out[O_SSSDC + ((size_t)(l * 128 + b) * 3 + r) * 768 + ch] = xx[4 + r];
    }
    if (tid < 4) { const int h = tid; float cum = 0.f; const float bias = p.in[20][l * 4 + h], A = -expf(p.in[21][l * 4 + h]);
        for (int t = 0; t < 4; ++t) { const float dt = softplusf_(SDT[(size_t)(R0 + t) * 4 + h] + bias); cum += A * dt; DTs[h * 4 + t] = dt; CUs[h * 4 + t] = cum; } }
    __syncthreads();
    for (int idx = tid; idx < 2048; idx += NTHR) { const int h = idx >> 9, t = (idx >> 7) & 3, n = idx & 127, g = h >> 1;
        QDs[(h * 4 + t) * 128 + n] = XB[t * 768 + 512 + g * 128 + n] * __expf(CUs[h * 4 + t]);
        KWs[(h * 4 + t) * 128 + n] = XB[t * 768 + 256 + g * 128 + n] * __expf(CUs[h * 4 + 3] - CUs[h * 4 + t]) * DTs[h * 4 + t]; }
    for (int idx = tid; idx < 1024; idx += NTHR) Vs[idx] = XB[(idx >> 8) * 768 + (idx & 255)];
    DECs[(tid >> 7) * 128 + (tid & 127)] = __expf(CUs[(tid >> 7) * 4 + 3]);
    if (tid < 64) { const int h = tid >> 4, t = (tid >> 2) & 3, s = tid & 3, g = h >> 1; float val = 0.f;
        if (s <= t) { float dot = 0.f; for (int n = 0; n < 128; ++n) dot += XB[t * 768 + 512 + g * 128 + n] * XB[s * 768 + 256 + g * 128 + n];
            val = dot * __expf(CUs[h * 4 + t] - CUs[h * 4 + s]) * DTs[h * 4 + s]; }
        Ps[tid] = val; }
    __syncthreads();
    dec_engine<128>(p.in[2] + (size_t)(l * 128 + b) * 32768, p.out + O_SSSD + (size_t)(l * 128 + b) * 32768, lds);
    for (int idx = tid; idx < 1024; idx += NTHR) { const int t = idx >> 8, ch = idx & 255, h = ch >> 6;
        const float y = Ys[idx] + p.in[22][l * 4 + h] * XB[t * 768 + ch];
        Ys[idx] = y * siluf_(bf2f(U[(size_t)(R0 + t) * NU + UZ + ch])); }
    __syncthreads();
    if (wave < 4) { const int t = wave; float v[4], ss = 0.f;
#pragma unroll
        for (int i = 0; i < 4; ++i) { v[i] = Ys[t * 256 + lane + 64 * i]; ss += v[i] * v[i]; }
        const float rstd = 1.0f / sqrtf(wave_sum(ss) * (1.0f / 256.0f) + EPS);
#pragma unroll
        for (int i = 0; i < 4; ++i) ((bf16_t*)(p.ws + OFF_YC))[(size_t)(R0 + t) * D + lane + 64 * i] = f2bf(v[i] * rstd * p.in[23][l * 256 + lane + 64 * i]); }
    __syncthreads();
}

template <bool CENTER>
__device__ __forceinline__ void sample_headnorm(const Params& p, LAS unsigned char* lds, int R0, const float* gain, int gcol, int ocol) {
    const int tid = tidx(), lane = tid & 63, wave = tid >> 6;
    const bf16_t* U = (const bf16_t*)(p.ws + OFF_U); const LAS float* Ys = (const LAS float*)(lds + S_Y);
#pragma unroll
    for (int q = 0; q < 2; ++q) { const int gi = wave * 2 + q, t = gi >> 2, h = gi & 3;
        const float y = Ys[t * 256 + h * 64 + lane];
        const float mean = CENTER ? wave_sum(y) * (1.0f / 64.0f) : 0.f; const float d = y - mean;
        const float var = wave_sum(d * d) * (1.0f / 64.0f);
        const float o = d / sqrtf(var + EPS) * gain[h * 64 + lane] * siluf_(bf2f(U[(size_t)(R0 + t) * NU + gcol + h * 64 + lane]));
        ((bf16_t*)(p.ws + OFF_YC))[(size_t)(R0 + t) * D + ocol + h * 64 + lane] = f2bf(o); }
}

__device__ __forceinline__ void sample_ret(const Params& p, LAS unsigned char* lds, int l, int b) {
    const int tid = tidx(), R0 = TP + b * 4;
    const bf16_t* U = (const bf16_t*)(p.ws + OFF_U);
    const float* RC = (const float*)(p.ws + OFF_ROPE); const float* RS = RC + 2052 * 32;
    LAS float* QDs = (LAS float*)(lds + S_QD); LAS float* KWs = (LAS float*)(lds + S_KW); LAS float* Vs = (LAS float*)(lds + S_V);
    LAS float* DECs = (LAS float*)(lds + S_DEC); LAS float* Ps = (LAS float*)(lds + S_P);
    LAS float* Qr = (LAS float*)(lds + S_SCR); LAS float* Kr = Qr + 1024;
    { const int h = tid >> 7, t = (tid >> 5) & 3, j = tid & 31; const bf16_t* ur = U + (size_t)(R0 + t) * NU;
        const float cs = RC[(2048 + t) * 32 + j], sn = RS[(2048 + t) * 32 + j];
        const float q1 = bf2f(ur[URQ + h * 64 + j]), q2 = bf2f(ur[URQ + h * 64 + j + 32]), k1 = bf2f(ur[URK + h * 64 + j]), k2 = bf2f(ur[URK + h * 64 + j + 32]);
        Qr[(h * 4 + t) * 64 + j] = q1 * cs - q2 * sn; Qr[(h * 4 + t) * 64 + j + 32] = q2 * cs + q1 * sn;
        Kr[(h * 4 + t) * 64 + j] = (k1 * cs - k2 * sn) * 0.125f; Kr[(h * 4 + t) * 64 + j + 32] = (k2 * cs + k1 * sn) * 0.125f; }
    for (int idx = tid; idx < 1024; idx += NTHR) Vs[idx] = bf2f(U[(size_t)(R0 + (idx >> 8)) * NU + URV + (idx & 255)]);
    __syncthreads();
    for (int idx = tid; idx < 1024; idx += NTHR) { const int h = idx >> 8, t = (idx >> 6) & 3, k = idx & 63; const float lg = logf(1.0f - exp2f(-5.0f - (float)h));
        QDs[(h * 4 + t) * 128 + k] = Qr[(h * 4 + t) * 64 + k] * __expf((float)(t + 1) * lg);
        KWs[(h * 4 + t) * 128 + k] = Kr[(h * 4 + t) * 64 + k] * __expf((float)(3 - t) * lg); }
    if (tid < 256) { const int h = tid >> 6; DECs[h * 128 + (tid & 63)] = __expf(4.0f * logf(1.0f - exp2f(-5.0f - (float)h))); }
    if (tid < 64) { const int h = tid >> 4, t = (tid >> 2) & 3, s = tid & 3; float val = 0.f;
        if (s <= t) { float dot = 0.f; for (int k = 0; k < 64; ++k) dot += Qr[(h * 4 + t) * 64 + k] * Kr[(h * 4 + s) * 64 + k];
            val = dot * __expf((float)(t - s) * logf(1.0f - exp2f(-5.0f - (float)h))); }
        Ps[tid] = val; }
    __syncthreads();
    dec_engine<64>(p.in[4] + (size_t)(l * 128 + b) * 16384, p.out + O_SRET + (size_t)(l * 128 + b) * 16384, lds);
    sample_headnorm<true>(p, lds, R0, p.in[24] + l * 256, URG, 256);
    __syncthreads();
}

__device__ __forceinline__ void sample_hg(const Params& p, LAS unsigned char* lds, int l, int b) {
    const int tid = tidx(), R0 = TP + b * 4;
    const bf16_t* U = (const bf16_t*)(p.ws + OFF_U);
    LAS float* QDs = (LAS float*)(lds + S_QD); LAS float* KWs = (LAS float*)(lds + S_KW); LAS float* Vs = (LAS float*)(lds + S_V);
    LAS float* DECs = (LAS float*)(lds + S_DEC); LAS float* Ps = (LAS float*)(lds + S_P);
    LAS float* LF = (LAS float*)(lds + S_SCR); LAS float* KK = LF + 1024; LAS float* QH = KK + 1024;
    for (int idx = tid; idx < 1024; idx += NTHR) { const int t = idx >> 8, ch = idx & 255; const bf16_t* ur = U + (size_t)(R0 + t) * NU;
        float lbk = 0.f;
        if (l > 0) { const float a0 = p.in[32][ch], a1 = p.in[32][256 + ch]; const float mx = fmaxf(a0, a1), e0 = expf(a0 - mx), e1 = expf(a1 - mx); lbk = e1 / (e0 + e1); }
        const float hf = bf2f(ur[UHF + ch]);
        LF[idx] = logf(lbk + (1.0f - lbk) * sigmoidf_(hf)); KK[idx] = (1.0f - lbk) * sigmoidf_(-hf); QH[idx] = siluf_(bf2f(ur[UHQ + ch])); Vs[idx] = bf2f(ur[UHI + ch]); }
    __syncthreads();
    if (tid < 256) { float c = 0.f; for (int t = 0; t < 4; ++t) { c += LF[t * 256 + tid]; LF[t * 256 + tid] = c; } }
    __syncthreads();
    for (int idx = tid; idx < 1024; idx += NTHR) { const int h = idx >> 8, t = (idx >> 6) & 3, k = idx & 63, ch = h * 64 + k;
        const float cum = LF[t * 256 + ch], last = LF[3 * 256 + ch];
        QDs[(h * 4 + t) * 128 + k] = QH[t * 256 + ch] * __expf(cum); KWs[(h * 4 + t) * 128 + k] = KK[t * 256 + ch] * __expf(last - cum); }
    if (tid < 256) DECs[(tid >> 6) * 128 + (tid & 63)] = __expf(LF[3 * 256 + tid]);
    if (tid < 64) { const int h = tid >> 4, t = (tid >> 2) & 3, s = tid & 3; float val = 0.f;
        if (s <= t) for (int k = 0; k < 64; ++k) { const int ch = h * 64 + k; val += QH[t * 256 + ch] * KK[s * 256 + ch] * __expf(LF[t * 256 + ch] - LF[s * 256 + ch]); }
        Ps[tid] = val; }
    __syncthreads();
    dec_engine<64>(p.in[7] + (size_t)(l * 128 + b) * 16384, p.out + O_SHG + (size_t)(l * 128 + b) * 16384, lds);
    sample_headnorm<false>(p, lds, R0, p.in[33] + l * 256, UHG, 768);
    __syncthreads();
}

__device__ __forceinline__ void sample_rg(const Params& p, LAS unsigned char* lds, int l, int b) {
    const int tid = tidx(), R0 = TP + b * 4;
    const bf16_t* U = (const bf16_t*)(p.ws + OFF_U);
    LAS float* XRs = (LAS float*)(lds + S_SCR); LAS float* GA = XRs + 1024;
    if (tid < 256) { const int ch = tid; float xx[7];
#pragma unroll
        for (int r = 0; r < 3; ++r) xx[r] = p.in[6][((size_t)(l * 128 + b) * 3 + r) * 256 + ch];
#pragma unroll
        for (int t = 0; t < 4; ++t) xx[3 + t] = bf2f(U[(size_t)(R0 + t) * NU + UGX + ch]);
        const float* cw = p.in[25] + (size_t)l * 4 * 256 + ch; const float w0 = cw[0], w1 = cw[256], w2 = cw[512], w3 = cw[768], bias = p.in[26][l * 256 + ch];
#pragma unroll
        for (int t = 0; t < 4; ++t) XRs[t * 256 + ch] = bias + w0 * xx[t] + w1 * xx[t + 1] + w2 * xx[t + 2] + w3 * xx[t + 3];
#pragma unroll
        for (int r = 0; r < 3; ++r) p.out[O_SRGC + ((size_t)(l * 128 + b) * 3 + r) * 256 + ch] = xx[4 + r]; }
    __syncthreads();
    { const int ch = tid & 255, gate = tid >> 8, blk = ch >> 6, j = ch & 63; const float* W = p.in[gate ? 29 : 27] + (size_t)(l * 4 + blk) * 4096;
        float a0 = 0.f, a1 = 0.f, a2 = 0.f, a3 = 0.f;
#pragma unroll 8
        for (int i = 0; i < 64; ++i) { const float w = W[i * 64 + j];
            a0 += XRs[blk * 64 + i] * w; a1 += XRs[256 + blk * 64 + i] * w; a2 += XRs[512 + blk * 64 + i] * w; a3 += XRs[768 + blk * 64 + i] * w; }
        GA[(gate * 4 + 0) * 256 + ch] = a0; GA[(gate * 4 + 1) * 256 + ch] = a1; GA[(gate * 4 + 2) * 256 + ch] = a2; GA[(gate * 4 + 3) * 256 + ch] = a3; }
    __syncthreads();
    if (tid < 256) { const int ch = tid; float h = p.in[5][(size_t)(l * 128 + b) * 256 + ch];
        const float ba = p.in[28][l * 256 + ch], bx = p.in[30][l * 256 + ch], sp = -8.0f * softplusf_(-p.in[31][l * 256 + ch]);
        for (int t = 0; t < 4; ++t) { const float r = sigmoidf_(GA[t * 256 + ch] + ba), ig = sigmoidf_(GA[(4 + t) * 256 + ch] + bx);
            const float la = sp * r; h = __expf(la) * h + sqrtf(-expm1f(2.0f * la)) * ig * XRs[t * 256 + ch];
            ((bf16_t*)(p.ws + OFF_YC))[(size_t)(R0 + t) * D + 512 + ch] = f2bf(geluf_(bf2f(U[(size_t)(R0 + t) * NU + UGY + ch])) * h); }
        p.out[O_SRG + (size_t)(l * 128 + b) * 256 + ch] = h; }
    __syncthreads();
}

__device__ __forceinline__ void attn_prompt(const Params& p, LAS unsigned char* lds, int u) {
    const int tid = tidx(), lane = tid & 63, wave = tid >> 6;
    const int qt = u & 15, h = (u >> 4) & 3, b = u >> 6, r0 = b * 2048 + qt * 128;
    const bf16_t* Q = (const bf16_t*)(p.ws + OFF_Q); const bf16_t* KBp = (const bf16_t*)(p.ws + OFF_KB) + (size_t)(b * 4 + h) * 65536;
    const bf16_t* VTp = (const bf16_t*)(p.ws + OFF_VTB) + (size_t)(b * 4 + h) * 65536; bf16_t* OB = (bf16_t*)(p.ws + OFF_YC);
    LAS bf16_t* QC = (LAS bf16_t*)lds; LAS bf16_t* KC = (LAS bf16_t*)(lds + 18432); LAS bf16_t* PS = (LAS bf16_t*)(lds + 55296); LAS bf16_t* VC = (LAS bf16_t*)(lds + 122880);
    f32x4 S[16];
#pragma unroll
    for (int j = 0; j < 16; ++j) S[j] = (f32x4){0.f, 0.f, 0.f, 0.f};
    for (int dc = 0; dc < 4; ++dc) {
        for (int idx = tid; idx < 1024; idx += NTHR) { const int r = idx >> 3, c8 = idx & 7; *(LAS u32x4*)(QC + r * 72 + c8 * 8) = *(const u32x4*)(Q + (size_t)(r0 + r) * D + h * 256 + dc * 64 + c8 * 8); }
        for (int idx = tid; idx < 2048; idx += NTHR) { const int r = idx >> 3, c8 = idx & 7; *(LAS u32x4*)(KC + r * 72 + c8 * 8) = *(const u32x4*)(KBp + (size_t)r * 256 + dc * 64 + c8 * 8); }
        __syncthreads();
        mm_nt<16, 2>(S, QC + 16 * wave * 72, 72, KC, 72, lane);
        __syncthreads();
    }
    {
        float inv[4];
#pragma unroll
        for (int e = 0; e < 4; ++e) { float m = -3.0e38f;
#pragma unroll
            for (int j = 0; j < 16; ++j) m = fmaxf(m, S[j][e]);
#pragma unroll
            for (int o = 1; o < 16; o <<= 1) m = fmaxf(m, __shfl_xor(m, o));
            float sm = 0.f;
#pragma unroll
            for (int j = 0; j < 16; ++j) { const float ev = __expf((S[j][e] - m) * 0.0625f); S[j][e] = ev; sm += ev; }
#pragma unroll
            for (int o = 1; o < 16; o <<= 1) sm += __shfl_xor(sm, o);
            inv[e] = 1.0f / sm; }
#pragma unroll
        for (int j = 0; j < 16; ++j)
#pragma unroll
            for (int e = 0; e < 4; ++e) PS[(16 * wave + (lane >> 4) * 4 + e) * 264 + 16 * j + (lane & 15)] = f2bf(S[j][e] * inv[e]);
    }
    f32x4 O[16];
#pragma unroll
    for (int j = 0; j < 16; ++j) O[j] = (f32x4){0.f, 0.f, 0.f, 0.f};
    for (int kc = 0; kc < 4; ++kc) {
        for (int idx = tid; idx < 2048; idx += NTHR) { const int r = idx >> 3, c8 = idx & 7; *(LAS u32x4*)(VC + r * 72 + c8 * 8) = *(const u32x4*)(VTp + (size_t)r * 256 + kc * 64 + c8 * 8); }
        __syncthreads();
        mm_nt<16, 2>(O, PS + 16 * wave * 264 + kc * 64, 264, VC, 72, lane);
        __syncthreads();
    }
#pragma unroll
    for (int j = 0; j < 16; ++j)
#pragma unroll
        for (int e = 0; e < 4; ++e) OB[(size_t)(r0 + 16 * wave + (lane >> 4) * 4 + e) * D + h * 256 + 16 * j + (lane & 15)] = f2bf(O[j][e]);
}

__device__ __forceinline__ void attn_sample(const Params& p, LAS unsigned char* lds, int l, int u) {
    const int tid = tidx(), lane = tid & 63, wave = tid >> 6;
    const int h = u & 3, b = u >> 2, R0 = TP + b * 4;
    const bf16_t* Q = (const bf16_t*)(p.ws + OFF_Q); bf16_t* OB = (bf16_t*)(p.ws + OFF_YC);
    LAS float* QSs = (LAS float*)lds; LAS float* SC = QSs + 1024; LAS float* OP = SC + 1024;
    for (int idx = tid; idx < 1024; idx += NTHR) QSs[idx] = bf2f(Q[(size_t)(R0 + (idx >> 8)) * D + h * 256 + (idx & 255)]) * 0.0625f;
    __syncthreads();
    f32x4 q[4];
#pragma unroll
    for (int t = 0; t < 4; ++t) q[t] = *(const LAS f32x4*)(QSs + t * 256 + lane * 4);
    const float* Kp = p.in[8] + ((size_t)(l * 128 + b) * 256) * 1024 + h * 256 + lane * 4;
#pragma unroll 4
    for (int i = 0; i < 32; ++i) { const int m = wave * 32 + i; const f32x4 kv = *(const f32x4*)(Kp + (size_t)m * 1024);
        float d[4];
#pragma unroll
        for (int t = 0; t < 4; ++t) d[t] = wave_sum(kv.x * q[t].x + kv.y * q[t].y + kv.z * q[t].z + kv.w * q[t].w);
        if (lane == 0) { SC[m] = d[0]; SC[256 + m] = d[1]; SC[512 + m] = d[2]; SC[768 + m] = d[3]; } }
    __syncthreads();
    if (wave < 4) { const int t = wave; float v[4], m = -3.0e38f;
#pragma unroll
        for (int i = 0; i < 4; ++i) { v[i] = SC[t * 256 + lane + 64 * i]; m = fmaxf(m, v[i]); }
        m = wave_max(m); float sm = 0.f;
#pragma unroll
        for (int i = 0; i < 4; ++i) { v[i] = __expf(v[i] - m); sm += v[i]; }
        sm = 1.0f / wave_sum(sm);
#pragma unroll
        for (int i = 0; i < 4; ++i) SC[t * 256 + lane + 64 * i] = v[i] * sm; }
    __syncthreads();
    { const int d = tid & 255, half = tid >> 8; const float* Vp = p.in[9] + ((size_t)(l * 128 + b) * 256) * 1024 + h * 256 + d;
        float a0 = 0.f, a1 = 0.f, a2 = 0.f, a3 = 0.f;
#pragma unroll 8
        for (int mm = 0; mm < 128; ++mm) { const int m = half * 128 + mm; const float v = Vp[(size_t)m * 1024];
            a0 += SC[m] * v; a1 += SC[256 + m] * v; a2 += SC[512 + m] * v; a3 += SC[768 + m] * v; }
        OP[(half * 4 + 0) * 256 + d] = a0; OP[(half * 4 + 1) * 256 + d] = a1; OP[(half * 4 + 2) * 256 + d] = a2; OP[(half * 4 + 3) * 256 + d] = a3; }
    __syncthreads();
    for (int idx = tid; idx < 1024; idx += NTHR) OB[(size_t)(R0 + (idx >> 8)) * D + h * 256 + (idx & 255)] = f2bf(OP[idx] + OP[1024 + idx]);
    __syncthreads();
}

__global__ void __launch_bounds__(512) mega(Params p) {
    extern __shared__ __attribute__((aligned(16))) unsigned char shm[];
    LAS unsigned char* lds = (LAS unsigned char*)shm;
    cg::grid_group grid = cg::this_grid();
    unsigned char* ws = p.ws;
    bf16_t* H = (bf16_t*)(ws + OFF_H); bf16_t* UB = (bf16_t*)(ws + OFF_U); bf16_t* YC = (bf16_t*)(ws + OFF_YC); float* M = (float*)(ws + OFF_M);
    bf16_t* QB = (bf16_t*)(ws + OFF_Q); bf16_t* ACT = (bf16_t*)(ws + OFF_ACT); float* X = p.out; float* SDT = (float*)(ws + OFF_SDT);
#ifndef SKIP_P0
    phase0(p, lds);
#endif
    grid.sync();
#pragma unroll 1
    for (int l = 0; l < NL; ++l) {
#ifndef SKIP_G1
        { EpiBf16 e{UB, NU}; run_gemm(lds, H, (const bf16_t*)(ws + OFF_WIN) + (size_t)l * NU * D, TT, NU, D, e, 0); }
#endif
#ifndef SKIP_GKV
        { EpiMemKV e{p.out + O_PMK + (size_t)l * 8 * 256 * 1024, p.out + O_PMV + (size_t)l * 8 * 256 * 1024, (bf16_t*)(ws + OFF_KB), (bf16_t*)(ws + OFF_VTB)};
          run_gemm(lds, (const bf16_t*)(ws + OFF_HM) + (size_t)l * 2048 * D, (const bf16_t*)(ws + OFF_WXKV) + (size_t)l * 2048 * D, 2048, 2048, D, e, 64); }
#endif
        grid.sync();
#ifndef SKIP_P2
        for (int u = blockIdx.x; u < 4096; u += gridDim.x) {
            if (u < 128) sample_ssd(p, lds, l, u);
            else if (u < 256) sample_ret(p, lds, l, u - 128);
            else if (u < 384) sample_hg(p, lds, l, u - 256);
            else if (u < 512) sample_rg(p, lds, l, u - 384);
            else if (u < 1024) ssd_passA(p, lds, l, u - 512);
            else if (u < 2048) ret_unit<false>(p, lds, l, u - 1024);
            else if (u < 3072) hg_unit<false>(p, lds, l, u - 2048);
            else rg_unit<false>(p, lds, l, u - 3072);
        }
#endif
        grid.sync();
#ifndef SKIP_P3
        carry_phase(p, l);
#endif
        grid.sync();
#ifndef SKIP_P4
        for (int u = blockIdx.x; u < 3328; u += gridDim.x) {
            if (u < 256) ssd_passC(p, lds, l, u);
            else if (u < 1280) ret_unit<true>(p, lds, l, u - 256);
            else if (u < 2304) hg_unit<true>(p, lds, l, u - 1280);
            else rg_unit<true>(p, lds, l, u - 2304);
        }
#endif
        grid.sync();
#ifndef SKIP_G2
        { EpiF32 e{M, D}; run_gemm(lds, YC, (const bf16_t*)(ws + OFF_WOUT) + (size_t)l * D * D, TT, D, D, e, 0); }
#endif
        grid.sync();
        rows_phase(lds, TT, nullptr, nullptr, X, M, p.in[12] + l * D, p.in[13] + l * D, H, nullptr, nullptr);
        grid.sync();
#ifndef SKIP_G3
        { EpiBf16 e{QB, D}; run_gemm(lds, H, (const bf16_t*)(ws + OFF_WXQ) + (size_t)l * D * D, TT, D, D, e, 0); }
#endif
        grid.sync();
#ifndef SKIP_ATT
        for (int u = blockIdx.x; u < 1024; u += gridDim.x) { if (u < 512) attn_prompt(p, lds, u); else attn_sample(p, lds, l, u - 512); }
#endif
        grid.sync();
#ifndef SKIP_G4
        { EpiF32 e{M, D}; run_gemm(lds, YC, (const bf16_t*)(ws + OFF_WXO) + (size_t)l * D * D, TT, D, D, e, 0); }
#endif
        grid.sync();
        rows_phase(lds, TT, nullptr, nullptr, X, M, p.in[14] + l * D, p.in[15] + l * D, H, nullptr, nullptr);
        grid.sync();
#ifndef SKIP_G5
        { EpiSwiGLU e{ACT}; run_gemm(lds, H, (const bf16_t*)(ws + OFF_WGU) + (size_t)l * 5632 * D, TT, 5632, D, e, 0); }
#endif
        grid.sync();
#ifndef SKIP_G6
        { EpiF32 e{M, D}; run_gemm(lds, ACT, (const bf16_t*)(ws + OFF_WDN) + (size_t)l * D * DFF, TT, D, DFF, e, 0); }
#endif
        grid.sync();
        rows_phase(lds, TT, nullptr, nullptr, X, M, p.in[16] + l * D, l + 1 < NL ? p.in[11] + (l + 1) * D : nullptr, H, l + 1 < NL ? p.in[17] + (size_t)(l + 1) * D * DIN : nullptr, SDT);
        grid.sync();
    }
}

extern "C" void kernel_launch(void* const* d_in, const int* in_sizes, int n_in, void* d_out, int out_size, void* d_ws, size_t ws_size, hipStream_t stream) {
    constexpr int LDS_BYTES = 160 * 1024;
    static int grid = 0;
    if (grid == 0) {
        if (n_in != 41 || (size_t)out_size != O_END || ws_size < WS_END) { fprintf(stderr, "kernel_launch: unexpected shapes (n_in %d out %d ws %zu need %zu)\n", n_in, out_size, ws_size, (size_t)WS_END); grid = -1; return; }
        int dev = 0, cus = 0, per_cu = 0;
        (void)hipGetDevice(&dev);
        (void)hipDeviceGetAttribute(&cus, hipDeviceAttributeMultiprocessorCount, dev);
        (void)hipFuncSetAttribute((const void*)mega, hipFuncAttributeMaxDynamicSharedMemorySize, LDS_BYTES);
        (void)hipOccupancyMaxActiveBlocksPerMultiprocessor(&per_cu, (const void*)mega, 512, LDS_BYTES);
        if (per_cu < 1) { fprintf(stderr, "kernel_launch: occupancy query reports %d blocks per CU\n", per_cu); per_cu = 1; }
        grid = cus;
    }
    if (grid < 0) return;
    Params p{};
    for (int i = 0; i < 41; ++i) p.in[i] = (const float*)d_in[i];
    p.out = (float*)d_out; p.ws = (unsigned char*)d_ws;
    void* args[] = {&p};
    hipError_t e = hipLaunchCooperativeKernel((void*)mega, dim3(grid), dim3(512), args, LDS_BYTES, stream);
    if (e != hipSuccess) fprintf(stderr, "cooperative launch failed: %s (grid %d)\n", hipGetErrorString(e), grid);
}
```

```cpp
#include <hip/hip_runtime.h>
#include <hip/hip_cooperative_groups.h>
#include <cstdio>
#include <cstdint>
namespace cg = cooperative_groups;
__device__ __forceinline__ int tidx() { int t = threadIdx.x; asm volatile("" : "+v"(t)); return t; }
namespace pg8 {
#define PG8_LAS __attribute__((address_space(3)))
typedef unsigned short bf16_t;
typedef short bf16x8 __attribute__((ext_vector_type(8)));
typedef float f32x4 __attribute__((ext_vector_type(4)));
typedef unsigned u32x4 __attribute__((ext_vector_type(4)));
constexpr int BM = 256, BK = 64, HALF = 128, HTB = HALF * BK * 2  , STAGE_BYTES = 8 * HTB, NXCD = 8, WGM = 8;

__host__ __device__ __forceinline__ int lds_byte(int r, int c) { const int st = (r >> 4) * 2 + (c >> 5), rr = r & 15, cc = c & 31, ob = rr * 64 + cc * 2; return st * 1024 + (ob ^ (((ob >> 9) & 1) << 5)); }
__host__ __device__ __forceinline__ void stage_rc(int b, int& R, int& C) { const int st = b / 1024, sb = b % 1024, swz = sb ^ (((sb >> 9) & 1) << 5); R = (st >> 1) * 16 + swz / 64; C = (st & 1) * 32 + (swz % 64) / 2; }
__host__ __device__ __forceinline__ int perm32(int rho) { const int n = rho >> 4, i = rho & 15; return 8 * (i >> 2) + 4 * n + (i & 3); }

struct Unit { int pm, pn; };
struct Gemm { const bf16_t* A; const bf16_t* Bt; int M, N, K; };

struct StaticOrder {
    int nM, nN, nwg, G, c;
    __host__ __device__ void init(int M, int N, int G_, int c_) { nM = M / BM; nN = N / BM; nwg = nM * nN; G = G_; c = c_; }
    __host__ __device__ bool next(int i, Unit& u) const {
        const long L = (long)i * G + c; if (L >= nwg) return false;
        int wgid = (int)L; { const int q = nwg / NXCD, r = nwg % NXCD, xcd = wgid % NXCD, off = wgid / NXCD; wgid = (xcd < r ? xcd * (q + 1) : r * (q + 1) + (xcd - r) * q) + off; }
        const int nig = WGM * nN, gid = wgid / nig, fm = gid * WGM, gsz = (nM - fm) < WGM ? (nM - fm) : WGM;
        u.pm = fm + ((wgid % nig) % gsz); u.pn = (wgid % nig) / gsz; return true;
    }
    __device__ __forceinline__ void a_ready(const Unit&) const {}
    __device__ __forceinline__ void done(const Unit&) const {}
};
}
namespace pg8 {
template <class Epi, class Sched, bool STAMP = false>
__device__ __forceinline__ void gemm_phase(PG8_LAS unsigned char* lds, const Gemm g, const Sched& S, const Epi& E, unsigned long long* stamps) {
    const int tid = tidx(), wid = __builtin_amdgcn_readfirstlane(tid >> 6), lane = tid & 63, wr = wid >> 2, wc = wid & 3, fr = lane & 15, fq = lane >> 4;
    const int K = g.K, nt = K / BK;
    int ts_lo = 0, ts_hi = 0, nts = 0; const unsigned long long rt_entry = STAMP ? (unsigned long long)wall_clock64() : 0ull;
#define PG8_STAMP() do { if (STAMP && wid == 0 && nts < 64) { const unsigned long long _c = (unsigned long long)clock64(); \
        ts_lo = (lane == nts) ? (int)(unsigned)_c : ts_lo; ts_hi = (lane == nts) ? (int)(unsigned)(_c >> 32) : ts_hi; ++nts; } } while (0)
    PG8_STAMP();
    unsigned voffA[2], voffB[2];
#pragma unroll
    for (int i = 0; i < 2; ++i) { int R, C; stage_rc(tid * 16 + i * 8192, R, C); const int Rb = Epi::PERM ? ((R & ~31) + perm32(R & 31)) : R;
        voffA[i] = (unsigned)(R * K + C) * 2u; voffB[i] = (unsigned)(Rb * K + C) * 2u; }
    const size_t kstep = (size_t)(BK * 2);
    const size_t hstep = (size_t)HALF * K * 2;
    const size_t tstep = 2 * hstep;
    const unsigned ldsw = (unsigned)wid * 1024u;
    const int aoff = lds_byte(wr * 64 + fr, fq * 8), boff = lds_byte(wc * 32 + fr, fq * 8);
#define PG8_SA(b, h) (((b) * 2 + (h)) * HTB)
#define PG8_SB(b, h) ((4 + (b) * 2 + (h)) * HTB)
#define PG8_STAGE(bufoff, gbase, voff) do { _Pragma("unroll") for (int _i = 0; _i < 2; ++_i) \
        __builtin_amdgcn_global_load_lds((const unsigned*)((const char*)(gbase) + (voff)[_i]), (PG8_LAS unsigned*)(lds + (bufoff) + ldsw + _i * 8192), 16, 0, 0); } while (0)
#define PG8_LDA(dst, b, h) do { _Pragma("unroll") for (int m = 0; m < 4; ++m) _Pragma("unroll") for (int k = 0; k < 2; ++k) dst[m][k] = *(const PG8_LAS bf16x8*)(lds + PG8_SA(b, h) + aoff + m * 2048 + k * 1024); } while (0)
#define PG8_LDB(dst, b, h) do { _Pragma("unroll") for (int n = 0; n < 2; ++n) _Pragma("unroll") for (int k = 0; k < 2; ++k) dst[n][k] = *(const PG8_LAS bf16x8*)(lds + PG8_SB(b, h) + boff + n * 2048 + k * 1024); } while (0)
#define PG8_MMA(ai, bj, At, Bt) do { __builtin_amdgcn_s_setprio(1); _Pragma("unroll") for (int m = 0; m < 4; ++m) _Pragma("unroll") for (int n = 0; n < 2; ++n) _Pragma("unroll") for (int k = 0; k < 2; ++k) \
        acc[ai][bj][m][n] = __builtin_amdgcn_mfma_f32_16x16x32_bf16(Bt[n][k], At[m][k], acc[ai][bj][m][n], 0, 0, 0); __builtin_amdgcn_s_setprio(0); } while (0)
#define PG8_WAIT_V(n) asm volatile("s_waitcnt vmcnt(" #n ")" ::: "memory")
#define PG8_WAIT_L(n) asm volatile("s_waitcnt lgkmcnt(" #n ")" ::: "memory")
#define PG8_BAR __builtin_amdgcn_s_barrier()
#define PG8_SCHED __builtin_amdgcn_sched_barrier(0)
    Unit cur, nxt; int ui = 0;
    if (!S.next(0, cur)) return;
    f32x4 acc[2][2][4][2];
#pragma unroll
    for (int a = 0; a < 2; ++a)
#pragma unroll
        for (int b = 0; b < 2; ++b)
#pragma unroll
            for (int m = 0; m < 4; ++m)
#pragma unroll
                for (int n = 0; n < 2; ++n) acc[a][b][m][n] = (f32x4){0.f, 0.f, 0.f, 0.f};
    bf16x8 At[4][2], B0[2][2], B1[2][2];
    const char* cA = (const char*)g.A + (size_t)cur.pm * tstep; const char* cB = (const char*)g.Bt + (size_t)cur.pn * tstep;
    S.a_ready(cur);
    PG8_STAGE(PG8_SB(0, 0), cB, voffB); PG8_STAGE(PG8_SA(0, 0), cA, voffA); PG8_STAGE(PG8_SB(0, 1), cB + hstep, voffB); PG8_STAGE(PG8_SA(0, 1), cA + hstep, voffA);
    if (wr == 1) PG8_BAR;
    PG8_WAIT_V(4); PG8_BAR;
    PG8_STAGE(PG8_SB(1, 0), cB + kstep, voffB); PG8_STAGE(PG8_SA(1, 0), cA + kstep, voffA); PG8_STAGE(PG8_SB(1, 1), cB + hstep + kstep, voffB);
    PG8_WAIT_V(6); PG8_BAR;
    PG8_STAMP();
    for (;;) {
        const bool has_next = S.next(ui + 1, nxt);
        const char* nA = has_next ? (const char*)g.A + (size_t)nxt.pm * tstep : cA; const char* nB = has_next ? (const char*)g.Bt + (size_t)nxt.pn * tstep : cB;
        for (int t = 0; t < nt; t += 2) {
            const bool last = (t == nt - 2);
            const char* a1 = cA + (size_t)(t + 1) * kstep;
            const char* a2 = last ? nA : cA + (size_t)(t + 2) * kstep; const char* b2 = last ? nB : cB + (size_t)(t + 2) * kstep;
            const char* a3 = a2 + kstep; const char* b3 = b2 + kstep;
            if (last && has_next) S.a_ready(nxt);
            PG8_LDB(B0, 0, 0); PG8_SCHED; PG8_LDA(At, 0, 0); PG8_STAGE(PG8_SA(1, 1), a1 + hstep, voffA);
            PG8_WAIT_L(8); PG8_BAR; PG8_WAIT_L(0); PG8_MMA(0, 0, At, B0); PG8_BAR; PG8_SCHED;
            PG8_LDB(B1, 0, 1); PG8_STAGE(PG8_SB(0, 0), b2, voffB);
            PG8_BAR; PG8_WAIT_L(0); PG8_MMA(0, 1, At, B1); PG8_BAR;
            PG8_LDA(At, 0, 1); PG8_STAGE(PG8_SA(0, 0), a2, voffA);
            PG8_BAR; PG8_WAIT_L(0); PG8_MMA(1, 0, At, B0); PG8_BAR; PG8_SCHED;
            PG8_STAGE(PG8_SB(0, 1), b2 + hstep, voffB);
            PG8_WAIT_V(6); PG8_BAR; PG8_MMA(1, 1, At, B1); PG8_BAR;
            PG8_LDB(B0, 1, 0); PG8_SCHED; PG8_LDA(At, 1, 0); PG8_STAGE(PG8_SA(0, 1), a2 + hstep, voffA);
            PG8_WAIT_L(8); PG8_BAR; PG8_WAIT_L(0); PG8_MMA(0, 0, At, B0); PG8_BAR; PG8_SCHED;
            PG8_LDB(B1, 1, 1); PG8_STAGE(PG8_SB(1, 0), b3, voffB);
            PG8_BAR; PG8_WAIT_L(0); PG8_MMA(0, 1, At, B1); PG8_BAR;
            PG8_LDA(At, 1, 1); PG8_STAGE(PG8_SA(1, 0), a3, voffA);
            PG8_BAR; PG8_WAIT_L(0); PG8_MMA(1, 0, At, B0); PG8_BAR; PG8_SCHED;
            PG8_STAGE(PG8_SB(1, 1), b3 + hstep, voffB);
            PG8_WAIT_V(6); PG8_BAR; PG8_MMA(1, 1, At, B1); PG8_BAR;
        }
        PG8_STAMP();
        if constexpr (!Epi::AFTER_DRAIN) { E(acc, cur, wr, wc, fr, fq); S.done(cur); }
        PG8_STAMP();
        if (!has_next) break;
#pragma unroll
        for (int a = 0; a < 2; ++a)
#pragma unroll
            for (int b = 0; b < 2; ++b)
#pragma unroll
                for (int m = 0; m < 4; ++m)
#pragma unroll
                    for (int n = 0; n < 2; ++n) acc[a][b][m][n] = (f32x4){0.f, 0.f, 0.f, 0.f};
        cur = nxt; cA = nA; cB = nB; ++ui;
    }
    PG8_WAIT_V(0);
    if (wr == 0) PG8_BAR;
    PG8_BAR;
    if constexpr (Epi::AFTER_DRAIN) { E.fused(acc, cur, wr, wc, fr, fq, lds, wid, lane); S.done(cur); }
    PG8_STAMP();
    if (STAMP && wid == 0) { stamps[lane] = lane < nts ? (((unsigned long long)(unsigned)ts_hi << 32) | (unsigned)ts_lo) : 0ull;
        if (lane == 62) stamps[62] = rt_entry; if (lane == 63) stamps[63] = (unsigned long long)wall_clock64(); }
#undef PG8_STAMP
#undef PG8_SA
#undef PG8_SB
#undef PG8_STAGE
#undef PG8_LDA
#undef PG8_LDB
#undef PG8_MMA
#undef PG8_WAIT_V
#undef PG8_WAIT_L
#undef PG8_BAR
#undef PG8_SCHED
}
}

#define LAS __attribute__((address_space(3)))
using pg8::bf16_t; using pg8::bf16x8; using pg8::f32x4; using pg8::u32x4;
typedef unsigned u32x2 __attribute__((ext_vector_type(2)));
typedef float f32x2 __attribute__((ext_vector_type(2)));

constexpr int D = 1024, TP = 16384, TS = 512, TT = TP + TS, NU = 3584, DIN = 3588, DFF = 2816, NL = 2;
constexpr int NTHR = 512;
constexpr float EPS = 1e-6f;
constexpr int UZ = 0, UXBC = 256, URQ = 1024, URK = 1280, URV = 1536, URG = 1792, UGX = 2048, UGY = 2304, UHQ = 2560, UHF = 2816, UHI = 3072, UHG = 3328;
constexpr size_t O_YP = 0, O_YS = O_YP + (size_t)8 * 2048 * 1024, O_PSSD = O_YS + (size_t)128 * 4 * 1024, O_PSSDC = O_PSSD + (size_t)2 * 8 * 4 * 128 * 64,
    O_PRET = O_PSSDC + (size_t)2 * 8 * 3 * 768, O_PRG = O_PRET + (size_t)2 * 8 * 4 * 64 * 64, O_PRGC = O_PRG + (size_t)2 * 8 * 256, O_PHG = O_PRGC + (size_t)2 * 8 * 3 * 256,
    O_PMK = O_PHG + (size_t)2 * 8 * 4 * 64 * 64, O_PMV = O_PMK + (size_t)2 * 8 * 256 * 1024, O_SSSD = O_PMV + (size_t)2 * 8 * 256 * 1024, O_SSSDC = O_SSSD + (size_t)2 * 128 * 4 * 128 * 64,
    O_SRET = O_SSSDC + (size_t)2 * 128 * 3 * 768, O_SRG = O_SRET + (size_t)2 * 128 * 4 * 64 * 64, O_SRGC = O_SRG + (size_t)2 * 128 * 256, O_SHG = O_SRGC + (size_t)2 * 128 * 3 * 256,
    O_END = O_SHG + (size_t)2 * 128 * 4 * 64 * 64;
constexpr size_t OFF_WIN = 0, OFF_WOUT = OFF_WIN + (size_t)NL * NU * D * 2, OFF_WXQ = OFF_WOUT + (size_t)NL * D * D * 2, OFF_WXO = OFF_WXQ + (size_t)NL * D * D * 2,
    OFF_WXKV = OFF_WXO + (size_t)NL * D * D * 2, OFF_WGU = OFF_WXKV + (size_t)NL * 2048 * D * 2, OFF_WDN = OFF_WGU + (size_t)NL * 5632 * D * 2, OFF_WRG = OFF_WDN + (size_t)NL * D * DFF * 2,
    OFF_ROPE = OFF_WRG + (size_t)NL * 2 * 4 * 64 * 64 * 2, OFF_H = OFF_ROPE + (size_t)2052 * 32 * 2 * 4, OFF_HM = OFF_H + (size_t)TT * D * 2, OFF_U = OFF_HM + (size_t)NL * 2048 * D * 2,
    OFF_SDT = OFF_U + (size_t)TT * NU * 2, OFF_YC = OFF_SDT + (size_t)TT * 4 * 4, OFF_M = OFF_YC + (size_t)TT * D * 2, OFF_Q = OFF_M + (size_t)TT * D * 4, OFF_ACT = OFF_Q + (size_t)TT * D * 2,
    OFF_KB = OFF_ACT + (size_t)TT * DFF * 2, OFF_VTB = OFF_KB + (size_t)8 * 4 * 256 * 256 * 2, OFF_DSS = OFF_VTB + (size_t)8 * 4 * 256 * 256 * 2, OFF_DECS = OFF_DSS + (size_t)8 * 4 * 32 * 8192 * 4,
    OFF_DSR = OFF_DECS + 4096, OFF_DSH = OFF_DSR + (size_t)8 * 4 * 32 * 4096 * 4, OFF_DECH = OFF_DSH + (size_t)8 * 4 * 32 * 4096 * 4, OFF_RGH = OFF_DECH + (size_t)8 * 4 * 32 * 64 * 4,
    OFF_RGA = OFF_RGH + (size_t)8 * 32 * 256 * 4, OFF_RGC = OFF_RGA + (size_t)8 * 32 * 256 * 4, OFF_BAR = OFF_RGC + (size_t)8 * 32 * 256 * 4, OFF_LB = OFF_BAR + 16384, OFF_XS = OFF_LB + 4096, OFF_HS = OFF_XS + (size_t)TT * D * 4, WS_END = OFF_HS + (size_t)TT * D * 2;

struct Params { const float* in[41]; float* out; unsigned char* ws; };
typedef const __attribute__((address_space(4))) Params* KPRM;
typedef const __attribute__((address_space(4))) Params& PRM;
__device__ __forceinline__ KPRM kp_launder(KPRM k) { asm volatile("" : "+s"(k)); return k; }

__device__ __forceinline__ float bf2f(bf16_t b) { return __uint_as_float(((unsigned)b) << 16); }
__device__ __forceinline__ unsigned pk2(float lo, float hi) { unsigned r; asm volatile("v_cvt_pk_bf16_f32 %0, %1, %2" : "=v"(r) : "v"(lo), "v"(hi)); return r; }
__device__ __forceinline__ bf16_t f2bf(float f) { return (bf16_t)(pk2(f, f) & 0xffffu); }
__device__ __forceinline__ float sigmoidf_(float x) { return __builtin_amdgcn_rcpf(1.0f + __expf(-x)); }
__device__ __forceinline__ float siluf_(float x) { return x * __builtin_amdgcn_rcpf(1.0f + __expf(-x)); }
__device__ __forceinline__ float siluf_div(float x) { return x / (1.0f + __expf(-x)); }
__device__ __forceinline__ float softplusf_(float x) { const float e = __expf(-fabsf(x)); const float l1p = e < 1.0e-3f ? e * (1.0f - e * (0.5f - e * 0.33333333f)) : __logf(1.0f + e); return fmaxf(x, 0.0f) + l1p; }
__device__ __forceinline__ float geluf_(float x) { const float u = 0.7978845608028654f * (x + 0.044715f * x * x * x); return x * __builtin_amdgcn_rcpf(1.0f + __expf(-2.0f * u)); }
__device__ __forceinline__ float wave_sum(float v) {
#pragma unroll
    for (int o = 1; o < 64; o <<= 1) v += __shfl_xor(v, o);
    return v;
}
__device__ __forceinline__ float wave_max(float v) {
#pragma unroll
    for (int o = 1; o < 64; o <<= 1) v = fmaxf(v, __shfl_xor(v, o));
    return v;
}
template <int NT, int KS>
__device__ __forceinline__ void mm_nt(f32x4 (&acc)[NT], const LAS bf16_t* A, int lda, const LAS bf16_t* B, int ldb, int lane) {
    const int r = lane & 15, q = (lane >> 4) * 8;
#pragma unroll
    for (int ks = 0; ks < KS; ++ks) {
        const bf16x8 a = *(const LAS bf16x8*)(A + r * lda + ks * 32 + q);
#pragma unroll
        for (int j = 0; j < NT; ++j) {
            const bf16x8 b = *(const LAS bf16x8*)(B + (16 * j + r) * ldb + ks * 32 + q);
            acc[j] = __builtin_amdgcn_mfma_f32_16x16x32_bf16(a, b, acc[j], 0, 0, 0);
        }
    }
}

struct EpiBf16 {
    static constexpr bool PERM = true, AFTER_DRAIN = false;
    bf16_t* O; int ldc;
    __device__ __forceinline__ void operator()(const f32x4 (&acc)[2][2][4][2], const pg8::Unit& u, int wr, int wc, int fr, int fq) const {
        const int row0 = u.pm * 256 + wr * 64 + fr, col0 = u.pn * 256 + wc * 32 + 8 * fq;
#pragma unroll
        for (int ai = 0; ai < 2; ++ai)
#pragma unroll
            for (int m = 0; m < 4; ++m) {
                bf16_t* rowp = O + (size_t)(row0 + ai * 128 + m * 16) * ldc + col0;
#pragma unroll
                for (int bj = 0; bj < 2; ++bj) {
                    const f32x4 v0 = acc[ai][bj][m][0], v1 = acc[ai][bj][m][1];
                    u32x4 w; w.x = pk2(v0[0], v0[1]); w.y = pk2(v0[2], v0[3]); w.z = pk2(v1[0], v1[1]); w.w = pk2(v1[2], v1[3]);
                    *(u32x4*)(rowp + bj * 128) = w;
                }
            }
    }
};
struct EpiF32 {
    static constexpr bool PERM = false, AFTER_DRAIN = false;
    float* C; int ldc;
    __device__ __forceinline__ void operator()(const f32x4 (&acc)[2][2][4][2], const pg8::Unit& u, int wr, int wc, int fr, int fq) const {
        const int row0 = u.pm * 256 + wr * 64 + fr, col0 = u.pn * 256 + wc * 32 + 4 * fq;
#pragma unroll
        for (int ai = 0; ai < 2; ++ai)
#pragma unroll
            for (int m = 0; m < 4; ++m) {
                float* rowp = C + (size_t)(row0 + ai * 128 + m * 16) * ldc + col0;
#pragma unroll
                for (int bj = 0; bj < 2; ++bj)
#pragma unroll
                    for (int n = 0; n < 2; ++n) *(f32x4*)(rowp + bj * 128 + n * 16) = acc[ai][bj][m][n];
            }
    }
};
struct EpiSwiGLU {
    static constexpr bool PERM = true, AFTER_DRAIN = false;
    bf16_t* O;
    __device__ __forceinline__ void operator()(const f32x4 (&acc)[2][2][4][2], const pg8::Unit& u, int wr, int wc, int fr, int fq) const {
        const int row0 = u.pm * 256 + wr * 64 + fr, col0 = u.pn * 128 + wc * 32 + 8 * fq;
#pragma unroll
        for (int ai = 0; ai < 2; ++ai)
#pragma unroll
            for (int m = 0; m < 4; ++m) {
                bf16_t* rowp = O + (size_t)(row0 + ai * 128 + m * 16) * DFF + col0;
                const f32x4 g0 = acc[ai][0][m][0], g1 = acc[ai][0][m][1], u0 = acc[ai][1][m][0], u1 = acc[ai][1][m][1];
                u32x4 w;
                w.x = pk2(siluf_(g0[0]) * u0[0], siluf_(g0[1]) * u0[1]); w.y = pk2(siluf_(g0[2]) * u0[2], siluf_(g0[3]) * u0[3]);
                w.z = pk2(siluf_(g1[0]) * u1[0], siluf_(g1[1]) * u1[1]); w.w = pk2(siluf_(g1[2]) * u1[2], siluf_(g1[3]) * u1[3]);
                *(u32x4*)rowp = w;
            }
    }
};
struct EpiMemKV {
    static constexpr bool PERM = false, AFTER_DRAIN = false;
    float* kout; float* vout; bf16_t* KB; bf16_t* VTB;
    __device__ __forceinline__ void operator()(const f32x4 (&acc)[2][2][4][2], const pg8::Unit& u, int wr, int wc, int fr, int fq) const {
        const int row0 = u.pm * 256 + wr * 64 + fr, col0 = u.pn * 256 + wc * 32 + 4 * fq;
#pragma unroll
        for (int ai = 0; ai < 2; ++ai)
#pragma unroll
            for (int m = 0; m < 4; ++m) {
                const int row = row0 + ai * 128 + m * 16, b = row >> 8, key = row & 255;
#pragma unroll
                for (int bj = 0; bj < 2; ++bj)
#pragma unroll
                    for (int n = 0; n < 2; ++n) {
                        const int col = col0 + bj * 128 + n * 16; const f32x4 v = acc[ai][bj][m][n];
                        if (col < 1024) {
                            *(f32x4*)(kout + (size_t)row * 1024 + col) = v;
                            u32x2 w; w.x = pk2(v[0], v[1]); w.y = pk2(v[2], v[3]);
                            *(u32x2*)(KB + ((size_t)(b * 4 + (col >> 8)) * 256 + key) * 256 + (col & 255)) = w;
                        } else {
                            const int c2 = col - 1024;
                            *(f32x4*)(vout + (size_t)row * 1024 + c2) = v;
                            bf16_t* vp = VTB + ((size_t)(b * 4 + (c2 >> 8)) * 256 + (c2 & 255)) * 256 + key;
                            vp[0] = f2bf(v[0]); vp[256] = f2bf(v[1]); vp[512] = f2bf(v[2]); vp[768] = f2bf(v[3]);
                        }
                    }
            }
    }
};
template <class Epi>
__device__ __forceinline__ void run_gemm(LAS unsigned char* lds, const bf16_t* A, const bf16_t* Bt, int M, int N, int K, const Epi& E, int cshift) {
    asm volatile("" : "+s"(M), "+s"(N), "+s"(K));
    pg8::Gemm g{A, Bt, M, N, K};
    pg8::StaticOrder S; S.init(M, N, (int)gridDim.x, (int)((blockIdx.x + cshift) % gridDim.x));
    pg8::gemm_phase<Epi, pg8::StaticOrder, false>(lds, g, S, E, nullptr);
}

struct TItem { const float* src; bf16_t* dst; int ldw, K, k0, srcc, dstr; };
constexpr int I_IN = 16 * 112, I_SQ = 16 * 32, I_KV = 16 * 64, I_GU = 16 * 176, I_DN = 44 * 32, I_RG = 16;
constexpr int I_PER = I_IN + 3 * I_SQ + I_KV + I_GU + I_DN + I_RG;
__device__ __forceinline__ bool titem(PRM p, int it, TItem& T) {
    if (it >= NL * I_PER) return false;
    const int l = it / I_PER; int r = it % I_PER;
    unsigned char* ws = p.ws;
    if (r < I_IN) { const int kb = r / 112, n0 = (r % 112) * 32; T.src = p.in[17] + (size_t)l * D * DIN; T.ldw = DIN; T.K = D; T.k0 = kb * 64; T.srcc = n0 < 1024 ? n0 : n0 + 4;
        T.dst = (bf16_t*)(ws + OFF_WIN) + (size_t)l * NU * D; T.dstr = n0; return true; }
    r -= I_IN;
    if (r < 3 * I_SQ) { const int which = r / I_SQ; r %= I_SQ; const int kb = r / 32, n0 = (r % 32) * 32;
        T.src = p.in[which == 0 ? 34 : (which == 1 ? 36 : 38)] + (size_t)l * D * D; T.ldw = D; T.K = D; T.k0 = kb * 64; T.srcc = n0;
        T.dst = (bf16_t*)(ws + (which == 0 ? OFF_WOUT : (which == 1 ? OFF_WXQ : OFF_WXO))) + (size_t)l * D * D; T.dstr = n0; return true; }
    r -= 3 * I_SQ;
    if (r < I_KV) { const int kb = r / 64, n0 = (r % 64) * 32; T.src = p.in[37] + (size_t)l * D * 2048; T.ldw = 2048; T.K = D; T.k0 = kb * 64; T.srcc = n0;
        T.dst = (bf16_t*)(ws + OFF_WXKV) + (size_t)l * 2048 * D; T.dstr = n0; return true; }
    r -= I_KV;
    if (r < I_GU) { const int kb = r / 176, n0 = (r % 176) * 32; const int pn = n0 >> 8, bj = (n0 & 255) >> 7, j = n0 & 127;
        T.src = p.in[39] + (size_t)l * D * 5632; T.ldw = 5632; T.K = D; T.k0 = kb * 64; T.srcc = bj * DFF + pn * 128 + j;
        T.dst = (bf16_t*)(ws + OFF_WGU) + (size_t)l * 5632 * D; T.dstr = n0; return true; }
    r -= I_GU;
    if (r < I_DN) { const int kb = r / 32, n0 = (r % 32) * 32; T.src = p.in[40] + (size_t)l * DFF * D; T.ldw = D; T.K = DFF; T.k0 = kb * 64; T.srcc = n0;
        T.dst = (bf16_t*)(ws + OFF_WDN) + (size_t)l * D * DFF; T.dstr = n0; return true; }
    r -= I_DN;
    { const int gate = r >> 3, blk = (r & 7) >> 1, nb = r & 1;
        T.src = p.in[gate ? 29 : 27] + (size_t)(l * 4 + blk) * 4096; T.ldw = 64; T.K = 64; T.k0 = 0; T.srcc = nb * 32;
        T.dst = (bf16_t*)(ws + OFF_WRG) + (size_t)((l * 2 + gate) * 4 + blk) * 4096; T.dstr = nb * 32; return true; }
}

__device__ __forceinline__ void rows_phase(LAS unsigned char* lds, int nrows, const float* xp, const float* xs, float* X, const bf16_t* M, const float* gpost,
                                           const float* gpre, bf16_t* H, const float* wdt, float* SDT) {
    const int tid = tidx(), lane = tid & 63, wave = tid >> 6;
    const int gw = blockIdx.x * 8 + wave, NGW = gridDim.x * 8;
    LAS float* wl = (LAS float*)lds;
    if (wdt) { for (int i = tid; i < 4096; i += NTHR) wl[i] = wdt[(size_t)(i >> 2) * DIN + 1024 + (i & 3)]; __syncthreads(); }
    constexpr int NR = 4;
    for (int rowb = gw; rowb < nrows; rowb += NR * NGW) {
        f32x4 v[NR][4], m[NR][4];
        bool ok[NR];
#pragma unroll
        for (int q = 0; q < NR; ++q) { const int row = rowb + q * NGW; ok[q] = row < nrows;
            if (ok[q]) {
                const float* xr = xp ? (row < TP ? xp + (size_t)row * D : xs + (size_t)(row - TP) * D) : X + (size_t)row * D;
#pragma unroll
                for (int j = 0; j < 4; ++j) v[q][j] = ((const f32x4*)xr)[lane + 64 * j];
                if (M) {
#pragma unroll
                    for (int j = 0; j < 4; ++j) { const u32x2 w = ((const u32x2*)(M + (size_t)row * D))[lane + 64 * j];
                        m[q][j] = (f32x4){__uint_as_float(w.x << 16), __uint_as_float(w.x & 0xffff0000u), __uint_as_float(w.y << 16), __uint_as_float(w.y & 0xffff0000u)}; }
                }
            } }
#pragma unroll
        for (int q = 0; q < NR; ++q) { const int row = rowb + q * NGW;
            if (!ok[q]) continue;
            if (M) {
                float ss = 0.f;
#pragma unroll
                for (int j = 0; j < 4; ++j) ss += m[q][j].x * m[q][j].x + m[q][j].y * m[q][j].y + m[q][j].z * m[q][j].z + m[q][j].w * m[q][j].w;
                const float rstd = 1.0f / sqrtf(wave_sum(ss) * (1.0f / D) + EPS);
#pragma unroll
                for (int j = 0; j < 4; ++j) { const f32x4 g = ((const f32x4*)gpost)[lane + 64 * j]; v[q][j] = v[q][j] + m[q][j] * rstd * g; }
            }
            if (X && (M || xp)) {
#pragma unroll
                for (int j = 0; j < 4; ++j) ((f32x4*)(X + (size_t)row * D))[lane + 64 * j] = v[q][j];
            }
            if (gpre) {
                float ss = 0.f;
#pragma unroll
                for (int j = 0; j < 4; ++j) ss += v[q][j].x * v[q][j].x + v[q][j].y * v[q][j].y + v[q][j].z * v[q][j].z + v[q][j].w * v[q][j].w;
                const float rstd = 1.0f / sqrtf(wave_sum(ss) * (1.0f / D) + EPS);
                float d0 = 0.f, d1 = 0.f, d2 = 0.f, d3 = 0.f;
#pragma unroll
                for (int j = 0; j < 4; ++j) {
                    const f32x4 g = ((const f32x4*)gpre)[lane + 64 * j]; const f32x4 h = v[q][j] * rstd * g;
                    u32x2 w; w.x = pk2(h.x, h.y); w.y = pk2(h.z, h.w);
                    ((u32x2*)(H + (size_t)row * D))[lane + 64 * j] = w;
                    if (wdt) {
#pragma unroll
                        for (int e = 0; e < 4; ++e) { const f32x4 wv = *(const LAS f32x4*)(wl + 4 * (4 * (lane + 64 * j) + e)); const float he = h[e];
                            d0 += he * wv.x; d1 += he * wv.y; d2 += he * wv.z; d3 += he * wv.w; }
                    }
                }
                if (wdt) { d0 = wave_sum(d0); d1 = wave_sum(d1); d2 = wave_sum(d2); d3 = wave_sum(d3);
                    if (lane == 0) { f32x4 o; o.x = d0; o.y = d1; o.z = d2; o.w = d3; *(f32x4*)(SDT + (size_t)row * 4) = o; } }
            }
        }
    }
    if (wdt) __syncthreads();
}

__device__ __forceinline__ void transposes(PRM p, LAS unsigned char* lds, int it_lo, int it_hi, int gwv, int ngw) {
    const int tid = tidx(), lane = tid & 63, wave = tid >> 6;
    LAS float* scr = (LAS float*)lds + wave * (64 * 33);
    for (int base = it_lo; base < it_hi; base += ngw) {
        TItem T; const bool ok = (base + gwv < it_hi) && titem(p, base + gwv, T);
        if (ok) {
            float tv[32];
#pragma unroll
            for (int i = 0; i < 32; ++i) tv[i] = T.src[(size_t)(T.k0 + 2 * i + (lane >> 5)) * T.ldw + T.srcc + (lane & 31)];
#pragma unroll
            for (int i = 0; i < 32; ++i) scr[(2 * i + (lane >> 5)) * 33 + (lane & 31)] = tv[i];
        }
        __syncthreads();
        if (ok) {
            const int c = lane & 7;
#pragma unroll
            for (int j = 0; j < 4; ++j) { const int n = (lane >> 3) + 8 * j; const LAS float* s = scr + (8 * c) * 33 + n;
                u32x4 o; o.x = pk2(s[0 * 33], s[1 * 33]); o.y = pk2(s[2 * 33], s[3 * 33]); o.z = pk2(s[4 * 33], s[5 * 33]); o.w = pk2(s[6 * 33], s[7 * 33]);
                *(u32x4*)(T.dst + (size_t)(T.dstr + n) * T.K + T.k0 + 8 * c) = o; }
        }
        __syncthreads();
    }
}

__device__ __forceinline__ void phase0(PRM p, LAS unsigned char* lds) {
    const int tid = tidx(), lane = tid & 63, wave = tid >> 6;
    const int gw = blockIdx.x * 8 + wave, NGW = gridDim.x * 8;
    transposes(p, lds, 0, NL * I_PER, gw, NGW);
    float* RC = (float*)(p.ws + OFF_ROPE); float* RS = RC + 2052 * 32;
    for (int i = blockIdx.x * NTHR + tid; i < 2052 * 32; i += gridDim.x * NTHR) {
        const int pi = i >> 5, j = i & 31;
        const double pos = pi < 2048 ? (double)pi : (double)(16384 + pi - 2048);
        const double inv = exp2(-(double)j * (13.287712379549449 / 32.0));
        const double ang = pos * inv;
        const double r = ang - 6.283185307179586 * rint(ang * 0.15915494309189535);
        const float rf = (float)r;
        RC[i] = cosf(rf); RS[i] = sinf(rf);
    }
    if (blockIdx.x == 0 && tid < 256) { const float a0 = p.in[32][tid], a1 = p.in[32][256 + tid]; const float mx = fmaxf(a0, a1), e0 = expf(a0 - mx), e1 = expf(a1 - mx);
        ((float*)(p.ws + OFF_LB))[tid] = 0.f; ((float*)(p.ws + OFF_LB))[256 + tid] = e1 / (e0 + e1); }
    rows_phase(lds, TT, p.in[0], p.in[1], nullptr, nullptr, nullptr, p.in[11], (bf16_t*)(p.ws + OFF_H), p.in[17], (float*)(p.ws + OFF_SDT));
    for (int l = 0; l < NL; ++l)
        rows_phase(lds, 2048, p.in[10], nullptr, nullptr, nullptr, nullptr, p.in[35] + l * D, (bf16_t*)(p.ws + OFF_HM) + (size_t)l * 2048 * D, nullptr, nullptr);
}
#define XB_TMO      128
#define XB_XCNT(j)  (256  + 64 * (j))
#define XB_XSUB(j)  (1280 + 64 * (j))
#define XB_XGEN(j)  (2304 + 64 * (j))
#define XB_TOP      3328
#define XB_TOPGEN   3392
#define XCD_BAR_WORDS 3456
#define XB_SPIN_CAP (1u << 18)

__device__ __forceinline__ unsigned xb_ld(unsigned* p)              { return __hip_atomic_load(p, __ATOMIC_RELAXED, __HIP_MEMORY_SCOPE_AGENT); }
__device__ __forceinline__ unsigned xb_add(unsigned* p, unsigned v) { return __hip_atomic_fetch_add(p, v, __ATOMIC_RELAXED, __HIP_MEMORY_SCOPE_AGENT); }
__device__ __forceinline__ unsigned xb_xcc_id() { return (unsigned)__builtin_amdgcn_s_getreg((3 << 11) | 20) & 0xFu; }
#define XB_SPIN(cond, bar) do { unsigned _sp = 0; while (cond) { __builtin_amdgcn_s_sleep(1); \
    if ((++_sp & 255u) == 0u) { if (xb_ld(&(bar)[XB_TMO])) break; if (_sp > XB_SPIN_CAP) { atomicAdd(&(bar)[XB_TMO], 1u); break; } } } } while (0)

struct XcdBarrier {
    unsigned* bar; unsigned x;
    volatile LAS unsigned* st;
};

__device__ __forceinline__ XcdBarrier xcd_barrier_post(unsigned* bar, volatile LAS unsigned* st) {
    XcdBarrier b; b.bar = bar; b.x = xb_xcc_id(); b.st = st;
    if (tidx() == 0) (void)xb_add(&bar[XB_XCNT(b.x)], 1u);
    return b;
}
__device__ __forceinline__ void xcd_barrier_complete(unsigned* bar, unsigned x, unsigned& nloc, unsigned& nx) {
    const unsigned G = gridDim.x * gridDim.y * gridDim.z;
    unsigned sum, cnt, mine, sp = 0u;
    for (;;) {
        sum = 0u; cnt = 0u; mine = 0u;
#pragma unroll
        for (unsigned j = 0; j < 16; ++j) { const unsigned c = xb_ld(&bar[XB_XCNT(j)]); sum += c; cnt += (c > 0u) ? 1u : 0u; mine = (j == x) ? c : mine; }
        if (sum == G) break;
        __builtin_amdgcn_s_sleep(1);
        if ((++sp & 255u) == 0u) { if (xb_ld(&bar[XB_TMO])) break; if (sp > XB_SPIN_CAP) { atomicAdd(&bar[XB_TMO], 1u); break; } }
    }
    nloc = mine > 0u ? mine : 1u; nx = cnt > 0u ? cnt : 1u;
}

__device__ __forceinline__ void xcd_barrier(const XcdBarrier& b) {
    asm volatile("s_waitcnt vmcnt(0)" ::: "memory");
    __syncthreads();
    if (tidx() == 0) {
        unsigned* bar = b.bar;
        __builtin_amdgcn_s_waitcnt(0);
        unsigned nloc = b.st[0], nx = b.st[1];
        if (nloc == 0u) { xcd_barrier_complete(bar, b.x, nloc, nx); b.st[0] = nloc; b.st[1] = nx; }
        const unsigned old = xb_add(&bar[XB_XSUB(b.x)], 1u);
        const unsigned gen = old / nloc;
        if (old + 1u == (gen + 1u) * nloc) {
            __builtin_amdgcn_fence(__ATOMIC_RELEASE, "agent");
            asm volatile("s_waitcnt vmcnt(0)" ::: "memory");
            const unsigned og = xb_add(&bar[XB_TOP], 1u);
            const unsigned tg = og / nx;
            if (og + 1u == (tg + 1u) * nx) xb_add(&bar[XB_TOPGEN], 1u);
            else XB_SPIN(xb_ld(&bar[XB_TOPGEN]) == tg, bar);
            __builtin_amdgcn_fence(__ATOMIC_ACQUIRE, "agent");
            xb_add(&bar[XB_XGEN(b.x)], 1u);
            asm volatile("s_waitcnt vmcnt(0)" ::: "memory");
        } else {
            XB_SPIN(xb_ld(&bar[XB_XGEN(b.x)]) == gen, bar);
            __builtin_amdgcn_fence(__ATOMIC_ACQUIRE, "agent");
            asm volatile("s_waitcnt vmcnt(0)" ::: "memory");
        }
    }
    __syncthreads();
}


template <int NTOK>
__device__ __forceinline__ void conv_run(const bf16_t* Ucol, bool hist_ok, float w0, float w1, float w2, float w3, float bias, float (&out)[NTOK]) {
    float x3 = 0.f, x2 = 0.f, x1 = 0.f;
    if (hist_ok) { x3 = bf2f(Ucol[-3 * NU]); x2 = bf2f(Ucol[-2 * NU]); x1 = bf2f(Ucol[-NU]); }
#pragma unroll
    for (int i = 0; i < NTOK; ++i) { const float x0 = bf2f(Ucol[i * NU]); out[i] = bias + w0 * x3 + w1 * x2 + w2 * x1 + w3 * x0; x3 = x2; x2 = x1; x1 = x0; }
}
__device__ __forceinline__ float scan64_add(float v, int lane) {
#pragma unroll
    for (int d = 1; d < 64; d <<= 1) { const float t = __shfl_up(v, d); if (lane >= d) v += t; }
    return v;
}


__device__ __forceinline__ void unpack8(const u32x4 w, float (&f)[8]) {
    f[0] = __uint_as_float(w.x << 16); f[1] = __uint_as_float(w.x & 0xffff0000u); f[2] = __uint_as_float(w.y << 16); f[3] = __uint_as_float(w.y & 0xffff0000u);
    f[4] = __uint_as_float(w.z << 16); f[5] = __uint_as_float(w.z & 0xffff0000u); f[6] = __uint_as_float(w.w << 16); f[7] = __uint_as_float(w.w & 0xffff0000u);
}
__device__ __forceinline__ u32x4 pack8(const float (&f)[8]) { u32x4 w; w.x = pk2(f[0], f[1]); w.y = pk2(f[2], f[3]); w.z = pk2(f[4], f[5]); w.w = pk2(f[6], f[7]); return w; }
__device__ __forceinline__ u32x4 ldg8(const bf16_t* p) { return *(const u32x4*)p; }
__device__ __forceinline__ bf16_t elem8(const u32x4 w, int i) { const unsigned x = (i >> 1) == 0 ? w.x : ((i >> 1) == 1 ? w.y : ((i >> 1) == 2 ? w.z : w.w)); return (bf16_t)((i & 1) ? (x >> 16) : (x & 0xffffu)); }
__device__ __forceinline__ void ld8f(const float* p, float (&f)[8]) { const f32x4 a = *(const f32x4*)p, b = *(const f32x4*)(p + 4); f[0] = a.x; f[1] = a.y; f[2] = a.z; f[3] = a.w; f[4] = b.x; f[5] = b.y; f[6] = b.z; f[7] = b.w; }
template <int NT>
__device__ __forceinline__ void conv8(const u32x4 (&rows)[NT + 3], const float (&w)[4][8], const float (&bias)[8], float (&o)[NT][8]) {
    float x[NT + 3][8];
#pragma unroll
    for (int r = 0; r < NT + 3; ++r) unpack8(rows[r], x[r]);
#pragma unroll
    for (int t = 0; t < NT; ++t)
#pragma unroll
        for (int i = 0; i < 8; ++i) o[t][i] = bias[i] + w[0][i] * x[t][i] + w[1][i] * x[t + 1][i] + w[2][i] * x[t + 2][i] + w[3][i] * x[t + 3][i];
}

__device__ __forceinline__ void ssd_passA(PRM p, LAS unsigned char* lds, int l, int u) {
    const int tid = tidx(), lane = tid & 63, wave = tid >> 6;
    const int c = u & 31, g = (u >> 5) & 1, b = u >> 6, row0 = b * 2048 + c * 64;
    const bf16_t* U = (const bf16_t*)(p.ws + OFF_U); const float* SDT = (const float*)(p.ws + OFF_SDT);
    LAS float* DT = (LAS float*)lds; LAS float* CU = DT + 128;
    LAS bf16_t* BT = (LAS bf16_t*)(lds + 1024); LAS bf16_t* VT = (LAS bf16_t*)(lds + 1024 + 18432);
    const int chl0 = (tid & 31) * 8, t0 = (tid >> 5) * 4;
    const int xc0 = chl0 < 128 ? g * 128 + chl0 : 256 + g * 128 + (chl0 - 128);
    u32x4 rows[7];
#pragma unroll
    for (int r = 0; r < 7; ++r) { const int t = t0 - 3 + r; rows[r] = (c > 0 || t >= 0) ? ldg8(U + (size_t)(row0 + t) * NU + UXBC + xc0) : (u32x4){0u, 0u, 0u, 0u}; }
    float w[4][8], bias[8];
#pragma unroll
    for (int j = 0; j < 4; ++j) ld8f(p.in[18] + (size_t)(l * 4 + j) * 768 + xc0, w[j]);
    ld8f(p.in[19] + l * 768 + xc0, bias);
    if (wave < 2) {
        const int h = 2 * g + wave;
        const float dt = softplusf_(SDT[(size_t)(row0 + lane) * 4 + h] + p.in[20][l * 4 + h]);
        const float cum = scan64_add(-expf(p.in[21][l * 4 + h]) * dt, lane);
        DT[wave * 64 + lane] = dt; CU[wave * 64 + lane] = cum;
    }
    float o[4][8]; conv8<4>(rows, w, bias, o);
    __syncthreads();
    if (chl0 < 128) { const int hh = chl0 >> 6; const float last = CU[hh * 64 + 63];
#pragma unroll
        for (int tt = 0; tt < 4; ++tt) { const int t = t0 + tt; const float sc = DT[hh * 64 + t] * __expf(last - CU[hh * 64 + t]);
#pragma unroll
            for (int i = 0; i < 8; ++i) VT[(chl0 + i) * 72 + t] = f2bf(siluf_(o[tt][i]) * sc); }
    } else { const int n0 = chl0 - 128;
#pragma unroll
        for (int tt = 0; tt < 4; ++tt)
#pragma unroll
            for (int i = 0; i < 8; ++i) BT[(n0 + i) * 72 + t0 + tt] = f2bf(siluf_(o[tt][i]));
    }
    __syncthreads();
    f32x4 acc[8];
#pragma unroll
    for (int j = 0; j < 8; ++j) acc[j] = (f32x4){0.f, 0.f, 0.f, 0.f};
    mm_nt<8, 2>(acc, BT + 16 * wave * 72, 72, VT, 72, lane);
    bf16_t* DS = (bf16_t*)(p.ws + OFF_DSS);
#pragma unroll
    for (int jj = 0; jj < 8; ++jj) { const int h = 2 * g + (jj >> 2), pc = (jj & 3) * 16 + (lane & 15);
#pragma unroll
        for (int e = 0; e < 4; ++e) { const int n = 16 * wave + (lane >> 4) * 4 + e; DS[(((size_t)(b * 4 + h) * 32 + c) * 128 + n) * 64 + pc] = f2bf(acc[jj][e]); } }
    if (tid < 2) ((float*)(p.ws + OFF_DECS))[(b * 4 + 2 * g + tid) * 32 + c] = __expf(CU[tid * 64 + 63]);
    __syncthreads();
}

__device__ __forceinline__ void ssd_passC(PRM p, LAS unsigned char* lds, int l, int u) {
    const int tid = tidx(), lane = tid & 63, wave = tid >> 6;
    const int c = u & 31, b = u >> 5, row0 = b * 2048 + c * 64;
    const bf16_t* U = (const bf16_t*)(p.ws + OFF_U); const float* SDT = (const float*)(p.ws + OFF_SDT);
    const bf16_t* DS = (const bf16_t*)(p.ws + OFF_DSS);
    bf16_t* YC = (bf16_t*)(p.ws + OFF_YC);
    LAS float* DT = (LAS float*)lds; LAS float* CU = (LAS float*)(lds + 1024); LAS float* SSQ = (LAS float*)(lds + 2048);
    LAS bf16_t* CM = (LAS bf16_t*)(lds + 3072); LAS bf16_t* BM = (LAS bf16_t*)(lds + 20480); LAS bf16_t* VT = (LAS bf16_t*)(lds + 37888);
    LAS bf16_t* PP = (LAS bf16_t*)(lds + 56320); LAS bf16_t* SINT = (LAS bf16_t*)(lds + 74752);
    if (wave < 4) {
        const int h = wave;
        const float dt = softplusf_(SDT[(size_t)(row0 + lane) * 4 + h] + p.in[20][l * 4 + h]);
        const float cum = scan64_add(-expf(p.in[21][l * 4 + h]) * dt, lane);
        DT[h * 64 + lane] = dt; CU[h * 64 + lane] = cum;
    }
    f32x4 yv[2][4];
#pragma unroll
    for (int g = 0; g < 2; ++g) {
        {
            u32x4 sv[4];
#pragma unroll
            for (int i = 0; i < 4; ++i) { const int idx8 = tid + i * NTHR, hh = idx8 >> 10, rem = idx8 & 1023, n = rem >> 3, p0 = (rem & 7) * 8;
                sv[i] = ldg8(DS + (((size_t)(b * 4 + 2 * g + hh) * 32 + c) * 128 + n) * 64 + p0); }
#pragma unroll
            for (int it = 0; it < 2; ++it) { const int item = tid + it * NTHR;
                if (item < 768) {
                    const int chl0 = (item % 48) * 8, t0 = (item / 48) * 4, which = chl0 >> 7, n0 = chl0 & 127, xc0 = which * 256 + g * 128 + n0;
                    u32x4 rows[7];
#pragma unroll
                    for (int r = 0; r < 7; ++r) { const int t = t0 - 3 + r; rows[r] = (c > 0 || t >= 0) ? ldg8(U + (size_t)(row0 + t) * NU + UXBC + xc0) : (u32x4){0u, 0u, 0u, 0u}; }
                    float w[4][8], bias[8];
#pragma unroll
                    for (int j = 0; j < 4; ++j) ld8f(p.in[18] + (size_t)(l * 4 + j) * 768 + xc0, w[j]);
                    ld8f(p.in[19] + l * 768 + xc0, bias);
                    float o[4][8]; conv8<4>(rows, w, bias, o);
                    if (which == 0) {
#pragma unroll
                        for (int tt = 0; tt < 4; ++tt)
#pragma unroll
                            for (int i = 0; i < 8; ++i) VT[(n0 + i) * 72 + t0 + tt] = f2bf(siluf_(o[tt][i]));
                    } else { LAS bf16_t* dstp = which == 1 ? BM : CM;
#pragma unroll
                        for (int tt = 0; tt < 4; ++tt) { float sv8[8];
#pragma unroll
                            for (int i = 0; i < 8; ++i) sv8[i] = siluf_(o[tt][i]);
                            *(LAS u32x4*)(dstp + (t0 + tt) * 136 + n0) = pack8(sv8); }
                    }
                } }
#pragma unroll
            for (int i = 0; i < 4; ++i) { const int idx8 = tid + i * NTHR, hh = idx8 >> 10, rem = idx8 & 1023, n = rem >> 3, p0 = (rem & 7) * 8;
#pragma unroll
                for (int e = 0; e < 8; ++e) SINT[(hh * 64 + p0 + e) * 136 + n] = elem8(sv[i], e); }
        }
        __syncthreads();
        {
            const int rt = wave & 3, ct0 = (wave >> 2) * 2;
            f32x4 sc[2]; sc[0] = (f32x4){0.f, 0.f, 0.f, 0.f}; sc[1] = sc[0];
            mm_nt<2, 4>(sc, CM + 16 * rt * 136, 136, BM + 16 * ct0 * 136, 136, lane);
#pragma unroll
            for (int hh = 0; hh < 2; ++hh) { const int h = 2 * g + hh;
#pragma unroll
                for (int jj = 0; jj < 2; ++jj)
#pragma unroll
                    for (int e = 0; e < 4; ++e) { const int t = 16 * rt + (lane >> 4) * 4 + e, s = 16 * (ct0 + jj) + (lane & 15);
                        const float val = s <= t ? sc[jj][e] * __expf(CU[h * 64 + t] - CU[h * 64 + s]) * DT[h * 64 + s] : 0.f;
                        PP[(hh * 64 + t) * 72 + s] = f2bf(val); } }
        }
        __syncthreads();
        {
            const int hh = wave >> 2, rt = wave & 3, h = 2 * g + hh;
            float zv[4][4];
#pragma unroll
            for (int e = 0; e < 4; ++e)
#pragma unroll
                for (int j = 0; j < 4; ++j) zv[e][j] = bf2f(U[(size_t)(row0 + 16 * rt + (lane >> 4) * 4 + e) * NU + UZ + h * 64 + 16 * j + (lane & 15)]);
#pragma unroll
            for (int j = 0; j < 4; ++j) yv[g][j] = (f32x4){0.f, 0.f, 0.f, 0.f};
            mm_nt<4, 4>(yv[g], CM + 16 * rt * 136, 136, SINT + hh * 64 * 136, 136, lane);
#pragma unroll
            for (int e = 0; e < 4; ++e) { const float sc = __expf(CU[h * 64 + 16 * rt + (lane >> 4) * 4 + e]);
#pragma unroll
                for (int j = 0; j < 4; ++j) yv[g][j][e] *= sc; }
            mm_nt<4, 2>(yv[g], PP + (hh * 64 + 16 * rt) * 72, 72, VT + hh * 64 * 72, 72, lane);
            const float Dh = p.in[22][l * 4 + h];
#pragma unroll
            for (int e = 0; e < 4; ++e) { const int t = 16 * rt + (lane >> 4) * 4 + e; float s2 = 0.f;
#pragma unroll
                for (int j = 0; j < 4; ++j) { const int pc = 16 * j + (lane & 15);
                    const float xs = bf2f(VT[(hh * 64 + pc) * 72 + t]);
                    const float v = (yv[g][j][e] + Dh * xs) * siluf_(zv[e][j]); yv[g][j][e] = v; s2 += v * v; }
                s2 += __shfl_xor(s2, 1); s2 += __shfl_xor(s2, 2); s2 += __shfl_xor(s2, 4); s2 += __shfl_xor(s2, 8);
                if ((lane & 15) == 0) SSQ[t * 4 + h] = s2; }
        }
        __syncthreads();
    }
#pragma unroll
    for (int g = 0; g < 2; ++g) { const int hh = wave >> 2, rt = wave & 3, h = 2 * g + hh;
#pragma unroll
        for (int e = 0; e < 4; ++e) { const int t = 16 * rt + (lane >> 4) * 4 + e;
            const float tot = SSQ[t * 4 + 0] + SSQ[t * 4 + 1] + SSQ[t * 4 + 2] + SSQ[t * 4 + 3];
            const float rstd = 1.0f / sqrtf(tot * (1.0f / 256.0f) + EPS);
#pragma unroll
            for (int j = 0; j < 4; ++j) { const int pc = 16 * j + (lane & 15);
                YC[(size_t)(row0 + t) * D + h * 64 + pc] = f2bf(yv[g][j][e] * rstd * p.in[23][l * 256 + h * 64 + pc]); } } }
    if (c == 31) for (int idx = tid; idx < 2304; idx += NTHR) { const int r = idx / 768, ch = idx % 768;
        p.out[O_PSSDC + ((size_t)(l * 8 + b) * 3 + r) * 768 + ch] = bf2f(U[(size_t)(b * 2048 + 2045 + r) * NU + UXBC + ch]); }
    __syncthreads();
}

constexpr int E_CUM = 0, E_QS = 16640, E_QD = 25856, E_KV = 35072, E_VT = 71936, E_SINT = 81152, E_PP = 90368, E_KWT = 99584, E_RSC = 108800, E_SSQ = 109056;
__device__ __forceinline__ void engineA(LAS unsigned char* lds, bf16_t* DS, int wave, int lane) {
    const LAS bf16_t* KWT = (const LAS bf16_t*)(lds + E_KWT); const LAS bf16_t* VT = (const LAS bf16_t*)(lds + E_VT);
    const int rt = wave >> 1, ct0 = (wave & 1) * 2;
    f32x4 acc[2]; acc[0] = (f32x4){0.f, 0.f, 0.f, 0.f}; acc[1] = acc[0];
    mm_nt<2, 2>(acc, KWT + 16 * rt * 72, 72, VT + 16 * ct0 * 72, 72, lane);
#pragma unroll
    for (int jj = 0; jj < 2; ++jj)
#pragma unroll
        for (int e = 0; e < 4; ++e) DS[(16 * rt + (lane >> 4) * 4 + e) * 64 + 16 * (ct0 + jj) + (lane & 15)] = f2bf(acc[jj][e]);
}
template <bool RET>
__device__ __forceinline__ void engineC(LAS unsigned char* lds, int qd_off, int kvstride, float lg, f32x4 (&y)[2], int wave, int lane) {
    const LAS bf16_t* QS = (const LAS bf16_t*)(lds + E_QS); const LAS bf16_t* QD = (const LAS bf16_t*)(lds + qd_off);
    const LAS bf16_t* KV = (const LAS bf16_t*)(lds + E_KV); const LAS bf16_t* VT = (const LAS bf16_t*)(lds + E_VT);
    const LAS bf16_t* SINT = (const LAS bf16_t*)(lds + E_SINT); LAS bf16_t* PP = (LAS bf16_t*)(lds + E_PP); const LAS float* RSC = (const LAS float*)(lds + E_RSC);
    const int rt = wave >> 1, ct0 = (wave & 1) * 2;
    f32x4 sc[2]; sc[0] = (f32x4){0.f, 0.f, 0.f, 0.f}; sc[1] = sc[0];
    mm_nt<2, 2>(sc, QS + 16 * rt * 72, 72, KV + kvstride * rt + 16 * ct0 * 72, 72, lane);
#pragma unroll
    for (int jj = 0; jj < 2; ++jj)
#pragma unroll
        for (int e = 0; e < 4; ++e) { const int t = 16 * rt + (lane >> 4) * 4 + e, s = 16 * (ct0 + jj) + (lane & 15);
            float val = 0.f; if (s <= t) val = RET ? sc[jj][e] * __expf((float)(t - s) * lg) : sc[jj][e];
            PP[t * 72 + s] = f2bf(val); }
    __syncthreads();
    y[0] = (f32x4){0.f, 0.f, 0.f, 0.f}; y[1] = y[0];
    mm_nt<2, 2>(y, QD + 16 * rt * 72, 72, SINT + 16 * ct0 * 72, 72, lane);
#pragma unroll
    for (int e = 0; e < 4; ++e) { const float r = RSC[16 * rt + (lane >> 4) * 4 + e]; y[0][e] *= r; y[1][e] *= r; }
    mm_nt<2, 2>(y, PP + 16 * rt * 72, 72, VT + 16 * ct0 * 72, 72, lane);
}
template <bool CENTER>
__device__ __forceinline__ void headnorm_store(LAS unsigned char* lds, const f32x4 (&y)[2], int wave, int lane, const float (&gate)[8], const float (&gain)[2], bf16_t* outp) {
    LAS f32x2* SSQ = (LAS f32x2*)(lds + E_SSQ);
    const int rt = wave >> 1, half = wave & 1, ct0 = half * 2;
#pragma unroll
    for (int e = 0; e < 4; ++e) { float s1 = y[0][e] + y[1][e], s2 = y[0][e] * y[0][e] + y[1][e] * y[1][e];
#pragma unroll
        for (int o = 1; o < 16; o <<= 1) { s1 += __shfl_xor(s1, o); s2 += __shfl_xor(s2, o); }
        if ((lane & 15) == 0) SSQ[(16 * rt + (lane >> 4) * 4 + e) * 2 + half] = (f32x2){s1, s2}; }
    __syncthreads();
#pragma unroll
    for (int e = 0; e < 4; ++e) { const int t = 16 * rt + (lane >> 4) * 4 + e;
        const f32x2 a = SSQ[t * 2], b2 = SSQ[t * 2 + 1];
        const float mean = CENTER ? (a.x + b2.x) * (1.0f / 64.0f) : 0.f;
        const float var = (a.y + b2.y) * (1.0f / 64.0f) - mean * mean;
        const float rstd = 1.0f / sqrtf(fmaxf(var, 0.f) + EPS);
#pragma unroll
        for (int jj = 0; jj < 2; ++jj) { const int pc = 16 * (ct0 + jj) + (lane & 15);
            outp[(size_t)t * D + pc] = f2bf((y[jj][e] - mean) * rstd * gain[jj] * siluf_(gate[e * 2 + jj])); } }
}
__device__ __forceinline__ void headnorm_prefetch(int wave, int lane, const bf16_t* Ugate, const float* gainp, float (&gate)[8], float (&gain)[2]) {
    const int rt = wave >> 1, ct0 = (wave & 1) * 2;
#pragma unroll
    for (int jj = 0; jj < 2; ++jj) { const int pc = 16 * (ct0 + jj) + (lane & 15); gain[jj] = gainp[pc];
#pragma unroll
        for (int e = 0; e < 4; ++e) gate[e * 2 + jj] = bf2f(Ugate[(size_t)(16 * rt + (lane >> 4) * 4 + e) * NU + pc]); }
}

struct RetRegs { u32x4 vraw, x1, x2, dsraw; float cs[8], sn[8], gate[8], gain[2]; };
template <bool PASSC>
__device__ __forceinline__ void ret_load(PRM p, int l, int u, RetRegs& r) {
    const int tid = tidx(), lane = tid & 63, wave = tid >> 6;
    const int h = u & 3, c = (u >> 2) & 31, b = u >> 7, row0 = b * 2048 + c * 64;
    const bf16_t* U = (const bf16_t*)(p.ws + OFF_U);
    const float* RC = (const float*)(p.ws + OFF_ROPE); const float* RS = RC + 2052 * 32;
    const bf16_t* DS = (const bf16_t*)(p.ws + OFF_DSR) + ((size_t)(b * 4 + h) * 32 + c) * 4096;
    const int t = tid >> 3, c8 = (tid & 7) * 8, isq = tid >> 8, tt = (tid & 255) >> 2, j0 = (tid & 3) * 8;
    r.vraw = ldg8(U + (size_t)(row0 + t) * NU + URV + h * 64 + c8); r.dsraw = (u32x4){0u, 0u, 0u, 0u};
    if (PASSC) { r.dsraw = ldg8(DS + t * 64 + c8); headnorm_prefetch(wave, lane, U + (size_t)row0 * NU + URG + h * 64, p.in[24] + l * 256 + h * 64, r.gate, r.gain); }
    r.x1 = (u32x4){0u, 0u, 0u, 0u}; r.x2 = r.x1;
    if (PASSC || isq == 0) { const bf16_t* ur = U + (size_t)(row0 + tt) * NU + (isq ? URQ : URK) + h * 64 + j0; r.x1 = ldg8(ur); r.x2 = ldg8(ur + 32);
        ld8f(RC + (size_t)(c * 64 + tt) * 32 + j0, r.cs); ld8f(RS + (size_t)(c * 64 + tt) * 32 + j0, r.sn); }
}
template <bool PASSC>
__device__ __forceinline__ void ret_body(PRM p, LAS unsigned char* lds, int l, int u, const RetRegs& r) {
    const int tid = tidx(), lane = tid & 63, wave = tid >> 6;
    const int h = u & 3, c = (u >> 2) & 31, b = u >> 7, row0 = b * 2048 + c * 64;
    const float lg = logf(1.0f - exp2f(-5.0f - (float)h));
    LAS bf16_t* QS = (LAS bf16_t*)(lds + E_QS); LAS bf16_t* KV = (LAS bf16_t*)(lds + E_KV); LAS bf16_t* VT = (LAS bf16_t*)(lds + E_VT);
    LAS bf16_t* SINT = (LAS bf16_t*)(lds + E_SINT); LAS bf16_t* KWT = (LAS bf16_t*)(lds + E_KWT); LAS float* RSC = (LAS float*)(lds + E_RSC);
    bf16_t* DS = (bf16_t*)(p.ws + OFF_DSR) + ((size_t)(b * 4 + h) * 32 + c) * 4096;
    const int t = tid >> 3, c8 = (tid & 7) * 8, isq = tid >> 8, tt = (tid & 255) >> 2, j0 = (tid & 3) * 8;
#pragma unroll
    for (int i = 0; i < 8; ++i) VT[(c8 + i) * 72 + t] = elem8(r.vraw, i);
    if (PASSC) {
#pragma unroll
        for (int i = 0; i < 8; ++i) SINT[(c8 + i) * 72 + t] = elem8(r.dsraw, i);
        if (tid < 64) RSC[tid] = __expf((float)(tid + 1) * lg);
    }
    if (PASSC || isq == 0) {
        float a[8], bb[8], ra[8], rb[8]; unpack8(r.x1, a); unpack8(r.x2, bb);
        const float scl = isq ? 1.0f : 0.125f;
#pragma unroll
        for (int i = 0; i < 8; ++i) { ra[i] = (a[i] * r.cs[i] - bb[i] * r.sn[i]) * scl; rb[i] = (bb[i] * r.cs[i] + a[i] * r.sn[i]) * scl; }
        if (PASSC) { LAS bf16_t* dst = isq ? QS : KV;
            *(LAS u32x4*)(dst + tt * 72 + j0) = pack8(ra); *(LAS u32x4*)(dst + tt * 72 + j0 + 32) = pack8(rb);
        } else { const float w = __expf((float)(63 - tt) * lg);
#pragma unroll
            for (int i = 0; i < 8; ++i) { KWT[(j0 + i) * 72 + tt] = f2bf(ra[i] * w); KWT[(j0 + 32 + i) * 72 + tt] = f2bf(rb[i] * w); } }
    }
    __syncthreads();
    if (PASSC) {
        f32x4 y[2]; engineC<true>(lds, E_QS, 0, lg, y, wave, lane);
        headnorm_store<true>(lds, y, wave, lane, r.gate, r.gain, (bf16_t*)(p.ws + OFF_YC) + (size_t)row0 * D + 256 + h * 64);
    } else engineA(lds, DS, wave, lane);
    __syncthreads();
}

struct HgRegs { u32x4 hfraw, viraw, hqraw, dsraw; float lb[8], gate[8], gain[2]; };
template <bool PASSC>
__device__ __forceinline__ void hg_load(PRM p, int l, int u, HgRegs& r) {
    const int tid = tidx(), lane = tid & 63, wave = tid >> 6;
    const int h = u & 3, c = (u >> 2) & 31, b = u >> 7, row0 = b * 2048 + c * 64;
    const bf16_t* U = (const bf16_t*)(p.ws + OFF_U);
    const bf16_t* DS = (const bf16_t*)(p.ws + OFF_DSH) + ((size_t)(b * 4 + h) * 32 + c) * 4096;
    const int t = tid >> 3, c8 = (tid & 7) * 8;
    const bf16_t* ur = U + (size_t)(row0 + t) * NU + h * 64 + c8;
    r.hfraw = ldg8(ur + UHF); r.viraw = ldg8(ur + UHI); r.hqraw = (u32x4){0u, 0u, 0u, 0u}; r.dsraw = r.hqraw;
    if (PASSC) { r.hqraw = ldg8(ur + UHQ); r.dsraw = ldg8(DS + t * 64 + c8); headnorm_prefetch(wave, lane, U + (size_t)row0 * NU + UHG + h * 64, p.in[33] + l * 256 + h * 64, r.gate, r.gain); }
    ld8f((const float*)(p.ws + OFF_LB) + l * 256 + h * 64 + c8, r.lb);
}
template <bool PASSC>
__device__ __forceinline__ void hg_body(PRM p, LAS unsigned char* lds, int l, int u, const HgRegs& r) {
    const int tid = tidx(), lane = tid & 63, wave = tid >> 6;
    const int h = u & 3, c = (u >> 2) & 31, b = u >> 7, row0 = b * 2048 + c * 64;
    LAS float* CUM = (LAS float*)(lds + E_CUM);
    LAS bf16_t* QS = (LAS bf16_t*)(lds + E_QS); LAS bf16_t* QD = (LAS bf16_t*)(lds + E_QD); LAS bf16_t* KV = (LAS bf16_t*)(lds + E_KV); LAS bf16_t* VT = (LAS bf16_t*)(lds + E_VT);
    LAS bf16_t* SINT = (LAS bf16_t*)(lds + E_SINT); LAS bf16_t* KWT = (LAS bf16_t*)(lds + E_KWT); LAS float* RSC = (LAS float*)(lds + E_RSC);
    bf16_t* DS = (bf16_t*)(p.ws + OFF_DSH) + ((size_t)(b * 4 + h) * 32 + c) * 4096;
    const int t = tid >> 3, c8 = (tid & 7) * 8;
#pragma unroll
    for (int i = 0; i < 8; ++i) VT[(c8 + i) * 72 + t] = elem8(r.viraw, i);
    if (PASSC) {
#pragma unroll
        for (int i = 0; i < 8; ++i) SINT[(c8 + i) * 72 + t] = elem8(r.dsraw, i);
        if (tid < 64) RSC[tid] = 1.0f;
    }
    float hf[8]; unpack8(r.hfraw, hf);
#pragma unroll
    for (int i = 0; i < 8; ++i) CUM[t * 65 + c8 + i] = __logf(r.lb[i] + (1.0f - r.lb[i]) * sigmoidf_(hf[i]));
    __syncthreads();
#pragma unroll
    for (int kk = 0; kk < 8; ++kk) { const int k = wave * 8 + kk; const float v = scan64_add(CUM[lane * 65 + k], lane); CUM[lane * 65 + k] = v; }
    __syncthreads();
    {
        float cum[8], kk_[8];
#pragma unroll
        for (int i = 0; i < 8; ++i) { cum[i] = CUM[t * 65 + c8 + i]; kk_[i] = (1.0f - r.lb[i]) * sigmoidf_(-hf[i]); }
        if (PASSC) {
            float q[8], qd[8], qs[8]; unpack8(r.hqraw, q); const int i_ = t >> 4;
#pragma unroll
            for (int i = 0; i < 8; ++i) { q[i] = siluf_(q[i]); const float ci0 = i_ ? CUM[(16 * i_ - 1) * 65 + c8 + i] : 0.f; qd[i] = q[i] * __expf(cum[i]); qs[i] = q[i] * __expf(cum[i] - ci0); }
            *(LAS u32x4*)(QD + t * 72 + c8) = pack8(qd); *(LAS u32x4*)(QS + t * 72 + c8) = pack8(qs);
#pragma unroll
            for (int i2 = 0; i2 < 4; ++i2) { float kv[8];
#pragma unroll
                for (int i = 0; i < 8; ++i) { float val = 0.f;
                    if (i2 >= i_) { const float c0 = i2 ? CUM[(16 * i2 - 1) * 65 + c8 + i] : 0.f; val = kk_[i] * __expf(fminf(c0 - cum[i], 60.f)); }
                    kv[i] = val; }
                *(LAS u32x4*)(KV + i2 * 4608 + t * 72 + c8) = pack8(kv); }
        } else {
#pragma unroll
            for (int i = 0; i < 8; ++i) KWT[(c8 + i) * 72 + t] = f2bf(kk_[i] * __expf(CUM[63 * 65 + c8 + i] - cum[i]));
            if (tid < 64) ((float*)(p.ws + OFF_DECH))[((size_t)(b * 4 + h) * 32 + c) * 64 + tid] = __expf(CUM[63 * 65 + tid]);
        }
    }
    __syncthreads();
    if (PASSC) {
        f32x4 y[2]; engineC<false>(lds, E_QD, 4608, 0.f, y, wave, lane);
        headnorm_store<false>(lds, y, wave, lane, r.gate, r.gain, (bf16_t*)(p.ws + OFF_YC) + (size_t)row0 * D + 768 + h * 64);
    } else engineA(lds, DS, wave, lane);
    __syncthreads();
}

struct RgRegs { u32x4 rows[4], wt[2], gyraw; float w[4][8], bias[8], hin[8], ba[2], bx[2], lam[2]; };
template <bool PASSC>
__device__ __forceinline__ void rg_load(PRM p, int l, int u, RgRegs& r) {
    const int tid = tidx(), lane = tid & 63, wave = tid >> 6;
    const int blk = u & 3, c = (u >> 2) & 31, b = u >> 7, row0 = b * 2048 + c * 64;
    const bf16_t* U = (const bf16_t*)(p.ws + OFF_U);
    const int t = tid >> 3, c8 = (tid & 7) * 8, ch0 = blk * 64 + c8;
#pragma unroll
    for (int q = 0; q < 4; ++q) { const int tr = t - 3 + q; r.rows[q] = (c > 0 || tr >= 0) ? ldg8(U + (size_t)(row0 + tr) * NU + UGX + ch0) : (u32x4){0u, 0u, 0u, 0u}; }
#pragma unroll
    for (int j = 0; j < 4; ++j) ld8f(p.in[25] + (size_t)(l * 4 + j) * 256 + ch0, r.w[j]);
    ld8f(p.in[26] + l * 256 + ch0, r.bias);
    const bf16_t* WRG = (const bf16_t*)(p.ws + OFF_WRG);
#pragma unroll
    for (int i = 0; i < 2; ++i) { const int idx = tid + i * NTHR, gate = idx >> 9, rem = idx & 511; r.wt[i] = *(const u32x4*)(WRG + (size_t)((l * 2 + gate) * 4 + blk) * 4096 + (rem >> 3) * 64 + (rem & 7) * 8); }
    r.gyraw = (u32x4){0u, 0u, 0u, 0u};
    if (PASSC) { r.gyraw = ldg8(U + (size_t)(row0 + t) * NU + UGY + ch0);
#pragma unroll
        for (int kk = 0; kk < 8; ++kk) r.hin[kk] = ((const float*)(p.ws + OFF_RGC))[(size_t)(b * 32 + c) * 256 + blk * 64 + wave * 8 + kk]; }
#pragma unroll
    for (int jj = 0; jj < 2; ++jj) { const int ch = blk * 64 + 16 * ((wave >> 2) * 2 + jj) + (lane & 15);
        r.ba[jj] = p.in[28][l * 256 + ch]; r.bx[jj] = p.in[30][l * 256 + ch]; r.lam[jj] = p.in[31][l * 256 + ch]; }
}
template <bool PASSC>
__device__ __forceinline__ void rg_body(PRM p, LAS unsigned char* lds, int l, int u, const RgRegs& r) {
    const int tid = tidx(), lane = tid & 63, wave = tid >> 6;
    const int blk = u & 3, c = (u >> 2) & 31, b = u >> 7, row0 = b * 2048 + c * 64;
    const bf16_t* U = (const bf16_t*)(p.ws + OFF_U);
    LAS float* XR = (LAS float*)lds; LAS bf16_t* XRB = (LAS bf16_t*)(lds + 16640); LAS bf16_t* WT = (LAS bf16_t*)(lds + 25856);
    LAS float* AA = (LAS float*)(lds + 44288); LAS float* BB = (LAS float*)(lds + 60928); LAS float* HL = (LAS float*)(lds + 77568);
    const int t = tid >> 3, c8 = (tid & 7) * 8, ch0 = blk * 64 + c8;
    {
        float o[1][8]; conv8<1>(r.rows, r.w, r.bias, o);
#pragma unroll
        for (int i = 0; i < 8; ++i) XR[t * 65 + c8 + i] = o[0][i];
        *(LAS u32x4*)(XRB + t * 72 + c8) = pack8(o[0]);
#pragma unroll
        for (int i = 0; i < 2; ++i) { const int idx = tid + i * NTHR, gate = idx >> 9, rem = idx & 511; *(LAS u32x4*)(WT + gate * 4608 + (rem >> 3) * 72 + (rem & 7) * 8) = r.wt[i]; }
    }
    __syncthreads();
    {
        const int rt = wave & 3, ct0 = (wave >> 2) * 2;
        f32x4 aA[2], aX[2]; aA[0] = (f32x4){0.f, 0.f, 0.f, 0.f}; aA[1] = aA[0]; aX[0] = aA[0]; aX[1] = aA[0];
        mm_nt<2, 2>(aA, XRB + 16 * rt * 72, 72, WT + 16 * ct0 * 72, 72, lane);
        mm_nt<2, 2>(aX, XRB + 16 * rt * 72, 72, WT + 4608 + 16 * ct0 * 72, 72, lane);
#pragma unroll
        for (int jj = 0; jj < 2; ++jj) { const int j = 16 * (ct0 + jj) + (lane & 15);
            const float sp = -8.0f * softplusf_(-r.lam[jj]);
#pragma unroll
            for (int e = 0; e < 4; ++e) { const int tq = 16 * rt + (lane >> 4) * 4 + e;
                const float rr = sigmoidf_(aA[jj][e] + r.ba[jj]), ig = sigmoidf_(aX[jj][e] + r.bx[jj]);
                const float la = sp * rr; AA[tq * 65 + j] = __expf(la); BB[tq * 65 + j] = sqrtf(fmaxf(1.0f - __expf(2.0f * la), 0.f)) * ig * XR[tq * 65 + j]; } }
    }
    __syncthreads();
#pragma unroll
    for (int kk = 0; kk < 8; ++kk) { const int j = wave * 8 + kk, ch = blk * 64 + j;
        float A = AA[lane * 65 + j], B = BB[lane * 65 + j];
#pragma unroll
        for (int d = 1; d < 64; d <<= 1) { const float Ap = __shfl_up(A, d), Bp = __shfl_up(B, d); if (lane >= d) { B = A * Bp + B; A = A * Ap; } }
        if (PASSC) HL[lane * 65 + j] = B + A * r.hin[kk];
        else if (lane == 63) { ((float*)(p.ws + OFF_RGH))[(size_t)(b * 32 + c) * 256 + ch] = B; ((float*)(p.ws + OFF_RGA))[(size_t)(b * 32 + c) * 256 + ch] = A; }
    }
    if (PASSC) {
        __syncthreads();
        float gy[8], y[8]; unpack8(r.gyraw, gy);
#pragma unroll
        for (int i = 0; i < 8; ++i) y[i] = geluf_(gy[i]) * HL[t * 65 + c8 + i];
        *(u32x4*)((bf16_t*)(p.ws + OFF_YC) + (size_t)(row0 + t) * D + 512 + ch0) = pack8(y);
        if (c == 31 && tid < 192) { const int rr = tid >> 6, j = tid & 63;
            p.out[O_PRGC + ((size_t)(l * 8 + b) * 3 + rr) * 256 + blk * 64 + j] = bf2f(U[(size_t)(b * 2048 + 2045 + rr) * NU + UGX + blk * 64 + j]); }
    }
    __syncthreads();
}

#define UNIT_LOOP(NAME, REGS, LOADF, BODYF)                                                                             \
template <bool PASSC> __device__ __forceinline__ void NAME(PRM p, LAS unsigned char* lds, int l) {            \
    int u = blockIdx.x; if (u >= 1024) return;                                                                          \
    REGS cur; LOADF<PASSC>(p, l, u, cur);                                                                               \
    _Pragma("unroll 1") for (; u < 1024; u += gridDim.x) { REGS nx; const int un = u + gridDim.x;                        \
        if (un < 1024) LOADF<PASSC>(p, l, un, nx);                                                                      \
        BODYF<PASSC>(p, lds, l, u, cur);                                                                                \
        if (un < 1024) cur = nx; } }
UNIT_LOOP(ret_loop, RetRegs, ret_load, ret_body)
UNIT_LOOP(hg_loop, HgRegs, hg_load, hg_body)
template <bool PASSC> __device__ __forceinline__ void rg_loop(PRM p, LAS unsigned char* lds, int l) {
    _Pragma("unroll 1") for (int u = blockIdx.x; u < 1024; u += gridDim.x) { RgRegs r; rg_load<PASSC>(p, l, u, r); rg_body<PASSC>(p, lds, l, u, r); } }

__device__ __forceinline__ void retC2_unit(PRM p, LAS unsigned char* lds, int l, int u) {
    const int tid = tidx(), lane = tid & 63, wave = tid >> 6;
    const int hp = u & 1, c = (u >> 1) & 31, b = u >> 6, row0 = b * 2048 + c * 64;
    const bf16_t* U = (const bf16_t*)(p.ws + OFF_U);
    const float* RC = (const float*)(p.ws + OFF_ROPE); const float* RS = RC + 2052 * 32;
    LAS bf16_t* QS = (LAS bf16_t*)lds; LAS bf16_t* KV = (LAS bf16_t*)(lds + 18432); LAS bf16_t* VT = (LAS bf16_t*)(lds + 36864);
    LAS bf16_t* SINT = (LAS bf16_t*)(lds + 55296); LAS bf16_t* PP = (LAS bf16_t*)(lds + 73728);
    const int t = tid >> 3, c8 = (tid & 7) * 8, isq = tid >> 8, tt = (tid & 255) >> 2, j0 = (tid & 3) * 8;
    const int hw = wave >> 2, rt = wave & 3, hme = 2 * hp + hw;
    u32x4 vraw[2], dsraw[2], x1[2], x2[2]; float cs[8], sn[8], gate[16], gain[4];
#pragma unroll
    for (int hh = 0; hh < 2; ++hh) { const int h = 2 * hp + hh;
        vraw[hh] = ldg8(U + (size_t)(row0 + t) * NU + URV + h * 64 + c8);
        dsraw[hh] = ldg8((const bf16_t*)(p.ws + OFF_DSR) + ((size_t)(b * 4 + h) * 32 + c) * 4096 + t * 64 + c8);
        const bf16_t* ur = U + (size_t)(row0 + tt) * NU + (isq ? URQ : URK) + h * 64 + j0; x1[hh] = ldg8(ur); x2[hh] = ldg8(ur + 32); }
    ld8f(RC + (size_t)(c * 64 + tt) * 32 + j0, cs); ld8f(RS + (size_t)(c * 64 + tt) * 32 + j0, sn);
#pragma unroll
    for (int j = 0; j < 4; ++j) { const int pc = 16 * j + (lane & 15); gain[j] = p.in[24][l * 256 + hme * 64 + pc];
#pragma unroll
        for (int e = 0; e < 4; ++e) gate[e * 4 + j] = bf2f(U[(size_t)(row0 + 16 * rt + (lane >> 4) * 4 + e) * NU + URG + hme * 64 + pc]); }
#pragma unroll
    for (int hh = 0; hh < 2; ++hh) {
#pragma unroll
        for (int i = 0; i < 8; ++i) { VT[hh * 4608 + (c8 + i) * 72 + t] = elem8(vraw[hh], i); SINT[hh * 4608 + (c8 + i) * 72 + t] = elem8(dsraw[hh], i); }
        float a[8], bb[8], ra[8], rb[8]; unpack8(x1[hh], a); unpack8(x2[hh], bb);
        const float scl = isq ? 1.0f : 0.125f;
#pragma unroll
        for (int i = 0; i < 8; ++i) { ra[i] = (a[i] * cs[i] - bb[i] * sn[i]) * scl; rb[i] = (bb[i] * cs[i] + a[i] * sn[i]) * scl; }
        LAS bf16_t* dst = (isq ? QS : KV) + hh * 4608;
        *(LAS u32x4*)(dst + tt * 72 + j0) = pack8(ra); *(LAS u32x4*)(dst + tt * 72 + j0 + 32) = pack8(rb);
    }
    __syncthreads();
    const float lg = logf(1.0f - exp2f(-5.0f - (float)hme));
    {
        f32x4 sc[4];
#pragma unroll
        for (int j = 0; j < 4; ++j) sc[j] = (f32x4){0.f, 0.f, 0.f, 0.f};
        mm_nt<4, 2>(sc, QS + hw * 4608 + 16 * rt * 72, 72, KV + hw * 4608, 72, lane);
#pragma unroll
        for (int j = 0; j < 4; ++j)
#pragma unroll
            for (int e = 0; e < 4; ++e) { const int tq = 16 * rt + (lane >> 4) * 4 + e, sq = 16 * j + (lane & 15);
                PP[hw * 4608 + tq * 72 + sq] = f2bf(sq <= tq ? sc[j][e] * __expf((float)(tq - sq) * lg) : 0.f); }
    }
    __syncthreads();
    f32x4 y[4];
#pragma unroll
    for (int j = 0; j < 4; ++j) y[j] = (f32x4){0.f, 0.f, 0.f, 0.f};
    mm_nt<4, 2>(y, QS + hw * 4608 + 16 * rt * 72, 72, SINT + hw * 4608, 72, lane);
#pragma unroll
    for (int e = 0; e < 4; ++e) { const float r = __expf((float)(16 * rt + (lane >> 4) * 4 + e + 1) * lg);
#pragma unroll
        for (int j = 0; j < 4; ++j) y[j][e] *= r; }
    mm_nt<4, 2>(y, PP + hw * 4608 + 16 * rt * 72, 72, VT + hw * 4608, 72, lane);
    bf16_t* outp = (bf16_t*)(p.ws + OFF_YC) + (size_t)row0 * D + 256 + hme * 64;
#pragma unroll
    for (int e = 0; e < 4; ++e) { const int tq = 16 * rt + (lane >> 4) * 4 + e;
        float s1 = (y[0][e] + y[1][e]) + (y[2][e] + y[3][e]);
#pragma unroll
        for (int o = 1; o < 16; o <<= 1) s1 += __shfl_xor(s1, o);
        const float mean = s1 * (1.0f / 64.0f);
        float s2 = 0.f;
#pragma unroll
        for (int j = 0; j < 4; ++j) { const float d = y[j][e] - mean; s2 += d * d; }
#pragma unroll
        for (int o = 1; o < 16; o <<= 1) s2 += __shfl_xor(s2, o);
        const float rstd = 1.0f / sqrtf(s2 * (1.0f / 64.0f) + EPS);
#pragma unroll
        for (int j = 0; j < 4; ++j) outp[(size_t)tq * D + 16 * j + (lane & 15)] = f2bf((y[j][e] - mean) * rstd * gain[j] * siluf_(gate[e * 4 + j])); }
    __syncthreads();
}

__device__ __forceinline__ void engineA4(const LAS bf16_t* KWT, const LAS bf16_t* VT, bf16_t* DSbase  , int wave, int lane) {
    const int hh = wave >> 1, rt0 = (wave & 1) * 2;
#pragma unroll
    for (int q = 0; q < 2; ++q) { const int rt = rt0 + q;
        f32x4 acc[4];
#pragma unroll
        for (int j = 0; j < 4; ++j) acc[j] = (f32x4){0.f, 0.f, 0.f, 0.f};
        mm_nt<4, 2>(acc, KWT + (hh * 64 + 16 * rt) * 72, 72, VT + hh * 64 * 72, 72, lane);
        bf16_t* DS = DSbase + (size_t)hh * 32 * 4096;
#pragma unroll
        for (int j = 0; j < 4; ++j)
#pragma unroll
            for (int e = 0; e < 4; ++e) DS[(16 * rt + (lane >> 4) * 4 + e) * 64 + 16 * j + (lane & 15)] = f2bf(acc[j][e]); }
}
__device__ __forceinline__ void retA4_unit(PRM p, LAS unsigned char* lds, int l, int u) {
    const int tid = tidx(), lane = tid & 63, wave = tid >> 6;
    const int c = u & 31, b = u >> 5, row0 = b * 2048 + c * 64;
    const bf16_t* U = (const bf16_t*)(p.ws + OFF_U);
    const float* RC = (const float*)(p.ws + OFF_ROPE); const float* RS = RC + 2052 * 32;
    LAS bf16_t* KWT = (LAS bf16_t*)lds; LAS bf16_t* VT = (LAS bf16_t*)(lds + 36864);
    const int t = tid >> 3, c8 = (tid & 7) * 8, tt = (tid & 255) >> 2, j0 = (tid & 3) * 8;
    u32x4 vraw[4], x1[2], x2[2]; float cs[8], sn[8];
#pragma unroll
    for (int hh = 0; hh < 4; ++hh) vraw[hh] = ldg8(U + (size_t)(row0 + t) * NU + URV + hh * 64 + c8);
#pragma unroll
    for (int it = 0; it < 2; ++it) { const int hh = it * 2 + (tid >> 8); const bf16_t* ur = U + (size_t)(row0 + tt) * NU + URK + hh * 64 + j0; x1[it] = ldg8(ur); x2[it] = ldg8(ur + 32); }
    ld8f(RC + (size_t)(c * 64 + tt) * 32 + j0, cs); ld8f(RS + (size_t)(c * 64 + tt) * 32 + j0, sn);
#pragma unroll
    for (int hh = 0; hh < 4; ++hh)
#pragma unroll
        for (int i = 0; i < 8; ++i) VT[(hh * 64 + c8 + i) * 72 + t] = elem8(vraw[hh], i);
#pragma unroll
    for (int it = 0; it < 2; ++it) { const int hh = it * 2 + (tid >> 8);
        const float lg = logf(1.0f - exp2f(-5.0f - (float)hh)); const float w = __expf((float)(63 - tt) * lg) * 0.125f;
        float a[8], bb[8]; unpack8(x1[it], a); unpack8(x2[it], bb);
#pragma unroll
        for (int i = 0; i < 8; ++i) { KWT[(hh * 64 + j0 + i) * 72 + tt] = f2bf((a[i] * cs[i] - bb[i] * sn[i]) * w); KWT[(hh * 64 + j0 + 32 + i) * 72 + tt] = f2bf((bb[i] * cs[i] + a[i] * sn[i]) * w); } }
    __syncthreads();
    engineA4(KWT, VT, (bf16_t*)(p.ws + OFF_DSR) + ((size_t)(b * 4) * 32 + c) * 4096, wave, lane);
    __syncthreads();
}
__device__ __forceinline__ void hgA4_unit(PRM p, LAS unsigned char* lds, int l, int u) {
    const int tid = tidx(), lane = tid & 63, wave = tid >> 6;
    const int c = u & 31, b = u >> 5, row0 = b * 2048 + c * 64;
    const bf16_t* U = (const bf16_t*)(p.ws + OFF_U);
    LAS float* CUM = (LAS float*)lds; LAS bf16_t* KWT = (LAS bf16_t*)(lds + 65792); LAS bf16_t* VT = (LAS bf16_t*)(lds + 102656);
    const int t = tid >> 3, c8 = (tid & 7) * 8;
    u32x4 hfraw[4], viraw[4];
#pragma unroll
    for (int hh = 0; hh < 4; ++hh) { const bf16_t* ur = U + (size_t)(row0 + t) * NU + hh * 64 + c8; hfraw[hh] = ldg8(ur + UHF); viraw[hh] = ldg8(ur + UHI); }
#pragma unroll
    for (int hh = 0; hh < 4; ++hh) { float lb[8], hf[8]; ld8f((const float*)(p.ws + OFF_LB) + l * 256 + hh * 64 + c8, lb); unpack8(hfraw[hh], hf);
#pragma unroll
        for (int i = 0; i < 8; ++i) { VT[(hh * 64 + c8 + i) * 72 + t] = elem8(viraw[hh], i); CUM[t * 257 + hh * 64 + c8 + i] = __logf(lb[i] + (1.0f - lb[i]) * sigmoidf_(hf[i])); } }
    __syncthreads();
#pragma unroll 8
    for (int kk = 0; kk < 32; ++kk) { const int k = wave * 32 + kk; const float v = scan64_add(CUM[lane * 257 + k], lane); CUM[lane * 257 + k] = v; }
    __syncthreads();
#pragma unroll
    for (int hh = 0; hh < 4; ++hh) { float lb[8], hf[8]; ld8f((const float*)(p.ws + OFF_LB) + l * 256 + hh * 64 + c8, lb); unpack8(hfraw[hh], hf);
#pragma unroll
        for (int i = 0; i < 8; ++i) { const int ch = hh * 64 + c8 + i; const float kk_ = (1.0f - lb[i]) * sigmoidf_(-hf[i]);
            KWT[ch * 72 + t] = f2bf(kk_ * __expf(CUM[63 * 257 + ch] - CUM[t * 257 + ch])); } }
    if (tid < 256) ((float*)(p.ws + OFF_DECH))[((size_t)(b * 4 + (tid >> 6)) * 32 + c) * 64 + (tid & 63)] = __expf(CUM[63 * 257 + tid]);
    __syncthreads();
    engineA4(KWT, VT, (bf16_t*)(p.ws + OFF_DSH) + ((size_t)(b * 4) * 32 + c) * 4096, wave, lane);
    __syncthreads();
}

__device__ __forceinline__ void mixA_unit(PRM p, LAS unsigned char* lds, int l, int u) {
    RetRegs rr; HgRegs hr; RgRegs gr;
    ret_load<false>(p, l, u, rr); hg_load<false>(p, l, u, hr); rg_load<false>(p, l, u, gr);
    ret_body<false>(p, lds, l, u, rr); hg_body<false>(p, lds, l, u, hr); rg_body<false>(p, lds, l, u, gr);
}

__device__ __forceinline__ void mixC_unit(PRM p, LAS unsigned char* lds, int l, int u) {
    RetRegs rr; HgRegs hr; RgRegs gr;
    ret_load<true>(p, l, u, rr); hg_load<true>(p, l, u, hr); rg_load<true>(p, l, u, gr);
    ret_body<true>(p, lds, l, u, rr); hg_body<true>(p, lds, l, u, hr); rg_body<true>(p, lds, l, u, gr);
}

__device__ __forceinline__ void carry_phase(PRM p, int l) {
    const int gt = blockIdx.x * NTHR + tidx(), NG = gridDim.x * NTHR;
    constexpr int N_SSD = 8 * 4 * 4096, N_RET = 8 * 4 * 2048, N_HG = N_RET, N_RG = 8 * 256;
    for (int i = gt; i < N_SSD + N_RET + N_HG + N_RG; i += NG) {
        if (i < N_SSD + N_RET + N_HG) {
            unsigned* base; float dec[32]; size_t stride, oo;
            if (i < N_SSD) { const int bh = i >> 12, e2 = i & 4095; base = (unsigned*)(p.ws + OFF_DSS) + (size_t)bh * 32 * 4096 + e2; stride = 4096;
                const float* dc = (const float*)(p.ws + OFF_DECS) + bh * 32;
#pragma unroll
                for (int c = 0; c < 32; ++c) dec[c] = dc[c];
                oo = O_PSSD + (size_t)l * 8 * 32768 + (size_t)bh * 8192 + 2 * e2;
            } else if (i < N_SSD + N_RET) { const int j = i - N_SSD, bh = j >> 11, e2 = j & 2047; base = (unsigned*)(p.ws + OFF_DSR) + (size_t)bh * 32 * 2048 + e2; stride = 2048;
                const float d = expf(64.0f * logf(1.0f - exp2f(-5.0f - (float)(bh & 3))));
#pragma unroll
                for (int c = 0; c < 32; ++c) dec[c] = d;
                oo = O_PRET + (size_t)l * 8 * 16384 + (size_t)bh * 4096 + 2 * e2;
            } else { const int j = i - N_SSD - N_RET, bh = j >> 11, e2 = j & 2047; base = (unsigned*)(p.ws + OFF_DSH) + (size_t)bh * 32 * 2048 + e2; stride = 2048;
                const float* dc = (const float*)(p.ws + OFF_DECH) + (size_t)bh * 32 * 64 + (e2 >> 5);
#pragma unroll
                for (int c = 0; c < 32; ++c) dec[c] = dc[c * 64];
                oo = O_PHG + (size_t)l * 8 * 16384 + (size_t)bh * 4096 + 2 * e2;
            }
            unsigned tmp[32];
#pragma unroll
            for (int c = 0; c < 32; ++c) tmp[c] = base[(size_t)c * stride];
            float s0 = 0.f, s1 = 0.f;
#pragma unroll
            for (int c = 0; c < 32; ++c) { base[(size_t)c * stride] = pk2(s0, s1);
                s0 = dec[c] * s0 + __uint_as_float(tmp[c] << 16); s1 = dec[c] * s1 + __uint_as_float(tmp[c] & 0xffff0000u); }
            *(f32x2*)(p.out + oo) = (f32x2){s0, s1};
        } else {
            const int j = i - N_SSD - N_RET - N_HG, b = j >> 8, ch = j & 255;
            const float* hl = (const float*)(p.ws + OFF_RGH) + (size_t)b * 32 * 256 + ch; const float* at = (const float*)(p.ws + OFF_RGA) + (size_t)b * 32 * 256 + ch;
            float* cr = (float*)(p.ws + OFF_RGC) + (size_t)b * 32 * 256 + ch;
            float tmp[32], dec[32];
#pragma unroll
            for (int c = 0; c < 32; ++c) { tmp[c] = hl[c * 256]; dec[c] = at[c * 256]; }
            float sacc = 0.f;
#pragma unroll
            for (int c = 0; c < 32; ++c) { cr[c * 256] = sacc; sacc = dec[c] * sacc + tmp[c]; }
            p.out[O_PRG + (size_t)l * 8 * 256 + b * 256 + ch] = sacc;
        }
    }
}

constexpr int S_QD = 0, S_KW = 8192, S_V = 16384, S_DEC = 20480, S_P = 22528, S_Y = 22784, S_RED = 26880, S_SCR = 59648;
template <int KD>
__device__ __forceinline__ void dec_engine(const float* S0, float* S1, LAS unsigned char* lds) {
    const int tid = tidx(), p_ = tid & 63, kq = tid >> 6; constexpr int KPER = KD / 8;
    const LAS float* QDs = (const LAS float*)(lds + S_QD); const LAS float* KWs = (const LAS float*)(lds + S_KW); const LAS float* Vs = (const LAS float*)(lds + S_V);
    const LAS float* DECs = (const LAS float*)(lds + S_DEC); const LAS float* Ps = (const LAS float*)(lds + S_P); LAS float* Ys = (LAS float*)(lds + S_Y); LAS float* RED = (LAS float*)(lds + S_RED);
    float v[4][4], yp[4][4];
#pragma unroll
    for (int h = 0; h < 4; ++h)
#pragma unroll
        for (int s = 0; s < 4; ++s) { v[h][s] = Vs[s * 256 + h * 64 + p_]; yp[h][s] = 0.f; }
#pragma unroll
    for (int h = 0; h < 4; ++h) {
#pragma unroll
        for (int kk = 0; kk < KPER; ++kk) { const int k = kq * KPER + kk;
            const float s0 = S0[(size_t)(h * KD + k) * 64 + p_];
            const f32x4 kw = *(const LAS f32x4*)(KWs + (h * 128 + k) * 4), qd = *(const LAS f32x4*)(QDs + (h * 128 + k) * 4);
            const float acc = DECs[h * 128 + k] * s0 + kw.x * v[h][0] + kw.y * v[h][1] + kw.z * v[h][2] + kw.w * v[h][3];
            S1[(size_t)(h * KD + k) * 64 + p_] = acc;
            yp[h][0] += qd.x * s0; yp[h][1] += qd.y * s0; yp[h][2] += qd.z * s0; yp[h][3] += qd.w * s0;
        }
    }
#pragma unroll
    for (int h = 0; h < 4; ++h)
#pragma unroll
        for (int t = 0; t < 4; ++t) RED[(kq * 16 + h * 4 + t) * 64 + p_] = yp[h][t];
    __syncthreads();
    for (int idx = tid; idx < 1024; idx += NTHR) { const int p2 = idx & 63, ht = idx >> 6, h = ht >> 2, t = ht & 3;
        float sum = 0.f;
#pragma unroll
        for (int q = 0; q < 8; ++q) sum += RED[(q * 16 + ht) * 64 + p2];
        for (int s = 0; s <= t; ++s) sum += Ps[ht * 4 + s] * Vs[s * 256 + h * 64 + p2];
        Ys[t * 256 + h * 64 + p2] = sum; }
    __syncthreads();
}

__device__ __forceinline__ void sample_ssd(PRM p, LAS unsigned char* lds, int l, int b) {
    const int tid = tidx(), lane = tid & 63, wave = tid >> 6, R0 = TP + b * 4;
    const bf16_t* U = (const bf16_t*)(p.ws + OFF_U); const float* SDT = (const float*)(p.ws + OFF_SDT);
    LAS float* QDs = (LAS float*)(lds + S_QD); LAS float* KWs = (LAS float*)(lds + S_KW); LAS float* Vs = (LAS float*)(lds + S_V);
    LAS float* DECs = (LAS float*)(lds + S_DEC); LAS float* Ps = (LAS float*)(lds + S_P); LAS float* Ys = (LAS float*)(lds + S_Y);
    LAS float* XB = (LAS float*)(lds + S_SCR); LAS float* DTs = (LAS float*)(lds + S_SCR + 12288); LAS float* CUs = DTs + 16;
    for (int ch = tid; ch < 768; ch += NTHR) {
        float xx[7];
#pragma unroll
        for (int r = 0; r < 3; ++r) xx[r] = p.in[3][((size_t)(l * 128 + b) * 3 + r) * 768 + ch];
#pragma unroll
        for (int t = 0; t < 4; ++t) xx[3 + t] = bf2f(U[(size_t)(R0 + t) * NU + UXBC + ch]);
        const float* cw = p.in[18] + (size_t)l * 4 * 768 + ch; const float w0 = cw[0], w1 = cw[768], w2 = cw[1536], w3 = cw[2304], bias = p.in[19][l * 768 + ch];
#pragma unroll
        for (int t = 0; t < 4; ++t) XB[t * 768 + ch] = siluf_(bias + w0 * xx[t] + w1 * xx[t + 1] + w2 * xx[t + 2] + w3 * xx[t + 3]);
#pragma unroll
        for (int r = 0; r < 3; ++r) p.out[O_SSSDC + ((size_t)(l * 128 + b) * 3 + r) * 768 + ch] = xx[4 + r];
    }
    if (tid < 4) { const int h = tid; float cum = 0.f; const float bias = p.in[20][l * 4 + h], A = -expf(p.in[21][l * 4 + h]);
        for (int t = 0; t < 4; ++t) { const float dt = softplusf_(SDT[(size_t)(R0 + t) * 4 + h] + bias); cum += A * dt; DTs[h * 4 + t] = dt; CUs[h * 4 + t] = cum; } }
    __syncthreads();
    for (int idx = tid; idx < 2048; idx += NTHR) { const int h = idx >> 9, t = (idx >> 7) & 3, n = idx & 127, g = h >> 1;
        QDs[(h * 128 + n) * 4 + t] = XB[t * 768 + 512 + g * 128 + n] * __expf(CUs[h * 4 + t]);
        KWs[(h * 128 + n) * 4 + t] = XB[t * 768 + 256 + g * 128 + n] * __expf(CUs[h * 4 + 3] - CUs[h * 4 + t]) * DTs[h * 4 + t]; }
    for (int idx = tid; idx < 1024; idx += NTHR) Vs[idx] = XB[(idx >> 8) * 768 + (idx & 255)];
    DECs[(tid >> 7) * 128 + (tid & 127)] = __expf(CUs[(tid >> 7) * 4 + 3]);
    if (tid < 64) { const int h = tid >> 4, t = (tid >> 2) & 3, s = tid & 3, g = h >> 1; float val = 0.f;
        if (s <= t) { float dot = 0.f;
#pragma unroll 32
            for (int n = 0; n < 128; ++n) dot += XB[t * 768 + 512 + g * 128 + n] * XB[s * 768 + 256 + g * 128 + n];
            val = dot * __expf(CUs[h * 4 + t] - CUs[h * 4 + s]) * DTs[h * 4 + s]; }
        Ps[tid] = val; }
    __syncthreads();
    dec_engine<128>(p.in[2] + (size_t)(l * 128 + b) * 32768, p.out + O_SSSD + (size_t)(l * 128 + b) * 32768, lds);
    for (int idx = tid; idx < 1024; idx += NTHR) { const int t = idx >> 8, ch = idx & 255, h = ch >> 6;
        const float y = Ys[idx] + p.in[22][l * 4 + h] * XB[t * 768 + ch];
        Ys[idx] = y * siluf_(bf2f(U[(size_t)(R0 + t) * NU + UZ + ch])); }
    __syncthreads();
    if (wave < 4) { const int t = wave; float v[4], ss = 0.f;
#pragma unroll
        for (int i = 0; i < 4; ++i) { v[i] = Ys[t * 256 + lane + 64 * i]; ss += v[i] * v[i]; }
        const float rstd = 1.0f / sqrtf(wave_sum(ss) * (1.0f / 256.0f) + EPS);
#pragma unroll
        for (int i = 0; i < 4; ++i) ((bf16_t*)(p.ws + OFF_YC))[(size_t)(R0 + t) * D + lane + 64 * i] = f2bf(v[i] * rstd * p.in[23][l * 256 + lane + 64 * i]); }
    __syncthreads();
}

template <bool CENTER>
__device__ __forceinline__ void sample_headnorm(PRM p, LAS unsigned char* lds, int R0, const float* gain, int gcol, int ocol) {
    const int tid = tidx(), lane = tid & 63, wave = tid >> 6;
    const bf16_t* U = (const bf16_t*)(p.ws + OFF_U); const LAS float* Ys = (const LAS float*)(lds + S_Y);
#pragma unroll
    for (int q = 0; q < 2; ++q) { const int gi = wave * 2 + q, t = gi >> 2, h = gi & 3;
        const float y = Ys[t * 256 + h * 64 + lane];
        const float mean = CENTER ? wave_sum(y) * (1.0f / 64.0f) : 0.f; const float d = y - mean;
        const float var = wave_sum(d * d) * (1.0f / 64.0f);
        const float o = d / sqrtf(var + EPS) * gain[h * 64 + lane] * siluf_(bf2f(U[(size_t)(R0 + t) * NU + gcol + h * 64 + lane]));
        ((bf16_t*)(p.ws + OFF_YC))[(size_t)(R0 + t) * D + ocol + h * 64 + lane] = f2bf(o); }
}

__device__ __forceinline__ void sample_ret(PRM p, LAS unsigned char* lds, int l, int b) {
    const int tid = tidx(), R0 = TP + b * 4;
    const bf16_t* U = (const bf16_t*)(p.ws + OFF_U);
    const float* RC = (const float*)(p.ws + OFF_ROPE); const float* RS = RC + 2052 * 32;
    LAS float* QDs = (LAS float*)(lds + S_QD); LAS float* KWs = (LAS float*)(lds + S_KW); LAS float* Vs = (LAS float*)(lds + S_V);
    LAS float* DECs = (LAS float*)(lds + S_DEC); LAS float* Ps = (LAS float*)(lds + S_P);
    LAS float* Qr = (LAS float*)(lds + S_SCR); LAS float* Kr = Qr + 1024;
    { const int h = tid >> 7, t = (tid >> 5) & 3, j = tid & 31; const bf16_t* ur = U + (size_t)(R0 + t) * NU;
        const float cs = RC[(2048 + t) * 32 + j], sn = RS[(2048 + t) * 32 + j];
        const float q1 = bf2f(ur[URQ + h * 64 + j]), q2 = bf2f(ur[URQ + h * 64 + j + 32]), k1 = bf2f(ur[URK + h * 64 + j]), k2 = bf2f(ur[URK + h * 64 + j + 32]);
        Qr[(h * 4 + t) * 64 + j] = q1 * cs - q2 * sn; Qr[(h * 4 + t) * 64 + j + 32] = q2 * cs + q1 * sn;
        Kr[(h * 4 + t) * 64 + j] = (k1 * cs - k2 * sn) * 0.125f; Kr[(h * 4 + t) * 64 + j + 32] = (k2 * cs + k1 * sn) * 0.125f; }
    for (int idx = tid; idx < 1024; idx += NTHR) Vs[idx] = bf2f(U[(size_t)(R0 + (idx >> 8)) * NU + URV + (idx & 255)]);
    __syncthreads();
    for (int idx = tid; idx < 1024; idx += NTHR) { const int h = idx >> 8, t = (idx >> 6) & 3, k = idx & 63; const float lg = logf(1.0f - exp2f(-5.0f - (float)h));
        QDs[(h * 128 + k) * 4 + t] = Qr[(h * 4 + t) * 64 + k] * __expf((float)(t + 1) * lg);
        KWs[(h * 128 + k) * 4 + t] = Kr[(h * 4 + t) * 64 + k] * __expf((float)(3 - t) * lg); }
    if (tid < 256) { const int h = tid >> 6; DECs[h * 128 + (tid & 63)] = __expf(4.0f * logf(1.0f - exp2f(-5.0f - (float)h))); }
    if (tid < 64) { const int h = tid >> 4, t = (tid >> 2) & 3, s = tid & 3; float val = 0.f;
        if (s <= t) { float dot = 0.f;
#pragma unroll 32
            for (int k = 0; k < 64; ++k) dot += Qr[(h * 4 + t) * 64 + k] * Kr[(h * 4 + s) * 64 + k];
            val = dot * __expf((float)(t - s) * logf(1.0f - exp2f(-5.0f - (float)h))); }
        Ps[tid] = val; }
    __syncthreads();
    dec_engine<64>(p.in[4] + (size_t)(l * 128 + b) * 16384, p.out + O_SRET + (size_t)(l * 128 + b) * 16384, lds);
    sample_headnorm<true>(p, lds, R0, p.in[24] + l * 256, URG, 256);
    __syncthreads();
}

__device__ __forceinline__ void sample_hg(PRM p, LAS unsigned char* lds, int l, int b) {
    const int tid = tidx(), R0 = TP + b * 4;
    const bf16_t* U = (const bf16_t*)(p.ws + OFF_U);
    LAS float* QDs = (LAS float*)(lds + S_QD); LAS float* KWs = (LAS float*)(lds + S_KW); LAS float* Vs = (LAS float*)(lds + S_V);
    LAS float* DECs = (LAS float*)(lds + S_DEC); LAS float* Ps = (LAS float*)(lds + S_P);
    LAS float* LF = (LAS float*)(lds + S_SCR); LAS float* KK = LF + 1024; LAS float* QH = KK + 1024;
    for (int idx = tid; idx < 1024; idx += NTHR) { const int t = idx >> 8, ch = idx & 255; const bf16_t* ur = U + (size_t)(R0 + t) * NU;
        float lbk = 0.f;
        if (l > 0) { const float a0 = p.in[32][ch], a1 = p.in[32][256 + ch]; const float mx = fmaxf(a0, a1), e0 = expf(a0 - mx), e1 = expf(a1 - mx); lbk = e1 / (e0 + e1); }
        const float hf = bf2f(ur[UHF + ch]);
        LF[idx] = logf(lbk + (1.0f - lbk) * sigmoidf_(hf)); KK[idx] = (1.0f - lbk) * sigmoidf_(-hf); QH[idx] = siluf_(bf2f(ur[UHQ + ch])); Vs[idx] = bf2f(ur[UHI + ch]); }
    __syncthreads();
    if (tid < 256) { float c = 0.f; for (int t = 0; t < 4; ++t) { c += LF[t * 256 + tid]; LF[t * 256 + tid] = c; } }
    __syncthreads();
    for (int idx = tid; idx < 1024; idx += NTHR) { const int h = idx >> 8, t = (idx >> 6) & 3, k = idx & 63, ch = h * 64 + k;
        const float cum = LF[t * 256 + ch], last = LF[3 * 256 + ch];
        QDs[(h * 128 + k) * 4 + t] = QH[t * 256 + ch] * __expf(cum); KWs[(h * 128 + k) * 4 + t] = KK[t * 256 + ch] * __expf(last - cum); }
    if (tid < 256) DECs[(tid >> 6) * 128 + (tid & 63)] = __expf(LF[3 * 256 + tid]);
    if (tid < 64) { const int h = tid >> 4, t = (tid >> 2) & 3, s = tid & 3; float val = 0.f;
        if (s <= t)
#pragma unroll 16
            for (int k = 0; k < 64; ++k) { const int ch = h * 64 + k; val += QH[t * 256 + ch] * KK[s * 256 + ch] * __expf(LF[t * 256 + ch] - LF[s * 256 + ch]); }
        Ps[tid] = val; }
    __syncthreads();
    dec_engine<64>(p.in[7] + (size_t)(l * 128 + b) * 16384, p.out + O_SHG + (size_t)(l * 128 + b) * 16384, lds);
    sample_headnorm<false>(p, lds, R0, p.in[33] + l * 256, UHG, 768);
    __syncthreads();
}

__device__ __forceinline__ void sample_rg(PRM p, LAS unsigned char* lds, int l, int b) {
    const int tid = tidx(), R0 = TP + b * 4;
    const bf16_t* U = (const bf16_t*)(p.ws + OFF_U);
    LAS float* XRs = (LAS float*)(lds + S_SCR); LAS float* GA = XRs + 1024;
    if (tid < 256) { const int ch = tid; float xx[7];
#pragma unroll
        for (int r = 0; r < 3; ++r) xx[r] = p.in[6][((size_t)(l * 128 + b) * 3 + r) * 256 + ch];
#pragma unroll
        for (int t = 0; t < 4; ++t) xx[3 + t] = bf2f(U[(size_t)(R0 + t) * NU + UGX + ch]);
        const float* cw = p.in[25] + (size_t)l * 4 * 256 + ch; const float w0 = cw[0], w1 = cw[256], w2 = cw[512], w3 = cw[768], bias = p.in[26][l * 256 + ch];
#pragma unroll
        for (int t = 0; t < 4; ++t) XRs[t * 256 + ch] = bias + w0 * xx[t] + w1 * xx[t + 1] + w2 * xx[t + 2] + w3 * xx[t + 3];
#pragma unroll
        for (int r = 0; r < 3; ++r) p.out[O_SRGC + ((size_t)(l * 128 + b) * 3 + r) * 256 + ch] = xx[4 + r]; }
    __syncthreads();
    { const int ch = tid & 255, gate = tid >> 8, blk = ch >> 6, j = ch & 63; const float* W = p.in[gate ? 29 : 27] + (size_t)(l * 4 + blk) * 4096;
        float a0 = 0.f, a1 = 0.f, a2 = 0.f, a3 = 0.f, wv[64];
#pragma unroll
        for (int i = 0; i < 64; ++i) wv[i] = W[i * 64 + j];
#pragma unroll
        for (int i = 0; i < 64; ++i) { const float w = wv[i];
            a0 += XRs[blk * 64 + i] * w; a1 += XRs[256 + blk * 64 + i] * w; a2 += XRs[512 + blk * 64 + i] * w; a3 += XRs[768 + blk * 64 + i] * w; }
        GA[(gate * 4 + 0) * 256 + ch] = a0; GA[(gate * 4 + 1) * 256 + ch] = a1; GA[(gate * 4 + 2) * 256 + ch] = a2; GA[(gate * 4 + 3) * 256 + ch] = a3; }
    __syncthreads();
    if (tid < 256) { const int ch = tid; float h = p.in[5][(size_t)(l * 128 + b) * 256 + ch];
        const float ba = p.in[28][l * 256 + ch], bx = p.in[30][l * 256 + ch], sp = -8.0f * softplusf_(-p.in[31][l * 256 + ch]);
        for (int t = 0; t < 4; ++t) { const float r = sigmoidf_(GA[t * 256 + ch] + ba), ig = sigmoidf_(GA[(4 + t) * 256 + ch] + bx);
            const float la = sp * r; h = __expf(la) * h + sqrtf(-expm1f(2.0f * la)) * ig * XRs[t * 256 + ch];
            ((bf16_t*)(p.ws + OFF_YC))[(size_t)(R0 + t) * D + 512 + ch] = f2bf(geluf_(bf2f(U[(size_t)(R0 + t) * NU + UGY + ch])) * h); }
        p.out[O_SRG + (size_t)(l * 128 + b) * 256 + ch] = h; }
    __syncthreads();
}

__device__ __forceinline__ void attn_prompt(PRM p, LAS unsigned char* lds, int u) {
    const int tid = tidx(), lane = tid & 63, wave = tid >> 6, fr = lane & 15, fq = lane >> 4;
    const int qt = u & 15, h = (u >> 4) & 3, b = u >> 6, r0 = b * 2048 + qt * 128;
    const bf16_t* Q = (const bf16_t*)(p.ws + OFF_Q); const bf16_t* KBp = (const bf16_t*)(p.ws + OFF_KB) + (size_t)(b * 4 + h) * 65536;
    const bf16_t* VTp = (const bf16_t*)(p.ws + OFF_VTB) + (size_t)(b * 4 + h) * 65536; bf16_t* OB = (bf16_t*)(p.ws + OFF_YC);
    LAS bf16_t* KC = (LAS bf16_t*)lds; LAS bf16_t* PS = (LAS bf16_t*)(lds + 36864);
    bf16x8 qf[8];
#pragma unroll
    for (int ks = 0; ks < 8; ++ks) qf[ks] = *(const bf16x8*)(Q + (size_t)(r0 + 16 * wave + fr) * D + h * 256 + ks * 32 + fq * 8);
    u32x4 kr[4];
    const int sr = tid >> 3, sc8 = (tid & 7) * 8;
#pragma unroll
    for (int i = 0; i < 4; ++i) kr[i] = *(const u32x4*)(KBp + (size_t)(sr + 64 * i) * 256 + sc8);
    f32x4 S[16];
#pragma unroll
    for (int j = 0; j < 16; ++j) S[j] = (f32x4){0.f, 0.f, 0.f, 0.f};
#pragma unroll
    for (int dc = 0; dc < 4; ++dc) {
#pragma unroll
        for (int i = 0; i < 4; ++i) *(LAS u32x4*)(KC + (sr + 64 * i) * 72 + sc8) = kr[i];
        __syncthreads();
        if (dc < 3) {
#pragma unroll
            for (int i = 0; i < 4; ++i) kr[i] = *(const u32x4*)(KBp + (size_t)(sr + 64 * i) * 256 + (dc + 1) * 64 + sc8);
        } else {
#pragma unroll
            for (int i = 0; i < 4; ++i) kr[i] = *(const u32x4*)(VTp + (size_t)(sr + 64 * i) * 256 + sc8);
        }
#pragma unroll
        for (int k2 = 0; k2 < 2; ++k2)
#pragma unroll
            for (int j = 0; j < 16; ++j) { const bf16x8 kf = *(const LAS bf16x8*)(KC + (16 * j + fr) * 72 + k2 * 32 + fq * 8);
                S[j] = __builtin_amdgcn_mfma_f32_16x16x32_bf16(kf, qf[dc * 2 + k2], S[j], 0, 0, 0); }
        __syncthreads();
    }
    {
        float m = -3.0e38f;
#pragma unroll
        for (int j = 0; j < 16; ++j) m = fmaxf(fmaxf(m, fmaxf(S[j][0], S[j][1])), fmaxf(S[j][2], S[j][3]));
        m = fmaxf(m, __shfl_xor(m, 16)); m = fmaxf(m, __shfl_xor(m, 32));
        float sm = 0.f;
#pragma unroll
        for (int j = 0; j < 16; ++j)
#pragma unroll
            for (int e = 0; e < 4; ++e) { const float ev = __expf((S[j][e] - m) * 0.0625f); S[j][e] = ev; sm += ev; }
        sm += __shfl_xor(sm, 16); sm += __shfl_xor(sm, 32);
        const float inv = 1.0f / sm;
#pragma unroll
        for (int j = 0; j < 16; ++j) { u32x2 w; w.x = pk2(S[j][0] * inv, S[j][1] * inv); w.y = pk2(S[j][2] * inv, S[j][3] * inv);
            *(LAS u32x2*)(PS + (16 * wave + fr) * 264 + 16 * j + 4 * fq) = w; }
    }
    f32x4 O[16];
#pragma unroll
    for (int j = 0; j < 16; ++j) O[j] = (f32x4){0.f, 0.f, 0.f, 0.f};
#pragma unroll
    for (int kc = 0; kc < 4; ++kc) {
#pragma unroll
        for (int i = 0; i < 4; ++i) *(LAS u32x4*)(KC + (sr + 64 * i) * 72 + sc8) = kr[i];
        __syncthreads();
        if (kc < 3) {
#pragma unroll
            for (int i = 0; i < 4; ++i) kr[i] = *(const u32x4*)(VTp + (size_t)(sr + 64 * i) * 256 + (kc + 1) * 64 + sc8);
        }
#pragma unroll
        for (int k2 = 0; k2 < 2; ++k2) { const bf16x8 pf = *(const LAS bf16x8*)(PS + (16 * wave + fr) * 264 + kc * 64 + k2 * 32 + fq * 8);
#pragma unroll
            for (int j = 0; j < 16; ++j) { const bf16x8 vf = *(const LAS bf16x8*)(KC + (16 * j + fr) * 72 + k2 * 32 + fq * 8);
                O[j] = __builtin_amdgcn_mfma_f32_16x16x32_bf16(vf, pf, O[j], 0, 0, 0); } }
        __syncthreads();
    }
#pragma unroll
    for (int j = 0; j < 16; ++j) { u32x2 w; w.x = pk2(O[j][0], O[j][1]); w.y = pk2(O[j][2], O[j][3]);
        *(u32x2*)(OB + (size_t)(r0 + 16 * wave + fr) * D + h * 256 + 16 * j + 4 * fq) = w; }
}

__device__ __forceinline__ void attn_sample(PRM p, LAS unsigned char* lds, int l, int u) {
    const int tid = tidx(), lane = tid & 63, wave = tid >> 6;
    const int h = u & 3, b = u >> 2, R0 = TP + b * 4;
    const bf16_t* Q = (const bf16_t*)(p.ws + OFF_Q); bf16_t* OB = (bf16_t*)(p.ws + OFF_YC);
    LAS float* QSs = (LAS float*)lds; LAS float* SCT = QSs + 1024; LAS float* OP = SCT + 1024;
    const float* Kp = p.in[8] + ((size_t)(l * 128 + b) * 256) * 1024 + h * 256 + lane * 4;
    f32x4 kvn[8];
#pragma unroll
    for (int i = 0; i < 8; ++i) kvn[i] = *(const f32x4*)(Kp + (size_t)(wave * 32 + i) * 1024);
    for (int idx = tid; idx < 1024; idx += NTHR) QSs[idx] = bf2f(Q[(size_t)(R0 + (idx >> 8)) * D + h * 256 + (idx & 255)]) * 0.0625f;
    __syncthreads();
    f32x4 q[4];
#pragma unroll
    for (int t = 0; t < 4; ++t) q[t] = *(const LAS f32x4*)(QSs + t * 256 + lane * 4);
#pragma unroll 1
    for (int i0 = 0; i0 < 32; i0 += 8) {
        f32x4 kv[8];
#pragma unroll
        for (int i = 0; i < 8; ++i) kv[i] = kvn[i];
        if (i0 + 8 < 32) {
#pragma unroll
            for (int i = 0; i < 8; ++i) kvn[i] = *(const f32x4*)(Kp + (size_t)(wave * 32 + i0 + 8 + i) * 1024);
        }
        float vals[32];
#pragma unroll
        for (int i = 0; i < 8; ++i)
#pragma unroll
            for (int t = 0; t < 4; ++t) vals[i * 4 + t] = kv[i].x * q[t].x + kv[i].y * q[t].y + kv[i].z * q[t].z + kv[i].w * q[t].w;
#pragma unroll
        for (int n = 16, mask = 32; n >= 1; n >>= 1, mask >>= 1) { const bool up = (lane & mask) != 0;
#pragma unroll
            for (int i = 0; i < n; ++i) { const float send = up ? vals[i] : vals[i + n]; const float keep = up ? vals[i + n] : vals[i]; vals[i] = keep + __shfl_xor(send, mask); } }
        const float tot = vals[0] + __shfl_xor(vals[0], 1);
        if ((lane & 1) == 0) { const int vi = lane >> 1; SCT[(wave * 32 + i0 + (vi >> 2)) * 4 + (vi & 3)] = tot; }
    }
    const float* Vp = p.in[9] + ((size_t)(l * 128 + b) * 256) * 1024 + h * 256 + lane * 4;
    f32x4 vvn[8];
#pragma unroll
    for (int i = 0; i < 8; ++i) vvn[i] = *(const f32x4*)(Vp + (size_t)(wave * 32 + i) * 1024);
    __syncthreads();
    if (wave < 4) { const int t = wave; float v[4], m = -3.0e38f;
#pragma unroll
        for (int i = 0; i < 4; ++i) { v[i] = SCT[(lane + 64 * i) * 4 + t]; m = fmaxf(m, v[i]); }
        m = wave_max(m); float sm = 0.f;
#pragma unroll
        for (int i = 0; i < 4; ++i) { v[i] = __expf(v[i] - m); sm += v[i]; }
        sm = 1.0f / wave_sum(sm);
#pragma unroll
        for (int i = 0; i < 4; ++i) SCT[(lane + 64 * i) * 4 + t] = v[i] * sm; }
    __syncthreads();
    {
        f32x4 acc[4];
#pragma unroll
        for (int t = 0; t < 4; ++t) acc[t] = (f32x4){0.f, 0.f, 0.f, 0.f};
#pragma unroll 1
        for (int i0 = 0; i0 < 32; i0 += 8) {
            f32x4 vv[8];
#pragma unroll
            for (int i = 0; i < 8; ++i) vv[i] = vvn[i];
            if (i0 + 8 < 32) {
#pragma unroll
                for (int i = 0; i < 8; ++i) vvn[i] = *(const f32x4*)(Vp + (size_t)(wave * 32 + i0 + 8 + i) * 1024);
            }
#pragma unroll
            for (int i = 0; i < 8; ++i) { const f32x4 pr = *(const LAS f32x4*)(SCT + (wave * 32 + i0 + i) * 4);
                acc[0] = acc[0] + vv[i] * pr.x; acc[1] = acc[1] + vv[i] * pr.y; acc[2] = acc[2] + vv[i] * pr.z; acc[3] = acc[3] + vv[i] * pr.w; }
        }
#pragma unroll
        for (int t = 0; t < 4; ++t) *(LAS f32x4*)(OP + (wave * 4 + t) * 256 + lane * 4) = acc[t];
    }
    __syncthreads();
    for (int idx = tid; idx < 1024; idx += NTHR) { float o = 0.f;
#pragma unroll
        for (int w = 0; w < 8; ++w) o += OP[w * 1024 + idx];
        OB[(size_t)(R0 + (idx >> 8)) * D + h * 256 + (idx & 255)] = f2bf(o); }
    __syncthreads();
}

template <int MODE, int K, int KC>
__device__ __forceinline__ void sgemm(LAS unsigned char* lds, const bf16_t* A, const bf16_t* Bt, float* Cf, bf16_t* Cb) {
    const int tid = tidx(), lane = tid & 63, wave = tid >> 6, fr = lane & 15, fq = lane >> 4;
    constexpr int NCH = KC / 8, NI = (32 * NCH + NTHR - 1) / NTHR, LD = KC + 8, NSLAB = K / KC;
    LAS bf16_t* AS = (LAS bf16_t*)lds; LAS bf16_t* BS = (LAS bf16_t*)(lds + 32 * LD * 2);
    const int rt = (wave >> 1) & 1, ct = wave & 1;
    const int ntile = (512 - (int)blockIdx.x + (int)gridDim.x - 1) / (int)gridDim.x, nstep = ntile * NSLAB;
    u32x4 ra[NI], rb[NI];
    auto issue = [&](int step) { const int tile = blockIdx.x + (step / NSLAB) * gridDim.x, k0 = (step % NSLAB) * KC, tm = tile >> 5, tn = tile & 31;
#pragma unroll
        for (int i = 0; i < NI; ++i) { const int idx = tid + i * NTHR; const int r = idx / NCH, cc = idx % NCH;
            if (idx < 32 * NCH) { ra[i] = ldg8(A + (size_t)(tm * 32 + r) * K + k0 + cc * 8); rb[i] = ldg8(Bt + (size_t)(tn * 32 + r) * K + k0 + cc * 8); } } };
    if (nstep > 0) issue(0);
    f32x4 acc = (f32x4){0.f, 0.f, 0.f, 0.f};
#pragma unroll 1
    for (int step = 0; step < nstep; ++step) {
#pragma unroll
        for (int i = 0; i < NI; ++i) { const int idx = tid + i * NTHR; const int r = idx / NCH, cc = idx % NCH;
            if (idx < 32 * NCH) { *(LAS u32x4*)(AS + r * LD + cc * 8) = ra[i]; *(LAS u32x4*)(BS + r * LD + cc * 8) = rb[i]; } }
        __syncthreads();
        if (step + 1 < nstep) issue(step + 1);
        if (wave < 4) {
#pragma unroll 4
            for (int ks = 0; ks < KC / 32; ++ks) { const bf16x8 a = *(const LAS bf16x8*)(AS + (16 * rt + fr) * LD + ks * 32 + fq * 8);
                const bf16x8 b = *(const LAS bf16x8*)(BS + (16 * ct + fr) * LD + ks * 32 + fq * 8);
                acc = __builtin_amdgcn_mfma_f32_16x16x32_bf16(a, b, acc, 0, 0, 0); }
            if ((step % NSLAB) == NSLAB - 1) { const int tile = blockIdx.x + (step / NSLAB) * gridDim.x, tm = tile >> 5, tn = tile & 31;
#pragma unroll
                for (int e = 0; e < 4; ++e) { const size_t o = (size_t)(tm * 32 + 16 * rt + fq * 4 + e) * 1024 + tn * 32 + 16 * ct + fr;
                    if (MODE == 0) Cf[o] = acc[e]; else Cb[o] = f2bf(acc[e]); }
                acc = (f32x4){0.f, 0.f, 0.f, 0.f}; }
        }
        __syncthreads();
    }
}

#ifndef REP_SYNC
#define REP_SYNC 1
#endif
#define GSYNC() do { _Pragma("unroll 1") for (int _r = 0; _r < REP_SYNC; ++_r) xcd_barrier(xb); } while (0)
#ifndef REP_SAMP
#define REP_SAMP 1
#endif
#ifndef REP_SSD
#define REP_SSD 1
#endif
#ifndef REP_ROWS
#define REP_ROWS 1
#endif
#ifndef REP_P0
#define REP_P0 1
#endif
#ifndef REP_GEMM
#define REP_GEMM 1
#endif
#ifndef REP_MIX
#define REP_MIX 1
#endif
#ifndef REP_ATT
#define REP_ATT 1
#endif
__global__ void __launch_bounds__(512) mega(Params p_unused) {
    const KPRM kp = (KPRM)__builtin_amdgcn_kernarg_segment_ptr();
#define PP (*kp_launder(kp))
    extern __shared__ __attribute__((aligned(16))) unsigned char shm[];
    LAS unsigned char* lds = (LAS unsigned char*)shm;
    cg::grid_group grid = cg::this_grid();
    unsigned char* ws = PP.ws;
    bf16_t* H = (bf16_t*)(ws + OFF_H); bf16_t* UB = (bf16_t*)(ws + OFF_U); bf16_t* YC = (bf16_t*)(ws + OFF_YC); bf16_t* M = (bf16_t*)(ws + OFF_M);
    bf16_t* QB = (bf16_t*)(ws + OFF_Q); bf16_t* ACT = (bf16_t*)(ws + OFF_ACT); float* X = PP.out; float* SDT = (float*)(ws + OFF_SDT);
    volatile LAS unsigned* xst = (volatile LAS unsigned*)(lds + 163824);
    unsigned* bar = (unsigned*)(ws + OFF_BAR);
    { const int t0 = tidx(); if (t0 == 0) { xst[0] = 0u; xst[1] = 0u; } if (blockIdx.x == 0) for (int i = t0; i < XCD_BAR_WORDS; i += NTHR) bar[i] = 0u; }
    __syncthreads();
    phase0(PP, lds);
    grid.sync();
    XcdBarrier xb = xcd_barrier_post(bar, xst);
#pragma unroll 1
    for (int rep = 1; rep < REP_P0; ++rep) { phase0(PP, lds); GSYNC(); }
#pragma unroll 1
    for (int l = 0; l < NL; ++l) {
#pragma unroll 1
        for (int rep = 0; rep < REP_GEMM; ++rep) {
            { EpiBf16 e{UB, NU}; run_gemm(lds, H, (const bf16_t*)(ws + OFF_WIN) + (size_t)l * NU * D, TT, NU, D, e, 0); }
            { EpiMemKV e{PP.out + O_PMK + (size_t)l * 8 * 256 * 1024, PP.out + O_PMV + (size_t)l * 8 * 256 * 1024, (bf16_t*)(ws + OFF_KB), (bf16_t*)(ws + OFF_VTB)};
              run_gemm(lds, (const bf16_t*)(ws + OFF_HM) + (size_t)l * 2048 * D, (const bf16_t*)(ws + OFF_WXKV) + (size_t)l * 2048 * D, 2048, 2048, D, e, 64); }
            GSYNC();
        }
#pragma unroll 1
        for (int rep = 0; rep < REP_MIX; ++rep) {
#pragma unroll 1
            for (int grp = 0; grp < 2; ++grp) { const int gsel = (blockIdx.x & 1) ? 1 - grp : grp;
                if (gsel == 0) {
#pragma unroll 1
                    for (int r2 = 0; r2 < REP_SSD; ++r2)
                    for (int u = blockIdx.x; u < 512; u += gridDim.x) ssd_passA(PP, lds, l, u);
                } else {
#pragma unroll 1
                    for (int u = blockIdx.x; u < 256; u += gridDim.x) { retA4_unit(PP, lds, l, u); hgA4_unit(PP, lds, l, u); }
                    rg_loop<false>(PP, lds, l);
                }
            }
            GSYNC();
#pragma unroll 1
            for (int grp = 0; grp < 2; ++grp) { const int gsel = (blockIdx.x & 1) ? 1 - grp : grp;
                if (gsel == 0) {
#pragma unroll 1
                    for (int r2 = 0; r2 < REP_SAMP; ++r2)
                    for (int u = blockIdx.x; u < 512; u += gridDim.x) {
                        if (u < 128) sample_ssd(PP, lds, l, u);
                        else if (u < 256) sample_ret(PP, lds, l, u - 128);
                        else if (u < 384) sample_hg(PP, lds, l, u - 256);
                        else sample_rg(PP, lds, l, u - 384);
                    }
                } else carry_phase(PP, l);
            }
            GSYNC();
            if ((blockIdx.x & 1) == 0) {
#pragma unroll 1
                for (int r2 = 0; r2 < REP_SSD; ++r2)
                for (int u = blockIdx.x; u < 256; u += gridDim.x) ssd_passC(PP, lds, l, u);
            }
#if 1
#if 1
            ret_loop<true>(PP, lds, l);
#else
#pragma unroll 1
            for (int u = blockIdx.x; u < 512; u += gridDim.x) retC2_unit(PP, lds, l, u);
#endif
            hg_loop<true>(PP, lds, l); rg_loop<true>(PP, lds, l);
            if (blockIdx.x & 1) {
#pragma unroll 1
                for (int r2 = 0; r2 < REP_SSD; ++r2)
                for (int u = blockIdx.x; u < 256; u += gridDim.x) ssd_passC(PP, lds, l, u);
            }
#else
#pragma unroll 1
            for (int u = blockIdx.x; u < 1024; u += gridDim.x) mixC_unit(PP, lds, l, u);
#endif
            GSYNC();
        }
#pragma unroll 1
        for (int rep = 0; rep < REP_GEMM; ++rep) { EpiBf16 e{M, D}; run_gemm(lds, YC, (const bf16_t*)(ws + OFF_WOUT) + (size_t)l * D * D, TP, D, D, e, 0);
            sgemm<1, 1024, 1024>(lds, YC + (size_t)TP * D, (const bf16_t*)(ws + OFF_WOUT) + (size_t)l * D * D, nullptr, M + (size_t)TP * D); GSYNC(); }
        rows_phase(lds, TT, l == 0 ? PP.in[0] : nullptr, l == 0 ? PP.in[1] : nullptr, X, M, PP.in[12] + l * D, PP.in[13] + l * D, H, nullptr, nullptr);
#if REP_ROWS > 1
        rows_phase(lds, TT, nullptr, nullptr, (float*)(ws + OFF_XS), M, PP.in[12] + l * D, PP.in[13] + l * D, (bf16_t*)(ws + OFF_HS), nullptr, nullptr);
#endif
        GSYNC();
#pragma unroll 1
        for (int rep = 0; rep < REP_GEMM; ++rep) { EpiBf16 e{QB, D}; run_gemm(lds, H, (const bf16_t*)(ws + OFF_WXQ) + (size_t)l * D * D, TP, D, D, e, 0);
            sgemm<1, 1024, 1024>(lds, H + (size_t)TP * D, (const bf16_t*)(ws + OFF_WXQ) + (size_t)l * D * D, nullptr, QB + (size_t)TP * D); GSYNC(); }
#pragma unroll 1
        for (int rep = 0; rep < REP_ATT; ++rep) {
            for (int k = 0; k < 1024; k += gridDim.x) { const int u = (gridDim.x == 256 && (blockIdx.x & 1)) ? (int)((blockIdx.x + k + 512) & 1023) : (int)(blockIdx.x + k);
                if (u < 512) attn_prompt(PP, lds, u); else if (u < 1024) attn_sample(PP, lds, l, u - 512); }
            GSYNC();
        }
#pragma unroll 1
        for (int rep = 0; rep < REP_GEMM; ++rep) { EpiBf16 e{M, D}; run_gemm(lds, YC, (const bf16_t*)(ws + OFF_WXO) + (size_t)l * D * D, TP, D, D, e, 0);
            sgemm<1, 1024, 1024>(lds, YC + (size_t)TP * D, (const bf16_t*)(ws + OFF_WXO) + (size_t)l * D * D, nullptr, M + (size_t)TP * D); GSYNC(); }
        rows_phase(lds, TT, nullptr, nullptr, X, M, PP.in[14] + l * D, PP.in[15] + l * D, H, nullptr, nullptr);
#if REP_ROWS > 1
        rows_phase(lds, TT, nullptr, nullptr, (float*)(ws + OFF_XS), M, PP.in[14] + l * D, PP.in[15] + l * D, (bf16_t*)(ws + OFF_HS), nullptr, nullptr);
#endif
        GSYNC();
#pragma unroll 1
        for (int rep = 0; rep < REP_GEMM; ++rep) { EpiSwiGLU e{ACT}; run_gemm(lds, H, (const bf16_t*)(ws + OFF_WGU) + (size_t)l * 5632 * D, TT, 5632, D, e, 0); GSYNC(); }
#pragma unroll 1
        for (int rep = 0; rep < REP_GEMM; ++rep) { EpiBf16 e{M, D}; run_gemm(lds, ACT, (const bf16_t*)(ws + OFF_WDN) + (size_t)l * D * DFF, TP, D, DFF, e, 0);
            sgemm<1, 2816, 704>(lds, ACT + (size_t)TP * DFF, (const bf16_t*)(ws + OFF_WDN) + (size_t)l * D * DFF, nullptr, M + (size_t)TP * D); GSYNC(); }
        rows_phase(lds, TT, nullptr, nullptr, X, M, PP.in[16] + l * D, l + 1 < NL ? PP.in[11] + (l + 1) * D : nullptr, H, l + 1 < NL ? PP.in[17] + (size_t)(l + 1) * D * DIN : nullptr, SDT);
#if REP_ROWS > 1
        rows_phase(lds, TT, nullptr, nullptr, (float*)(ws + OFF_XS), M, PP.in[16] + l * D, l + 1 < NL ? PP.in[11] + (l + 1) * D : nullptr, (bf16_t*)(ws + OFF_HS), l + 1 < NL ? PP.in[17] + (size_t)(l + 1) * D * DIN : nullptr, (float*)(ws + OFF_HS));
#endif
        GSYNC();
    }
}

#undef PP
extern "C" void kernel_launch(void* const* d_in, const int* in_sizes, int n_in, void* d_out, int out_size, void* d_ws, size_t ws_size, hipStream_t stream) {
    constexpr int LDS_BYTES = 160 * 1024;
    static int grid = 0;
    if (grid == 0) {
        if (n_in != 41 || (size_t)out_size != O_END || ws_size < WS_END) { fprintf(stderr, "kernel_launch: unexpected shapes (n_in %d out %d ws %zu need %zu)\n", n_in, out_size, ws_size, (size_t)WS_END); grid = -1; return; }
        int dev = 0, cus = 0, per_cu = 0;
        (void)hipGetDevice(&dev);
        (void)hipDeviceGetAttribute(&cus, hipDeviceAttributeMultiprocessorCount, dev);
        (void)hipFuncSetAttribute((const void*)mega, hipFuncAttributeMaxDynamicSharedMemorySize, LDS_BYTES);
        (void)hipOccupancyMaxActiveBlocksPerMultiprocessor(&per_cu, (const void*)mega, 512, LDS_BYTES);
        if (per_cu < 1) { fprintf(stderr, "kernel_launch: occupancy query reports %d blocks per CU\n", per_cu); per_cu = 1; }
        grid = cus < 256 ? cus : 256;
    }
    if (grid < 0) return;
    Params p{};
    for (int i = 0; i < 41; ++i) p.in[i] = (const float*)d_in[i];
    p.out = (float*)d_out; p.ws = (unsigned char*)d_ws;
    void* args[] = {&p};
    hipError_t e = hipLaunchCooperativeKernel((void*)mega, dim3(grid), dim3(512), args, LDS_BYTES, stream);
    if (e != hipSuccess) fprintf(stderr, "cooperative launch failed: %s (grid %d)\n", hipGetErrorString(e), grid);
}
```

```cpp
#include <hip/hip_runtime.h>
#include <hip/hip_cooperative_groups.h>
#include <cstdio>
#include <cstdint>
namespace cg = cooperative_groups;
__device__ __forceinline__ int tidx() { int t = threadIdx.x; asm volatile("" : "+v"(t)); return t; }
namespace pg8 {
#define PG8_LAS __attribute__((address_space(3)))
typedef unsigned short bf16_t;
typedef short bf16x8 __attribute__((ext_vector_type(8)));
typedef float f32x4 __attribute__((ext_vector_type(4)));
typedef unsigned u32x4 __attribute__((ext_vector_type(4)));
constexpr int BM = 256, BK = 64, HALF = 128, HTB = HALF * BK * 2  , STAGE_BYTES = 8 * HTB, NXCD = 8, WGM = 8;

__host__ __device__ __forceinline__ int lds_byte(int r, int c) { const int st = (r >> 4) * 2 + (c >> 5), rr = r & 15, cc = c & 31, ob = rr * 64 + cc * 2; return st * 1024 + (ob ^ (((ob >> 9) & 1) << 5)); }
__host__ __device__ __forceinline__ void stage_rc(int b, int& R, int& C) { const int st = b / 1024, sb = b % 1024, swz = sb ^ (((sb >> 9) & 1) << 5); R = (st >> 1) * 16 + swz / 64; C = (st & 1) * 32 + (swz % 64) / 2; }
__host__ __device__ __forceinline__ int perm32(int rho) { const int n = rho >> 4, i = rho & 15; return 8 * (i >> 2) + 4 * n + (i & 3); }

struct Unit { int pm, pn; };
struct Gemm { const bf16_t* A; const bf16_t* Bt; int M, N, K; };

struct StaticOrder {
    int nM, nN, nwg, G, c;
    __host__ __device__ void init(int M, int N, int G_, int c_) { nM = M / BM; nN = N / BM; nwg = nM * nN; G = G_; c = c_; }
    __host__ __device__ bool next(int i, Unit& u) const {
        const long L = (long)i * G + c; if (L >= nwg) return false;
        int wgid = (int)L; { const int q = nwg / NXCD, r = nwg % NXCD, xcd = wgid % NXCD, off = wgid / NXCD; wgid = (xcd < r ? xcd * (q + 1) : r * (q + 1) + (xcd - r) * q) + off; }
        const int nig = WGM * nN, gid = wgid / nig, fm = gid * WGM, gsz = (nM - fm) < WGM ? (nM - fm) : WGM;
        u.pm = fm + ((wgid % nig) % gsz); u.pn = (wgid % nig) / gsz; return true;
    }
    __device__ __forceinline__ void a_ready(const Unit&) const {}
    __device__ __forceinline__ void done(const Unit&) const {}
};
}
namespace pg8 {
template <class Epi, class Sched, bool STAMP = false>
__device__ __forceinline__ void gemm_phase(PG8_LAS unsigned char* lds, const Gemm g, const Sched& S, const Epi& E, unsigned long long* stamps) {
    const int tid = tidx(), wid = __builtin_amdgcn_readfirstlane(tid >> 6), lane = tid & 63, wr = wid >> 2, wc = wid & 3, fr = lane & 15, fq = lane >> 4;
    const int K = g.K, nt = K / BK;
    int ts_lo = 0, ts_hi = 0, nts = 0; const unsigned long long rt_entry = STAMP ? (unsigned long long)wall_clock64() : 0ull;
#define PG8_STAMP() do { if (STAMP && wid == 0 && nts < 64) { const unsigned long long _c = (unsigned long long)clock64(); \
        ts_lo = (lane == nts) ? (int)(unsigned)_c : ts_lo; ts_hi = (lane == nts) ? (int)(unsigned)(_c >> 32) : ts_hi; ++nts; } } while (0)
    PG8_STAMP();
    unsigned voffA[2], voffB[2];
#pragma unroll
    for (int i = 0; i < 2; ++i) { int R, C; stage_rc(tid * 16 + i * 8192, R, C); const int Rb = Epi::PERM ? ((R & ~31) + perm32(R & 31)) : R;
        voffA[i] = (unsigned)(R * K + C) * 2u; voffB[i] = (unsigned)(Rb * K + C) * 2u; }
    const size_t kstep = (size_t)(BK * 2);
    const size_t hstep = (size_t)HALF * K * 2;
    const size_t tstep = 2 * hstep;
    const unsigned ldsw = (unsigned)wid * 1024u;
    const int aoff = lds_byte(wr * 64 + fr, fq * 8), boff = lds_byte(wc * 32 + fr, fq * 8);
#define PG8_SA(b, h) (((b) * 2 + (h)) * HTB)
#define PG8_SB(b, h) ((4 + (b) * 2 + (h)) * HTB)
#define PG8_STAGE(bufoff, gbase, voff) do { _Pragma("unroll") for (int _i = 0; _i < 2; ++_i) \
        __builtin_amdgcn_global_load_lds((const unsigned*)((const char*)(gbase) + (voff)[_i]), (PG8_LAS unsigned*)(lds + (bufoff) + ldsw + _i * 8192), 16, 0, 0); } while (0)
#define PG8_LDA(dst, b, h) do { _Pragma("unroll") for (int m = 0; m < 4; ++m) _Pragma("unroll") for (int k = 0; k < 2; ++k) dst[m][k] = *(const PG8_LAS bf16x8*)(lds + PG8_SA(b, h) + aoff + m * 2048 + k * 1024); } while (0)
#define PG8_LDB(dst, b, h) do { _Pragma("unroll") for (int n = 0; n < 2; ++n) _Pragma("unroll") for (int k = 0; k < 2; ++k) dst[n][k] = *(const PG8_LAS bf16x8*)(lds + PG8_SB(b, h) + boff + n * 2048 + k * 1024); } while (0)
#define PG8_MMA(ai, bj, At, Bt) do { __builtin_amdgcn_s_setprio(1); _Pragma("unroll") for (int m = 0; m < 4; ++m) _Pragma("unroll") for (int n = 0; n < 2; ++n) _Pragma("unroll") for (int k = 0; k < 2; ++k) \
        acc[ai][bj][m][n] = __builtin_amdgcn_mfma_f32_16x16x32_bf16(Bt[n][k], At[m][k], acc[ai][bj][m][n], 0, 0, 0); __builtin_amdgcn_s_setprio(0); } while (0)
#define PG8_WAIT_V(n) asm volatile("s_waitcnt vmcnt(" #n ")" ::: "memory")
#define PG8_WAIT_L(n) asm volatile("s_waitcnt lgkmcnt(" #n ")" ::: "memory")
#define PG8_BAR __builtin_amdgcn_s_barrier()
#define PG8_SCHED __builtin_amdgcn_sched_barrier(0)
    Unit cur, nxt; int ui = 0;
    if (!S.next(0, cur)) return;
    f32x4 acc[2][2][4][2];
#pragma unroll
    for (int a = 0; a < 2; ++a)
#pragma unroll
        for (int b = 0; b < 2; ++b)
#pragma unroll
            for (int m = 0; m < 4; ++m)
#pragma unroll
                for (int n = 0; n < 2; ++n) acc[a][b][m][n] = (f32x4){0.f, 0.f, 0.f, 0.f};
    bf16x8 At[4][2], B0[2][2], B1[2][2];
    const char* cA = (const char*)g.A + (size_t)cur.pm * tstep; const char* cB = (const char*)g.Bt + (size_t)cur.pn * tstep;
    S.a_ready(cur);
    PG8_STAGE(PG8_SB(0, 0), cB, voffB); PG8_STAGE(PG8_SA(0, 0), cA, voffA); PG8_STAGE(PG8_SB(0, 1), cB + hstep, voffB); PG8_STAGE(PG8_SA(0, 1), cA + hstep, voffA);
    if (wr == 1) PG8_BAR;
    PG8_WAIT_V(4); PG8_BAR;
    PG8_STAGE(PG8_SB(1, 0), cB + kstep, voffB); PG8_STAGE(PG8_SA(1, 0), cA + kstep, voffA); PG8_STAGE(PG8_SB(1, 1), cB + hstep + kstep, voffB);
    PG8_WAIT_V(6); PG8_BAR;
    PG8_STAMP();
    for (;;) {
        const bool has_next = S.next(ui + 1, nxt);
        const char* nA = has_next ? (const char*)g.A + (size_t)nxt.pm * tstep : cA; const char* nB = has_next ? (const char*)g.Bt + (size_t)nxt.pn * tstep : cB;
        for (int t = 0; t < nt; t += 2) {
            const bool last = (t == nt - 2);
            const char* a1 = cA + (size_t)(t + 1) * kstep;
            const char* a2 = last ? nA : cA + (size_t)(t + 2) * kstep; const char* b2 = last ? nB : cB + (size_t)(t + 2) * kstep;
            const char* a3 = a2 + kstep; const char* b3 = b2 + kstep;
            if (last && has_next) S.a_ready(nxt);
            PG8_LDB(B0, 0, 0); PG8_SCHED; PG8_LDA(At, 0, 0); PG8_STAGE(PG8_SA(1, 1), a1 + hstep, voffA);
            PG8_WAIT_L(8); PG8_BAR; PG8_WAIT_L(0); PG8_MMA(0, 0, At, B0); PG8_BAR; PG8_SCHED;
            PG8_LDB(B1, 0, 1); PG8_STAGE(PG8_SB(0, 0), b2, voffB);
            PG8_BAR; PG8_WAIT_L(0); PG8_MMA(0, 1, At, B1); PG8_BAR;
            PG8_LDA(At, 0, 1); PG8_STAGE(PG8_SA(0, 0), a2, voffA);
            PG8_BAR; PG8_WAIT_L(0); PG8_MMA(1, 0, At, B0); PG8_BAR; PG8_SCHED;
            PG8_STAGE(PG8_SB(0, 1), b2 + hstep, voffB);
            PG8_WAIT_V(6); PG8_BAR; PG8_MMA(1, 1, At, B1); PG8_BAR;
            PG8_LDB(B0, 1, 0); PG8_SCHED; PG8_LDA(At, 1, 0); PG8_STAGE(PG8_SA(0, 1), a2 + hstep, voffA);
            PG8_WAIT_L(8); PG8_BAR; PG8_WAIT_L(0); PG8_MMA(0, 0, At, B0); PG8_BAR; PG8_SCHED;
            PG8_LDB(B1, 1, 1); PG8_STAGE(PG8_SB(1, 0), b3, voffB);
            PG8_BAR; PG8_WAIT_L(0); PG8_MMA(0, 1, At, B1); PG8_BAR;
            PG8_LDA(At, 1, 1); PG8_STAGE(PG8_SA(1, 0), a3, voffA);
            PG8_BAR; PG8_WAIT_L(0); PG8_MMA(1, 0, At, B0); PG8_BAR; PG8_SCHED;
            PG8_STAGE(PG8_SB(1, 1), b3 + hstep, voffB);
            PG8_WAIT_V(6); PG8_BAR; PG8_MMA(1, 1, At, B1); PG8_BAR;
        }
        PG8_STAMP();
        if constexpr (!Epi::AFTER_DRAIN) { E(acc, cur, wr, wc, fr, fq); S.done(cur); }
        PG8_STAMP();
        if (!has_next) break;
#pragma unroll
        for (int a = 0; a < 2; ++a)
#pragma unroll
            for (int b = 0; b < 2; ++b)
#pragma unroll
                for (int m = 0; m < 4; ++m)
#pragma unroll
                    for (int n = 0; n < 2; ++n) acc[a][b][m][n] = (f32x4){0.f, 0.f, 0.f, 0.f};
        cur = nxt; cA = nA; cB = nB; ++ui;
    }
    PG8_WAIT_V(0);
    if (wr == 0) PG8_BAR;
    PG8_BAR;
    if constexpr (Epi::AFTER_DRAIN) { E.fused(acc, cur, wr, wc, fr, fq, lds, wid, lane); S.done(cur); }
    PG8_STAMP();
    if (STAMP && wid == 0) { stamps[lane] = lane < nts ? (((unsigned long long)(unsigned)ts_hi << 32) | (unsigned)ts_lo) : 0ull;
        if (lane == 62) stamps[62] = rt_entry; if (lane == 63) stamps[63] = (unsigned long long)wall_clock64(); }
#undef PG8_STAMP
#undef PG8_SA
#undef PG8_SB
#undef PG8_STAGE
#undef PG8_LDA
#undef PG8_LDB
#undef PG8_MMA
#undef PG8_WAIT_V
#undef PG8_WAIT_L
#undef PG8_BAR
#undef PG8_SCHED
}
}

#define LAS __attribute__((address_space(3)))
using pg8::bf16_t; using pg8::bf16x8; using pg8::f32x4; using pg8::u32x4;
typedef unsigned u32x2 __attribute__((ext_vector_type(2)));
typedef float f32x2 __attribute__((ext_vector_type(2)));

constexpr int D = 1024, TP = 16384, TS = 512, TT = TP + TS, NU = 3584, DIN = 3588, DFF = 2816, NL = 2;
constexpr int NTHR = 512;
constexpr float EPS = 1e-6f;
constexpr int UZ = 0, UXBC = 256, URQ = 1024, URK = 1280, URV = 1536, URG = 1792, UGX = 2048, UGY = 2304, UHQ = 2560, UHF = 2816, UHI = 3072, UHG = 3328;
constexpr size_t O_YP = 0, O_YS = O_YP + (size_t)8 * 2048 * 1024, O_PSSD = O_YS + (size_t)128 * 4 * 1024, O_PSSDC = O_PSSD + (size_t)2 * 8 * 4 * 128 * 64,
    O_PRET = O_PSSDC + (size_t)2 * 8 * 3 * 768, O_PRG = O_PRET + (size_t)2 * 8 * 4 * 64 * 64, O_PRGC = O_PRG + (size_t)2 * 8 * 256, O_PHG = O_PRGC + (size_t)2 * 8 * 3 * 256,
    O_PMK = O_PHG + (size_t)2 * 8 * 4 * 64 * 64, O_PMV = O_PMK + (size_t)2 * 8 * 256 * 1024, O_SSSD = O_PMV + (size_t)2 * 8 * 256 * 1024, O_SSSDC = O_SSSD + (size_t)2 * 128 * 4 * 128 * 64,
    O_SRET = O_SSSDC + (size_t)2 * 128 * 3 * 768, O_SRG = O_SRET + (size_t)2 * 128 * 4 * 64 * 64, O_SRGC = O_SRG + (size_t)2 * 128 * 256, O_SHG = O_SRGC + (size_t)2 * 128 * 3 * 256,
    O_END = O_SHG + (size_t)2 * 128 * 4 * 64 * 64;
constexpr size_t OFF_WIN = 0, OFF_WOUT = OFF_WIN + (size_t)NL * NU * D * 2, OFF_WXQ = OFF_WOUT + (size_t)NL * D * D * 2, OFF_WXO = OFF_WXQ + (size_t)NL * D * D * 2,
    OFF_WXKV = OFF_WXO + (size_t)NL * D * D * 2, OFF_WGU = OFF_WXKV + (size_t)NL * 2048 * D * 2, OFF_WDN = OFF_WGU + (size_t)NL * 5632 * D * 2, OFF_WRG = OFF_WDN + (size_t)NL * D * DFF * 2,
    OFF_ROPE = OFF_WRG + (size_t)NL * 2 * 4 * 64 * 64 * 2, OFF_H = OFF_ROPE + (size_t)2052 * 32 * 2 * 4, OFF_HM = OFF_H + (size_t)TT * D * 2, OFF_U = OFF_HM + (size_t)NL * 2048 * D * 2,
    OFF_SDT = OFF_U + (size_t)TT * NU * 2, OFF_YC = OFF_SDT + (size_t)TT * 4 * 4, OFF_M = OFF_YC + (size_t)TT * D * 2, OFF_Q = OFF_M + (size_t)TT * D * 4, OFF_ACT = OFF_Q + (size_t)TT * D * 2,
    OFF_KB = OFF_ACT + (size_t)TT * DFF * 2, OFF_VTB = OFF_KB + (size_t)8 * 4 * 256 * 256 * 2, OFF_DSS = OFF_VTB + (size_t)8 * 4 * 256 * 256 * 2, OFF_DECS = OFF_DSS + (size_t)8 * 4 * 32 * 8192 * 4,
    OFF_DSR = OFF_DECS + 4096, OFF_DSH = OFF_DSR + (size_t)8 * 4 * 32 * 4096 * 4, OFF_DECH = OFF_DSH + (size_t)8 * 4 * 32 * 4096 * 4, OFF_RGH = OFF_DECH + (size_t)8 * 4 * 32 * 64 * 4,
    OFF_RGA = OFF_RGH + (size_t)8 * 32 * 256 * 4, OFF_RGC = OFF_RGA + (size_t)8 * 32 * 256 * 4, OFF_BAR = OFF_RGC + (size_t)8 * 32 * 256 * 4, OFF_LB = OFF_BAR + 16384, OFF_XS = OFF_LB + 4096, OFF_HS = OFF_XS + (size_t)TT * D * 4, WS_END = OFF_HS + (size_t)TT * D * 2;

struct Params { const float* in[41]; float* out; unsigned char* ws; };
typedef const __attribute__((address_space(4))) Params* KPRM;
typedef const __attribute__((address_space(4))) Params& PRM;
__device__ __forceinline__ KPRM kp_launder(KPRM k) { asm volatile("" : "+s"(k)); return k; }

__device__ __forceinline__ float bf2f(bf16_t b) { return __uint_as_float(((unsigned)b) << 16); }
__device__ __forceinline__ unsigned pk2(float lo, float hi) { unsigned r; asm volatile("v_cvt_pk_bf16_f32 %0, %1, %2" : "=v"(r) : "v"(lo), "v"(hi)); return r; }
__device__ __forceinline__ bf16_t f2bf(float f) { return (bf16_t)(pk2(f, f) & 0xffffu); }
__device__ __forceinline__ float sigmoidf_(float x) { return __builtin_amdgcn_rcpf(1.0f + __expf(-x)); }
__device__ __forceinline__ float siluf_(float x) { return x * __builtin_amdgcn_rcpf(1.0f + __expf(-x)); }
__device__ __forceinline__ float siluf_div(float x) { return x / (1.0f + __expf(-x)); }
__device__ __forceinline__ float softplusf_(float x) { const float e = __expf(-fabsf(x)); const float l1p = e < 1.0e-3f ? e * (1.0f - e * (0.5f - e * 0.33333333f)) : __logf(1.0f + e); return fmaxf(x, 0.0f) + l1p; }
__device__ __forceinline__ float geluf_(float x) { const float u = 0.7978845608028654f * (x + 0.044715f * x * x * x); return x * __builtin_amdgcn_rcpf(1.0f + __expf(-2.0f * u)); }
__device__ __forceinline__ float wave_sum(float v) {
#pragma unroll
    for (int o = 1; o < 64; o <<= 1) v += __shfl_xor(v, o);
    return v;
}
__device__ __forceinline__ float wave_max(float v) {
#pragma unroll
    for (int o = 1; o < 64; o <<= 1) v = fmaxf(v, __shfl_xor(v, o));
    return v;
}
template <int NT, int KS>
__device__ __forceinline__ void mm_nt(f32x4 (&acc)[NT], const LAS bf16_t* A, int lda, const LAS bf16_t* B, int ldb, int lane) {
    const int r = lane & 15, q = (lane >> 4) * 8;
#pragma unroll
    for (int ks = 0; ks < KS; ++ks) {
        const bf16x8 a = *(const LAS bf16x8*)(A + r * lda + ks * 32 + q);
#pragma unroll
        for (int j = 0; j < NT; ++j) {
            const bf16x8 b = *(const LAS bf16x8*)(B + (16 * j + r) * ldb + ks * 32 + q);
            acc[j] = __builtin_amdgcn_mfma_f32_16x16x32_bf16(a, b, acc[j], 0, 0, 0);
        }
    }
}

struct EpiBf16 {
    static constexpr bool PERM = true, AFTER_DRAIN = false;
    bf16_t* O; int ldc;
    __device__ __forceinline__ void operator()(const f32x4 (&acc)[2][2][4][2], const pg8::Unit& u, int wr, int wc, int fr, int fq) const {
        const int row0 = u.pm * 256 + wr * 64 + fr, col0 = u.pn * 256 + wc * 32 + 8 * fq;
#pragma unroll
        for (int ai = 0; ai < 2; ++ai)
#pragma unroll
            for (int m = 0; m < 4; ++m) {
                bf16_t* rowp = O + (size_t)(row0 + ai * 128 + m * 16) * ldc + col0;
#pragma unroll
                for (int bj = 0; bj < 2; ++bj) {
                    const f32x4 v0 = acc[ai][bj][m][0], v1 = acc[ai][bj][m][1];
                    u32x4 w; w.x = pk2(v0[0], v0[1]); w.y = pk2(v0[2], v0[3]); w.z = pk2(v1[0], v1[1]); w.w = pk2(v1[2], v1[3]);
                    *(u32x4*)(rowp + bj * 128) = w;
                }
            }
    }
};
struct EpiF32 {
    static constexpr bool PERM = false, AFTER_DRAIN = false;
    float* C; int ldc;
    __device__ __forceinline__ void operator()(const f32x4 (&acc)[2][2][4][2], const pg8::Unit& u, int wr, int wc, int fr, int fq) const {
        const int row0 = u.pm * 256 + wr * 64 + fr, col0 = u.pn * 256 + wc * 32 + 4 * fq;
#pragma unroll
        for (int ai = 0; ai < 2; ++ai)
#pragma unroll
            for (int m = 0; m < 4; ++m) {
                float* rowp = C + (size_t)(row0 + ai * 128 + m * 16) * ldc + col0;
#pragma unroll
                for (int bj = 0; bj < 2; ++bj)
#pragma unroll
                    for (int n = 0; n < 2; ++n) *(f32x4*)(rowp + bj * 128 + n * 16) = acc[ai][bj][m][n];
            }
    }
};
struct EpiSwiGLU {
    static constexpr bool PERM = true, AFTER_DRAIN = false;
    bf16_t* O;
    __device__ __forceinline__ void operator()(const f32x4 (&acc)[2][2][4][2], const pg8::Unit& u, int wr, int wc, int fr, int fq) const {
        const int row0 = u.pm * 256 + wr * 64 + fr, col0 = u.pn * 128 + wc * 32 + 8 * fq;
#pragma unroll
        for (int ai = 0; ai < 2; ++ai)
#pragma unroll
            for (int m = 0; m < 4; ++m) {
                bf16_t* rowp = O + (size_t)(row0 + ai * 128 + m * 16) * DFF + col0;
                const f32x4 g0 = acc[ai][0][m][0], g1 = acc[ai][0][m][1], u0 = acc[ai][1][m][0], u1 = acc[ai][1][m][1];
                u32x4 w;
                w.x = pk2(siluf_(g0[0]) * u0[0], siluf_(g0[1]) * u0[1]); w.y = pk2(siluf_(g0[2]) * u0[2], siluf_(g0[3]) * u0[3]);
                w.z = pk2(siluf_(g1[0]) * u1[0], siluf_(g1[1]) * u1[1]); w.w = pk2(siluf_(g1[2]) * u1[2], siluf_(g1[3]) * u1[3]);
                *(u32x4*)rowp = w;
            }
    }
};
struct EpiMemKV {
    static constexpr bool PERM = false, AFTER_DRAIN = false;
    float* kout; float* vout; bf16_t* KB; bf16_t* VTB;
    __device__ __forceinline__ void operator()(const f32x4 (&acc)[2][2][4][2], const pg8::Unit& u, int wr, int wc, int fr, int fq) const {
        const int row0 = u.pm * 256 + wr * 64 + fr, col0 = u.pn * 256 + wc * 32 + 4 * fq;
#pragma unroll
        for (int ai = 0; ai < 2; ++ai)
#pragma unroll
            for (int m = 0; m < 4; ++m) {
                const int row = row0 + ai * 128 + m * 16, b = row >> 8, key = row & 255;
#pragma unroll
                for (int bj = 0; bj < 2; ++bj)
#pragma unroll
                    for (int n = 0; n < 2; ++n) {
                        const int col = col0 + bj * 128 + n * 16; const f32x4 v = acc[ai][bj][m][n];
                        if (col < 1024) {
                            *(f32x4*)(kout + (size_t)row * 1024 + col) = v;
                            u32x2 w; w.x = pk2(v[0], v[1]); w.y = pk2(v[2], v[3]);
                            *(u32x2*)(KB + ((size_t)(b * 4 + (col >> 8)) * 256 + key) * 256 + (col & 255)) = w;
                        } else {
                            const int c2 = col - 1024;
                            *(f32x4*)(vout + (size_t)row * 1024 + c2) = v;
                            bf16_t* vp = VTB + ((size_t)(b * 4 + (c2 >> 8)) * 256 + (c2 & 255)) * 256 + key;
                            vp[0] = f2bf(v[0]); vp[256] = f2bf(v[1]); vp[512] = f2bf(v[2]); vp[768] = f2bf(v[3]);
                        }
                    }
            }
    }
};
template <class Epi>
__device__ __forceinline__ void run_gemm(LAS unsigned char* lds, const bf16_t* A, const bf16_t* Bt, int M, int N, int K, const Epi& E, int cshift) {
    asm volatile("" : "+s"(M), "+s"(N), "+s"(K));
    pg8::Gemm g{A, Bt, M, N, K};
    pg8::StaticOrder S; S.init(M, N, (int)gridDim.x, (int)((blockIdx.x + cshift) % gridDim.x));
    pg8::gemm_phase<Epi, pg8::StaticOrder, false>(lds, g, S, E, nullptr);
}

struct TItem { const float* src; bf16_t* dst; int ldw, K, k0, srcc, dstr; };
constexpr int I_IN = 16 * 112, I_SQ = 16 * 32, I_KV = 16 * 64, I_GU = 16 * 176, I_DN = 44 * 32, I_RG = 16;
constexpr int I_PER = I_IN + 3 * I_SQ + I_KV + I_GU + I_DN + I_RG;
__device__ __forceinline__ bool titem(PRM p, int it, TItem& T) {
    if (it >= NL * I_PER) return false;
    const int l = it / I_PER; int r = it % I_PER;
    unsigned char* ws = p.ws;
    if (r < I_IN) { const int kb = r / 112, n0 = (r % 112) * 32; T.src = p.in[17] + (size_t)l * D * DIN; T.ldw = DIN; T.K = D; T.k0 = kb * 64; T.srcc = n0 < 1024 ? n0 : n0 + 4;
        T.dst = (bf16_t*)(ws + OFF_WIN) + (size_t)l * NU * D; T.dstr = n0; return true; }
    r -= I_IN;
    if (r < 3 * I_SQ) { const int which = r / I_SQ; r %= I_SQ; const int kb = r / 32, n0 = (r % 32) * 32;
        T.src = p.in[which == 0 ? 34 : (which == 1 ? 36 : 38)] + (size_t)l * D * D; T.ldw = D; T.K = D; T.k0 = kb * 64; T.srcc = n0;
        T.dst = (bf16_t*)(ws + (which == 0 ? OFF_WOUT : (which == 1 ? OFF_WXQ : OFF_WXO))) + (size_t)l * D * D; T.dstr = n0; return true; }
    r -= 3 * I_SQ;
    if (r < I_KV) { const int kb = r / 64, n0 = (r % 64) * 32; T.src = p.in[37] + (size_t)l * D * 2048; T.ldw = 2048; T.K = D; T.k0 = kb * 64; T.srcc = n0;
        T.dst = (bf16_t*)(ws + OFF_WXKV) + (size_t)l * 2048 * D; T.dstr = n0; return true; }
    r -= I_KV;
    if (r < I_GU) { const int kb = r / 176, n0 = (r % 176) * 32; const int pn = n0 >> 8, bj = (n0 & 255) >> 7, j = n0 & 127;
        T.src = p.in[39] + (size_t)l * D * 5632; T.ldw = 5632; T.K = D; T.k0 = kb * 64; T.srcc = bj * DFF + pn * 128 + j;
        T.dst = (bf16_t*)(ws + OFF_WGU) + (size_t)l * 5632 * D; T.dstr = n0; return true; }
    r -= I_GU;
    if (r < I_DN) { const int kb = r / 32, n0 = (r % 32) * 32; T.src = p.in[40] + (size_t)l * DFF * D; T.ldw = D; T.K = DFF; T.k0 = kb * 64; T.srcc = n0;
        T.dst = (bf16_t*)(ws + OFF_WDN) + (size_t)l * D * DFF; T.dstr = n0; return true; }
    r -= I_DN;
    { const int gate = r >> 3, blk = (r & 7) >> 1, nb = r & 1;
        T.src = p.in[gate ? 29 : 27] + (size_t)(l * 4 + blk) * 4096; T.ldw = 64; T.K = 64; T.k0 = 0; T.srcc = nb * 32;
        T.dst = (bf16_t*)(ws + OFF_WRG) + (size_t)((l * 2 + gate) * 4 + blk) * 4096; T.dstr = nb * 32; return true; }
}

__device__ __forceinline__ void rows_phase(LAS unsigned char* lds, int nrows, const float* xp, const float* xs, float* X, const bf16_t* M, const float* gpost,
                                           const float* gpre, bf16_t* H, const float* wdt, float* SDT) {
    const int tid = tidx(), lane = tid & 63, wave = tid >> 6;
    const int gw = blockIdx.x * 8 + wave, NGW = gridDim.x * 8;
    LAS float* wl = (LAS float*)lds;
    if (wdt) { for (int i = tid; i < 4096; i += NTHR) wl[i] = wdt[(size_t)(i >> 2) * DIN + 1024 + (i & 3)]; __syncthreads(); }
    constexpr int NR = 4;
    for (int rowb = gw; rowb < nrows; rowb += NR * NGW) {
        f32x4 v[NR][4], m[NR][4];
        bool ok[NR];
#pragma unroll
        for (int q = 0; q < NR; ++q) { const int row = rowb + q * NGW; ok[q] = row < nrows;
            if (ok[q]) {
                const float* xr = xp ? (row < TP ? xp + (size_t)row * D : xs + (size_t)(row - TP) * D) : X + (size_t)row * D;
#pragma unroll
                for (int j = 0; j < 4; ++j) v[q][j] = ((const f32x4*)xr)[lane + 64 * j];
                if (M) {
#pragma unroll
                    for (int j = 0; j < 4; ++j) { const u32x2 w = ((const u32x2*)(M + (size_t)row * D))[lane + 64 * j];
                        m[q][j] = (f32x4){__uint_as_float(w.x << 16), __uint_as_float(w.x & 0xffff0000u), __uint_as_float(w.y << 16), __uint_as_float(w.y & 0xffff0000u)}; }
                }
            } }
#pragma unroll
        for (int q = 0; q < NR; ++q) { const int row = rowb + q * NGW;
            if (!ok[q]) continue;
            if (M) {
                float ss = 0.f;
#pragma unroll
                for (int j = 0; j < 4; ++j) ss += m[q][j].x * m[q][j].x + m[q][j].y * m[q][j].y + m[q][j].z * m[q][j].z + m[q][j].w * m[q][j].w;
                const float rstd = 1.0f / sqrtf(wave_sum(ss) * (1.0f / D) + EPS);
#pragma unroll
                for (int j = 0; j < 4; ++j) { const f32x4 g = ((const f32x4*)gpost)[lane + 64 * j]; v[q][j] = v[q][j] + m[q][j] * rstd * g; }
            }
            if (X && (M || xp)) {
#pragma unroll
                for (int j = 0; j < 4; ++j) ((f32x4*)(X + (size_t)row * D))[lane + 64 * j] = v[q][j];
            }
            if (gpre) {
                float ss = 0.f;
#pragma unroll
                for (int j = 0; j < 4; ++j) ss += v[q][j].x * v[q][j].x + v[q][j].y * v[q][j].y + v[q][j].z * v[q][j].z + v[q][j].w * v[q][j].w;
                const float rstd = 1.0f / sqrtf(wave_sum(ss) * (1.0f / D) + EPS);
                float d0 = 0.f, d1 = 0.f, d2 = 0.f, d3 = 0.f;
#pragma unroll
                for (int j = 0; j < 4; ++j) {
                    const f32x4 g = ((const f32x4*)gpre)[lane + 64 * j]; const f32x4 h = v[q][j] * rstd * g;
                    u32x2 w; w.x = pk2(h.x, h.y); w.y = pk2(h.z, h.w);
                    ((u32x2*)(H + (size_t)row * D))[lane + 64 * j] = w;
                    if (wdt) {
#pragma unroll
                        for (int e = 0; e < 4; ++e) { const f32x4 wv = *(const LAS f32x4*)(wl + 4 * (4 * (lane + 64 * j) + e)); const float he = h[e];
                            d0 += he * wv.x; d1 += he * wv.y; d2 += he * wv.z; d3 += he * wv.w; }
                    }
                }
                if (wdt) { d0 = wave_sum(d0); d1 = wave_sum(d1); d2 = wave_sum(d2); d3 = wave_sum(d3);
                    if (lane == 0) { f32x4 o; o.x = d0; o.y = d1; o.z = d2; o.w = d3; *(f32x4*)(SDT + (size_t)row * 4) = o; } }
            }
        }
    }
    if (wdt) __syncthreads();
}

__device__ __forceinline__ void transposes(PRM p, LAS unsigned char* lds, int it_lo, int it_hi, int gwv, int ngw) {
    const int tid = tidx(), lane = tid & 63, wave = tid >> 6;
    LAS float* scr = (LAS float*)lds + wave * (64 * 33);
    for (int base = it_lo; base < it_hi; base += ngw) {
        TItem T; const bool ok = (base + gwv < it_hi) && titem(p, base + gwv, T);
        if (ok) {
            float tv[32];
#pragma unroll
            for (int i = 0; i < 32; ++i) tv[i] = T.src[(size_t)(T.k0 + 2 * i + (lane >> 5)) * T.ldw + T.srcc + (lane & 31)];
#pragma unroll
            for (int i = 0; i < 32; ++i) scr[(2 * i + (lane >> 5)) * 33 + (lane & 31)] = tv[i];
        }
        __syncthreads();
        if (ok) {
            const int c = lane & 7;
#pragma unroll
            for (int j = 0; j < 4; ++j) { const int n = (lane >> 3) + 8 * j; const LAS float* s = scr + (8 * c) * 33 + n;
                u32x4 o; o.x = pk2(s[0 * 33], s[1 * 33]); o.y = pk2(s[2 * 33], s[3 * 33]); o.z = pk2(s[4 * 33], s[5 * 33]); o.w = pk2(s[6 * 33], s[7 * 33]);
                *(u32x4*)(T.dst + (size_t)(T.dstr + n) * T.K + T.k0 + 8 * c) = o; }
        }
        __syncthreads();
    }
}

__device__ __forceinline__ void phase0(PRM p, LAS unsigned char* lds) {
    const int tid = tidx(), lane = tid & 63, wave = tid >> 6;
    const int gw = blockIdx.x * 8 + wave, NGW = gridDim.x * 8;
    transposes(p, lds, 0, NL * I_PER, gw, NGW);
    float* RC = (float*)(p.ws + OFF_ROPE); float* RS = RC + 2052 * 32;
    for (int i = blockIdx.x * NTHR + tid; i < 2052 * 32; i += gridDim.x * NTHR) {
        const int pi = i >> 5, j = i & 31;
        const double pos = pi < 2048 ? (double)pi : (double)(16384 + pi - 2048);
        const double inv = exp2(-(double)j * (13.287712379549449 / 32.0));
        const double ang = pos * inv;
        const double r = ang - 6.283185307179586 * rint(ang * 0.15915494309189535);
        const float rf = (float)r;
        RC[i] = cosf(rf); RS[i] = sinf(rf);
    }
    if (blockIdx.x == 0 && tid < 256) { const float a0 = p.in[32][tid], a1 = p.in[32][256 + tid]; const float mx = fmaxf(a0, a1), e0 = expf(a0 - mx), e1 = expf(a1 - mx);
        ((float*)(p.ws + OFF_LB))[tid] = 0.f; ((float*)(p.ws + OFF_LB))[256 + tid] = e1 / (e0 + e1); }
    rows_phase(lds, TT, p.in[0], p.in[1], nullptr, nullptr, nullptr, p.in[11], (bf16_t*)(p.ws + OFF_H), p.in[17], (float*)(p.ws + OFF_SDT));
    for (int l = 0; l < NL; ++l)
        rows_phase(lds, 2048, p.in[10], nullptr, nullptr, nullptr, nullptr, p.in[35] + l * D, (bf16_t*)(p.ws + OFF_HM) + (size_t)l * 2048 * D, nullptr, nullptr);
}
#define XB_TMO      128
#define XB_XCNT(j)  (256  + 64 * (j))
#define XB_XSUB(j)  (1280 + 64 * (j))
#define XB_XGEN(j)  (2304 + 64 * (j))
#define XB_TOP      3328
#define XB_TOPGEN   3392
#define XCD_BAR_WORDS 3456
#define XB_SPIN_CAP (1u << 18)

__device__ __forceinline__ unsigned xb_ld(unsigned* p)              { return __hip_atomic_load(p, __ATOMIC_RELAXED, __HIP_MEMORY_SCOPE_AGENT); }
__device__ __forceinline__ unsigned xb_add(unsigned* p, unsigned v) { return __hip_atomic_fetch_add(p, v, __ATOMIC_RELAXED, __HIP_MEMORY_SCOPE_AGENT); }
__device__ __forceinline__ unsigned xb_xcc_id() { return (unsigned)__builtin_amdgcn_s_getreg((3 << 11) | 20) & 0xFu; }
#define XB_SPIN(cond, bar) do { unsigned _sp = 0; while (cond) { __builtin_amdgcn_s_sleep(1); \
    if ((++_sp & 255u) == 0u) { if (xb_ld(&(bar)[XB_TMO])) break; if (_sp > XB_SPIN_CAP) { atomicAdd(&(bar)[XB_TMO], 1u); break; } } } } while (0)

struct XcdBarrier {
    unsigned* bar; unsigned x;
    volatile LAS unsigned* st;
};

__device__ __forceinline__ XcdBarrier xcd_barrier_post(unsigned* bar, volatile LAS unsigned* st) {
    XcdBarrier b; b.bar = bar; b.x = xb_xcc_id(); b.st = st;
    if (tidx() == 0) (void)xb_add(&bar[XB_XCNT(b.x)], 1u);
    return b;
}
__device__ __forceinline__ void xcd_barrier_complete(unsigned* bar, unsigned x, unsigned& nloc, unsigned& nx) {
    const unsigned G = gridDim.x * gridDim.y * gridDim.z;
    unsigned sum, cnt, mine, sp = 0u;
    for (;;) {
        sum = 0u; cnt = 0u; mine = 0u;
#pragma unroll
        for (unsigned j = 0; j < 16; ++j) { const unsigned c = xb_ld(&bar[XB_XCNT(j)]); sum += c; cnt += (c > 0u) ? 1u : 0u; mine = (j == x) ? c : mine; }
        if (sum == G) break;
        __builtin_amdgcn_s_sleep(1);
        if ((++sp & 255u) == 0u) { if (xb_ld(&bar[XB_TMO])) break; if (sp > XB_SPIN_CAP) { atomicAdd(&bar[XB_TMO], 1u); break; } }
    }
    nloc = mine > 0u ? mine : 1u; nx = cnt > 0u ? cnt : 1u;
}

__device__ __forceinline__ void xcd_barrier(const XcdBarrier& b) {
    asm volatile("s_waitcnt vmcnt(0)" ::: "memory");
    __syncthreads();
    if (tidx() == 0) {
        unsigned* bar = b.bar;
        __builtin_amdgcn_s_waitcnt(0);
        unsigned nloc = b.st[0], nx = b.st[1];
        if (nloc == 0u) { xcd_barrier_complete(bar, b.x, nloc, nx); b.st[0] = nloc; b.st[1] = nx; }
        const unsigned old = xb_add(&bar[XB_XSUB(b.x)], 1u);
        const unsigned gen = old / nloc;
        if (old + 1u == (gen + 1u) * nloc) {
            __builtin_amdgcn_fence(__ATOMIC_RELEASE, "agent");
            asm volatile("s_waitcnt vmcnt(0)" ::: "memory");
            const unsigned og = xb_add(&bar[XB_TOP], 1u);
            const unsigned tg = og / nx;
            if (og + 1u == (tg + 1u) * nx) xb_add(&bar[XB_TOPGEN], 1u);
            else XB_SPIN(xb_ld(&bar[XB_TOPGEN]) == tg, bar);
            __builtin_amdgcn_fence(__ATOMIC_ACQUIRE, "agent");
            xb_add(&bar[XB_XGEN(b.x)], 1u);
            asm volatile("s_waitcnt vmcnt(0)" ::: "memory");
        } else {
            XB_SPIN(xb_ld(&bar[XB_XGEN(b.x)]) == gen, bar);
            __builtin_amdgcn_fence(__ATOMIC_ACQUIRE, "agent");
            asm volatile("s_waitcnt vmcnt(0)" ::: "memory");
        }
    }
    __syncthreads();
}


template <int NTOK>
__device__ __forceinline__ void conv_run(const bf16_t* Ucol, bool hist_ok, float w0, float w1, float w2, float w3, float bias, float (&out)[NTOK]) {
    float x3 = 0.f, x2 = 0.f, x1 = 0.f;
    if (hist_ok) { x3 = bf2f(Ucol[-3 * NU]); x2 = bf2f(Ucol[-2 * NU]); x1 = bf2f(Ucol[-NU]); }
#pragma unroll
    for (int i = 0; i < NTOK; ++i) { const float x0 = bf2f(Ucol[i * NU]); out[i] = bias + w0 * x3 + w1 * x2 + w2 * x1 + w3 * x0; x3 = x2; x2 = x1; x1 = x0; }
}
#define DPP_F(old, src, ctrl, rmask) __int_as_float(__builtin_amdgcn_update_dpp(__float_as_int(old), __float_as_int(src), (ctrl), (rmask), 0xf, false))
__device__ __forceinline__ float scan64_add(float v, int lane) {
    (void)lane;
    v += DPP_F(0.f, v, 0x111, 0xf); v += DPP_F(0.f, v, 0x112, 0xf); v += DPP_F(0.f, v, 0x114, 0xf); v += DPP_F(0.f, v, 0x118, 0xf);
    v += DPP_F(0.f, v, 0x142, 0xa); v += DPP_F(0.f, v, 0x143, 0xc);
    return v;
}
__device__ __forceinline__ void scan64_lin(float& A, float& B) {
#define LIN_STEP(ctrl, rmask) { const float Ap = DPP_F(1.f, A, ctrl, rmask), Bp = DPP_F(0.f, B, ctrl, rmask); B = A * Bp + B; A = A * Ap; }
    LIN_STEP(0x111, 0xf) LIN_STEP(0x112, 0xf) LIN_STEP(0x114, 0xf) LIN_STEP(0x118, 0xf) LIN_STEP(0x142, 0xa) LIN_STEP(0x143, 0xc)
#undef LIN_STEP
}


__device__ __forceinline__ void unpack8(const u32x4 w, float (&f)[8]) {
    f[0] = __uint_as_float(w.x << 16); f[1] = __uint_as_float(w.x & 0xffff0000u); f[2] = __uint_as_float(w.y << 16); f[3] = __uint_as_float(w.y & 0xffff0000u);
    f[4] = __uint_as_float(w.z << 16); f[5] = __uint_as_float(w.z & 0xffff0000u); f[6] = __uint_as_float(w.w << 16); f[7] = __uint_as_float(w.w & 0xffff0000u);
}
__device__ __forceinline__ u32x4 pack8(const float (&f)[8]) { u32x4 w; w.x = pk2(f[0], f[1]); w.y = pk2(f[2], f[3]); w.z = pk2(f[4], f[5]); w.w = pk2(f[6], f[7]); return w; }
__device__ __forceinline__ u32x4 ldg8(const bf16_t* p) { return *(const u32x4*)p; }
__device__ __forceinline__ bf16_t elem8(const u32x4 w, int i) { const unsigned x = (i >> 1) == 0 ? w.x : ((i >> 1) == 1 ? w.y : ((i >> 1) == 2 ? w.z : w.w)); return (bf16_t)((i & 1) ? (x >> 16) : (x & 0xffffu)); }
__device__ __forceinline__ void ld8f(const float* p, float (&f)[8]) { const f32x4 a = *(const f32x4*)p, b = *(const f32x4*)(p + 4); f[0] = a.x; f[1] = a.y; f[2] = a.z; f[3] = a.w; f[4] = b.x; f[5] = b.y; f[6] = b.z; f[7] = b.w; }
template <int NT>
__device__ __forceinline__ void conv8(const u32x4 (&rows)[NT + 3], const float (&w)[4][8], const float (&bias)[8], float (&o)[NT][8]) {
    float x[NT + 3][8];
#pragma unroll
    for (int r = 0; r < NT + 3; ++r) unpack8(rows[r], x[r]);
#pragma unroll
    for (int t = 0; t < NT; ++t)
#pragma unroll
        for (int i = 0; i < 8; ++i) o[t][i] = bias[i] + w[0][i] * x[t][i] + w[1][i] * x[t + 1][i] + w[2][i] * x[t + 2][i] + w[3][i] * x[t + 3][i];
}

__device__ __forceinline__ void ssd_passA(PRM p, LAS unsigned char* lds, int l, int u) {
    const int tid = tidx(), lane = tid & 63, wave = tid >> 6;
    const int c = u & 31, g = (u >> 5) & 1, b = u >> 6, row0 = b * 2048 + c * 64;
    const bf16_t* U = (const bf16_t*)(p.ws + OFF_U); const float* SDT = (const float*)(p.ws + OFF_SDT);
    LAS float* DT = (LAS float*)lds; LAS float* CU = DT + 128;
    LAS bf16_t* BT = (LAS bf16_t*)(lds + 1024); LAS bf16_t* VT = (LAS bf16_t*)(lds + 1024 + 18432);
    const int chl0 = (tid & 31) * 8, t0 = (tid >> 5) * 4;
    const int xc0 = chl0 < 128 ? g * 128 + chl0 : 256 + g * 128 + (chl0 - 128);
    u32x4 rows[7];
#pragma unroll
    for (int r = 0; r < 7; ++r) { const int t = t0 - 3 + r; rows[r] = (c > 0 || t >= 0) ? ldg8(U + (size_t)(row0 + t) * NU + UXBC + xc0) : (u32x4){0u, 0u, 0u, 0u}; }
    float w[4][8], bias[8];
#pragma unroll
    for (int j = 0; j < 4; ++j) ld8f(p.in[18] + (size_t)(l * 4 + j) * 768 + xc0, w[j]);
    ld8f(p.in[19] + l * 768 + xc0, bias);
    if (wave < 2) {
        const int h = 2 * g + wave;
        const float dt = softplusf_(SDT[(size_t)(row0 + lane) * 4 + h] + p.in[20][l * 4 + h]);
        const float cum = scan64_add(-expf(p.in[21][l * 4 + h]) * dt, lane);
        DT[wave * 64 + lane] = dt; CU[wave * 64 + lane] = cum;
    }
    float o[4][8]; conv8<4>(rows, w, bias, o);
    __syncthreads();
    if (chl0 < 128) { const int hh = chl0 >> 6; const float last = CU[hh * 64 + 63];
#pragma unroll
        for (int tt = 0; tt < 4; ++tt) { const int t = t0 + tt; const float sc = DT[hh * 64 + t] * __expf(last - CU[hh * 64 + t]);
#pragma unroll
            for (int i = 0; i < 8; ++i) VT[(chl0 + i) * 72 + t] = f2bf(siluf_(o[tt][i]) * sc); }
    } else { const int n0 = chl0 - 128;
#pragma unroll
        for (int tt = 0; tt < 4; ++tt)
#pragma unroll
            for (int i = 0; i < 8; ++i) BT[(n0 + i) * 72 + t0 + tt] = f2bf(siluf_(o[tt][i]));
    }
    __syncthreads();
    f32x4 acc[8];
#pragma unroll
    for (int j = 0; j < 8; ++j) acc[j] = (f32x4){0.f, 0.f, 0.f, 0.f};
    mm_nt<8, 2>(acc, BT + 16 * wave * 72, 72, VT, 72, lane);
    bf16_t* DS = (bf16_t*)(p.ws + OFF_DSS);
#pragma unroll
    for (int jj = 0; jj < 8; ++jj) { const int h = 2 * g + (jj >> 2), pc = (jj & 3) * 16 + (lane & 15);
#pragma unroll
        for (int e = 0; e < 4; ++e) { const int n = 16 * wave + (lane >> 4) * 4 + e; DS[(((size_t)(b * 4 + h) * 32 + c) * 128 + n) * 64 + pc] = f2bf(acc[jj][e]); } }
    if (tid < 2) ((float*)(p.ws + OFF_DECS))[(b * 4 + 2 * g + tid) * 32 + c] = __expf(CU[tid * 64 + 63]);
    __syncthreads();
}

__device__ __forceinline__ void ssd_passC(PRM p, LAS unsigned char* lds, int l, int u) {
    const int tid = tidx(), lane = tid & 63, wave = tid >> 6;
    const int c = u & 31, b = u >> 5, row0 = b * 2048 + c * 64;
    const bf16_t* U = (const bf16_t*)(p.ws + OFF_U); const float* SDT = (const float*)(p.ws + OFF_SDT);
    const bf16_t* DS = (const bf16_t*)(p.ws + OFF_DSS);
    bf16_t* YC = (bf16_t*)(p.ws + OFF_YC);
    LAS float* DT = (LAS float*)lds; LAS float* CU = (LAS float*)(lds + 1024); LAS float* SSQ = (LAS float*)(lds + 2048);
    LAS bf16_t* CM = (LAS bf16_t*)(lds + 3072); LAS bf16_t* BM = (LAS bf16_t*)(lds + 20480); LAS bf16_t* VT = (LAS bf16_t*)(lds + 37888);
    LAS bf16_t* PP = (LAS bf16_t*)(lds + 56320); LAS bf16_t* SINT = (LAS bf16_t*)(lds + 74752);
    if (wave < 4) {
        const int h = wave;
        const float dt = softplusf_(SDT[(size_t)(row0 + lane) * 4 + h] + p.in[20][l * 4 + h]);
        const float cum = scan64_add(-expf(p.in[21][l * 4 + h]) * dt, lane);
        DT[h * 64 + lane] = dt; CU[h * 64 + lane] = cum;
    }
    f32x4 yv[2][4];
#pragma unroll
    for (int g = 0; g < 2; ++g) {
        {
            u32x4 sv[4];
#pragma unroll
            for (int i = 0; i < 4; ++i) { const int idx8 = tid + i * NTHR, hh = idx8 >> 10, rem = idx8 & 1023, n = rem >> 3, p0 = (rem & 7) * 8;
                sv[i] = ldg8(DS + (((size_t)(b * 4 + 2 * g + hh) * 32 + c) * 128 + n) * 64 + p0); }
#pragma unroll
            for (int it = 0; it < 2; ++it) { const int item = tid + it * NTHR;
                if (item < 768) {
                    const int chl0 = (item % 48) * 8, t0 = (item / 48) * 4, which = chl0 >> 7, n0 = chl0 & 127, xc0 = which * 256 + g * 128 + n0;
                    u32x4 rows[7];
#pragma unroll
                    for (int r = 0; r < 7; ++r) { const int t = t0 - 3 + r; rows[r] = (c > 0 || t >= 0) ? ldg8(U + (size_t)(row0 + t) * NU + UXBC + xc0) : (u32x4){0u, 0u, 0u, 0u}; }
                    float w[4][8], bias[8];
#pragma unroll
                    for (int j = 0; j < 4; ++j) ld8f(p.in[18] + (size_t)(l * 4 + j) * 768 + xc0, w[j]);
                    ld8f(p.in[19] + l * 768 + xc0, bias);
                    float o[4][8]; conv8<4>(rows, w, bias, o);
                    if (which == 0) {
#pragma unroll
                        for (int tt = 0; tt < 4; ++tt)
#pragma unroll
                            for (int i = 0; i < 8; ++i) VT[(n0 + i) * 72 + t0 + tt] = f2bf(siluf_(o[tt][i]));
                    } else { LAS bf16_t* dstp = which == 1 ? BM : CM;
#pragma unroll
                        for (int tt = 0; tt < 4; ++tt) { float sv8[8];
#pragma unroll
                            for (int i = 0; i < 8; ++i) sv8[i] = siluf_(o[tt][i]);
                            *(LAS u32x4*)(dstp + (t0 + tt) * 136 + n0) = pack8(sv8); }
                    }
                } }
#pragma unroll
            for (int i = 0; i < 4; ++i) { const int idx8 = tid + i * NTHR, hh = idx8 >> 10, rem = idx8 & 1023, n = rem >> 3, p0 = (rem & 7) * 8;
#pragma unroll
                for (int e = 0; e < 8; ++e) SINT[(hh * 64 + p0 + e) * 136 + n] = elem8(sv[i], e); }
        }
        __syncthreads();
        {
            const int rt = wave & 3, ct0 = (wave >> 2) * 2;
            f32x4 sc[2]; sc[0] = (f32x4){0.f, 0.f, 0.f, 0.f}; sc[1] = sc[0];
            mm_nt<2, 4>(sc, CM + 16 * rt * 136, 136, BM + 16 * ct0 * 136, 136, lane);
#pragma unroll
            for (int hh = 0; hh < 2; ++hh) { const int h = 2 * g + hh;
#pragma unroll
                for (int jj = 0; jj < 2; ++jj)
#pragma unroll
                    for (int e = 0; e < 4; ++e) { const int t = 16 * rt + (lane >> 4) * 4 + e, s = 16 * (ct0 + jj) + (lane & 15);
                        const float val = s <= t ? sc[jj][e] * __expf(CU[h * 64 + t] - CU[h * 64 + s]) * DT[h * 64 + s] : 0.f;
                        PP[(hh * 64 + t) * 72 + s] = f2bf(val); } }
        }
        __syncthreads();
        {
            const int hh = wave >> 2, rt = wave & 3, h = 2 * g + hh;
            float zv[4][4];
#pragma unroll
            for (int e = 0; e < 4; ++e)
#pragma unroll
                for (int j = 0; j < 4; ++j) zv[e][j] = bf2f(U[(size_t)(row0 + 16 * rt + (lane >> 4) * 4 + e) * NU + UZ + h * 64 + 16 * j + (lane & 15)]);
#pragma unroll
            for (int j = 0; j < 4; ++j) yv[g][j] = (f32x4){0.f, 0.f, 0.f, 0.f};
            mm_nt<4, 4>(yv[g], CM + 16 * rt * 136, 136, SINT + hh * 64 * 136, 136, lane);
#pragma unroll
            for (int e = 0; e < 4; ++e) { const float sc = __expf(CU[h * 64 + 16 * rt + (lane >> 4) * 4 + e]);
#pragma unroll
                for (int j = 0; j < 4; ++j) yv[g][j][e] *= sc; }
            mm_nt<4, 2>(yv[g], PP + (hh * 64 + 16 * rt) * 72, 72, VT + hh * 64 * 72, 72, lane);
            const float Dh = p.in[22][l * 4 + h];
#pragma unroll
            for (int e = 0; e < 4; ++e) { const int t = 16 * rt + (lane >> 4) * 4 + e; float s2 = 0.f;
#pragma unroll
                for (int j = 0; j < 4; ++j) { const int pc = 16 * j + (lane & 15);
                    const float xs = bf2f(VT[(hh * 64 + pc) * 72 + t]);
                    const float v = (yv[g][j][e] + Dh * xs) * siluf_(zv[e][j]); yv[g][j][e] = v; s2 += v * v; }
                s2 += __shfl_xor(s2, 1); s2 += __shfl_xor(s2, 2); s2 += __shfl_xor(s2, 4); s2 += __shfl_xor(s2, 8);
                if ((lane & 15) == 0) SSQ[t * 4 + h] = s2; }
        }
        __syncthreads();
    }
#pragma unroll
    for (int g = 0; g < 2; ++g) { const int hh = wave >> 2, rt = wave & 3, h = 2 * g + hh;
#pragma unroll
        for (int e = 0; e < 4; ++e) { const int t = 16 * rt + (lane >> 4) * 4 + e;
            const float tot = SSQ[t * 4 + 0] + SSQ[t * 4 + 1] + SSQ[t * 4 + 2] + SSQ[t * 4 + 3];
            const float rstd = 1.0f / sqrtf(tot * (1.0f / 256.0f) + EPS);
#pragma unroll
            for (int j = 0; j < 4; ++j) { const int pc = 16 * j + (lane & 15);
                YC[(size_t)(row0 + t) * D + h * 64 + pc] = f2bf(yv[g][j][e] * rstd * p.in[23][l * 256 + h * 64 + pc]); } } }
    if (c == 31) for (int idx = tid; idx < 2304; idx += NTHR) { const int r = idx / 768, ch = idx % 768;
        p.out[O_PSSDC + ((size_t)(l * 8 + b) * 3 + r) * 768 + ch] = bf2f(U[(size_t)(b * 2048 + 2045 + r) * NU + UXBC + ch]); }
    __syncthreads();
}

constexpr int E_CUM = 0, E_QS = 16640, E_QD = 25856, E_KV = 35072, E_VT = 71936, E_SINT = 81152, E_PP = 90368, E_KWT = 99584, E_RSC = 108800, E_SSQ = 109056;
__device__ __forceinline__ void engineA(LAS unsigned char* lds, bf16_t* DS, int wave, int lane) {
    const LAS bf16_t* KWT = (const LAS bf16_t*)(lds + E_KWT); const LAS bf16_t* VT = (const LAS bf16_t*)(lds + E_VT);
    const int rt = wave >> 1, ct0 = (wave & 1) * 2;
    f32x4 acc[2]; acc[0] = (f32x4){0.f, 0.f, 0.f, 0.f}; acc[1] = acc[0];
    mm_nt<2, 2>(acc, KWT + 16 * rt * 72, 72, VT + 16 * ct0 * 72, 72, lane);
#pragma unroll
    for (int jj = 0; jj < 2; ++jj)
#pragma unroll
        for (int e = 0; e < 4; ++e) DS[(16 * rt + (lane >> 4) * 4 + e) * 64 + 16 * (ct0 + jj) + (lane & 15)] = f2bf(acc[jj][e]);
}
template <bool RET>
__device__ __forceinline__ void engineC(LAS unsigned char* lds, int qd_off, int kvstride, float lg, f32x4 (&y)[2], int wave, int lane) {
    const LAS bf16_t* QS = (const LAS bf16_t*)(lds + E_QS); const LAS bf16_t* QD = (const LAS bf16_t*)(lds + qd_off);
    const LAS bf16_t* KV = (const LAS bf16_t*)(lds + E_KV); const LAS bf16_t* VT = (const LAS bf16_t*)(lds + E_VT);
    const LAS bf16_t* SINT = (const LAS bf16_t*)(lds + E_SINT); LAS bf16_t* PP = (LAS bf16_t*)(lds + E_PP); const LAS float* RSC = (const LAS float*)(lds + E_RSC);
    const int rt = wave >> 1, ct0 = (wave & 1) * 2;
    f32x4 sc[2]; sc[0] = (f32x4){0.f, 0.f, 0.f, 0.f}; sc[1] = sc[0];
    mm_nt<2, 2>(sc, QS + 16 * rt * 72, 72, KV + kvstride * rt + 16 * ct0 * 72, 72, lane);
#pragma unroll
    for (int jj = 0; jj < 2; ++jj)
#pragma unroll
        for (int e = 0; e < 4; ++e) { const int t = 16 * rt + (lane >> 4) * 4 + e, s = 16 * (ct0 + jj) + (lane & 15);
            float val = 0.f; if (s <= t) val = RET ? sc[jj][e] * __expf((float)(t - s) * lg) : sc[jj][e];
            PP[t * 72 + s] = f2bf(val); }
    __syncthreads();
    y[0] = (f32x4){0.f, 0.f, 0.f, 0.f}; y[1] = y[0];
    mm_nt<2, 2>(y, QD + 16 * rt * 72, 72, SINT + 16 * ct0 * 72, 72, lane);
#pragma unroll
    for (int e = 0; e < 4; ++e) { const float r = RSC[16 * rt + (lane >> 4) * 4 + e]; y[0][e] *= r; y[1][e] *= r; }
    mm_nt<2, 2>(y, PP + 16 * rt * 72, 72, VT + 16 * ct0 * 72, 72, lane);
}
template <bool CENTER>
__device__ __forceinline__ void headnorm_store(LAS unsigned char* lds, const f32x4 (&y)[2], int wave, int lane, const float (&gate)[8], const float (&gain)[2], bf16_t* outp) {
    LAS f32x2* SSQ = (LAS f32x2*)(lds + E_SSQ);
    const int rt = wave >> 1, half = wave & 1, ct0 = half * 2;
#pragma unroll
    for (int e = 0; e < 4; ++e) { float s1 = y[0][e] + y[1][e], s2 = y[0][e] * y[0][e] + y[1][e] * y[1][e];
#pragma unroll
        for (int o = 1; o < 16; o <<= 1) { s1 += __shfl_xor(s1, o); s2 += __shfl_xor(s2, o); }
        if ((lane & 15) == 0) SSQ[(16 * rt + (lane >> 4) * 4 + e) * 2 + half] = (f32x2){s1, s2}; }
    __syncthreads();
#pragma unroll
    for (int e = 0; e < 4; ++e) { const int t = 16 * rt + (lane >> 4) * 4 + e;
        const f32x2 a = SSQ[t * 2], b2 = SSQ[t * 2 + 1];
        const float mean = CENTER ? (a.x + b2.x) * (1.0f / 64.0f) : 0.f;
        const float var = (a.y + b2.y) * (1.0f / 64.0f) - mean * mean;
        const float rstd = 1.0f / sqrtf(fmaxf(var, 0.f) + EPS);
#pragma unroll
        for (int jj = 0; jj < 2; ++jj) { const int pc = 16 * (ct0 + jj) + (lane & 15);
            outp[(size_t)t * D + pc] = f2bf((y[jj][e] - mean) * rstd * gain[jj] * siluf_(gate[e * 2 + jj])); } }
}
__device__ __forceinline__ void headnorm_prefetch(int wave, int lane, const bf16_t* Ugate, const float* gainp, float (&gate)[8], float (&gain)[2]) {
    const int rt = wave >> 1, ct0 = (wave & 1) * 2;
#pragma unroll
    for (int jj = 0; jj < 2; ++jj) { const int pc = 16 * (ct0 + jj) + (lane & 15); gain[jj] = gainp[pc];
#pragma unroll
        for (int e = 0; e < 4; ++e) gate[e * 2 + jj] = bf2f(Ugate[(size_t)(16 * rt + (lane >> 4) * 4 + e) * NU + pc]); }
}

struct RetRegs { u32x4 vraw, x1, x2, dsraw; float cs[8], sn[8], gate[8], gain[2]; };
template <bool PASSC>
__device__ __forceinline__ void ret_load(PRM p, int l, int u, RetRegs& r) {
    const int tid = tidx(), lane = tid & 63, wave = tid >> 6;
    const int h = u & 3, c = (u >> 2) & 31, b = u >> 7, row0 = b * 2048 + c * 64;
    const bf16_t* U = (const bf16_t*)(p.ws + OFF_U);
    const float* RC = (const float*)(p.ws + OFF_ROPE); const float* RS = RC + 2052 * 32;
    const bf16_t* DS = (const bf16_t*)(p.ws + OFF_DSR) + ((size_t)(b * 4 + h) * 32 + c) * 4096;
    const int t = tid >> 3, c8 = (tid & 7) * 8, isq = tid >> 8, tt = (tid & 255) >> 2, j0 = (tid & 3) * 8;
    r.vraw = ldg8(U + (size_t)(row0 + t) * NU + URV + h * 64 + c8); r.dsraw = (u32x4){0u, 0u, 0u, 0u};
    if (PASSC) { r.dsraw = ldg8(DS + t * 64 + c8); headnorm_prefetch(wave, lane, U + (size_t)row0 * NU + URG + h * 64, p.in[24] + l * 256 + h * 64, r.gate, r.gain); }
    r.x1 = (u32x4){0u, 0u, 0u, 0u}; r.x2 = r.x1;
    if (PASSC || isq == 0) { const bf16_t* ur = U + (size_t)(row0 + tt) * NU + (isq ? URQ : URK) + h * 64 + j0; r.x1 = ldg8(ur); r.x2 = ldg8(ur + 32);
        ld8f(RC + (size_t)(c * 64 + tt) * 32 + j0, r.cs); ld8f(RS + (size_t)(c * 64 + tt) * 32 + j0, r.sn); }
}
template <bool PASSC>
__device__ __forceinline__ void ret_body(PRM p, LAS unsigned char* lds, int l, int u, const RetRegs& r) {
    const int tid = tidx(), lane = tid & 63, wave = tid >> 6;
    const int h = u & 3, c = (u >> 2) & 31, b = u >> 7, row0 = b * 2048 + c * 64;
    const float lg = logf(1.0f - exp2f(-5.0f - (float)h));
    LAS bf16_t* QS = (LAS bf16_t*)(lds + E_QS); LAS bf16_t* KV = (LAS bf16_t*)(lds + E_KV); LAS bf16_t* VT = (LAS bf16_t*)(lds + E_VT);
    LAS bf16_t* SINT = (LAS bf16_t*)(lds + E_SINT); LAS bf16_t* KWT = (LAS bf16_t*)(lds + E_KWT); LAS float* RSC = (LAS float*)(lds + E_RSC);
    bf16_t* DS = (bf16_t*)(p.ws + OFF_DSR) + ((size_t)(b * 4 + h) * 32 + c) * 4096;
    const int t = tid >> 3, c8 = (tid & 7) * 8, isq = tid >> 8, tt = (tid & 255) >> 2, j0 = (tid & 3) * 8;
#pragma unroll
    for (int i = 0; i < 8; ++i) VT[(c8 + i) * 72 + t] = elem8(r.vraw, i);
    if (PASSC) {
#pragma unroll
        for (int i = 0; i < 8; ++i) SINT[(c8 + i) * 72 + t] = elem8(r.dsraw, i);
        if (tid < 64) RSC[tid] = __expf((float)(tid + 1) * lg);
    }
    if (PASSC || isq == 0) {
        float a[8], bb[8], ra[8], rb[8]; unpack8(r.x1, a); unpack8(r.x2, bb);
        const float scl = isq ? 1.0f : 0.125f;
#pragma unroll
        for (int i = 0; i < 8; ++i) { ra[i] = (a[i] * r.cs[i] - bb[i] * r.sn[i]) * scl; rb[i] = (bb[i] * r.cs[i] + a[i] * r.sn[i]) * scl; }
        if (PASSC) { LAS bf16_t* dst = isq ? QS : KV;
            *(LAS u32x4*)(dst + tt * 72 + j0) = pack8(ra); *(LAS u32x4*)(dst + tt * 72 + j0 + 32) = pack8(rb);
        } else { const float w = __expf((float)(63 - tt) * lg);
#pragma unroll
            for (int i = 0; i < 8; ++i) { KWT[(j0 + i) * 72 + tt] = f2bf(ra[i] * w); KWT[(j0 + 32 + i) * 72 + tt] = f2bf(rb[i] * w); } }
    }
    __syncthreads();
    if (PASSC) {
        f32x4 y[2]; engineC<true>(lds, E_QS, 0, lg, y, wave, lane);
        headnorm_store<true>(lds, y, wave, lane, r.gate, r.gain, (bf16_t*)(p.ws + OFF_YC) + (size_t)row0 * D + 256 + h * 64);
    } else engineA(lds, DS, wave, lane);
    __syncthreads();
}

struct HgRegs { u32x4 hfraw, viraw, hqraw, dsraw; float lb[8], gate[8], gain[2]; };
template <bool PASSC>
__device__ __forceinline__ void hg_load(PRM p, int l, int u, HgRegs& r) {
    const int tid = tidx(), lane = tid & 63, wave = tid >> 6;
    const int h = u & 3, c = (u >> 2) & 31, b = u >> 7, row0 = b * 2048 + c * 64;
    const bf16_t* U = (const bf16_t*)(p.ws + OFF_U);
    const bf16_t* DS = (const bf16_t*)(p.ws + OFF_DSH) + ((size_t)(b * 4 + h) * 32 + c) * 4096;
    const int t = tid >> 3, c8 = (tid & 7) * 8;
    const bf16_t* ur = U + (size_t)(row0 + t) * NU + h * 64 + c8;
    r.hfraw = ldg8(ur + UHF); r.viraw = ldg8(ur + UHI); r.hqraw = (u32x4){0u, 0u, 0u, 0u}; r.dsraw = r.hqraw;
    if (PASSC) { r.hqraw = ldg8(ur + UHQ); r.dsraw = ldg8(DS + t * 64 + c8); headnorm_prefetch(wave, lane, U + (size_t)row0 * NU + UHG + h * 64, p.in[33] + l * 256 + h * 64, r.gate, r.gain); }
    ld8f((const float*)(p.ws + OFF_LB) + l * 256 + h * 64 + c8, r.lb);
}
template <bool PASSC>
__device__ __forceinline__ void hg_body(PRM p, LAS unsigned char* lds, int l, int u, const HgRegs& r) {
    const int tid = tidx(), lane = tid & 63, wave = tid >> 6;
    const int h = u & 3, c = (u >> 2) & 31, b = u >> 7, row0 = b * 2048 + c * 64;
    LAS float* CUM = (LAS float*)(lds + E_CUM);
    LAS bf16_t* QS = (LAS bf16_t*)(lds + E_QS); LAS bf16_t* QD = (LAS bf16_t*)(lds + E_QD); LAS bf16_t* KV = (LAS bf16_t*)(lds + E_KV); LAS bf16_t* VT = (LAS bf16_t*)(lds + E_VT);
    LAS bf16_t* SINT = (LAS bf16_t*)(lds + E_SINT); LAS bf16_t* KWT = (LAS bf16_t*)(lds + E_KWT); LAS float* RSC = (LAS float*)(lds + E_RSC);
    bf16_t* DS = (bf16_t*)(p.ws + OFF_DSH) + ((size_t)(b * 4 + h) * 32 + c) * 4096;
    const int t = tid >> 3, c8 = (tid & 7) * 8;
#pragma unroll
    for (int i = 0; i < 8; ++i) VT[(c8 + i) * 72 + t] = elem8(r.viraw, i);
    if (PASSC) {
#pragma unroll
        for (int i = 0; i < 8; ++i) SINT[(c8 + i) * 72 + t] = elem8(r.dsraw, i);
        if (tid < 64) RSC[tid] = 1.0f;
    }
    float hf[8]; unpack8(r.hfraw, hf);
#pragma unroll
    for (int i = 0; i < 8; ++i) CUM[t * 65 + c8 + i] = __logf(r.lb[i] + (1.0f - r.lb[i]) * sigmoidf_(hf[i]));
    __syncthreads();
#pragma unroll
    for (int kk = 0; kk < 8; ++kk) { const int k = wave * 8 + kk; const float v = scan64_add(CUM[lane * 65 + k], lane); CUM[lane * 65 + k] = v; }
    __syncthreads();
    {
        float cum[8], kk_[8];
#pragma unroll
        for (int i = 0; i < 8; ++i) { cum[i] = CUM[t * 65 + c8 + i]; kk_[i] = (1.0f - r.lb[i]) * sigmoidf_(-hf[i]); }
        if (PASSC) {
            float q[8], qd[8], qs[8]; unpack8(r.hqraw, q); const int i_ = t >> 4;
#pragma unroll
            for (int i = 0; i < 8; ++i) { q[i] = siluf_(q[i]); const float ci0 = i_ ? CUM[(16 * i_ - 1) * 65 + c8 + i] : 0.f; qd[i] = q[i] * __expf(cum[i]); qs[i] = q[i] * __expf(cum[i] - ci0); }
            *(LAS u32x4*)(QD + t * 72 + c8) = pack8(qd); *(LAS u32x4*)(QS + t * 72 + c8) = pack8(qs);
#pragma unroll
            for (int i2 = 0; i2 < 4; ++i2) { float kv[8];
#pragma unroll
                for (int i = 0; i < 8; ++i) { float val = 0.f;
                    if (i2 >= i_) { const float c0 = i2 ? CUM[(16 * i2 - 1) * 65 + c8 + i] : 0.f; val = kk_[i] * __expf(fminf(c0 - cum[i], 60.f)); }
                    kv[i] = val; }
                *(LAS u32x4*)(KV + i2 * 4608 + t * 72 + c8) = pack8(kv); }
        } else {
#pragma unroll
            for (int i = 0; i < 8; ++i) KWT[(c8 + i) * 72 + t] = f2bf(kk_[i] * __expf(CUM[63 * 65 + c8 + i] - cum[i]));
            if (tid < 64) ((float*)(p.ws + OFF_DECH))[((size_t)(b * 4 + h) * 32 + c) * 64 + tid] = __expf(CUM[63 * 65 + tid]);
        }
    }
    __syncthreads();
    if (PASSC) {
        f32x4 y[2]; engineC<false>(lds, E_QD, 4608, 0.f, y, wave, lane);
        headnorm_store<false>(lds, y, wave, lane, r.gate, r.gain, (bf16_t*)(p.ws + OFF_YC) + (size_t)row0 * D + 768 + h * 64);
    } else engineA(lds, DS, wave, lane);
    __syncthreads();
}

struct RgRegs { u32x4 rows[4], wt[2], gyraw; float w[4][8], bias[8], hin[8], ba[2], bx[2], lam[2]; };
template <bool PASSC>
__device__ __forceinline__ void rg_load(PRM p, int l, int u, RgRegs& r) {
    const int tid = tidx(), lane = tid & 63, wave = tid >> 6;
    const int blk = u & 3, c = (u >> 2) & 31, b = u >> 7, row0 = b * 2048 + c * 64;
    const bf16_t* U = (const bf16_t*)(p.ws + OFF_U);
    const int t = tid >> 3, c8 = (tid & 7) * 8, ch0 = blk * 64 + c8;
#pragma unroll
    for (int q = 0; q < 4; ++q) { const int tr = t - 3 + q; r.rows[q] = (c > 0 || tr >= 0) ? ldg8(U + (size_t)(row0 + tr) * NU + UGX + ch0) : (u32x4){0u, 0u, 0u, 0u}; }
#pragma unroll
    for (int j = 0; j < 4; ++j) ld8f(p.in[25] + (size_t)(l * 4 + j) * 256 + ch0, r.w[j]);
    ld8f(p.in[26] + l * 256 + ch0, r.bias);
    const bf16_t* WRG = (const bf16_t*)(p.ws + OFF_WRG);
#pragma unroll
    for (int i = 0; i < 2; ++i) { const int idx = tid + i * NTHR, gate = idx >> 9, rem = idx & 511; r.wt[i] = *(const u32x4*)(WRG + (size_t)((l * 2 + gate) * 4 + blk) * 4096 + (rem >> 3) * 64 + (rem & 7) * 8); }
    r.gyraw = (u32x4){0u, 0u, 0u, 0u};
    if (PASSC) { r.gyraw = ldg8(U + (size_t)(row0 + t) * NU + UGY + ch0);
#pragma unroll
        for (int kk = 0; kk < 8; ++kk) r.hin[kk] = ((const float*)(p.ws + OFF_RGC))[(size_t)(b * 32 + c) * 256 + blk * 64 + wave * 8 + kk]; }
#pragma unroll
    for (int jj = 0; jj < 2; ++jj) { const int ch = blk * 64 + 16 * ((wave >> 2) * 2 + jj) + (lane & 15);
        r.ba[jj] = p.in[28][l * 256 + ch]; r.bx[jj] = p.in[30][l * 256 + ch]; r.lam[jj] = p.in[31][l * 256 + ch]; }
}
template <bool PASSC>
__device__ __forceinline__ void rg_body(PRM p, LAS unsigned char* lds, int l, int u, const RgRegs& r) {
    const int tid = tidx(), lane = tid & 63, wave = tid >> 6;
    const int blk = u & 3, c = (u >> 2) & 31, b = u >> 7, row0 = b * 2048 + c * 64;
    const bf16_t* U = (const bf16_t*)(p.ws + OFF_U);
    LAS float* XR = (LAS float*)lds; LAS bf16_t* XRB = (LAS bf16_t*)(lds + 16640); LAS bf16_t* WT = (LAS bf16_t*)(lds + 25856);
    LAS float* AA = (LAS float*)(lds + 44288); LAS float* BB = (LAS float*)(lds + 60928); LAS float* HL = (LAS float*)(lds + 77568);
    const int t = tid >> 3, c8 = (tid & 7) * 8, ch0 = blk * 64 + c8;
    {
        float o[1][8]; conv8<1>(r.rows, r.w, r.bias, o);
#pragma unroll
        for (int i = 0; i < 8; ++i) XR[t * 65 + c8 + i] = o[0][i];
        *(LAS u32x4*)(XRB + t * 72 + c8) = pack8(o[0]);
#pragma unroll
        for (int i = 0; i < 2; ++i) { const int idx = tid + i * NTHR, gate = idx >> 9, rem = idx & 511; *(LAS u32x4*)(WT + gate * 4608 + (rem >> 3) * 72 + (rem & 7) * 8) = r.wt[i]; }
    }
    __syncthreads();
    {
        const int rt = wave & 3, ct0 = (wave >> 2) * 2;
        f32x4 aA[2], aX[2]; aA[0] = (f32x4){0.f, 0.f, 0.f, 0.f}; aA[1] = aA[0]; aX[0] = aA[0]; aX[1] = aA[0];
        mm_nt<2, 2>(aA, XRB + 16 * rt * 72, 72, WT + 16 * ct0 * 72, 72, lane);
        mm_nt<2, 2>(aX, XRB + 16 * rt * 72, 72, WT + 4608 + 16 * ct0 * 72, 72, lane);
#pragma unroll
        for (int jj = 0; jj < 2; ++jj) { const int j = 16 * (ct0 + jj) + (lane & 15);
            const float sp = -8.0f * softplusf_(-r.lam[jj]);
#pragma unroll
            for (int e = 0; e < 4; ++e) { const int tq = 16 * rt + (lane >> 4) * 4 + e;
                const float rr = sigmoidf_(aA[jj][e] + r.ba[jj]), ig = sigmoidf_(aX[jj][e] + r.bx[jj]);
                const float la = sp * rr; AA[tq * 65 + j] = __expf(la); BB[tq * 65 + j] = sqrtf(fmaxf(1.0f - __expf(2.0f * la), 0.f)) * ig * XR[tq * 65 + j]; } }
    }
    __syncthreads();
#pragma unroll
    for (int kk = 0; kk < 8; ++kk) { const int j = wave * 8 + kk, ch = blk * 64 + j;
        float A = AA[lane * 65 + j], B = BB[lane * 65 + j];
        scan64_lin(A, B);
        if (PASSC) HL[lane * 65 + j] = B + A * r.hin[kk];
        else if (lane == 63) { ((float*)(p.ws + OFF_RGH))[(size_t)(b * 32 + c) * 256 + ch] = B; ((float*)(p.ws + OFF_RGA))[(size_t)(b * 32 + c) * 256 + ch] = A; }
    }
    if (PASSC) {
        __syncthreads();
        float gy[8], y[8]; unpack8(r.gyraw, gy);
#pragma unroll
        for (int i = 0; i < 8; ++i) y[i] = geluf_(gy[i]) * HL[t * 65 + c8 + i];
        *(u32x4*)((bf16_t*)(p.ws + OFF_YC) + (size_t)(row0 + t) * D + 512 + ch0) = pack8(y);
        if (c == 31 && tid < 192) { const int rr = tid >> 6, j = tid & 63;
            p.out[O_PRGC + ((size_t)(l * 8 + b) * 3 + rr) * 256 + blk * 64 + j] = bf2f(U[(size_t)(b * 2048 + 2045 + rr) * NU + UGX + blk * 64 + j]); }
    }
    __syncthreads();
}

#define UNIT_LOOP(NAME, REGS, LOADF, BODYF)                                                                             \
template <bool PASSC> __device__ __forceinline__ void NAME(PRM p, LAS unsigned char* lds, int l) {            \
    int u = blockIdx.x; if (u >= 1024) return;                                                                          \
    REGS cur; LOADF<PASSC>(p, l, u, cur);                                                                               \
    _Pragma("unroll 1") for (; u < 1024; u += gridDim.x) { REGS nx; const int un = u + gridDim.x;                        \
        if (un < 1024) LOADF<PASSC>(p, l, un, nx);                                                                      \
        BODYF<PASSC>(p, lds, l, u, cur);                                                                                \
        if (un < 1024) cur = nx; } }
UNIT_LOOP(ret_loop, RetRegs, ret_load, ret_body)
UNIT_LOOP(hg_loop, HgRegs, hg_load, hg_body)
template <bool PASSC> __device__ __forceinline__ void rg_loop(PRM p, LAS unsigned char* lds, int l) {
    _Pragma("unroll 1") for (int u = blockIdx.x; u < 1024; u += gridDim.x) { RgRegs r; rg_load<PASSC>(p, l, u, r); rg_body<PASSC>(p, lds, l, u, r); } }

__device__ __forceinline__ void retC2_unit(PRM p, LAS unsigned char* lds, int l, int u) {
    const int tid = tidx(), lane = tid & 63, wave = tid >> 6;
    const int hp = u & 1, c = (u >> 1) & 31, b = u >> 6, row0 = b * 2048 + c * 64;
    const bf16_t* U = (const bf16_t*)(p.ws + OFF_U);
    const float* RC = (const float*)(p.ws + OFF_ROPE); const float* RS = RC + 2052 * 32;
    LAS bf16_t* QS = (LAS bf16_t*)lds; LAS bf16_t* KV = (LAS bf16_t*)(lds + 18432); LAS bf16_t* VT = (LAS bf16_t*)(lds + 36864);
    LAS bf16_t* SINT = (LAS bf16_t*)(lds + 55296); LAS bf16_t* PP = (LAS bf16_t*)(lds + 73728);
    const int t = tid >> 3, c8 = (tid & 7) * 8, isq = tid >> 8, tt = (tid & 255) >> 2, j0 = (tid & 3) * 8;
    const int hw = wave >> 2, rt = wave & 3, hme = 2 * hp + hw;
    u32x4 vraw[2], dsraw[2], x1[2], x2[2]; float cs[8], sn[8], gate[16], gain[4];
#pragma unroll
    for (int hh = 0; hh < 2; ++hh) { const int h = 2 * hp + hh;
        vraw[hh] = ldg8(U + (size_t)(row0 + t) * NU + URV + h * 64 + c8);
        dsraw[hh] = ldg8((const bf16_t*)(p.ws + OFF_DSR) + ((size_t)(b * 4 + h) * 32 + c) * 4096 + t * 64 + c8);
        const bf16_t* ur = U + (size_t)(row0 + tt) * NU + (isq ? URQ : URK) + h * 64 + j0; x1[hh] = ldg8(ur); x2[hh] = ldg8(ur + 32); }
    ld8f(RC + (size_t)(c * 64 + tt) * 32 + j0, cs); ld8f(RS + (size_t)(c * 64 + tt) * 32 + j0, sn);
#pragma unroll
    for (int j = 0; j < 4; ++j) { const int pc = 16 * j + (lane & 15); gain[j] = p.in[24][l * 256 + hme * 64 + pc];
#pragma unroll
        for (int e = 0; e < 4; ++e) gate[e * 4 + j] = bf2f(U[(size_t)(row0 + 16 * rt + (lane >> 4) * 4 + e) * NU + URG + hme * 64 + pc]); }
#pragma unroll
    for (int hh = 0; hh < 2; ++hh) {
#pragma unroll
        for (int i = 0; i < 8; ++i) { VT[hh * 4608 + (c8 + i) * 72 + t] = elem8(vraw[hh], i); SINT[hh * 4608 + (c8 + i) * 72 + t] = elem8(dsraw[hh], i); }
        float a[8], bb[8], ra[8], rb[8]; unpack8(x1[hh], a); unpack8(x2[hh], bb);
        const float scl = isq ? 1.0f : 0.125f;
#pragma unroll
        for (int i = 0; i < 8; ++i) { ra[i] = (a[i] * cs[i] - bb[i] * sn[i]) * scl; rb[i] = (bb[i] * cs[i] + a[i] * sn[i]) * scl; }
        LAS bf16_t* dst = (isq ? QS : KV) + hh * 4608;
        *(LAS u32x4*)(dst + tt * 72 + j0) = pack8(ra); *(LAS u32x4*)(dst + tt * 72 + j0 + 32) = pack8(rb);
    }
    __syncthreads();
    const float lg = logf(1.0f - exp2f(-5.0f - (float)hme));
    {
        f32x4 sc[4];
#pragma unroll
        for (int j = 0; j < 4; ++j) sc[j] = (f32x4){0.f, 0.f, 0.f, 0.f};
        mm_nt<4, 2>(sc, QS + hw * 4608 + 16 * rt * 72, 72, KV + hw * 4608, 72, lane);
#pragma unroll
        for (int j = 0; j < 4; ++j)
#pragma unroll
            for (int e = 0; e < 4; ++e) { const int tq = 16 * rt + (lane >> 4) * 4 + e, sq = 16 * j + (lane & 15);
                PP[hw * 4608 + tq * 72 + sq] = f2bf(sq <= tq ? sc[j][e] * __expf((float)(tq - sq) * lg) : 0.f); }
    }
    __syncthreads();
    f32x4 y[4];
#pragma unroll
    for (int j = 0; j < 4; ++j) y[j] = (f32x4){0.f, 0.f, 0.f, 0.f};
    mm_nt<4, 2>(y, QS + hw * 4608 + 16 * rt * 72, 72, SINT + hw * 4608, 72, lane);
#pragma unroll
    for (int e = 0; e < 4; ++e) { const float r = __expf((float)(16 * rt + (lane >> 4) * 4 + e + 1) * lg);
#pragma unroll
        for (int j = 0; j < 4; ++j) y[j][e] *= r; }
    mm_nt<4, 2>(y, PP + hw * 4608 + 16 * rt * 72, 72, VT + hw * 4608, 72, lane);
    bf16_t* outp = (bf16_t*)(p.ws + OFF_YC) + (size_t)row0 * D + 256 + hme * 64;
#pragma unroll
    for (int e = 0; e < 4; ++e) { const int tq = 16 * rt + (lane >> 4) * 4 + e;
        float s1 = (y[0][e] + y[1][e]) + (y[2][e] + y[3][e]);
#pragma unroll
        for (int o = 1; o < 16; o <<= 1) s1 += __shfl_xor(s1, o);
        const float mean = s1 * (1.0f / 64.0f);
        float s2 = 0.f;
#pragma unroll
        for (int j = 0; j < 4; ++j) { const float d = y[j][e] - mean; s2 += d * d; }
#pragma unroll
        for (int o = 1; o < 16; o <<= 1) s2 += __shfl_xor(s2, o);
        const float rstd = 1.0f / sqrtf(s2 * (1.0f / 64.0f) + EPS);
#pragma unroll
        for (int j = 0; j < 4; ++j) outp[(size_t)tq * D + 16 * j + (lane & 15)] = f2bf((y[j][e] - mean) * rstd * gain[j] * siluf_(gate[e * 4 + j])); }
    __syncthreads();
}

__device__ __forceinline__ void engineA4(const LAS bf16_t* KWT, const LAS bf16_t* VT, bf16_t* DSbase  , int wave, int lane) {
    const int hh = wave >> 1, rt0 = (wave & 1) * 2;
#pragma unroll
    for (int q = 0; q < 2; ++q) { const int rt = rt0 + q;
        f32x4 acc[4];
#pragma unroll
        for (int j = 0; j < 4; ++j) acc[j] = (f32x4){0.f, 0.f, 0.f, 0.f};
        mm_nt<4, 2>(acc, KWT + (hh * 64 + 16 * rt) * 72, 72, VT + hh * 64 * 72, 72, lane);
        bf16_t* DS = DSbase + (size_t)hh * 32 * 4096;
#pragma unroll
        for (int j = 0; j < 4; ++j)
#pragma unroll
            for (int e = 0; e < 4; ++e) DS[(16 * rt + (lane >> 4) * 4 + e) * 64 + 16 * j + (lane & 15)] = f2bf(acc[j][e]); }
}
__device__ __forceinline__ void retA4_unit(PRM p, LAS unsigned char* lds, int l, int u) {
    const int tid = tidx(), lane = tid & 63, wave = tid >> 6;
    const int c = u & 31, b = u >> 5, row0 = b * 2048 + c * 64;
    const bf16_t* U = (const bf16_t*)(p.ws + OFF_U);
    const float* RC = (const float*)(p.ws + OFF_ROPE); const float* RS = RC + 2052 * 32;
    LAS bf16_t* KWT = (LAS bf16_t*)lds; LAS bf16_t* VT = (LAS bf16_t*)(lds + 36864);
    const int t = tid >> 3, c8 = (tid & 7) * 8, tt = (tid & 255) >> 2, j0 = (tid & 3) * 8;
    u32x4 vraw[4], x1[2], x2[2]; float cs[8], sn[8];
#pragma unroll
    for (int hh = 0; hh < 4; ++hh) vraw[hh] = ldg8(U + (size_t)(row0 + t) * NU + URV + hh * 64 + c8);
#pragma unroll
    for (int it = 0; it < 2; ++it) { const int hh = it * 2 + (tid >> 8); const bf16_t* ur = U + (size_t)(row0 + tt) * NU + URK + hh * 64 + j0; x1[it] = ldg8(ur); x2[it] = ldg8(ur + 32); }
    ld8f(RC + (size_t)(c * 64 + tt) * 32 + j0, cs); ld8f(RS + (size_t)(c * 64 + tt) * 32 + j0, sn);
#pragma unroll
    for (int hh = 0; hh < 4; ++hh)
#pragma unroll
        for (int i = 0; i < 8; ++i) VT[(hh * 64 + c8 + i) * 72 + t] = elem8(vraw[hh], i);
#pragma unroll
    for (int it = 0; it < 2; ++it) { const int hh = it * 2 + (tid >> 8);
        const float lg = logf(1.0f - exp2f(-5.0f - (float)hh)); const float w = __expf((float)(63 - tt) * lg) * 0.125f;
        float a[8], bb[8]; unpack8(x1[it], a); unpack8(x2[it], bb);
#pragma unroll
        for (int i = 0; i < 8; ++i) { KWT[(hh * 64 + j0 + i) * 72 + tt] = f2bf((a[i] * cs[i] - bb[i] * sn[i]) * w); KWT[(hh * 64 + j0 + 32 + i) * 72 + tt] = f2bf((bb[i] * cs[i] + a[i] * sn[i]) * w); } }
    __syncthreads();
    engineA4(KWT, VT, (bf16_t*)(p.ws + OFF_DSR) + ((size_t)(b * 4) * 32 + c) * 4096, wave, lane);
    __syncthreads();
}
__device__ __forceinline__ void hgA4_unit(PRM p, LAS unsigned char* lds, int l, int u) {
    const int tid = tidx(), lane = tid & 63, wave = tid >> 6;
    const int c = u & 31, b = u >> 5, row0 = b * 2048 + c * 64;
    const bf16_t* U = (const bf16_t*)(p.ws + OFF_U);
    LAS float* CUM = (LAS float*)lds; LAS bf16_t* KWT = (LAS bf16_t*)(lds + 65792); LAS bf16_t* VT = (LAS bf16_t*)(lds + 102656);
    const int t = tid >> 3, c8 = (tid & 7) * 8;
    u32x4 hfraw[4], viraw[4];
#pragma unroll
    for (int hh = 0; hh < 4; ++hh) { const bf16_t* ur = U + (size_t)(row0 + t) * NU + hh * 64 + c8; hfraw[hh] = ldg8(ur + UHF); viraw[hh] = ldg8(ur + UHI); }
#pragma unroll
    for (int hh = 0; hh < 4; ++hh) { float lb[8], hf[8]; ld8f((const float*)(p.ws + OFF_LB) + l * 256 + hh * 64 + c8, lb); unpack8(hfraw[hh], hf);
#pragma unroll
        for (int i = 0; i < 8; ++i) { VT[(hh * 64 + c8 + i) * 72 + t] = elem8(viraw[hh], i); CUM[t * 257 + hh * 64 + c8 + i] = __logf(lb[i] + (1.0f - lb[i]) * sigmoidf_(hf[i])); } }
    __syncthreads();
#pragma unroll 8
    for (int kk = 0; kk < 32; ++kk) { const int k = wave * 32 + kk; const float v = scan64_add(CUM[lane * 257 + k], lane); CUM[lane * 257 + k] = v; }
    __syncthreads();
#pragma unroll
    for (int hh = 0; hh < 4; ++hh) { float lb[8], hf[8]; ld8f((const float*)(p.ws + OFF_LB) + l * 256 + hh * 64 + c8, lb); unpack8(hfraw[hh], hf);
#pragma unroll
        for (int i = 0; i < 8; ++i) { const int ch = hh * 64 + c8 + i; const float kk_ = (1.0f - lb[i]) * sigmoidf_(-hf[i]);
            KWT[ch * 72 + t] = f2bf(kk_ * __expf(CUM[63 * 257 + ch] - CUM[t * 257 + ch])); } }
    if (tid < 256) ((float*)(p.ws + OFF_DECH))[((size_t)(b * 4 + (tid >> 6)) * 32 + c) * 64 + (tid & 63)] = __expf(CUM[63 * 257 + tid]);
    __syncthreads();
    engineA4(KWT, VT, (bf16_t*)(p.ws + OFF_DSH) + ((size_t)(b * 4) * 32 + c) * 4096, wave, lane);
    __syncthreads();
}

__device__ __forceinline__ void mixA_unit(PRM p, LAS unsigned char* lds, int l, int u) {
    RetRegs rr; HgRegs hr; RgRegs gr;
    ret_load<false>(p, l, u, rr); hg_load<false>(p, l, u, hr); rg_load<false>(p, l, u, gr);
    ret_body<false>(p, lds, l, u, rr); hg_body<false>(p, lds, l, u, hr); rg_body<false>(p, lds, l, u, gr);
}

__device__ __forceinline__ void mixC_unit(PRM p, LAS unsigned char* lds, int l, int u) {
    RetRegs rr; HgRegs hr; RgRegs gr;
    ret_load<true>(p, l, u, rr); hg_load<true>(p, l, u, hr); rg_load<true>(p, l, u, gr);
    ret_body<true>(p, lds, l, u, rr); hg_body<true>(p, lds, l, u, hr); rg_body<true>(p, lds, l, u, gr);
}

__device__ __forceinline__ void carry_phase(PRM p, int l) {
    const int gt = blockIdx.x * NTHR + tidx(), NG = gridDim.x * NTHR;
    constexpr int N_SSD = 8 * 4 * 4096, N_RET = 8 * 4 * 2048, N_HG = N_RET, N_RG = 8 * 256;
    for (int i = gt; i < N_SSD + N_RET + N_HG + N_RG; i += NG) {
        if (i < N_SSD + N_RET + N_HG) {
            unsigned* base; float dec[32]; size_t stride, oo;
            if (i < N_SSD) { const int bh = i >> 12, e2 = i & 4095; base = (unsigned*)(p.ws + OFF_DSS) + (size_t)bh * 32 * 4096 + e2; stride = 4096;
                const float* dc = (const float*)(p.ws + OFF_DECS) + bh * 32;
#pragma unroll
                for (int c = 0; c < 32; ++c) dec[c] = dc[c];
                oo = O_PSSD + (size_t)l * 8 * 32768 + (size_t)bh * 8192 + 2 * e2;
            } else if (i < N_SSD + N_RET) { const int j = i - N_SSD, bh = j >> 11, e2 = j & 2047; base = (unsigned*)(p.ws + OFF_DSR) + (size_t)bh * 32 * 2048 + e2; stride = 2048;
                const float d = expf(64.0f * logf(1.0f - exp2f(-5.0f - (float)(bh & 3))));
#pragma unroll
                for (int c = 0; c < 32; ++c) dec[c] = d;
                oo = O_PRET + (size_t)l * 8 * 16384 + (size_t)bh * 4096 + 2 * e2;
            } else { const int j = i - N_SSD - N_RET, bh = j >> 11, e2 = j & 2047; base = (unsigned*)(p.ws + OFF_DSH) + (size_t)bh * 32 * 2048 + e2; stride = 2048;
                const float* dc = (const float*)(p.ws + OFF_DECH) + (size_t)bh * 32 * 64 + (e2 >> 5);
#pragma unroll
                for (int c = 0; c < 32; ++c) dec[c] = dc[c * 64];
                oo = O_PHG + (size_t)l * 8 * 16384 + (size_t)bh * 4096 + 2 * e2;
            }
            unsigned tmp[32];
#pragma unroll
            for (int c = 0; c < 32; ++c) tmp[c] = base[(size_t)c * stride];
            float s0 = 0.f, s1 = 0.f;
#pragma unroll
            for (int c = 0; c < 32; ++c) { base[(size_t)c * stride] = pk2(s0, s1);
                s0 = dec[c] * s0 + __uint_as_float(tmp[c] << 16); s1 = dec[c] * s1 + __uint_as_float(tmp[c] & 0xffff0000u); }
            *(f32x2*)(p.out + oo) = (f32x2){s0, s1};
        } else {
            const int j = i - N_SSD - N_RET - N_HG, b = j >> 8, ch = j & 255;
            const float* hl = (const float*)(p.ws + OFF_RGH) + (size_t)b * 32 * 256 + ch; const float* at = (const float*)(p.ws + OFF_RGA) + (size_t)b * 32 * 256 + ch;
            float* cr = (float*)(p.ws + OFF_RGC) + (size_t)b * 32 * 256 + ch;
            float tmp[32], dec[32];
#pragma unroll
            for (int c = 0; c < 32; ++c) { tmp[c] = hl[c * 256]; dec[c] = at[c * 256]; }
            float sacc = 0.f;
#pragma unroll
            for (int c = 0; c < 32; ++c) { cr[c * 256] = sacc; sacc = dec[c] * sacc + tmp[c]; }
            p.out[O_PRG + (size_t)l * 8 * 256 + b * 256 + ch] = sacc;
        }
    }
}

constexpr int S_QD = 0, S_KW = 8192, S_V = 16384, S_DEC = 20480, S_P = 22528, S_Y = 22784, S_RED = 26880, S_SCR = 59648;
template <int KD>
__device__ __forceinline__ void dec_engine(const float* S0, float* S1, LAS unsigned char* lds) {
    const int tid = tidx(), p_ = tid & 63, kq = tid >> 6; constexpr int KPER = KD / 8;
    const LAS float* QDs = (const LAS float*)(lds + S_QD); const LAS float* KWs = (const LAS float*)(lds + S_KW); const LAS float* Vs = (const LAS float*)(lds + S_V);
    const LAS float* DECs = (const LAS float*)(lds + S_DEC); const LAS float* Ps = (const LAS float*)(lds + S_P); LAS float* Ys = (LAS float*)(lds + S_Y); LAS float* RED = (LAS float*)(lds + S_RED);
    float v[4][4], yp[4][4];
#pragma unroll
    for (int h = 0; h < 4; ++h)
#pragma unroll
        for (int s = 0; s < 4; ++s) { v[h][s] = Vs[s * 256 + h * 64 + p_]; yp[h][s] = 0.f; }
#pragma unroll
    for (int h = 0; h < 4; ++h) {
#pragma unroll
        for (int kk = 0; kk < KPER; ++kk) { const int k = kq * KPER + kk;
            const float s0 = S0[(size_t)(h * KD + k) * 64 + p_];
            const f32x4 kw = *(const LAS f32x4*)(KWs + (h * 128 + k) * 4), qd = *(const LAS f32x4*)(QDs + (h * 128 + k) * 4);
            const float acc = DECs[h * 128 + k] * s0 + kw.x * v[h][0] + kw.y * v[h][1] + kw.z * v[h][2] + kw.w * v[h][3];
            S1[(size_t)(h * KD + k) * 64 + p_] = acc;
            yp[h][0] += qd.x * s0; yp[h][1] += qd.y * s0; yp[h][2] += qd.z * s0; yp[h][3] += qd.w * s0;
        }
    }
#pragma unroll
    for (int h = 0; h < 4; ++h)
#pragma unroll
        for (int t = 0; t < 4; ++t) RED[(kq * 16 + h * 4 + t) * 64 + p_] = yp[h][t];
    __syncthreads();
    for (int idx = tid; idx < 1024; idx += NTHR) { const int p2 = idx & 63, ht = idx >> 6, h = ht >> 2, t = ht & 3;
        float sum = 0.f;
#pragma unroll
        for (int q = 0; q < 8; ++q) sum += RED[(q * 16 + ht) * 64 + p2];
        for (int s = 0; s <= t; ++s) sum += Ps[ht * 4 + s] * Vs[s * 256 + h * 64 + p2];
        Ys[t * 256 + h * 64 + p2] = sum; }
    __syncthreads();
}

__device__ __forceinline__ void sample_ssd(PRM p, LAS unsigned char* lds, int l, int b) {
    const int tid = tidx(), lane = tid & 63, wave = tid >> 6, R0 = TP + b * 4;
    const bf16_t* U = (const bf16_t*)(p.ws + OFF_U); const float* SDT = (const float*)(p.ws + OFF_SDT);
    LAS float* QDs = (LAS float*)(lds + S_QD); LAS float* KWs = (LAS float*)(lds + S_KW); LAS float* Vs = (LAS float*)(lds + S_V);
    LAS float* DECs = (LAS float*)(lds + S_DEC); LAS float* Ps = (LAS float*)(lds + S_P); LAS float* Ys = (LAS float*)(lds + S_Y);
    LAS float* XB = (LAS float*)(lds + S_SCR); LAS float* DTs = (LAS float*)(lds + S_SCR + 12288); LAS float* CUs = DTs + 16;
    for (int ch = tid; ch < 768; ch += NTHR) {
        float xx[7];
#pragma unroll
        for (int r = 0; r < 3; ++r) xx[r] = p.in[3][((size_t)(l * 128 + b) * 3 + r) * 768 + ch];
#pragma unroll
        for (int t = 0; t < 4; ++t) xx[3 + t] = bf2f(U[(size_t)(R0 + t) * NU + UXBC + ch]);
        const float* cw = p.in[18] + (size_t)l * 4 * 768 + ch; const float w0 = cw[0], w1 = cw[768], w2 = cw[1536], w3 = cw[2304], bias = p.in[19][l * 768 + ch];
#pragma unroll
        for (int t = 0; t < 4; ++t) XB[t * 768 + ch] = siluf_(bias + w0 * xx[t] + w1 * xx[t + 1] + w2 * xx[t + 2] + w3 * xx[t + 3]);
#pragma unroll
        for (int r = 0; r < 3; ++r) p.out[O_SSSDC + ((size_t)(l * 128 + b) * 3 + r) * 768 + ch] = xx[4 + r];
    }
    if (tid < 4) { const int h = tid; float cum = 0.f; const float bias = p.in[20][l * 4 + h], A = -expf(p.in[21][l * 4 + h]);
        for (int t = 0; t < 4; ++t) { const float dt = softplusf_(SDT[(size_t)(R0 + t) * 4 + h] + bias); cum += A * dt; DTs[h * 4 + t] = dt; CUs[h * 4 + t] = cum; } }
    __syncthreads();
    for (int idx = tid; idx < 2048; idx += NTHR) { const int h = idx >> 9, t = (idx >> 7) & 3, n = idx & 127, g = h >> 1;
        QDs[(h * 128 + n) * 4 + t] = XB[t * 768 + 512 + g * 128 + n] * __expf(CUs[h * 4 + t]);
        KWs[(h * 128 + n) * 4 + t] = XB[t * 768 + 256 + g * 128 + n] * __expf(CUs[h * 4 + 3] - CUs[h * 4 + t]) * DTs[h * 4 + t]; }
    for (int idx = tid; idx < 1024; idx += NTHR) Vs[idx] = XB[(idx >> 8) * 768 + (idx & 255)];
    DECs[(tid >> 7) * 128 + (tid & 127)] = __expf(CUs[(tid >> 7) * 4 + 3]);
    if (tid < 64) { const int h = tid >> 4, t = (tid >> 2) & 3, s = tid & 3, g = h >> 1; float val = 0.f;
        if (s <= t) { float dot = 0.f;
#pragma unroll 32
            for (int n = 0; n < 128; ++n) dot += XB[t * 768 + 512 + g * 128 + n] * XB[s * 768 + 256 + g * 128 + n];
            val = dot * __expf(CUs[h * 4 + t] - CUs[h * 4 + s]) * DTs[h * 4 + s]; }
        Ps[tid] = val; }
    __syncthreads();
    dec_engine<128>(p.in[2] + (size_t)(l * 128 + b) * 32768, p.out + O_SSSD + (size_t)(l * 128 + b) * 32768, lds);
    for (int idx = tid; idx < 1024; idx += NTHR) { const int t = idx >> 8, ch = idx & 255, h = ch >> 6;
        const float y = Ys[idx] + p.in[22][l * 4 + h] * XB[t * 768 + ch];
        Ys[idx] = y * siluf_(bf2f(U[(size_t)(R0 + t) * NU + UZ + ch])); }
    __syncthreads();
    if (wave < 4) { const int t = wave; float v[4], ss = 0.f;
#pragma unroll
        for (int i = 0; i < 4; ++i) { v[i] = Ys[t * 256 + lane + 64 * i]; ss += v[i] * v[i]; }
        const float rstd = 1.0f / sqrtf(wave_sum(ss) * (1.0f / 256.0f) + EPS);
#pragma unroll
        for (int i = 0; i < 4; ++i) ((bf16_t*)(p.ws + OFF_YC))[(size_t)(R0 + t) * D + lane + 64 * i] = f2bf(v[i] * rstd * p.in[23][l * 256 + lane + 64 * i]); }
    __syncthreads();
}

template <bool CENTER>
__device__ __forceinline__ void sample_headnorm(PRM p, LAS unsigned char* lds, int R0, const float* gain, int gcol, int ocol) {
    const int tid = tidx(), lane = tid & 63, wave = tid >> 6;
    const bf16_t* U = (const bf16_t*)(p.ws + OFF_U); const LAS float* Ys = (const LAS float*)(lds + S_Y);
#pragma unroll
    for (int q = 0; q < 2; ++q) { const int gi = wave * 2 + q, t = gi >> 2, h = gi & 3;
        const float y = Ys[t * 256 + h * 64 + lane];
        const float mean = CENTER ? wave_sum(y) * (1.0f / 64.0f) : 0.f; const float d = y - mean;
        const float var = wave_sum(d * d) * (1.0f / 64.0f);
        const float o = d / sqrtf(var + EPS) * gain[h * 64 + lane] * siluf_(bf2f(U[(size_t)(R0 + t) * NU + gcol + h * 64 + lane]));
        ((bf16_t*)(p.ws + OFF_YC))[(size_t)(R0 + t) * D + ocol + h * 64 + lane] = f2bf(o); }
}

__device__ __forceinline__ void sample_ret(PRM p, LAS unsigned char* lds, int l, int b) {
    const int tid = tidx(), R0 = TP + b * 4;
    const bf16_t* U = (const bf16_t*)(p.ws + OFF_U);
    const float* RC = (const float*)(p.ws + OFF_ROPE); const float* RS = RC + 2052 * 32;
    LAS float* QDs = (LAS float*)(lds + S_QD); LAS float* KWs = (LAS float*)(lds + S_KW); LAS float* Vs = (LAS float*)(lds + S_V);
    LAS float* DECs = (LAS float*)(lds + S_DEC); LAS float* Ps = (LAS float*)(lds + S_P);
    LAS float* Qr = (LAS float*)(lds + S_SCR); LAS float* Kr = Qr + 1024;
    { const int h = tid >> 7, t = (tid >> 5) & 3, j = tid & 31; const bf16_t* ur = U + (size_t)(R0 + t) * NU;
        const float cs = RC[(2048 + t) * 32 + j], sn = RS[(2048 + t) * 32 + j];
        const float q1 = bf2f(ur[URQ + h * 64 + j]), q2 = bf2f(ur[URQ + h * 64 + j + 32]), k1 = bf2f(ur[URK + h * 64 + j]), k2 = bf2f(ur[URK + h * 64 + j + 32]);
        Qr[(h * 4 + t) * 64 + j] = q1 * cs - q2 * sn; Qr[(h * 4 + t) * 64 + j + 32] = q2 * cs + q1 * sn;
        Kr[(h * 4 + t) * 64 + j] = (k1 * cs - k2 * sn) * 0.125f; Kr[(h * 4 + t) * 64 + j + 32] = (k2 * cs + k1 * sn) * 0.125f; }
    for (int idx = tid; idx < 1024; idx += NTHR) Vs[idx] = bf2f(U[(size_t)(R0 + (idx >> 8)) * NU + URV + (idx & 255)]);
    __syncthreads();
    for (int idx = tid; idx < 1024; idx += NTHR) { const int h = idx >> 8, t = (idx >> 6) & 3, k = idx & 63; const float lg = logf(1.0f - exp2f(-5.0f - (float)h));
        QDs[(h * 128 + k) * 4 + t] = Qr[(h * 4 + t) * 64 + k] * __expf((float)(t + 1) * lg);
        KWs[(h * 128 + k) * 4 + t] = Kr[(h * 4 + t) * 64 + k] * __expf((float)(3 - t) * lg); }
    if (tid < 256) { const int h = tid >> 6; DECs[h * 128 + (tid & 63)] = __expf(4.0f * logf(1.0f - exp2f(-5.0f - (float)h))); }
    if (tid < 64) { const int h = tid >> 4, t = (tid >> 2) & 3, s = tid & 3; float val = 0.f;
        if (s <= t) { float dot = 0.f;
#pragma unroll 32
            for (int k = 0; k < 64; ++k) dot += Qr[(h * 4 + t) * 64 + k] * Kr[(h * 4 + s) * 64 + k];
            val = dot * __expf((float)(t - s) * logf(1.0f - exp2f(-5.0f - (float)h))); }
        Ps[tid] = val; }
    __syncthreads();
    dec_engine<64>(p.in[4] + (size_t)(l * 128 + b) * 16384, p.out + O_SRET + (size_t)(l * 128 + b) * 16384, lds);
    sample_headnorm<true>(p, lds, R0, p.in[24] + l * 256, URG, 256);
    __syncthreads();
}

__device__ __forceinline__ void sample_hg(PRM p, LAS unsigned char* lds, int l, int b) {
    const int tid = tidx(), R0 = TP + b * 4;
    const bf16_t* U = (const bf16_t*)(p.ws + OFF_U);
    LAS float* QDs = (LAS float*)(lds + S_QD); LAS float* KWs = (LAS float*)(lds + S_KW); LAS float* Vs = (LAS float*)(lds + S_V);
    LAS float* DECs = (LAS float*)(lds + S_DEC); LAS float* Ps = (LAS float*)(lds + S_P);
    LAS float* LF = (LAS float*)(lds + S_SCR); LAS float* KK = LF + 1024; LAS float* QH = KK + 1024;
    for (int idx = tid; idx < 1024; idx += NTHR) { const int t = idx >> 8, ch = idx & 255; const bf16_t* ur = U + (size_t)(R0 + t) * NU;
        float lbk = 0.f;
        if (l > 0) { const float a0 = p.in[32][ch], a1 = p.in[32][256 + ch]; const float mx = fmaxf(a0, a1), e0 = expf(a0 - mx), e1 = expf(a1 - mx); lbk = e1 / (e0 + e1); }
        const float hf = bf2f(ur[UHF + ch]);
        LF[idx] = logf(lbk + (1.0f - lbk) * sigmoidf_(hf)); KK[idx] = (1.0f - lbk) * sigmoidf_(-hf); QH[idx] = siluf_(bf2f(ur[UHQ + ch])); Vs[idx] = bf2f(ur[UHI + ch]); }
    __syncthreads();
    if (tid < 256) { float c = 0.f; for (int t = 0; t < 4; ++t) { c += LF[t * 256 + tid]; LF[t * 256 + tid] = c; } }
    __syncthreads();
    for (int idx = tid; idx < 1024; idx += NTHR) { const int h = idx >> 8, t = (idx >> 6) & 3, k = idx & 63, ch = h * 64 + k;
        const float cum = LF[t * 256 + ch], last = LF[3 * 256 + ch];
        QDs[(h * 128 + k) * 4 + t] = QH[t * 256 + ch] * __expf(cum); KWs[(h * 128 + k) * 4 + t] = KK[t * 256 + ch] * __expf(last - cum); }
    if (tid < 256) DECs[(tid >> 6) * 128 + (tid & 63)] = __expf(LF[3 * 256 + tid]);
    if (tid < 64) { const int h = tid >> 4, t = (tid >> 2) & 3, s = tid & 3; float val = 0.f;
        if (s <= t)
#pragma unroll 16
            for (int k = 0; k < 64; ++k) { const int ch = h * 64 + k; val += QH[t * 256 + ch] * KK[s * 256 + ch] * __expf(LF[t * 256 + ch] - LF[s * 256 + ch]); }
        Ps[tid] = val; }
    __syncthreads();
    dec_engine<64>(p.in[7] + (size_t)(l * 128 + b) * 16384, p.out + O_SHG + (size_t)(l * 128 + b) * 16384, lds);
    sample_headnorm<false>(p, lds, R0, p.in[33] + l * 256, UHG, 768);
    __syncthreads();
}

__device__ __forceinline__ void sample_rg(PRM p, LAS unsigned char* lds, int l, int b) {
    const int tid = tidx(), R0 = TP + b * 4;
    const bf16_t* U = (const bf16_t*)(p.ws + OFF_U);
    LAS float* XRs = (LAS float*)(lds + S_SCR); LAS float* GA = XRs + 1024;
    if (tid < 256) { const int ch = tid; float xx[7];
#pragma unroll
        for (int r = 0; r < 3; ++r) xx[r] = p.in[6][((size_t)(l * 128 + b) * 3 + r) * 256 + ch];
#pragma unroll
        for (int t = 0; t < 4; ++t) xx[3 + t] = bf2f(U[(size_t)(R0 + t) * NU + UGX + ch]);
        const float* cw = p.in[25] + (size_t)l * 4 * 256 + ch; const float w0 = cw[0], w1 = cw[256], w2 = cw[512], w3 = cw[768], bias = p.in[26][l * 256 + ch];
#pragma unroll
        for (int t = 0; t < 4; ++t) XRs[t * 256 + ch] = bias + w0 * xx[t] + w1 * xx[t + 1] + w2 * xx[t + 2] + w3 * xx[t + 3];
#pragma unroll
        for (int r = 0; r < 3; ++r) p.out[O_SRGC + ((size_t)(l * 128 + b) * 3 + r) * 256 + ch] = xx[4 + r]; }
    __syncthreads();
    { const int ch = tid & 255, gate = tid >> 8, blk = ch >> 6, j = ch & 63; const float* W = p.in[gate ? 29 : 27] + (size_t)(l * 4 + blk) * 4096;
        float a0 = 0.f, a1 = 0.f, a2 = 0.f, a3 = 0.f, wv[64];
#pragma unroll
        for (int i = 0; i < 64; ++i) wv[i] = W[i * 64 + j];
#pragma unroll
        for (int i = 0; i < 64; ++i) { const float w = wv[i];
            a0 += XRs[blk * 64 + i] * w; a1 += XRs[256 + blk * 64 + i] * w; a2 += XRs[512 + blk * 64 + i] * w; a3 += XRs[768 + blk * 64 + i] * w; }
        GA[(gate * 4 + 0) * 256 + ch] = a0; GA[(gate * 4 + 1) * 256 + ch] = a1; GA[(gate * 4 + 2) * 256 + ch] = a2; GA[(gate * 4 + 3) * 256 + ch] = a3; }
    __syncthreads();
    if (tid < 256) { const int ch = tid; float h = p.in[5][(size_t)(l * 128 + b) * 256 + ch];
        const float ba = p.in[28][l * 256 + ch], bx = p.in[30][l * 256 + ch], sp = -8.0f * softplusf_(-p.in[31][l * 256 + ch]);
        for (int t = 0; t < 4; ++t) { const float r = sigmoidf_(GA[t * 256 + ch] + ba), ig = sigmoidf_(GA[(4 + t) * 256 + ch] + bx);
            const float la = sp * r; h = __expf(la) * h + sqrtf(-expm1f(2.0f * la)) * ig * XRs[t * 256 + ch];
            ((bf16_t*)(p.ws + OFF_YC))[(size_t)(R0 + t) * D + 512 + ch] = f2bf(geluf_(bf2f(U[(size_t)(R0 + t) * NU + UGY + ch])) * h); }
        p.out[O_SRG + (size_t)(l * 128 + b) * 256 + ch] = h; }
    __syncthreads();
}

__device__ __forceinline__ void attn_prompt(PRM p, LAS unsigned char* lds, int u) {
    const int tid = tidx(), lane = tid & 63, wave = tid >> 6, fr = lane & 15, fq = lane >> 4;
    const int qt = u & 15, h = (u >> 4) & 3, b = u >> 6, r0 = b * 2048 + qt * 128;
    const bf16_t* Q = (const bf16_t*)(p.ws + OFF_Q); const bf16_t* KBp = (const bf16_t*)(p.ws + OFF_KB) + (size_t)(b * 4 + h) * 65536;
    const bf16_t* VTp = (const bf16_t*)(p.ws + OFF_VTB) + (size_t)(b * 4 + h) * 65536; bf16_t* OB = (bf16_t*)(p.ws + OFF_YC);
    LAS bf16_t* KC = (LAS bf16_t*)lds; LAS bf16_t* PS = (LAS bf16_t*)(lds + 36864);
    bf16x8 qf[8];
#pragma unroll
    for (int ks = 0; ks < 8; ++ks) qf[ks] = *(const bf16x8*)(Q + (size_t)(r0 + 16 * wave + fr) * D + h * 256 + ks * 32 + fq * 8);
    u32x4 kr[4];
    const int sr = tid >> 3, sc8 = (tid & 7) * 8;
#pragma unroll
    for (int i = 0; i < 4; ++i) kr[i] = *(const u32x4*)(KBp + (size_t)(sr + 64 * i) * 256 + sc8);
    f32x4 S[16];
#pragma unroll
    for (int j = 0; j < 16; ++j) S[j] = (f32x4){0.f, 0.f, 0.f, 0.f};
#pragma unroll
    for (int dc = 0; dc < 4; ++dc) {
#pragma unroll
        for (int i = 0; i < 4; ++i) *(LAS u32x4*)(KC + (sr + 64 * i) * 72 + sc8) = kr[i];
        __syncthreads();
        if (dc < 3) {
#pragma unroll
            for (int i = 0; i < 4; ++i) kr[i] = *(const u32x4*)(KBp + (size_t)(sr + 64 * i) * 256 + (dc + 1) * 64 + sc8);
        } else {
#pragma unroll
            for (int i = 0; i < 4; ++i) kr[i] = *(const u32x4*)(VTp + (size_t)(sr + 64 * i) * 256 + sc8);
        }
#pragma unroll
        for (int k2 = 0; k2 < 2; ++k2)
#pragma unroll
            for (int j = 0; j < 16; ++j) { const bf16x8 kf = *(const LAS bf16x8*)(KC + (16 * j + fr) * 72 + k2 * 32 + fq * 8);
                S[j] = __builtin_amdgcn_mfma_f32_16x16x32_bf16(kf, qf[dc * 2 + k2], S[j], 0, 0, 0); }
        __syncthreads();
    }
    {
        float m = -3.0e38f;
#pragma unroll
        for (int j = 0; j < 16; ++j) m = fmaxf(fmaxf(m, fmaxf(S[j][0], S[j][1])), fmaxf(S[j][2], S[j][3]));
        m = fmaxf(m, __shfl_xor(m, 16)); m = fmaxf(m, __shfl_xor(m, 32));
        float sm = 0.f;
#pragma unroll
        for (int j = 0; j < 16; ++j)
#pragma unroll
            for (int e = 0; e < 4; ++e) { const float ev = __expf((S[j][e] - m) * 0.0625f); S[j][e] = ev; sm += ev; }
        sm += __shfl_xor(sm, 16); sm += __shfl_xor(sm, 32);
        const float inv = 1.0f / sm;
#pragma unroll
        for (int j = 0; j < 16; ++j) { u32x2 w; w.x = pk2(S[j][0] * inv, S[j][1] * inv); w.y = pk2(S[j][2] * inv, S[j][3] * inv);
            *(LAS u32x2*)(PS + (16 * wave + fr) * 264 + 16 * j + 4 * fq) = w; }
    }
    f32x4 O[16];
#pragma unroll
    for (int j = 0; j < 16; ++j) O[j] = (f32x4){0.f, 0.f, 0.f, 0.f};
#pragma unroll
    for (int kc = 0; kc < 4; ++kc) {
#pragma unroll
        for (int i = 0; i < 4; ++i) *(LAS u32x4*)(KC + (sr + 64 * i) * 72 + sc8) = kr[i];
        __syncthreads();
        if (kc < 3) {
#pragma unroll
            for (int i = 0; i < 4; ++i) kr[i] = *(const u32x4*)(VTp + (size_t)(sr + 64 * i) * 256 + (kc + 1) * 64 + sc8);
        }
#pragma unroll
        for (int k2 = 0; k2 < 2; ++k2) { const bf16x8 pf = *(const LAS bf16x8*)(PS + (16 * wave + fr) * 264 + kc * 64 + k2 * 32 + fq * 8);
#pragma unroll
            for (int j = 0; j < 16; ++j) { const bf16x8 vf = *(const LAS bf16x8*)(KC + (16 * j + fr) * 72 + k2 * 32 + fq * 8);
                O[j] = __builtin_amdgcn_mfma_f32_16x16x32_bf16(vf, pf, O[j], 0, 0, 0); } }
        __syncthreads();
    }
#pragma unroll
    for (int j = 0; j < 16; ++j) { u32x2 w; w.x = pk2(O[j][0], O[j][1]); w.y = pk2(O[j][2], O[j][3]);
        *(u32x2*)(OB + (size_t)(r0 + 16 * wave + fr) * D + h * 256 + 16 * j + 4 * fq) = w; }
}

__device__ __forceinline__ void attn_sample(PRM p, LAS unsigned char* lds, int l, int u) {
    const int tid = tidx(), lane = tid & 63, wave = tid >> 6;
    const int h = u & 3, b = u >> 2, R0 = TP + b * 4;
    const bf16_t* Q = (const bf16_t*)(p.ws + OFF_Q); bf16_t* OB = (bf16_t*)(p.ws + OFF_YC);
    LAS float* QSs = (LAS float*)lds; LAS float* SCT = QSs + 1024; LAS float* OP = SCT + 1024;
    const float* Kp = p.in[8] + ((size_t)(l * 128 + b) * 256) * 1024 + h * 256 + lane * 4;
    f32x4 kvn[8];
#pragma unroll
    for (int i = 0; i < 8; ++i) kvn[i] = *(const f32x4*)(Kp + (size_t)(wave * 32 + i) * 1024);
    for (int idx = tid; idx < 1024; idx += NTHR) QSs[idx] = bf2f(Q[(size_t)(R0 + (idx >> 8)) * D + h * 256 + (idx & 255)]) * 0.0625f;
    __syncthreads();
    f32x4 q[4];
#pragma unroll
    for (int t = 0; t < 4; ++t) q[t] = *(const LAS f32x4*)(QSs + t * 256 + lane * 4);
#pragma unroll 1
    for (int i0 = 0; i0 < 32; i0 += 8) {
        f32x4 kv[8];
#pragma unroll
        for (int i = 0; i < 8; ++i) kv[i] = kvn[i];
        if (i0 + 8 < 32) {
#pragma unroll
            for (int i = 0; i < 8; ++i) kvn[i] = *(const f32x4*)(Kp + (size_t)(wave * 32 + i0 + 8 + i) * 1024);
        }
        float vals[32];
#pragma unroll
        for (int i = 0; i < 8; ++i)
#pragma unroll
            for (int t = 0; t < 4; ++t) vals[i * 4 + t] = kv[i].x * q[t].x + kv[i].y * q[t].y + kv[i].z * q[t].z + kv[i].w * q[t].w;
#pragma unroll
        for (int n = 16, mask = 32; n >= 1; n >>= 1, mask >>= 1) { const bool up = (lane & mask) != 0;
#pragma unroll
            for (int i = 0; i < n; ++i) { const float send = up ? vals[i] : vals[i + n]; const float keep = up ? vals[i + n] : vals[i]; vals[i] = keep + __shfl_xor(send, mask); } }
        const float tot = vals[0] + __shfl_xor(vals[0], 1);
        if ((lane & 1) == 0) { const int vi = lane >> 1; SCT[(wave * 32 + i0 + (vi >> 2)) * 4 + (vi & 3)] = tot; }
    }
    const float* Vp = p.in[9] + ((size_t)(l * 128 + b) * 256) * 1024 + h * 256 + lane * 4;
    f32x4 vvn[8];
#pragma unroll
    for (int i = 0; i < 8; ++i) vvn[i] = *(const f32x4*)(Vp + (size_t)(wave * 32 + i) * 1024);
    __syncthreads();
    if (wave < 4) { const int t = wave; float v[4], m = -3.0e38f;
#pragma unroll
        for (int i = 0; i < 4; ++i) { v[i] = SCT[(lane + 64 * i) * 4 + t]; m = fmaxf(m, v[i]); }
        m = wave_max(m); float sm = 0.f;
#pragma unroll
        for (int i = 0; i < 4; ++i) { v[i] = __expf(v[i] - m); sm += v[i]; }
        sm = 1.0f / wave_sum(sm);
#pragma unroll
        for (int i = 0; i < 4; ++i) SCT[(lane + 64 * i) * 4 + t] = v[i] * sm; }
    __syncthreads();
    {
        f32x4 acc[4];
#pragma unroll
        for (int t = 0; t < 4; ++t) acc[t] = (f32x4){0.f, 0.f, 0.f, 0.f};
#pragma unroll 1
        for (int i0 = 0; i0 < 32; i0 += 8) {
            f32x4 vv[8];
#pragma unroll
            for (int i = 0; i < 8; ++i) vv[i] = vvn[i];
            if (i0 + 8 < 32) {
#pragma unroll
                for (int i = 0; i < 8; ++i) vvn[i] = *(const f32x4*)(Vp + (size_t)(wave * 32 + i0 + 8 + i) * 1024);
            }
#pragma unroll
            for (int i = 0; i < 8; ++i) { const f32x4 pr = *(const LAS f32x4*)(SCT + (wave * 32 + i0 + i) * 4);
                acc[0] = acc[0] + vv[i] * pr.x; acc[1] = acc[1] + vv[i] * pr.y; acc[2] = acc[2] + vv[i] * pr.z; acc[3] = acc[3] + vv[i] * pr.w; }
        }
#pragma unroll
        for (int t = 0; t < 4; ++t) *(LAS f32x4*)(OP + (wave * 4 + t) * 256 + lane * 4) = acc[t];
    }
    __syncthreads();
    for (int idx = tid; idx < 1024; idx += NTHR) { float o = 0.f;
#pragma unroll
        for (int w = 0; w < 8; ++w) o += OP[w * 1024 + idx];
        OB[(size_t)(R0 + (idx >> 8)) * D + h * 256 + (idx & 255)] = f2bf(o); }
    __syncthreads();
}

template <int MODE, int K, int KC>
__device__ __forceinline__ void sgemm(LAS unsigned char* lds, const bf16_t* A, const bf16_t* Bt, float* Cf, bf16_t* Cb) {
    const int tid = tidx(), lane = tid & 63, wave = tid >> 6, fr = lane & 15, fq = lane >> 4;
    constexpr int NCH = KC / 8, NI = (32 * NCH + NTHR - 1) / NTHR, LD = KC + 8, NSLAB = K / KC;
    LAS bf16_t* AS = (LAS bf16_t*)lds; LAS bf16_t* BS = (LAS bf16_t*)(lds + 32 * LD * 2);
    const int rt = (wave >> 1) & 1, ct = wave & 1;
    const int ntile = (512 - (int)blockIdx.x + (int)gridDim.x - 1) / (int)gridDim.x, nstep = ntile * NSLAB;
    u32x4 ra[NI], rb[NI];
    auto issue = [&](int step) { const int tile = blockIdx.x + (step / NSLAB) * gridDim.x, k0 = (step % NSLAB) * KC, tm = tile >> 5, tn = tile & 31;
#pragma unroll
        for (int i = 0; i < NI; ++i) { const int idx = tid + i * NTHR; const int r = idx / NCH, cc = idx % NCH;
            if (idx < 32 * NCH) { ra[i] = ldg8(A + (size_t)(tm * 32 + r) * K + k0 + cc * 8); rb[i] = ldg8(Bt + (size_t)(tn * 32 + r) * K + k0 + cc * 8); } } };
    if (nstep > 0) issue(0);
    f32x4 acc = (f32x4){0.f, 0.f, 0.f, 0.f};
#pragma unroll 1
    for (int step = 0; step < nstep; ++step) {
#pragma unroll
        for (int i = 0; i < NI; ++i) { const int idx = tid + i * NTHR; const int r = idx / NCH, cc = idx % NCH;
            if (idx < 32 * NCH) { *(LAS u32x4*)(AS + r * LD + cc * 8) = ra[i]; *(LAS u32x4*)(BS + r * LD + cc * 8) = rb[i]; } }
        __syncthreads();
        if (step + 1 < nstep) issue(step + 1);
        if (wave < 4) {
#pragma unroll 4
            for (int ks = 0; ks < KC / 32; ++ks) { const bf16x8 a = *(const LAS bf16x8*)(AS + (16 * rt + fr) * LD + ks * 32 + fq * 8);
                const bf16x8 b = *(const LAS bf16x8*)(BS + (16 * ct + fr) * LD + ks * 32 + fq * 8);
                acc = __builtin_amdgcn_mfma_f32_16x16x32_bf16(a, b, acc, 0, 0, 0); }
            if ((step % NSLAB) == NSLAB - 1) { const int tile = blockIdx.x + (step / NSLAB) * gridDim.x, tm = tile >> 5, tn = tile & 31;
#pragma unroll
                for (int e = 0; e < 4; ++e) { const size_t o = (size_t)(tm * 32 + 16 * rt + fq * 4 + e) * 1024 + tn * 32 + 16 * ct + fr;
                    if (MODE == 0) Cf[o] = acc[e]; else Cb[o] = f2bf(acc[e]); }
                acc = (f32x4){0.f, 0.f, 0.f, 0.f}; }
        }
        __syncthreads();
    }
}

#ifndef REP_SYNC
#define REP_SYNC 1
#endif
#define GSYNC() do { _Pragma("unroll 1") for (int _r = 0; _r < REP_SYNC; ++_r) xcd_barrier(xb); } while (0)
#ifndef REP_SAMP
#define REP_SAMP 1
#endif
#ifndef REP_SSD
#define REP_SSD 1
#endif
#ifndef REP_ROWS
#define REP_ROWS 1
#endif
#ifndef REP_P0
#define REP_P0 1
#endif
#ifndef REP_GEMM
#define REP_GEMM 1
#endif
#ifndef REP_MIX
#define REP_MIX 1
#endif
#ifndef REP_ATT
#define REP_ATT 1
#endif
__global__ void __launch_bounds__(512) mega(Params p_unused) {
    const KPRM kp = (KPRM)__builtin_amdgcn_kernarg_segment_ptr();
#define PP (*kp_launder(kp))
    extern __shared__ __attribute__((aligned(16))) unsigned char shm[];
    LAS unsigned char* lds = (LAS unsigned char*)shm;
    cg::grid_group grid = cg::this_grid();
    unsigned char* ws = PP.ws;
    bf16_t* H = (bf16_t*)(ws + OFF_H); bf16_t* UB = (bf16_t*)(ws + OFF_U); bf16_t* YC = (bf16_t*)(ws + OFF_YC); bf16_t* M = (bf16_t*)(ws + OFF_M);
    bf16_t* QB = (bf16_t*)(ws + OFF_Q); bf16_t* ACT = (bf16_t*)(ws + OFF_ACT); float* X = PP.out; float* SDT = (float*)(ws + OFF_SDT);
    volatile LAS unsigned* xst = (volatile LAS unsigned*)(lds + 163824);
    unsigned* bar = (unsigned*)(ws + OFF_BAR);
    { const int t0 = tidx(); if (t0 == 0) { xst[0] = 0u; xst[1] = 0u; } if (blockIdx.x == 0) for (int i = t0; i < XCD_BAR_WORDS; i += NTHR) bar[i] = 0u; }
    __syncthreads();
    phase0(PP, lds);
    grid.sync();
    XcdBarrier xb = xcd_barrier_post(bar, xst);
#pragma unroll 1
    for (int rep = 1; rep < REP_P0; ++rep) { phase0(PP, lds); GSYNC(); }
#pragma unroll 1
    for (int l = 0; l < NL; ++l) {
#pragma unroll 1
        for (int rep = 0; rep < REP_GEMM; ++rep) {
            { EpiBf16 e{UB, NU}; run_gemm(lds, H, (const bf16_t*)(ws + OFF_WIN) + (size_t)l * NU * D, TT, NU, D, e, 0); }
            { EpiMemKV e{PP.out + O_PMK + (size_t)l * 8 * 256 * 1024, PP.out + O_PMV + (size_t)l * 8 * 256 * 1024, (bf16_t*)(ws + OFF_KB), (bf16_t*)(ws + OFF_VTB)};
              run_gemm(lds, (const bf16_t*)(ws + OFF_HM) + (size_t)l * 2048 * D, (const bf16_t*)(ws + OFF_WXKV) + (size_t)l * 2048 * D, 2048, 2048, D, e, 64); }
            GSYNC();
        }
#pragma unroll 1
        for (int rep = 0; rep < REP_MIX; ++rep) {
#pragma unroll 1
            for (int grp = 0; grp < 3; ++grp) { const int gsel = (blockIdx.x & 1) ? 2 - grp : grp;
                if (gsel == 0) {
#pragma unroll 1
                    for (int r2 = 0; r2 < REP_SAMP; ++r2)
                    for (int u = blockIdx.x; u < 512; u += gridDim.x) {
                        if (u < 128) sample_ssd(PP, lds, l, u);
                        else if (u < 256) sample_ret(PP, lds, l, u - 128);
                        else if (u < 384) sample_hg(PP, lds, l, u - 256);
                        else sample_rg(PP, lds, l, u - 384);
                    }
                } else if (gsel == 1) {
#pragma unroll 1
                    for (int r2 = 0; r2 < REP_SSD; ++r2)
                    for (int u = blockIdx.x; u < 512; u += gridDim.x) ssd_passA(PP, lds, l, u);
                } else {
#ifdef MIXA_PERHEAD
#pragma unroll 1
                    for (int u = blockIdx.x; u < 1024; u += gridDim.x) mixA_unit(PP, lds, l, u);
#else
#pragma unroll 1
                    for (int u = blockIdx.x; u < 256; u += gridDim.x) { retA4_unit(PP, lds, l, u); hgA4_unit(PP, lds, l, u); }
                    rg_loop<false>(PP, lds, l);
#endif
                }
            }
            GSYNC();
            carry_phase(PP, l);
            GSYNC();
            if ((blockIdx.x & 1) == 0) {
#pragma unroll 1
                for (int r2 = 0; r2 < REP_SSD; ++r2)
                for (int u = blockIdx.x; u < 256; u += gridDim.x) ssd_passC(PP, lds, l, u);
            }
#if 1
#if 1
            ret_loop<true>(PP, lds, l);
#else
#pragma unroll 1
            for (int u = blockIdx.x; u < 512; u += gridDim.x) retC2_unit(PP, lds, l, u);
#endif
            hg_loop<true>(PP, lds, l); rg_loop<true>(PP, lds, l);
            if (blockIdx.x & 1) {
#pragma unroll 1
                for (int r2 = 0; r2 < REP_SSD; ++r2)
                for (int u = blockIdx.x; u < 256; u += gridDim.x) ssd_passC(PP, lds, l, u);
            }
#else
#pragma unroll 1
            for (int u = blockIdx.x; u < 1024; u += gridDim.x) mixC_unit(PP, lds, l, u);
#endif
            GSYNC();
        }
#pragma unroll 1
        for (int rep = 0; rep < REP_GEMM; ++rep) { EpiBf16 e{M, D}; run_gemm(lds, YC, (const bf16_t*)(ws + OFF_WOUT) + (size_t)l * D * D, TP, D, D, e, 0);
            sgemm<1, 1024, 1024>(lds, YC + (size_t)TP * D, (const bf16_t*)(ws + OFF_WOUT) + (size_t)l * D * D, nullptr, M + (size_t)TP * D); GSYNC(); }
        rows_phase(lds, TT, l == 0 ? PP.in[0] : nullptr, l == 0 ? PP.in[1] : nullptr, X, M, PP.in[12] + l * D, PP.in[13] + l * D, H, nullptr, nullptr);
#if REP_ROWS > 1
        rows_phase(lds, TT, nullptr, nullptr, (float*)(ws + OFF_XS), M, PP.in[12] + l * D, PP.in[13] + l * D, (bf16_t*)(ws + OFF_HS), nullptr, nullptr);
#endif
        GSYNC();
#pragma unroll 1
        for (int rep = 0; rep < REP_GEMM; ++rep) { EpiBf16 e{QB, D}; run_gemm(lds, H, (const bf16_t*)(ws + OFF_WXQ) + (size_t)l * D * D, TP, D, D, e, 0);
            sgemm<1, 1024, 1024>(lds, H + (size_t)TP * D, (const bf16_t*)(ws + OFF_WXQ) + (size_t)l * D * D, nullptr, QB + (size_t)TP * D); GSYNC(); }
#pragma unroll 1
        for (int rep = 0; rep < REP_ATT; ++rep) {
            for (int k = 0; k < 1024; k += gridDim.x) { const int u = (gridDim.x == 256 && (blockIdx.x & 1)) ? (int)((blockIdx.x + k + 512) & 1023) : (int)(blockIdx.x + k);
                if (u < 512) attn_prompt(PP, lds, u); else if (u < 1024) attn_sample(PP, lds, l, u - 512); }
            GSYNC();
        }
#pragma unroll 1
        for (int rep = 0; rep < REP_GEMM; ++rep) { EpiBf16 e{M, D}; run_gemm(lds, YC, (const bf16_t*)(ws + OFF_WXO) + (size_t)l * D * D, TP, D, D, e, 0);
            sgemm<1, 1024, 1024>(lds, YC + (size_t)TP * D, (const bf16_t*)(ws + OFF_WXO) + (size_t)l * D * D, nullptr, M + (size_t)TP * D); GSYNC(); }
        rows_phase(lds, TT, nullptr, nullptr, X, M, PP.in[14] + l * D, PP.in[15] + l * D, H, nullptr, nullptr);
#if REP_ROWS > 1
        rows_phase(lds, TT, nullptr, nullptr, (float*)(ws + OFF_XS), M, PP.in[14] + l * D, PP.in[15] + l * D, (bf16_t*)(ws + OFF_HS), nullptr, nullptr);
#endif
        GSYNC();
#pragma unroll 1
        for (int rep = 0; rep < REP_GEMM; ++rep) { EpiSwiGLU e{ACT}; run_gemm(lds, H, (const bf16_t*)(ws + OFF_WGU) + (size_t)l * 5632 * D, TT, 5632, D, e, 0); GSYNC(); }
#pragma unroll 1
        for (int rep = 0; rep < REP_GEMM; ++rep) { EpiBf16 e{M, D}; run_gemm(lds, ACT, (const bf16_t*)(ws + OFF_WDN) + (size_t)l * D * DFF, TP, D, DFF, e, 0);
            sgemm<1, 2816, 704>(lds, ACT + (size_t)TP * DFF, (const bf16_t*)(ws + OFF_WDN) + (size_t)l * D * DFF, nullptr, M + (size_t)TP * D); GSYNC(); }
        rows_phase(lds, TT, nullptr, nullptr, X, M, PP.in[16] + l * D, l + 1 < NL ? PP.in[11] + (l + 1) * D : nullptr, H, l + 1 < NL ? PP.in[17] + (size_t)(l + 1) * D * DIN : nullptr, SDT);
#if REP_ROWS > 1
        rows_phase(lds, TT, nullptr, nullptr, (float*)(ws + OFF_XS), M, PP.in[16] + l * D, l + 1 < NL ? PP.in[11] + (l + 1) * D : nullptr, (bf16_t*)(ws + OFF_HS), l + 1 < NL ? PP.in[17] + (size_t)(l + 1) * D * DIN : nullptr, (float*)(ws + OFF_HS));
#endif
        GSYNC();
    }
}

#undef PP
extern "C" void kernel_launch(void* const* d_in, const int* in_sizes, int n_in, void* d_out, int out_size, void* d_ws, size_t ws_size, hipStream_t stream) {
    constexpr int LDS_BYTES = 160 * 1024;
    static int grid = 0;
    if (grid == 0) {
        if (n_in != 41 || (size_t)out_size != O_END || ws_size < WS_END) { fprintf(stderr, "kernel_launch: unexpected shapes (n_in %d out %d ws %zu need %zu)\n", n_in, out_size, ws_size, (size_t)WS_END); grid = -1; return; }
        int dev = 0, cus = 0, per_cu = 0;
        (void)hipGetDevice(&dev);
        (void)hipDeviceGetAttribute(&cus, hipDeviceAttributeMultiprocessorCount, dev);
        (void)hipFuncSetAttribute((const void*)mega, hipFuncAttributeMaxDynamicSharedMemorySize, LDS_BYTES);
        (void)hipOccupancyMaxActiveBlocksPerMultiprocessor(&per_cu, (const void*)mega, 512, LDS_BYTES);
        if (per_cu < 1) { fprintf(stderr, "kernel_launch: occupancy query reports %d blocks per CU\n", per_cu); per_cu = 1; }
        grid = cus < 256 ? cus : 256;
    }
    if (grid < 0) return;
    Params p{};
    for (int i = 0; i < 41; ++i) p.in[i] = (const float*)d_in[i];
    p.out = (float*)d_out; p.ws = (unsigned char*)d_ws;
    void* args[] = {&p};
    hipError_t e = hipLaunchCooperativeKernel((void*)mega, dim3(grid), dim3(512), args, LDS_BYTES, stream);
    if (e != hipSuccess) fprintf(stderr, "cooperative launch failed: %s (grid %d)\n", hipGetErrorString(e), grid);
}
```

```cpp
#include <hip/hip_runtime.h>
#include <hip/hip_cooperative_groups.h>
#include <cstdio>
#include <cstdint>
namespace cg = cooperative_groups;
__device__ __forceinline__ int tidx() { int t = threadIdx.x; asm volatile("" : "+v"(t)); return t; }
namespace pg8 {
#define PG8_LAS __attribute__((address_space(3)))
typedef unsigned short bf16_t;
typedef short bf16x8 __attribute__((ext_vector_type(8)));
typedef float f32x4 __attribute__((ext_vector_type(4)));
typedef unsigned u32x4 __attribute__((ext_vector_type(4)));
constexpr int BM = 256, BK = 64, HALF = 128, HTB = HALF * BK * 2  , STAGE_BYTES = 8 * HTB, NXCD = 8, WGM = 8;

__host__ __device__ __forceinline__ int lds_byte(int r, int c) { const int st = (r >> 4) * 2 + (c >> 5), rr = r & 15, cc = c & 31, ob = rr * 64 + cc * 2; return st * 1024 + (ob ^ (((ob >> 9) & 1) << 5)); }
__host__ __device__ __forceinline__ void stage_rc(int b, int& R, int& C) { const int st = b / 1024, sb = b % 1024, swz = sb ^ (((sb >> 9) & 1) << 5); R = (st >> 1) * 16 + swz / 64; C = (st & 1) * 32 + (swz % 64) / 2; }
__host__ __device__ __forceinline__ int perm32(int rho) { const int n = rho >> 4, i = rho & 15; return 8 * (i >> 2) + 4 * n + (i & 3); }

struct Unit { int pm, pn; };
struct Gemm { const bf16_t* A; const bf16_t* Bt; int M, N, K; };

struct StaticOrder {
    int nM, nN, nwg, G, c;
    __host__ __device__ void init(int M, int N, int G_, int c_) { nM = M / BM; nN = N / BM; nwg = nM * nN; G = G_; c = c_; }
    __host__ __device__ bool next(int i, Unit& u) const {
        const long L = (long)i * G + c; if (L >= nwg) return false;
        int wgid = (int)L; { const int q = nwg / NXCD, r = nwg % NXCD, xcd = wgid % NXCD, off = wgid / NXCD; wgid = (xcd < r ? xcd * (q + 1) : r * (q + 1) + (xcd - r) * q) + off; }
        const int nig = WGM * nN, gid = wgid / nig, fm = gid * WGM, gsz = (nM - fm) < WGM ? (nM - fm) : WGM;
        u.pm = fm + ((wgid % nig) % gsz); u.pn = (wgid % nig) / gsz; return true;
    }
    __device__ __forceinline__ void a_ready(const Unit&) const {}
    __device__ __forceinline__ void done(const Unit&) const {}
};
}
namespace pg8 {
template <class Epi, class Sched, bool STAMP = false>
__device__ __forceinline__ void gemm_phase(PG8_LAS unsigned char* lds, const Gemm g, const Sched& S, const Epi& E, unsigned long long* stamps) {
    const int tid = tidx(), wid = __builtin_amdgcn_readfirstlane(tid >> 6), lane = tid & 63, wr = wid >> 2, wc = wid & 3, fr = lane & 15, fq = lane >> 4;
    const int K = g.K, nt = K / BK;
    int ts_lo = 0, ts_hi = 0, nts = 0; const unsigned long long rt_entry = STAMP ? (unsigned long long)wall_clock64() : 0ull;
#define PG8_STAMP() do { if (STAMP && wid == 0 && nts < 64) { const unsigned long long _c = (unsigned long long)clock64(); \
        ts_lo = (lane == nts) ? (int)(unsigned)_c : ts_lo; ts_hi = (lane == nts) ? (int)(unsigned)(_c >> 32) : ts_hi; ++nts; } } while (0)
    PG8_STAMP();
    unsigned voffA[2], voffB[2];
#pragma unroll
    for (int i = 0; i < 2; ++i) { int R, C; stage_rc(tid * 16 + i * 8192, R, C); const int Rb = Epi::PERM ? ((R & ~31) + perm32(R & 31)) : R;
        voffA[i] = (unsigned)(R * K + C) * 2u; voffB[i] = (unsigned)(Rb * K + C) * 2u; }
    const size_t kstep = (size_t)(BK * 2);
    const size_t hstep = (size_t)HALF * K * 2;
    const size_t tstep = 2 * hstep;
    const unsigned ldsw = (unsigned)wid * 1024u;
    const int aoff = lds_byte(wr * 64 + fr, fq * 8), boff = lds_byte(wc * 32 + fr, fq * 8);
#define PG8_SA(b, h) (((b) * 2 + (h)) * HTB)
#define PG8_SB(b, h) ((4 + (b) * 2 + (h)) * HTB)
#define PG8_STAGE(bufoff, gbase, voff) do { _Pragma("unroll") for (int _i = 0; _i < 2; ++_i) \
        __builtin_amdgcn_global_load_lds((const unsigned*)((const char*)(gbase) + (voff)[_i]), (PG8_LAS unsigned*)(lds + (bufoff) + ldsw + _i * 8192), 16, 0, 0); } while (0)
#define PG8_LDA(dst, b, h) do { _Pragma("unroll") for (int m = 0; m < 4; ++m) _Pragma("unroll") for (int k = 0; k < 2; ++k) dst[m][k] = *(const PG8_LAS bf16x8*)(lds + PG8_SA(b, h) + aoff + m * 2048 + k * 1024); } while (0)
#define PG8_LDB(dst, b, h) do { _Pragma("unroll") for (int n = 0; n < 2; ++n) _Pragma("unroll") for (int k = 0; k < 2; ++k) dst[n][k] = *(const PG8_LAS bf16x8*)(lds + PG8_SB(b, h) + boff + n * 2048 + k * 1024); } while (0)
#define PG8_MMA(ai, bj, At, Bt) do { __builtin_amdgcn_s_setprio(1); _Pragma("unroll") for (int m = 0; m < 4; ++m) _Pragma("unroll") for (int n = 0; n < 2; ++n) _Pragma("unroll") for (int k = 0; k < 2; ++k) \
        acc[ai][bj][m][n] = __builtin_amdgcn_mfma_f32_16x16x32_bf16(Bt[n][k], At[m][k], acc[ai][bj][m][n], 0, 0, 0); __builtin_amdgcn_s_setprio(0); } while (0)
#define PG8_WAIT_V(n) asm volatile("s_waitcnt vmcnt(" #n ")" ::: "memory")
#define PG8_WAIT_L(n) asm volatile("s_waitcnt lgkmcnt(" #n ")" ::: "memory")
#define PG8_BAR __builtin_amdgcn_s_barrier()
#define PG8_SCHED __builtin_amdgcn_sched_barrier(0)
    Unit cur, nxt; int ui = 0;
    if (!S.next(0, cur)) return;
    f32x4 acc[2][2][4][2];
#pragma unroll
    for (int a = 0; a < 2; ++a)
#pragma unroll
        for (int b = 0; b < 2; ++b)
#pragma unroll
            for (int m = 0; m < 4; ++m)
#pragma unroll
                for (int n = 0; n < 2; ++n) acc[a][b][m][n] = (f32x4){0.f, 0.f, 0.f, 0.f};
    bf16x8 At[4][2], B0[2][2], B1[2][2];
    const char* cA = (const char*)g.A + (size_t)cur.pm * tstep; const char* cB = (const char*)g.Bt + (size_t)cur.pn * tstep;
    S.a_ready(cur);
    PG8_STAGE(PG8_SB(0, 0), cB, voffB); PG8_STAGE(PG8_SA(0, 0), cA, voffA); PG8_STAGE(PG8_SB(0, 1), cB + hstep, voffB); PG8_STAGE(PG8_SA(0, 1), cA + hstep, voffA);
    if (wr == 1) PG8_BAR;
    PG8_WAIT_V(4); PG8_BAR;
    PG8_STAGE(PG8_SB(1, 0), cB + kstep, voffB); PG8_STAGE(PG8_SA(1, 0), cA + kstep, voffA); PG8_STAGE(PG8_SB(1, 1), cB + hstep + kstep, voffB);
    PG8_WAIT_V(6); PG8_BAR;
    PG8_STAMP();
    for (;;) {
        const bool has_next = S.next(ui + 1, nxt);
        const char* nA = has_next ? (const char*)g.A + (size_t)nxt.pm * tstep : cA; const char* nB = has_next ? (const char*)g.Bt + (size_t)nxt.pn * tstep : cB;
        for (int t = 0; t < nt; t += 2) {
            const bool last = (t == nt - 2);
            const char* a1 = cA + (size_t)(t + 1) * kstep;
            const char* a2 = last ? nA : cA + (size_t)(t + 2) * kstep; const char* b2 = last ? nB : cB + (size_t)(t + 2) * kstep;
            const char* a3 = a2 + kstep; const char* b3 = b2 + kstep;
            if (last && has_next) S.a_ready(nxt);
            PG8_LDB(B0, 0, 0); PG8_SCHED; PG8_LDA(At, 0, 0); PG8_STAGE(PG8_SA(1, 1), a1 + hstep, voffA);
            PG8_WAIT_L(8); PG8_BAR; PG8_WAIT_L(0); PG8_MMA(0, 0, At, B0); PG8_BAR; PG8_SCHED;
            PG8_LDB(B1, 0, 1); PG8_STAGE(PG8_SB(0, 0), b2, voffB);
            PG8_BAR; PG8_WAIT_L(0); PG8_MMA(0, 1, At, B1); PG8_BAR;
            PG8_LDA(At, 0, 1); PG8_STAGE(PG8_SA(0, 0), a2, voffA);
            PG8_BAR; PG8_WAIT_L(0); PG8_MMA(1, 0, At, B0); PG8_BAR; PG8_SCHED;
            PG8_STAGE(PG8_SB(0, 1), b2 + hstep, voffB);
            PG8_WAIT_V(6); PG8_BAR; PG8_MMA(1, 1, At, B1); PG8_BAR;
            PG8_LDB(B0, 1, 0); PG8_SCHED; PG8_LDA(At, 1, 0); PG8_STAGE(PG8_SA(0, 1), a2 + hstep, voffA);
            PG8_WAIT_L(8); PG8_BAR; PG8_WAIT_L(0); PG8_MMA(0, 0, At, B0); PG8_BAR; PG8_SCHED;
            PG8_LDB(B1, 1, 1); PG8_STAGE(PG8_SB(1, 0), b3, voffB);
            PG8_BAR; PG8_WAIT_L(0); PG8_MMA(0, 1, At, B1); PG8_BAR;
            PG8_LDA(At, 1, 1); PG8_STAGE(PG8_SA(1, 0), a3, voffA);
            PG8_BAR; PG8_WAIT_L(0); PG8_MMA(1, 0, At, B0); PG8_BAR; PG8_SCHED;
            PG8_STAGE(PG8_SB(1, 1), b3 + hstep, voffB);
            PG8_WAIT_V(6); PG8_BAR; PG8_MMA(1, 1, At, B1); PG8_BAR;
        }
        PG8_STAMP();
        if constexpr (!Epi::AFTER_DRAIN) { E(acc, cur, wr, wc, fr, fq); S.done(cur); }
        PG8_STAMP();
        if (!has_next) break;
#pragma unroll
        for (int a = 0; a < 2; ++a)
#pragma unroll
            for (int b = 0; b < 2; ++b)
#pragma unroll
                for (int m = 0; m < 4; ++m)
#pragma unroll
                    for (int n = 0; n < 2; ++n) acc[a][b][m][n] = (f32x4){0.f, 0.f, 0.f, 0.f};
        cur = nxt; cA = nA; cB = nB; ++ui;
    }
    PG8_WAIT_V(0);
    if (wr == 0) PG8_BAR;
    PG8_BAR;
    if constexpr (Epi::AFTER_DRAIN) { E.fused(acc, cur, wr, wc, fr, fq, lds, wid, lane); S.done(cur); }
    PG8_STAMP();
    if (STAMP && wid == 0) { stamps[lane] = lane < nts ? (((unsigned long long)(unsigned)ts_hi << 32) | (unsigned)ts_lo) : 0ull;
        if (lane == 62) stamps[62] = rt_entry; if (lane == 63) stamps[63] = (unsigned long long)wall_clock64(); }
#undef PG8_STAMP
#undef PG8_SA
#undef PG8_SB
#undef PG8_STAGE
#undef PG8_LDA
#undef PG8_LDB
#undef PG8_MMA
#undef PG8_WAIT_V
#undef PG8_WAIT_L
#undef PG8_BAR
#undef PG8_SCHED
}
}

#define LAS __attribute__((address_space(3)))
using pg8::bf16_t; using pg8::bf16x8; using pg8::f32x4; using pg8::u32x4;
typedef unsigned u32x2 __attribute__((ext_vector_type(2)));
typedef float f32x2 __attribute__((ext_vector_type(2)));

constexpr int D = 1024, TP = 16384, TS = 512, TT = TP + TS, NU = 3584, DIN = 3588, DFF = 2816, NL = 2;
constexpr int NTHR = 512;
constexpr float EPS = 1e-6f;
constexpr int UZ = 0, UXBC = 256, URQ = 1024, URK = 1280, URV = 1536, URG = 1792, UGX = 2048, UGY = 2304, UHQ = 2560, UHF = 2816, UHI = 3072, UHG = 3328;
constexpr size_t O_YP = 0, O_YS = O_YP + (size_t)8 * 2048 * 1024, O_PSSD = O_YS + (size_t)128 * 4 * 1024, O_PSSDC = O_PSSD + (size_t)2 * 8 * 4 * 128 * 64,
    O_PRET = O_PSSDC + (size_t)2 * 8 * 3 * 768, O_PRG = O_PRET + (size_t)2 * 8 * 4 * 64 * 64, O_PRGC = O_PRG + (size_t)2 * 8 * 256, O_PHG = O_PRGC + (size_t)2 * 8 * 3 * 256,
    O_PMK = O_PHG + (size_t)2 * 8 * 4 * 64 * 64, O_PMV = O_PMK + (size_t)2 * 8 * 256 * 1024, O_SSSD = O_PMV + (size_t)2 * 8 * 256 * 1024, O_SSSDC = O_SSSD + (size_t)2 * 128 * 4 * 128 * 64,
    O_SRET = O_SSSDC + (size_t)2 * 128 * 3 * 768, O_SRG = O_SRET + (size_t)2 * 128 * 4 * 64 * 64, O_SRGC = O_SRG + (size_t)2 * 128 * 256, O_SHG = O_SRGC + (size_t)2 * 128 * 3 * 256,
    O_END = O_SHG + (size_t)2 * 128 * 4 * 64 * 64;
constexpr size_t OFF_WIN = 0, OFF_WOUT = OFF_WIN + (size_t)NL * NU * D * 2, OFF_WXQ = OFF_WOUT + (size_t)NL * D * D * 2, OFF_WXO = OFF_WXQ + (size_t)NL * D * D * 2,
    OFF_WXKV = OFF_WXO + (size_t)NL * D * D * 2, OFF_WGU = OFF_WXKV + (size_t)NL * 2048 * D * 2, OFF_WDN = OFF_WGU + (size_t)NL * 5632 * D * 2, OFF_WRG = OFF_WDN + (size_t)NL * D * DFF * 2,
    OFF_ROPE = OFF_WRG + (size_t)NL * 2 * 4 * 64 * 64 * 2, OFF_H = OFF_ROPE + (size_t)2052 * 32 * 2 * 4, OFF_HM = OFF_H + (size_t)TT * D * 2, OFF_U = OFF_HM + (size_t)NL * 2048 * D * 2,
    OFF_SDT = OFF_U + (size_t)TT * NU * 2, OFF_YC = OFF_SDT + (size_t)TT * 4 * 4, OFF_M = OFF_YC + (size_t)TT * D * 2, OFF_Q = OFF_M + (size_t)TT * D * 4, OFF_ACT = OFF_Q + (size_t)TT * D * 2,
    OFF_KB = OFF_ACT + (size_t)TT * DFF * 2, OFF_VTB = OFF_KB + (size_t)8 * 4 * 256 * 256 * 2, OFF_DSS = OFF_VTB + (size_t)8 * 4 * 256 * 256 * 2, OFF_DECS = OFF_DSS + (size_t)8 * 4 * 32 * 8192 * 4,
    OFF_DSR = OFF_DECS + 4096, OFF_DSH = OFF_DSR + (size_t)8 * 4 * 32 * 4096 * 4, OFF_DECH = OFF_DSH + (size_t)8 * 4 * 32 * 4096 * 4, OFF_RGH = OFF_DECH + (size_t)8 * 4 * 32 * 64 * 4,
    OFF_RGA = OFF_RGH + (size_t)8 * 32 * 256 * 4, OFF_RGC = OFF_RGA + (size_t)8 * 32 * 256 * 4, OFF_BAR = OFF_RGC + (size_t)8 * 32 * 256 * 4, OFF_LB = OFF_BAR + 16384, OFF_XS = OFF_LB + 4096, OFF_HS = OFF_XS + (size_t)TT * D * 4, WS_END = OFF_HS + (size_t)TT * D * 2;

struct Params { const float* in[41]; float* out; unsigned char* ws; };
typedef const __attribute__((address_space(4))) Params* KPRM;
typedef const __attribute__((address_space(4))) Params& PRM;
__device__ __forceinline__ KPRM kp_launder(KPRM k) { asm volatile("" : "+s"(k)); return k; }

__device__ __forceinline__ float bf2f(bf16_t b) { return __uint_as_float(((unsigned)b) << 16); }
__device__ __forceinline__ unsigned pk2(float lo, float hi) { unsigned r; asm volatile("v_cvt_pk_bf16_f32 %0, %1, %2" : "=v"(r) : "v"(lo), "v"(hi)); return r; }
__device__ __forceinline__ bf16_t f2bf(float f) { return (bf16_t)(pk2(f, f) & 0xffffu); }
__device__ __forceinline__ float sigmoidf_(float x) { return __builtin_amdgcn_rcpf(1.0f + __expf(-x)); }
__device__ __forceinline__ float siluf_(float x) { return x * __builtin_amdgcn_rcpf(1.0f + __expf(-x)); }
__device__ __forceinline__ float siluf_div(float x) { return x / (1.0f + __expf(-x)); }
__device__ __forceinline__ float softplusf_(float x) { const float e = __expf(-fabsf(x)); const float l1p = e < 1.0e-3f ? e * (1.0f - e * (0.5f - e * 0.33333333f)) : __logf(1.0f + e); return fmaxf(x, 0.0f) + l1p; }
__device__ __forceinline__ float geluf_(float x) { const float u = 0.7978845608028654f * (x + 0.044715f * x * x * x); return x * __builtin_amdgcn_rcpf(1.0f + __expf(-2.0f * u)); }
#define DPP_F(old, src, ctrl, rmask) __int_as_float(__builtin_amdgcn_update_dpp(__float_as_int(old), __float_as_int(src), (ctrl), (rmask), 0xf, false))
#define DPP_ROR(v, n) DPP_F(0.f, v, 0x120 + (n), 0xf)
__device__ __forceinline__ float row16_sum(float v) { v += DPP_ROR(v, 8); v += DPP_ROR(v, 4); v += DPP_ROR(v, 2); v += DPP_ROR(v, 1); return v; }
__device__ __forceinline__ float row16_max(float v) { v = fmaxf(v, DPP_ROR(v, 8)); v = fmaxf(v, DPP_ROR(v, 4)); v = fmaxf(v, DPP_ROR(v, 2)); v = fmaxf(v, DPP_ROR(v, 1)); return v; }
__device__ __forceinline__ float rl_(float v, int lane) { return __int_as_float(__builtin_amdgcn_readlane(__float_as_int(v), lane)); }
__device__ __forceinline__ float wave_sum(float v) { v = row16_sum(v); return (rl_(v, 0) + rl_(v, 16)) + (rl_(v, 32) + rl_(v, 48)); }
__device__ __forceinline__ float wave_max(float v) { v = row16_max(v); return fmaxf(fmaxf(rl_(v, 0), rl_(v, 16)), fmaxf(rl_(v, 32), rl_(v, 48))); }
template <int NT, int KS>
__device__ __forceinline__ void mm_nt(f32x4 (&acc)[NT], const LAS bf16_t* A, int lda, const LAS bf16_t* B, int ldb, int lane) {
    const int r = lane & 15, q = (lane >> 4) * 8;
#pragma unroll
    for (int ks = 0; ks < KS; ++ks) {
        const bf16x8 a = *(const LAS bf16x8*)(A + r * lda + ks * 32 + q);
#pragma unroll
        for (int j = 0; j < NT; ++j) {
            const bf16x8 b = *(const LAS bf16x8*)(B + (16 * j + r) * ldb + ks * 32 + q);
            acc[j] = __builtin_amdgcn_mfma_f32_16x16x32_bf16(a, b, acc[j], 0, 0, 0);
        }
    }
}

struct EpiBf16 {
    static constexpr bool PERM = true, AFTER_DRAIN = false;
    bf16_t* O; int ldc;
    __device__ __forceinline__ void operator()(const f32x4 (&acc)[2][2][4][2], const pg8::Unit& u, int wr, int wc, int fr, int fq) const {
        const int row0 = u.pm * 256 + wr * 64 + fr, col0 = u.pn * 256 + wc * 32 + 8 * fq;
#pragma unroll
        for (int ai = 0; ai < 2; ++ai)
#pragma unroll
            for (int m = 0; m < 4; ++m) {
                bf16_t* rowp = O + (size_t)(row0 + ai * 128 + m * 16) * ldc + col0;
#pragma unroll
                for (int bj = 0; bj < 2; ++bj) {
                    const f32x4 v0 = acc[ai][bj][m][0], v1 = acc[ai][bj][m][1];
                    u32x4 w; w.x = pk2(v0[0], v0[1]); w.y = pk2(v0[2], v0[3]); w.z = pk2(v1[0], v1[1]); w.w = pk2(v1[2], v1[3]);
                    *(u32x4*)(rowp + bj * 128) = w;
                }
            }
    }
};
struct EpiF32 {
    static constexpr bool PERM = false, AFTER_DRAIN = false;
    float* C; int ldc;
    __device__ __forceinline__ void operator()(const f32x4 (&acc)[2][2][4][2], const pg8::Unit& u, int wr, int wc, int fr, int fq) const {
        const int row0 = u.pm * 256 + wr * 64 + fr, col0 = u.pn * 256 + wc * 32 + 4 * fq;
#pragma unroll
        for (int ai = 0; ai < 2; ++ai)
#pragma unroll
            for (int m = 0; m < 4; ++m) {
                float* rowp = C + (size_t)(row0 + ai * 128 + m * 16) * ldc + col0;
#pragma unroll
                for (int bj = 0; bj < 2; ++bj)
#pragma unroll
                    for (int n = 0; n < 2; ++n) *(f32x4*)(rowp + bj * 128 + n * 16) = acc[ai][bj][m][n];
            }
    }
};
struct EpiSwiGLU {
    static constexpr bool PERM = true, AFTER_DRAIN = false;
    bf16_t* O;
    __device__ __forceinline__ void operator()(const f32x4 (&acc)[2][2][4][2], const pg8::Unit& u, int wr, int wc, int fr, int fq) const {
        const int row0 = u.pm * 256 + wr * 64 + fr, col0 = u.pn * 128 + wc * 32 + 8 * fq;
#pragma unroll
        for (int ai = 0; ai < 2; ++ai)
#pragma unroll
            for (int m = 0; m < 4; ++m) {
                bf16_t* rowp = O + (size_t)(row0 + ai * 128 + m * 16) * DFF + col0;
                const f32x4 g0 = acc[ai][0][m][0], g1 = acc[ai][0][m][1], u0 = acc[ai][1][m][0], u1 = acc[ai][1][m][1];
                u32x4 w;
                w.x = pk2(siluf_(g0[0]) * u0[0], siluf_(g0[1]) * u0[1]); w.y = pk2(siluf_(g0[2]) * u0[2], siluf_(g0[3]) * u0[3]);
                w.z = pk2(siluf_(g1[0]) * u1[0], siluf_(g1[1]) * u1[1]); w.w = pk2(siluf_(g1[2]) * u1[2], siluf_(g1[3]) * u1[3]);
                *(u32x4*)rowp = w;
            }
    }
};
struct EpiMemKV {
    static constexpr bool PERM = false, AFTER_DRAIN = false;
    float* kout; float* vout; bf16_t* KB; bf16_t* VTB;
    __device__ __forceinline__ void operator()(const f32x4 (&acc)[2][2][4][2], const pg8::Unit& u, int wr, int wc, int fr, int fq) const {
        const int row0 = u.pm * 256 + wr * 64 + fr, col0 = u.pn * 256 + wc * 32 + 4 * fq;
#pragma unroll
        for (int ai = 0; ai < 2; ++ai)
#pragma unroll
            for (int m = 0; m < 4; ++m) {
                const int row = row0 + ai * 128 + m * 16, b = row >> 8, key = row & 255;
#pragma unroll
                for (int bj = 0; bj < 2; ++bj)
#pragma unroll
                    for (int n = 0; n < 2; ++n) {
                        const int col = col0 + bj * 128 + n * 16; const f32x4 v = acc[ai][bj][m][n];
                        if (col < 1024) {
                            *(f32x4*)(kout + (size_t)row * 1024 + col) = v;
                            u32x2 w; w.x = pk2(v[0], v[1]); w.y = pk2(v[2], v[3]);
                            *(u32x2*)(KB + ((size_t)(b * 4 + (col >> 8)) * 256 + key) * 256 + (col & 255)) = w;
                        } else {
                            const int c2 = col - 1024;
                            *(f32x4*)(vout + (size_t)row * 1024 + c2) = v;
                            bf16_t* vp = VTB + ((size_t)(b * 4 + (c2 >> 8)) * 256 + (c2 & 255)) * 256 + key;
                            vp[0] = f2bf(v[0]); vp[256] = f2bf(v[1]); vp[512] = f2bf(v[2]); vp[768] = f2bf(v[3]);
                        }
                    }
            }
    }
};
template <class Epi>
__device__ __forceinline__ void run_gemm(LAS unsigned char* lds, const bf16_t* A, const bf16_t* Bt, int M, int N, int K, const Epi& E, int cshift) {
    asm volatile("" : "+s"(M), "+s"(N), "+s"(K));
    pg8::Gemm g{A, Bt, M, N, K};
    pg8::StaticOrder S; S.init(M, N, (int)gridDim.x, (int)((blockIdx.x + cshift) % gridDim.x));
    pg8::gemm_phase<Epi, pg8::StaticOrder, false>(lds, g, S, E, nullptr);
}

struct TItem { const float* src; bf16_t* dst; int ldw, K, k0, srcc, dstr; };
constexpr int I_IN = 16 * 112, I_SQ = 16 * 32, I_KV = 16 * 64, I_GU = 16 * 176, I_DN = 44 * 32, I_RG = 16;
constexpr int I_PER = I_IN + 3 * I_SQ + I_KV + I_GU + I_DN + I_RG;
__device__ __forceinline__ bool titem(PRM p, int it, TItem& T) {
    if (it >= NL * I_PER) return false;
    const int l = it / I_PER; int r = it % I_PER;
    unsigned char* ws = p.ws;
    if (r < I_IN) { const int kb = r / 112, n0 = (r % 112) * 32; T.src = p.in[17] + (size_t)l * D * DIN; T.ldw = DIN; T.K = D; T.k0 = kb * 64; T.srcc = n0 < 1024 ? n0 : n0 + 4;
        T.dst = (bf16_t*)(ws + OFF_WIN) + (size_t)l * NU * D; T.dstr = n0; return true; }
    r -= I_IN;
    if (r < 3 * I_SQ) { const int which = r / I_SQ; r %= I_SQ; const int kb = r / 32, n0 = (r % 32) * 32;
        T.src = p.in[which == 0 ? 34 : (which == 1 ? 36 : 38)] + (size_t)l * D * D; T.ldw = D; T.K = D; T.k0 = kb * 64; T.srcc = n0;
        T.dst = (bf16_t*)(ws + (which == 0 ? OFF_WOUT : (which == 1 ? OFF_WXQ : OFF_WXO))) + (size_t)l * D * D; T.dstr = n0; return true; }
    r -= 3 * I_SQ;
    if (r < I_KV) { const int kb = r / 64, n0 = (r % 64) * 32; T.src = p.in[37] + (size_t)l * D * 2048; T.ldw = 2048; T.K = D; T.k0 = kb * 64; T.srcc = n0;
        T.dst = (bf16_t*)(ws + OFF_WXKV) + (size_t)l * 2048 * D; T.dstr = n0; return true; }
    r -= I_KV;
    if (r < I_GU) { const int kb = r / 176, n0 = (r % 176) * 32; const int pn = n0 >> 8, bj = (n0 & 255) >> 7, j = n0 & 127;
        T.src = p.in[39] + (size_t)l * D * 5632; T.ldw = 5632; T.K = D; T.k0 = kb * 64; T.srcc = bj * DFF + pn * 128 + j;
        T.dst = (bf16_t*)(ws + OFF_WGU) + (size_t)l * 5632 * D; T.dstr = n0; return true; }
    r -= I_GU;
    if (r < I_DN) { const int kb = r / 32, n0 = (r % 32) * 32; T.src = p.in[40] + (size_t)l * DFF * D; T.ldw = D; T.K = DFF; T.k0 = kb * 64; T.srcc = n0;
        T.dst = (bf16_t*)(ws + OFF_WDN) + (size_t)l * D * DFF; T.dstr = n0; return true; }
    r -= I_DN;
    { const int gate = r >> 3, blk = (r & 7) >> 1, nb = r & 1;
        T.src = p.in[gate ? 29 : 27] + (size_t)(l * 4 + blk) * 4096; T.ldw = 64; T.K = 64; T.k0 = 0; T.srcc = nb * 32;
        T.dst = (bf16_t*)(ws + OFF_WRG) + (size_t)((l * 2 + gate) * 4 + blk) * 4096; T.dstr = nb * 32; return true; }
}

__device__ __forceinline__ void rows_phase(LAS unsigned char* lds, int nrows, const float* xp, const float* xs, float* X, const bf16_t* M, const float* gpost,
                                           const float* gpre, bf16_t* H, const float* wdt, float* SDT) {
    const int tid = tidx(), lane = tid & 63, wave = tid >> 6;
    const int gw = blockIdx.x * 8 + wave, NGW = gridDim.x * 8;
    LAS float* wl = (LAS float*)lds;
    if (wdt) { for (int i = tid; i < 4096; i += NTHR) wl[i] = wdt[(size_t)(i >> 2) * DIN + 1024 + (i & 3)]; __syncthreads(); }
    constexpr int NR = 4;
    for (int rowb = gw; rowb < nrows; rowb += NR * NGW) {
        f32x4 v[NR][4], m[NR][4];
        bool ok[NR];
#pragma unroll
        for (int q = 0; q < NR; ++q) { const int row = rowb + q * NGW; ok[q] = row < nrows;
            if (ok[q]) {
                const float* xr = xp ? (row < TP ? xp + (size_t)row * D : xs + (size_t)(row - TP) * D) : X + (size_t)row * D;
#pragma unroll
                for (int j = 0; j < 4; ++j) v[q][j] = ((const f32x4*)xr)[lane + 64 * j];
                if (M) {
#pragma unroll
                    for (int j = 0; j < 4; ++j) { const u32x2 w = ((const u32x2*)(M + (size_t)row * D))[lane + 64 * j];
                        m[q][j] = (f32x4){__uint_as_float(w.x << 16), __uint_as_float(w.x & 0xffff0000u), __uint_as_float(w.y << 16), __uint_as_float(w.y & 0xffff0000u)}; }
                }
            } }
#pragma unroll
        for (int q = 0; q < NR; ++q) { const int row = rowb + q * NGW;
            if (!ok[q]) continue;
            if (M) {
                float ss = 0.f;
#pragma unroll
                for (int j = 0; j < 4; ++j) ss += m[q][j].x * m[q][j].x + m[q][j].y * m[q][j].y + m[q][j].z * m[q][j].z + m[q][j].w * m[q][j].w;
                const float rstd = 1.0f / sqrtf(wave_sum(ss) * (1.0f / D) + EPS);
#pragma unroll
                for (int j = 0; j < 4; ++j) { const f32x4 g = ((const f32x4*)gpost)[lane + 64 * j]; v[q][j] = v[q][j] + m[q][j] * rstd * g; }
            }
            if (X && (M || xp)) {
#pragma unroll
                for (int j = 0; j < 4; ++j) ((f32x4*)(X + (size_t)row * D))[lane + 64 * j] = v[q][j];
            }
            if (gpre) {
                float ss = 0.f;
#pragma unroll
                for (int j = 0; j < 4; ++j) ss += v[q][j].x * v[q][j].x + v[q][j].y * v[q][j].y + v[q][j].z * v[q][j].z + v[q][j].w * v[q][j].w;
                const float rstd = 1.0f / sqrtf(wave_sum(ss) * (1.0f / D) + EPS);
                float d0 = 0.f, d1 = 0.f, d2 = 0.f, d3 = 0.f;
#pragma unroll
                for (int j = 0; j < 4; ++j) {
                    const f32x4 g = ((const f32x4*)gpre)[lane + 64 * j]; const f32x4 h = v[q][j] * rstd * g;
                    u32x2 w; w.x = pk2(h.x, h.y); w.y = pk2(h.z, h.w);
                    ((u32x2*)(H + (size_t)row * D))[lane + 64 * j] = w;
                    if (wdt) {
#pragma unroll
                        for (int e = 0; e < 4; ++e) { const f32x4 wv = *(const LAS f32x4*)(wl + 4 * (4 * (lane + 64 * j) + e)); const float he = h[e];
                            d0 += he * wv.x; d1 += he * wv.y; d2 += he * wv.z; d3 += he * wv.w; }
                    }
                }
                if (wdt) { d0 = wave_sum(d0); d1 = wave_sum(d1); d2 = wave_sum(d2); d3 = wave_sum(d3);
                    if (lane == 0) { f32x4 o; o.x = d0; o.y = d1; o.z = d2; o.w = d3; *(f32x4*)(SDT + (size_t)row * 4) = o; } }
            }
        }
    }
    if (wdt) __syncthreads();
}

__device__ __forceinline__ void transposes(PRM p, LAS unsigned char* lds, int it_lo, int it_hi, int gwv, int ngw) {
    const int tid = tidx(), lane = tid & 63, wave = tid >> 6;
    LAS float* scr = (LAS float*)lds + wave * (64 * 33);
    for (int base = it_lo; base < it_hi; base += ngw) {
        TItem T; const bool ok = (base + gwv < it_hi) && titem(p, base + gwv, T);
        if (ok) {
            float tv[32];
#pragma unroll
            for (int i = 0; i < 32; ++i) tv[i] = T.src[(size_t)(T.k0 + 2 * i + (lane >> 5)) * T.ldw + T.srcc + (lane & 31)];
#pragma unroll
            for (int i = 0; i < 32; ++i) scr[(2 * i + (lane >> 5)) * 33 + (lane & 31)] = tv[i];
        }
        __syncthreads();
        if (ok) {
            const int c = lane & 7;
#pragma unroll
            for (int j = 0; j < 4; ++j) { const int n = (lane >> 3) + 8 * j; const LAS float* s = scr + (8 * c) * 33 + n;
                u32x4 o; o.x = pk2(s[0 * 33], s[1 * 33]); o.y = pk2(s[2 * 33], s[3 * 33]); o.z = pk2(s[4 * 33], s[5 * 33]); o.w = pk2(s[6 * 33], s[7 * 33]);
                *(u32x4*)(T.dst + (size_t)(T.dstr + n) * T.K + T.k0 + 8 * c) = o; }
        }
        __syncthreads();
    }
}

__device__ __forceinline__ void phase0(PRM p, LAS unsigned char* lds) {
    const int tid = tidx(), lane = tid & 63, wave = tid >> 6;
    const int gw = blockIdx.x * 8 + wave, NGW = gridDim.x * 8;
    transposes(p, lds, 0, NL * I_PER, gw, NGW);
    float* RC = (float*)(p.ws + OFF_ROPE); float* RS = RC + 2052 * 32;
    for (int i = blockIdx.x * NTHR + tid; i < 2052 * 32; i += gridDim.x * NTHR) {
        const int pi = i >> 5, j = i & 31;
        const double pos = pi < 2048 ? (double)pi : (double)(16384 + pi - 2048);
        const double inv = exp2(-(double)j * (13.287712379549449 / 32.0));
        const double ang = pos * inv;
        const double r = ang - 6.283185307179586 * rint(ang * 0.15915494309189535);
        const float rf = (float)r;
        RC[i] = cosf(rf); RS[i] = sinf(rf);
    }
    if (blockIdx.x == 0 && tid < 256) { const float a0 = p.in[32][tid], a1 = p.in[32][256 + tid]; const float mx = fmaxf(a0, a1), e0 = expf(a0 - mx), e1 = expf(a1 - mx);
        ((float*)(p.ws + OFF_LB))[tid] = 0.f; ((float*)(p.ws + OFF_LB))[256 + tid] = e1 / (e0 + e1); }
    rows_phase(lds, TT, p.in[0], p.in[1], nullptr, nullptr, nullptr, p.in[11], (bf16_t*)(p.ws + OFF_H), p.in[17], (float*)(p.ws + OFF_SDT));
    for (int l = 0; l < NL; ++l)
        rows_phase(lds, 2048, p.in[10], nullptr, nullptr, nullptr, nullptr, p.in[35] + l * D, (bf16_t*)(p.ws + OFF_HM) + (size_t)l * 2048 * D, nullptr, nullptr);
}
#define XB_TMO      128
#define XB_XCNT(j)  (256  + 64 * (j))
#define XB_XSUB(j)  (1280 + 64 * (j))
#define XB_XGEN(j)  (2304 + 64 * (j))
#define XB_TOP      3328
#define XB_TOPGEN   3392
#define XCD_BAR_WORDS 3456
#define XB_SPIN_CAP (1u << 18)

__device__ __forceinline__ unsigned xb_ld(unsigned* p)              { return __hip_atomic_load(p, __ATOMIC_RELAXED, __HIP_MEMORY_SCOPE_AGENT); }
__device__ __forceinline__ unsigned xb_add(unsigned* p, unsigned v) { return __hip_atomic_fetch_add(p, v, __ATOMIC_RELAXED, __HIP_MEMORY_SCOPE_AGENT); }
__device__ __forceinline__ unsigned xb_xcc_id() { return (unsigned)__builtin_amdgcn_s_getreg((3 << 11) | 20) & 0xFu; }
#define XB_SPIN(cond, bar) do { unsigned _sp = 0; while (cond) { __builtin_amdgcn_s_sleep(1); \
    if ((++_sp & 255u) == 0u) { if (xb_ld(&(bar)[XB_TMO])) break; if (_sp > XB_SPIN_CAP) { atomicAdd(&(bar)[XB_TMO], 1u); break; } } } } while (0)

struct XcdBarrier {
    unsigned* bar; unsigned x;
    volatile LAS unsigned* st;
};

__device__ __forceinline__ XcdBarrier xcd_barrier_post(unsigned* bar, volatile LAS unsigned* st) {
    XcdBarrier b; b.bar = bar; b.x = xb_xcc_id(); b.st = st;
    if (tidx() == 0) (void)xb_add(&bar[XB_XCNT(b.x)], 1u);
    return b;
}
__device__ __forceinline__ void xcd_barrier_complete(unsigned* bar, unsigned x, unsigned& nloc, unsigned& nx) {
    const unsigned G = gridDim.x * gridDim.y * gridDim.z;
    unsigned sum, cnt, mine, sp = 0u;
    for (;;) {
        sum = 0u; cnt = 0u; mine = 0u;
#pragma unroll
        for (unsigned j = 0; j < 16; ++j) { const unsigned c = xb_ld(&bar[XB_XCNT(j)]); sum += c; cnt += (c > 0u) ? 1u : 0u; mine = (j == x) ? c : mine; }
        if (sum == G) break;
        __builtin_amdgcn_s_sleep(1);
        if ((++sp & 255u) == 0u) { if (xb_ld(&bar[XB_TMO])) break; if (sp > XB_SPIN_CAP) { atomicAdd(&bar[XB_TMO], 1u); break; } }
    }
    nloc = mine > 0u ? mine : 1u; nx = cnt > 0u ? cnt : 1u;
}

__device__ __forceinline__ void xcd_barrier(const XcdBarrier& b) {
    asm volatile("s_waitcnt vmcnt(0)" ::: "memory");
    __syncthreads();
    if (tidx() == 0) {
        unsigned* bar = b.bar;
        __builtin_amdgcn_s_waitcnt(0);
        unsigned nloc = b.st[0], nx = b.st[1];
        if (nloc == 0u) { xcd_barrier_complete(bar, b.x, nloc, nx); b.st[0] = nloc; b.st[1] = nx; }
        const unsigned old = xb_add(&bar[XB_XSUB(b.x)], 1u);
        const unsigned gen = old / nloc;
        if (old + 1u == (gen + 1u) * nloc) {
            __builtin_amdgcn_fence(__ATOMIC_RELEASE, "agent");
            asm volatile("s_waitcnt vmcnt(0)" ::: "memory");
            const unsigned og = xb_add(&bar[XB_TOP], 1u);
            const unsigned tg = og / nx;
            if (og + 1u == (tg + 1u) * nx) xb_add(&bar[XB_TOPGEN], 1u);
            else XB_SPIN(xb_ld(&bar[XB_TOPGEN]) == tg, bar);
            __builtin_amdgcn_fence(__ATOMIC_ACQUIRE, "agent");
            xb_add(&bar[XB_XGEN(b.x)], 1u);
            asm volatile("s_waitcnt vmcnt(0)" ::: "memory");
        } else {
            XB_SPIN(xb_ld(&bar[XB_XGEN(b.x)]) == gen, bar);
            __builtin_amdgcn_fence(__ATOMIC_ACQUIRE, "agent");
            asm volatile("s_waitcnt vmcnt(0)" ::: "memory");
        }
    }
    __syncthreads();
}


template <int NTOK>
__device__ __forceinline__ void conv_run(const bf16_t* Ucol, bool hist_ok, float w0, float w1, float w2, float w3, float bias, float (&out)[NTOK]) {
    float x3 = 0.f, x2 = 0.f, x1 = 0.f;
    if (hist_ok) { x3 = bf2f(Ucol[-3 * NU]); x2 = bf2f(Ucol[-2 * NU]); x1 = bf2f(Ucol[-NU]); }
#pragma unroll
    for (int i = 0; i < NTOK; ++i) { const float x0 = bf2f(Ucol[i * NU]); out[i] = bias + w0 * x3 + w1 * x2 + w2 * x1 + w3 * x0; x3 = x2; x2 = x1; x1 = x0; }
}
__device__ __forceinline__ float scan64_add(float v, int lane) {
    (void)lane;
    v += DPP_F(0.f, v, 0x111, 0xf); v += DPP_F(0.f, v, 0x112, 0xf); v += DPP_F(0.f, v, 0x114, 0xf); v += DPP_F(0.f, v, 0x118, 0xf);
    v += DPP_F(0.f, v, 0x142, 0xa); v += DPP_F(0.f, v, 0x143, 0xc);
    return v;
}
__device__ __forceinline__ void scan64_lin(float& A, float& B) {
#define LIN_STEP(ctrl, rmask) { const float Ap = DPP_F(1.f, A, ctrl, rmask), Bp = DPP_F(0.f, B, ctrl, rmask); B = A * Bp + B; A = A * Ap; }
    LIN_STEP(0x111, 0xf) LIN_STEP(0x112, 0xf) LIN_STEP(0x114, 0xf) LIN_STEP(0x118, 0xf) LIN_STEP(0x142, 0xa) LIN_STEP(0x143, 0xc)
#undef LIN_STEP
}


__device__ __forceinline__ void unpack8(const u32x4 w, float (&f)[8]) {
    f[0] = __uint_as_float(w.x << 16); f[1] = __uint_as_float(w.x & 0xffff0000u); f[2] = __uint_as_float(w.y << 16); f[3] = __uint_as_float(w.y & 0xffff0000u);
    f[4] = __uint_as_float(w.z << 16); f[5] = __uint_as_float(w.z & 0xffff0000u); f[6] = __uint_as_float(w.w << 16); f[7] = __uint_as_float(w.w & 0xffff0000u);
}
__device__ __forceinline__ u32x4 pack8(const float (&f)[8]) { u32x4 w; w.x = pk2(f[0], f[1]); w.y = pk2(f[2], f[3]); w.z = pk2(f[4], f[5]); w.w = pk2(f[6], f[7]); return w; }
__device__ __forceinline__ u32x4 ldg8(const bf16_t* p) { return *(const u32x4*)p; }
__device__ __forceinline__ bf16_t elem8(const u32x4 w, int i) { const unsigned x = (i >> 1) == 0 ? w.x : ((i >> 1) == 1 ? w.y : ((i >> 1) == 2 ? w.z : w.w)); return (bf16_t)((i & 1) ? (x >> 16) : (x & 0xffffu)); }
__device__ __forceinline__ void ld8f(const float* p, float (&f)[8]) { const f32x4 a = *(const f32x4*)p, b = *(const f32x4*)(p + 4); f[0] = a.x; f[1] = a.y; f[2] = a.z; f[3] = a.w; f[4] = b.x; f[5] = b.y; f[6] = b.z; f[7] = b.w; }
template <int NT>
__device__ __forceinline__ void conv8(const u32x4 (&rows)[NT + 3], const float (&w)[4][8], const float (&bias)[8], float (&o)[NT][8]) {
    float x[NT + 3][8];
#pragma unroll
    for (int r = 0; r < NT + 3; ++r) unpack8(rows[r], x[r]);
#pragma unroll
    for (int t = 0; t < NT; ++t)
#pragma unroll
        for (int i = 0; i < 8; ++i) o[t][i] = bias[i] + w[0][i] * x[t][i] + w[1][i] * x[t + 1][i] + w[2][i] * x[t + 2][i] + w[3][i] * x[t + 3][i];
}

__device__ __forceinline__ void ssd_passA(PRM p, LAS unsigned char* lds, int l, int u) {
    const int tid = tidx(), lane = tid & 63, wave = tid >> 6;
    const int c = u & 31, g = (u >> 5) & 1, b = u >> 6, row0 = b * 2048 + c * 64;
    const bf16_t* U = (const bf16_t*)(p.ws + OFF_U); const float* SDT = (const float*)(p.ws + OFF_SDT);
    LAS float* DT = (LAS float*)lds; LAS float* CU = DT + 128;
    LAS bf16_t* BT = (LAS bf16_t*)(lds + 1024); LAS bf16_t* VT = (LAS bf16_t*)(lds + 1024 + 18432);
    const int chl0 = (tid & 31) * 8, t0 = (tid >> 5) * 4;
    const int xc0 = chl0 < 128 ? g * 128 + chl0 : 256 + g * 128 + (chl0 - 128);
    u32x4 rows[7];
#pragma unroll
    for (int r = 0; r < 7; ++r) { const int t = t0 - 3 + r; rows[r] = (c > 0 || t >= 0) ? ldg8(U + (size_t)(row0 + t) * NU + UXBC + xc0) : (u32x4){0u, 0u, 0u, 0u}; }
    float w[4][8], bias[8];
#pragma unroll
    for (int j = 0; j < 4; ++j) ld8f(p.in[18] + (size_t)(l * 4 + j) * 768 + xc0, w[j]);
    ld8f(p.in[19] + l * 768 + xc0, bias);
    if (wave < 2) {
        const int h = 2 * g + wave;
        const float dt = softplusf_(SDT[(size_t)(row0 + lane) * 4 + h] + p.in[20][l * 4 + h]);
        const float cum = scan64_add(-expf(p.in[21][l * 4 + h]) * dt, lane);
        DT[wave * 64 + lane] = dt; CU[wave * 64 + lane] = cum;
    }
    float o[4][8]; conv8<4>(rows, w, bias, o);
    __syncthreads();
    if (chl0 < 128) { const int hh = chl0 >> 6; const float last = CU[hh * 64 + 63];
#pragma unroll
        for (int tt = 0; tt < 4; ++tt) { const int t = t0 + tt; const float sc = DT[hh * 64 + t] * __expf(last - CU[hh * 64 + t]);
#pragma unroll
            for (int i = 0; i < 8; ++i) VT[(chl0 + i) * 72 + t] = f2bf(siluf_(o[tt][i]) * sc); }
    } else { const int n0 = chl0 - 128;
#pragma unroll
        for (int tt = 0; tt < 4; ++tt)
#pragma unroll
            for (int i = 0; i < 8; ++i) BT[(n0 + i) * 72 + t0 + tt] = f2bf(siluf_(o[tt][i]));
    }
    __syncthreads();
    f32x4 acc[8];
#pragma unroll
    for (int j = 0; j < 8; ++j) acc[j] = (f32x4){0.f, 0.f, 0.f, 0.f};
    mm_nt<8, 2>(acc, BT + 16 * wave * 72, 72, VT, 72, lane);
    bf16_t* DS = (bf16_t*)(p.ws + OFF_DSS);
#pragma unroll
    for (int jj = 0; jj < 8; ++jj) { const int h = 2 * g + (jj >> 2), pc = (jj & 3) * 16 + (lane & 15);
#pragma unroll
        for (int e = 0; e < 4; ++e) { const int n = 16 * wave + (lane >> 4) * 4 + e; DS[(((size_t)(b * 4 + h) * 32 + c) * 128 + n) * 64 + pc] = f2bf(acc[jj][e]); } }
    if (tid < 2) ((float*)(p.ws + OFF_DECS))[(b * 4 + 2 * g + tid) * 32 + c] = __expf(CU[tid * 64 + 63]);
    __syncthreads();
}

__device__ __forceinline__ void ssd_passC(PRM p, LAS unsigned char* lds, int l, int u) {
    const int tid = tidx(), lane = tid & 63, wave = tid >> 6;
    const int c = u & 31, b = u >> 5, row0 = b * 2048 + c * 64;
    const bf16_t* U = (const bf16_t*)(p.ws + OFF_U); const float* SDT = (const float*)(p.ws + OFF_SDT);
    const bf16_t* DS = (const bf16_t*)(p.ws + OFF_DSS);
    bf16_t* YC = (bf16_t*)(p.ws + OFF_YC);
    LAS float* DT = (LAS float*)lds; LAS float* CU = (LAS float*)(lds + 1024); LAS float* SSQ = (LAS float*)(lds + 2048);
    LAS bf16_t* CM = (LAS bf16_t*)(lds + 3072); LAS bf16_t* BM = (LAS bf16_t*)(lds + 20480); LAS bf16_t* VT = (LAS bf16_t*)(lds + 37888);
    LAS bf16_t* PP = (LAS bf16_t*)(lds + 56320); LAS bf16_t* SINT = (LAS bf16_t*)(lds + 74752);
    if (wave < 4) {
        const int h = wave;
        const float dt = softplusf_(SDT[(size_t)(row0 + lane) * 4 + h] + p.in[20][l * 4 + h]);
        const float cum = scan64_add(-expf(p.in[21][l * 4 + h]) * dt, lane);
        DT[h * 64 + lane] = dt; CU[h * 64 + lane] = cum;
    }
    f32x4 yv[2][4];
#pragma unroll
    for (int g = 0; g < 2; ++g) {
        {
            u32x4 sv[4];
#pragma unroll
            for (int i = 0; i < 4; ++i) { const int idx8 = tid + i * NTHR, hh = idx8 >> 10, rem = idx8 & 1023, n = rem >> 3, p0 = (rem & 7) * 8;
                sv[i] = ldg8(DS + (((size_t)(b * 4 + 2 * g + hh) * 32 + c) * 128 + n) * 64 + p0); }
#pragma unroll
            for (int it = 0; it < 2; ++it) { const int item = tid + it * NTHR;
                if (item < 768) {
                    const int chl0 = (item % 48) * 8, t0 = (item / 48) * 4, which = chl0 >> 7, n0 = chl0 & 127, xc0 = which * 256 + g * 128 + n0;
                    u32x4 rows[7];
#pragma unroll
                    for (int r = 0; r < 7; ++r) { const int t = t0 - 3 + r; rows[r] = (c > 0 || t >= 0) ? ldg8(U + (size_t)(row0 + t) * NU + UXBC + xc0) : (u32x4){0u, 0u, 0u, 0u}; }
                    float w[4][8], bias[8];
#pragma unroll
                    for (int j = 0; j < 4; ++j) ld8f(p.in[18] + (size_t)(l * 4 + j) * 768 + xc0, w[j]);
                    ld8f(p.in[19] + l * 768 + xc0, bias);
                    float o[4][8]; conv8<4>(rows, w, bias, o);
                    if (which == 0) {
#pragma unroll
                        for (int tt = 0; tt < 4; ++tt)
#pragma unroll
                            for (int i = 0; i < 8; ++i) VT[(n0 + i) * 72 + t0 + tt] = f2bf(siluf_(o[tt][i]));
                    } else { LAS bf16_t* dstp = which == 1 ? BM : CM;
#pragma unroll
                        for (int tt = 0; tt < 4; ++tt) { float sv8[8];
#pragma unroll
                            for (int i = 0; i < 8; ++i) sv8[i] = siluf_(o[tt][i]);
                            *(LAS u32x4*)(dstp + (t0 + tt) * 136 + n0) = pack8(sv8); }
                    }
                } }
#pragma unroll
            for (int i = 0; i < 4; ++i) { const int idx8 = tid + i * NTHR, hh = idx8 >> 10, rem = idx8 & 1023, n = rem >> 3, p0 = (rem & 7) * 8;
#pragma unroll
                for (int e = 0; e < 8; ++e) SINT[(hh * 64 + p0 + e) * 136 + n] = elem8(sv[i], e); }
        }
        __syncthreads();
        {
            const int rt = wave & 3, ct0 = (wave >> 2) * 2;
            f32x4 sc[2]; sc[0] = (f32x4){0.f, 0.f, 0.f, 0.f}; sc[1] = sc[0];
            mm_nt<2, 4>(sc, CM + 16 * rt * 136, 136, BM + 16 * ct0 * 136, 136, lane);
#pragma unroll
            for (int hh = 0; hh < 2; ++hh) { const int h = 2 * g + hh;
#pragma unroll
                for (int jj = 0; jj < 2; ++jj)
#pragma unroll
                    for (int e = 0; e < 4; ++e) { const int t = 16 * rt + (lane >> 4) * 4 + e, s = 16 * (ct0 + jj) + (lane & 15);
                        const float val = s <= t ? sc[jj][e] * __expf(CU[h * 64 + t] - CU[h * 64 + s]) * DT[h * 64 + s] : 0.f;
                        PP[(hh * 64 + t) * 72 + s] = f2bf(val); } }
        }
        __syncthreads();
        {
            const int hh = wave >> 2, rt = wave & 3, h = 2 * g + hh;
            float zv[4][4];
#pragma unroll
            for (int e = 0; e < 4; ++e)
#pragma unroll
                for (int j = 0; j < 4; ++j) zv[e][j] = bf2f(U[(size_t)(row0 + 16 * rt + (lane >> 4) * 4 + e) * NU + UZ + h * 64 + 16 * j + (lane & 15)]);
#pragma unroll
            for (int j = 0; j < 4; ++j) yv[g][j] = (f32x4){0.f, 0.f, 0.f, 0.f};
            mm_nt<4, 4>(yv[g], CM + 16 * rt * 136, 136, SINT + hh * 64 * 136, 136, lane);
#pragma unroll
            for (int e = 0; e < 4; ++e) { const float sc = __expf(CU[h * 64 + 16 * rt + (lane >> 4) * 4 + e]);
#pragma unroll
                for (int j = 0; j < 4; ++j) yv[g][j][e] *= sc; }
            mm_nt<4, 2>(yv[g], PP + (hh * 64 + 16 * rt) * 72, 72, VT + hh * 64 * 72, 72, lane);
            const float Dh = p.in[22][l * 4 + h];
#pragma unroll
            for (int e = 0; e < 4; ++e) { const int t = 16 * rt + (lane >> 4) * 4 + e; float s2 = 0.f;
#pragma unroll
                for (int j = 0; j < 4; ++j) { const int pc = 16 * j + (lane & 15);
                    const float xs = bf2f(VT[(hh * 64 + pc) * 72 + t]);
                    const float v = (yv[g][j][e] + Dh * xs) * siluf_(zv[e][j]); yv[g][j][e] = v; s2 += v * v; }
                s2 = row16_sum(s2);
                if ((lane & 15) == 0) SSQ[t * 4 + h] = s2; }
        }
        __syncthreads();
    }
#pragma unroll
    for (int g = 0; g < 2; ++g) { const int hh = wave >> 2, rt = wave & 3, h = 2 * g + hh;
#pragma unroll
        for (int e = 0; e < 4; ++e) { const int t = 16 * rt + (lane >> 4) * 4 + e;
            const float tot = SSQ[t * 4 + 0] + SSQ[t * 4 + 1] + SSQ[t * 4 + 2] + SSQ[t * 4 + 3];
            const float rstd = 1.0f / sqrtf(tot * (1.0f / 256.0f) + EPS);
#pragma unroll
            for (int j = 0; j < 4; ++j) { const int pc = 16 * j + (lane & 15);
                YC[(size_t)(row0 + t) * D + h * 64 + pc] = f2bf(yv[g][j][e] * rstd * p.in[23][l * 256 + h * 64 + pc]); } } }
    if (c == 31) for (int idx = tid; idx < 2304; idx += NTHR) { const int r = idx / 768, ch = idx % 768;
        p.out[O_PSSDC + ((size_t)(l * 8 + b) * 3 + r) * 768 + ch] = bf2f(U[(size_t)(b * 2048 + 2045 + r) * NU + UXBC + ch]); }
    __syncthreads();
}

constexpr int E_CUM = 0, E_QS = 16640, E_QD = 25856, E_KV = 35072, E_VT = 71936, E_SINT = 81152, E_PP = 90368, E_KWT = 99584, E_RSC = 108800, E_SSQ = 109056;
__device__ __forceinline__ void engineA(LAS unsigned char* lds, bf16_t* DS, int wave, int lane) {
    const LAS bf16_t* KWT = (const LAS bf16_t*)(lds + E_KWT); const LAS bf16_t* VT = (const LAS bf16_t*)(lds + E_VT);
    const int rt = wave >> 1, ct0 = (wave & 1) * 2;
    f32x4 acc[2]; acc[0] = (f32x4){0.f, 0.f, 0.f, 0.f}; acc[1] = acc[0];
    mm_nt<2, 2>(acc, KWT + 16 * rt * 72, 72, VT + 16 * ct0 * 72, 72, lane);
#pragma unroll
    for (int jj = 0; jj < 2; ++jj)
#pragma unroll
        for (int e = 0; e < 4; ++e) DS[(16 * rt + (lane >> 4) * 4 + e) * 64 + 16 * (ct0 + jj) + (lane & 15)] = f2bf(acc[jj][e]);
}
template <bool RET>
__device__ __forceinline__ void engineC(LAS unsigned char* lds, int qd_off, int kvstride, float lg, f32x4 (&y)[2], int wave, int lane) {
    const LAS bf16_t* QS = (const LAS bf16_t*)(lds + E_QS); const LAS bf16_t* QD = (const LAS bf16_t*)(lds + qd_off);
    const LAS bf16_t* KV = (const LAS bf16_t*)(lds + E_KV); const LAS bf16_t* VT = (const LAS bf16_t*)(lds + E_VT);
    const LAS bf16_t* SINT = (const LAS bf16_t*)(lds + E_SINT); LAS bf16_t* PP = (LAS bf16_t*)(lds + E_PP); const LAS float* RSC = (const LAS float*)(lds + E_RSC);
    const int rt = wave >> 1, ct0 = (wave & 1) * 2;
    f32x4 sc[2]; sc[0] = (f32x4){0.f, 0.f, 0.f, 0.f}; sc[1] = sc[0];
    mm_nt<2, 2>(sc, QS + 16 * rt * 72, 72, KV + kvstride * rt + 16 * ct0 * 72, 72, lane);
#pragma unroll
    for (int jj = 0; jj < 2; ++jj)
#pragma unroll
        for (int e = 0; e < 4; ++e) { const int t = 16 * rt + (lane >> 4) * 4 + e, s = 16 * (ct0 + jj) + (lane & 15);
            float val = 0.f; if (s <= t) val = RET ? sc[jj][e] * __expf((float)(t - s) * lg) : sc[jj][e];
            PP[t * 72 + s] = f2bf(val); }
    __syncthreads();
    y[0] = (f32x4){0.f, 0.f, 0.f, 0.f}; y[1] = y[0];
    mm_nt<2, 2>(y, QD + 16 * rt * 72, 72, SINT + 16 * ct0 * 72, 72, lane);
#pragma unroll
    for (int e = 0; e < 4; ++e) { const float r = RSC[16 * rt + (lane >> 4) * 4 + e]; y[0][e] *= r; y[1][e] *= r; }
    mm_nt<2, 2>(y, PP + 16 * rt * 72, 72, VT + 16 * ct0 * 72, 72, lane);
}
template <bool CENTER>
__device__ __forceinline__ void headnorm_store(LAS unsigned char* lds, const f32x4 (&y)[2], int wave, int lane, const float (&gate)[8], const float (&gain)[2], bf16_t* outp) {
    LAS f32x2* SSQ = (LAS f32x2*)(lds + E_SSQ);
    const int rt = wave >> 1, half = wave & 1, ct0 = half * 2;
#pragma unroll
    for (int e = 0; e < 4; ++e) { float s1 = y[0][e] + y[1][e], s2 = y[0][e] * y[0][e] + y[1][e] * y[1][e];
        s1 = row16_sum(s1); s2 = row16_sum(s2);
        if ((lane & 15) == 0) SSQ[(16 * rt + (lane >> 4) * 4 + e) * 2 + half] = (f32x2){s1, s2}; }
    __syncthreads();
#pragma unroll
    for (int e = 0; e < 4; ++e) { const int t = 16 * rt + (lane >> 4) * 4 + e;
        const f32x2 a = SSQ[t * 2], b2 = SSQ[t * 2 + 1];
        const float mean = CENTER ? (a.x + b2.x) * (1.0f / 64.0f) : 0.f;
        const float var = (a.y + b2.y) * (1.0f / 64.0f) - mean * mean;
        const float rstd = 1.0f / sqrtf(fmaxf(var, 0.f) + EPS);
#pragma unroll
        for (int jj = 0; jj < 2; ++jj) { const int pc = 16 * (ct0 + jj) + (lane & 15);
            outp[(size_t)t * D + pc] = f2bf((y[jj][e] - mean) * rstd * gain[jj] * siluf_(gate[e * 2 + jj])); } }
}
__device__ __forceinline__ void headnorm_prefetch(int wave, int lane, const bf16_t* Ugate, const float* gainp, float (&gate)[8], float (&gain)[2]) {
    const int rt = wave >> 1, ct0 = (wave & 1) * 2;
#pragma unroll
    for (int jj = 0; jj < 2; ++jj) { const int pc = 16 * (ct0 + jj) + (lane & 15); gain[jj] = gainp[pc];
#pragma unroll
        for (int e = 0; e < 4; ++e) gate[e * 2 + jj] = bf2f(Ugate[(size_t)(16 * rt + (lane >> 4) * 4 + e) * NU + pc]); }
}

struct RetRegs { u32x4 vraw, x1, x2, dsraw; float cs[8], sn[8], gate[8], gain[2]; };
template <bool PASSC>
__device__ __forceinline__ void ret_load(PRM p, int l, int u, RetRegs& r) {
    const int tid = tidx(), lane = tid & 63, wave = tid >> 6;
    const int h = u & 3, c = (u >> 2) & 31, b = u >> 7, row0 = b * 2048 + c * 64;
    const bf16_t* U = (const bf16_t*)(p.ws + OFF_U);
    const float* RC = (const float*)(p.ws + OFF_ROPE); const float* RS = RC + 2052 * 32;
    const bf16_t* DS = (const bf16_t*)(p.ws + OFF_DSR) + ((size_t)(b * 4 + h) * 32 + c) * 4096;
    const int t = tid >> 3, c8 = (tid & 7) * 8, isq = tid >> 8, tt = (tid & 255) >> 2, j0 = (tid & 3) * 8;
    r.vraw = ldg8(U + (size_t)(row0 + t) * NU + URV + h * 64 + c8); r.dsraw = (u32x4){0u, 0u, 0u, 0u};
    if (PASSC) { r.dsraw = ldg8(DS + t * 64 + c8); headnorm_prefetch(wave, lane, U + (size_t)row0 * NU + URG + h * 64, p.in[24] + l * 256 + h * 64, r.gate, r.gain); }
    r.x1 = (u32x4){0u, 0u, 0u, 0u}; r.x2 = r.x1;
    if (PASSC || isq == 0) { const bf16_t* ur = U + (size_t)(row0 + tt) * NU + (isq ? URQ : URK) + h * 64 + j0; r.x1 = ldg8(ur); r.x2 = ldg8(ur + 32);
        ld8f(RC + (size_t)(c * 64 + tt) * 32 + j0, r.cs); ld8f(RS + (size_t)(c * 64 + tt) * 32 + j0, r.sn); }
}
template <bool PASSC>
__device__ __forceinline__ void ret_body(PRM p, LAS unsigned char* lds, int l, int u, const RetRegs& r) {
    const int tid = tidx(), lane = tid & 63, wave = tid >> 6;
    const int h = u & 3, c = (u >> 2) & 31, b = u >> 7, row0 = b * 2048 + c * 64;
    const float lg = logf(1.0f - exp2f(-5.0f - (float)h));
    LAS bf16_t* QS = (LAS bf16_t*)(lds + E_QS); LAS bf16_t* KV = (LAS bf16_t*)(lds + E_KV); LAS bf16_t* VT = (LAS bf16_t*)(lds + E_VT);
    LAS bf16_t* SINT = (LAS bf16_t*)(lds + E_SINT); LAS bf16_t* KWT = (LAS bf16_t*)(lds + E_KWT); LAS float* RSC = (LAS float*)(lds + E_RSC);
    bf16_t* DS = (bf16_t*)(p.ws + OFF_DSR) + ((size_t)(b * 4 + h) * 32 + c) * 4096;
    const int t = tid >> 3, c8 = (tid & 7) * 8, isq = tid >> 8, tt = (tid & 255) >> 2, j0 = (tid & 3) * 8;
#pragma unroll
    for (int i = 0; i < 8; ++i) VT[(c8 + i) * 72 + t] = elem8(r.vraw, i);
    if (PASSC) {
#pragma unroll
        for (int i = 0; i < 8; ++i) SINT[(c8 + i) * 72 + t] = elem8(r.dsraw, i);
        if (tid < 64) RSC[tid] = __expf((float)(tid + 1) * lg);
    }
    if (PASSC || isq == 0) {
        float a[8], bb[8], ra[8], rb[8]; unpack8(r.x1, a); unpack8(r.x2, bb);
        const float scl = isq ? 1.0f : 0.125f;
#pragma unroll
        for (int i = 0; i < 8; ++i) { ra[i] = (a[i] * r.cs[i] - bb[i] * r.sn[i]) * scl; rb[i] = (bb[i] * r.cs[i] + a[i] * r.sn[i]) * scl; }
        if (PASSC) { LAS bf16_t* dst = isq ? QS : KV;
            *(LAS u32x4*)(dst + tt * 72 + j0) = pack8(ra); *(LAS u32x4*)(dst + tt * 72 + j0 + 32) = pack8(rb);
        } else { const float w = __expf((float)(63 - tt) * lg);
#pragma unroll
            for (int i = 0; i < 8; ++i) { KWT[(j0 + i) * 72 + tt] = f2bf(ra[i] * w); KWT[(j0 + 32 + i) * 72 + tt] = f2bf(rb[i] * w); } }
    }
    __syncthreads();
    if (PASSC) {
        f32x4 y[2]; engineC<true>(lds, E_QS, 0, lg, y, wave, lane);
        headnorm_store<true>(lds, y, wave, lane, r.gate, r.gain, (bf16_t*)(p.ws + OFF_YC) + (size_t)row0 * D + 256 + h * 64);
    } else engineA(lds, DS, wave, lane);
    __syncthreads();
}

struct HgRegs { u32x4 hfraw, viraw, hqraw, dsraw; float lb[8], gate[8], gain[2]; };
template <bool PASSC>
__device__ __forceinline__ void hg_load(PRM p, int l, int u, HgRegs& r) {
    const int tid = tidx(), lane = tid & 63, wave = tid >> 6;
    const int h = u & 3, c = (u >> 2) & 31, b = u >> 7, row0 = b * 2048 + c * 64;
    const bf16_t* U = (const bf16_t*)(p.ws + OFF_U);
    const bf16_t* DS = (const bf16_t*)(p.ws + OFF_DSH) + ((size_t)(b * 4 + h) * 32 + c) * 4096;
    const int t = tid >> 3, c8 = (tid & 7) * 8;
    const bf16_t* ur = U + (size_t)(row0 + t) * NU + h * 64 + c8;
    r.hfraw = ldg8(ur + UHF); r.viraw = ldg8(ur + UHI); r.hqraw = (u32x4){0u, 0u, 0u, 0u}; r.dsraw = r.hqraw;
    if (PASSC) { r.hqraw = ldg8(ur + UHQ); r.dsraw = ldg8(DS + t * 64 + c8); headnorm_prefetch(wave, lane, U + (size_t)row0 * NU + UHG + h * 64, p.in[33] + l * 256 + h * 64, r.gate, r.gain); }
    ld8f((const float*)(p.ws + OFF_LB) + l * 256 + h * 64 + c8, r.lb);
}
template <bool PASSC>
__device__ __forceinline__ void hg_body(PRM p, LAS unsigned char* lds, int l, int u, const HgRegs& r) {
    const int tid = tidx(), lane = tid & 63, wave = tid >> 6;
    const int h = u & 3, c = (u >> 2) & 31, b = u >> 7, row0 = b * 2048 + c * 64;
    LAS float* CUM = (LAS float*)(lds + E_CUM);
    LAS bf16_t* QS = (LAS bf16_t*)(lds + E_QS); LAS bf16_t* QD = (LAS bf16_t*)(lds + E_QD); LAS bf16_t* KV = (LAS bf16_t*)(lds + E_KV); LAS bf16_t* VT = (LAS bf16_t*)(lds + E_VT);
    LAS bf16_t* SINT = (LAS bf16_t*)(lds + E_SINT); LAS bf16_t* KWT = (LAS bf16_t*)(lds + E_KWT); LAS float* RSC = (LAS float*)(lds + E_RSC);
    bf16_t* DS = (bf16_t*)(p.ws + OFF_DSH) + ((size_t)(b * 4 + h) * 32 + c) * 4096;
    const int t = tid >> 3, c8 = (tid & 7) * 8;
#pragma unroll
    for (int i = 0; i < 8; ++i) VT[(c8 + i) * 72 + t] = elem8(r.viraw, i);
    if (PASSC) {
#pragma unroll
        for (int i = 0; i < 8; ++i) SINT[(c8 + i) * 72 + t] = elem8(r.dsraw, i);
        if (tid < 64) RSC[tid] = 1.0f;
    }
    float hf[8]; unpack8(r.hfraw, hf);
#pragma unroll
    for (int i = 0; i < 8; ++i) CUM[t * 65 + c8 + i] = __logf(r.lb[i] + (1.0f - r.lb[i]) * sigmoidf_(hf[i]));
    __syncthreads();
#pragma unroll
    for (int kk = 0; kk < 8; ++kk) { const int k = wave * 8 + kk; const float v = scan64_add(CUM[lane * 65 + k], lane); CUM[lane * 65 + k] = v; }
    __syncthreads();
    {
        float cum[8], kk_[8];
#pragma unroll
        for (int i = 0; i < 8; ++i) { cum[i] = CUM[t * 65 + c8 + i]; kk_[i] = (1.0f - r.lb[i]) * sigmoidf_(-hf[i]); }
        if (PASSC) {
            float q[8], qd[8], qs[8]; unpack8(r.hqraw, q); const int i_ = t >> 4;
#pragma unroll
            for (int i = 0; i < 8; ++i) { q[i] = siluf_(q[i]); const float ci0 = i_ ? CUM[(16 * i_ - 1) * 65 + c8 + i] : 0.f; qd[i] = q[i] * __expf(cum[i]); qs[i] = q[i] * __expf(cum[i] - ci0); }
            *(LAS u32x4*)(QD + t * 72 + c8) = pack8(qd); *(LAS u32x4*)(QS + t * 72 + c8) = pack8(qs);
#pragma unroll
            for (int i2 = 0; i2 < 4; ++i2) { float kv[8];
#pragma unroll
                for (int i = 0; i < 8; ++i) { float val = 0.f;
                    if (i2 >= i_) { const float c0 = i2 ? CUM[(16 * i2 - 1) * 65 + c8 + i] : 0.f; val = kk_[i] * __expf(fminf(c0 - cum[i], 60.f)); }
                    kv[i] = val; }
                *(LAS u32x4*)(KV + i2 * 4608 + t * 72 + c8) = pack8(kv); }
        } else {
#pragma unroll
            for (int i = 0; i < 8; ++i) KWT[(c8 + i) * 72 + t] = f2bf(kk_[i] * __expf(CUM[63 * 65 + c8 + i] - cum[i]));
            if (tid < 64) ((float*)(p.ws + OFF_DECH))[((size_t)(b * 4 + h) * 32 + c) * 64 + tid] = __expf(CUM[63 * 65 + tid]);
        }
    }
    __syncthreads();
    if (PASSC) {
        f32x4 y[2]; engineC<false>(lds, E_QD, 4608, 0.f, y, wave, lane);
        headnorm_store<false>(lds, y, wave, lane, r.gate, r.gain, (bf16_t*)(p.ws + OFF_YC) + (size_t)row0 * D + 768 + h * 64);
    } else engineA(lds, DS, wave, lane);
    __syncthreads();
}

struct RgRegs { u32x4 rows[4], wt[2], gyraw; float w[4][8], bias[8], hin[8], ba[2], bx[2], lam[2]; };
template <bool PASSC>
__device__ __forceinline__ void rg_load(PRM p, int l, int u, RgRegs& r) {
    const int tid = tidx(), lane = tid & 63, wave = tid >> 6;
    const int blk = u & 3, c = (u >> 2) & 31, b = u >> 7, row0 = b * 2048 + c * 64;
    const bf16_t* U = (const bf16_t*)(p.ws + OFF_U);
    const int t = tid >> 3, c8 = (tid & 7) * 8, ch0 = blk * 64 + c8;
#pragma unroll
    for (int q = 0; q < 4; ++q) { const int tr = t - 3 + q; r.rows[q] = (c > 0 || tr >= 0) ? ldg8(U + (size_t)(row0 + tr) * NU + UGX + ch0) : (u32x4){0u, 0u, 0u, 0u}; }
#pragma unroll
    for (int j = 0; j < 4; ++j) ld8f(p.in[25] + (size_t)(l * 4 + j) * 256 + ch0, r.w[j]);
    ld8f(p.in[26] + l * 256 + ch0, r.bias);
    const bf16_t* WRG = (const bf16_t*)(p.ws + OFF_WRG);
#pragma unroll
    for (int i = 0; i < 2; ++i) { const int idx = tid + i * NTHR, gate = idx >> 9, rem = idx & 511; r.wt[i] = *(const u32x4*)(WRG + (size_t)((l * 2 + gate) * 4 + blk) * 4096 + (rem >> 3) * 64 + (rem & 7) * 8); }
    r.gyraw = (u32x4){0u, 0u, 0u, 0u};
    if (PASSC) { r.gyraw = ldg8(U + (size_t)(row0 + t) * NU + UGY + ch0);
#pragma unroll
        for (int kk = 0; kk < 8; ++kk) r.hin[kk] = ((const float*)(p.ws + OFF_RGC))[(size_t)(b * 32 + c) * 256 + blk * 64 + wave * 8 + kk]; }
#pragma unroll
    for (int jj = 0; jj < 2; ++jj) { const int ch = blk * 64 + 16 * ((wave >> 2) * 2 + jj) + (lane & 15);
        r.ba[jj] = p.in[28][l * 256 + ch]; r.bx[jj] = p.in[30][l * 256 + ch]; r.lam[jj] = p.in[31][l * 256 + ch]; }
}
template <bool PASSC>
__device__ __forceinline__ void rg_body(PRM p, LAS unsigned char* lds, int l, int u, const RgRegs& r) {
    const int tid = tidx(), lane = tid & 63, wave = tid >> 6;
    const int blk = u & 3, c = (u >> 2) & 31, b = u >> 7, row0 = b * 2048 + c * 64;
    const bf16_t* U = (const bf16_t*)(p.ws + OFF_U);
    LAS float* XR = (LAS float*)lds; LAS bf16_t* XRB = (LAS bf16_t*)(lds + 16640); LAS bf16_t* WT = (LAS bf16_t*)(lds + 25856);
    LAS float* AA = (LAS float*)(lds + 44288); LAS float* BB = (LAS float*)(lds + 60928); LAS float* HL = (LAS float*)(lds + 77568);
    const int t = tid >> 3, c8 = (tid & 7) * 8, ch0 = blk * 64 + c8;
    {
        float o[1][8]; conv8<1>(r.rows, r.w, r.bias, o);
#pragma unroll
        for (int i = 0; i < 8; ++i) XR[t * 65 + c8 + i] = o[0][i];
        *(LAS u32x4*)(XRB + t * 72 + c8) = pack8(o[0]);
#pragma unroll
        for (int i = 0; i < 2; ++i) { const int idx = tid + i * NTHR, gate = idx >> 9, rem = idx & 511; *(LAS u32x4*)(WT + gate * 4608 + (rem >> 3) * 72 + (rem & 7) * 8) = r.wt[i]; }
    }
    __syncthreads();
    {
        const int rt = wave & 3, ct0 = (wave >> 2) * 2;
        f32x4 aA[2], aX[2]; aA[0] = (f32x4){0.f, 0.f, 0.f, 0.f}; aA[1] = aA[0]; aX[0] = aA[0]; aX[1] = aA[0];
        mm_nt<2, 2>(aA, XRB + 16 * rt * 72, 72, WT + 16 * ct0 * 72, 72, lane);
        mm_nt<2, 2>(aX, XRB + 16 * rt * 72, 72, WT + 4608 + 16 * ct0 * 72, 72, lane);
#pragma unroll
        for (int jj = 0; jj < 2; ++jj) { const int j = 16 * (ct0 + jj) + (lane & 15);
            const float sp = -8.0f * softplusf_(-r.lam[jj]);
#pragma unroll
            for (int e = 0; e < 4; ++e) { const int tq = 16 * rt + (lane >> 4) * 4 + e;
                const float rr = sigmoidf_(aA[jj][e] + r.ba[jj]), ig = sigmoidf_(aX[jj][e] + r.bx[jj]);
                const float la = sp * rr; AA[tq * 65 + j] = __expf(la); BB[tq * 65 + j] = sqrtf(fmaxf(1.0f - __expf(2.0f * la), 0.f)) * ig * XR[tq * 65 + j]; } }
    }
    __syncthreads();
#pragma unroll
    for (int kk = 0; kk < 8; ++kk) { const int j = wave * 8 + kk, ch = blk * 64 + j;
        float A = AA[lane * 65 + j], B = BB[lane * 65 + j];
        scan64_lin(A, B);
        if (PASSC) HL[lane * 65 + j] = B + A * r.hin[kk];
        else if (lane == 63) { ((float*)(p.ws + OFF_RGH))[(size_t)(b * 32 + c) * 256 + ch] = B; ((float*)(p.ws + OFF_RGA))[(size_t)(b * 32 + c) * 256 + ch] = A; }
    }
    if (PASSC) {
        __syncthreads();
        float gy[8], y[8]; unpack8(r.gyraw, gy);
#pragma unroll
        for (int i = 0; i < 8; ++i) y[i] = geluf_(gy[i]) * HL[t * 65 + c8 + i];
        *(u32x4*)((bf16_t*)(p.ws + OFF_YC) + (size_t)(row0 + t) * D + 512 + ch0) = pack8(y);
        if (c == 31 && tid < 192) { const int rr = tid >> 6, j = tid & 63;
            p.out[O_PRGC + ((size_t)(l * 8 + b) * 3 + rr) * 256 + blk * 64 + j] = bf2f(U[(size_t)(b * 2048 + 2045 + rr) * NU + UGX + blk * 64 + j]); }
    }
    __syncthreads();
}

#define UNIT_LOOP(NAME, REGS, LOADF, BODYF)                                                                             \
template <bool PASSC> __device__ __forceinline__ void NAME(PRM p, LAS unsigned char* lds, int l) {            \
    int u = blockIdx.x; if (u >= 1024) return;                                                                          \
    REGS cur; LOADF<PASSC>(p, l, u, cur);                                                                               \
    _Pragma("unroll 1") for (; u < 1024; u += gridDim.x) { REGS nx; const int un = u + gridDim.x;                        \
        if (un < 1024) LOADF<PASSC>(p, l, un, nx);                                                                      \
        BODYF<PASSC>(p, lds, l, u, cur);                                                                                \
        if (un < 1024) cur = nx; } }
UNIT_LOOP(ret_loop, RetRegs, ret_load, ret_body)
UNIT_LOOP(hg_loop, HgRegs, hg_load, hg_body)
template <bool PASSC> __device__ __forceinline__ void rg_loop(PRM p, LAS unsigned char* lds, int l) {
    _Pragma("unroll 1") for (int u = blockIdx.x; u < 1024; u += gridDim.x) { RgRegs r; rg_load<PASSC>(p, l, u, r); rg_body<PASSC>(p, lds, l, u, r); } }

__device__ __forceinline__ void retC2_unit(PRM p, LAS unsigned char* lds, int l, int u) {
    const int tid = tidx(), lane = tid & 63, wave = tid >> 6;
    const int hp = u & 1, c = (u >> 1) & 31, b = u >> 6, row0 = b * 2048 + c * 64;
    const bf16_t* U = (const bf16_t*)(p.ws + OFF_U);
    const float* RC = (const float*)(p.ws + OFF_ROPE); const float* RS = RC + 2052 * 32;
    LAS bf16_t* QS = (LAS bf16_t*)lds; LAS bf16_t* KV = (LAS bf16_t*)(lds + 18432); LAS bf16_t* VT = (LAS bf16_t*)(lds + 36864);
    LAS bf16_t* SINT = (LAS bf16_t*)(lds + 55296); LAS bf16_t* PP = (LAS bf16_t*)(lds + 73728);
    const int t = tid >> 3, c8 = (tid & 7) * 8, isq = tid >> 8, tt = (tid & 255) >> 2, j0 = (tid & 3) * 8;
    const int hw = wave >> 2, rt = wave & 3, hme = 2 * hp + hw;
    u32x4 vraw[2], dsraw[2], x1[2], x2[2]; float cs[8], sn[8], gate[16], gain[4];
#pragma unroll
    for (int hh = 0; hh < 2; ++hh) { const int h = 2 * hp + hh;
        vraw[hh] = ldg8(U + (size_t)(row0 + t) * NU + URV + h * 64 + c8);
        dsraw[hh] = ldg8((const bf16_t*)(p.ws + OFF_DSR) + ((size_t)(b * 4 + h) * 32 + c) * 4096 + t * 64 + c8);
        const bf16_t* ur = U + (size_t)(row0 + tt) * NU + (isq ? URQ : URK) + h * 64 + j0; x1[hh] = ldg8(ur); x2[hh] = ldg8(ur + 32); }
    ld8f(RC + (size_t)(c * 64 + tt) * 32 + j0, cs); ld8f(RS + (size_t)(c * 64 + tt) * 32 + j0, sn);
#pragma unroll
    for (int j = 0; j < 4; ++j) { const int pc = 16 * j + (lane & 15); gain[j] = p.in[24][l * 256 + hme * 64 + pc];
#pragma unroll
        for (int e = 0; e < 4; ++e) gate[e * 4 + j] = bf2f(U[(size_t)(row0 + 16 * rt + (lane >> 4) * 4 + e) * NU + URG + hme * 64 + pc]); }
#pragma unroll
    for (int hh = 0; hh < 2; ++hh) {
#pragma unroll
        for (int i = 0; i < 8; ++i) { VT[hh * 4608 + (c8 + i) * 72 + t] = elem8(vraw[hh], i); SINT[hh * 4608 + (c8 + i) * 72 + t] = elem8(dsraw[hh], i); }
        float a[8], bb[8], ra[8], rb[8]; unpack8(x1[hh], a); unpack8(x2[hh], bb);
        const float scl = isq ? 1.0f : 0.125f;
#pragma unroll
        for (int i = 0; i < 8; ++i) { ra[i] = (a[i] * cs[i] - bb[i] * sn[i]) * scl; rb[i] = (bb[i] * cs[i] + a[i] * sn[i]) * scl; }
        LAS bf16_t* dst = (isq ? QS : KV) + hh * 4608;
        *(LAS u32x4*)(dst + tt * 72 + j0) = pack8(ra); *(LAS u32x4*)(dst + tt * 72 + j0 + 32) = pack8(rb);
    }
    __syncthreads();
    const float lg = logf(1.0f - exp2f(-5.0f - (float)hme));
    {
        f32x4 sc[4];
#pragma unroll
        for (int j = 0; j < 4; ++j) sc[j] = (f32x4){0.f, 0.f, 0.f, 0.f};
        mm_nt<4, 2>(sc, QS + hw * 4608 + 16 * rt * 72, 72, KV + hw * 4608, 72, lane);
#pragma unroll
        for (int j = 0; j < 4; ++j)
#pragma unroll
            for (int e = 0; e < 4; ++e) { const int tq = 16 * rt + (lane >> 4) * 4 + e, sq = 16 * j + (lane & 15);
                PP[hw * 4608 + tq * 72 + sq] = f2bf(sq <= tq ? sc[j][e] * __expf((float)(tq - sq) * lg) : 0.f); }
    }
    __syncthreads();
    f32x4 y[4];
#pragma unroll
    for (int j = 0; j < 4; ++j) y[j] = (f32x4){0.f, 0.f, 0.f, 0.f};
    mm_nt<4, 2>(y, QS + hw * 4608 + 16 * rt * 72, 72, SINT + hw * 4608, 72, lane);
#pragma unroll
    for (int e = 0; e < 4; ++e) { const float r = __expf((float)(16 * rt + (lane >> 4) * 4 + e + 1) * lg);
#pragma unroll
        for (int j = 0; j < 4; ++j) y[j][e] *= r; }
    mm_nt<4, 2>(y, PP + hw * 4608 + 16 * rt * 72, 72, VT + hw * 4608, 72, lane);
    bf16_t* outp = (bf16_t*)(p.ws + OFF_YC) + (size_t)row0 * D + 256 + hme * 64;
#pragma unroll
    for (int e = 0; e < 4; ++e) { const int tq = 16 * rt + (lane >> 4) * 4 + e;
        float s1 = (y[0][e] + y[1][e]) + (y[2][e] + y[3][e]);
#pragma unroll
        for (int o = 1; o < 16; o <<= 1) s1 += __shfl_xor(s1, o);
        const float mean = s1 * (1.0f / 64.0f);
        float s2 = 0.f;
#pragma unroll
        for (int j = 0; j < 4; ++j) { const float d = y[j][e] - mean; s2 += d * d; }
#pragma unroll
        for (int o = 1; o < 16; o <<= 1) s2 += __shfl_xor(s2, o);
        const float rstd = 1.0f / sqrtf(s2 * (1.0f / 64.0f) + EPS);
#pragma unroll
        for (int j = 0; j < 4; ++j) outp[(size_t)tq * D + 16 * j + (lane & 15)] = f2bf((y[j][e] - mean) * rstd * gain[j] * siluf_(gate[e * 4 + j])); }
    __syncthreads();
}

__device__ __forceinline__ void engineA4(const LAS bf16_t* KWT, const LAS bf16_t* VT, bf16_t* DSbase  , int wave, int lane) {
    const int hh = wave >> 1, rt0 = (wave & 1) * 2;
#pragma unroll
    for (int q = 0; q < 2; ++q) { const int rt = rt0 + q;
        f32x4 acc[4];
#pragma unroll
        for (int j = 0; j < 4; ++j) acc[j] = (f32x4){0.f, 0.f, 0.f, 0.f};
        mm_nt<4, 2>(acc, KWT + (hh * 64 + 16 * rt) * 72, 72, VT + hh * 64 * 72, 72, lane);
        bf16_t* DS = DSbase + (size_t)hh * 32 * 4096;
#pragma unroll
        for (int j = 0; j < 4; ++j)
#pragma unroll
            for (int e = 0; e < 4; ++e) DS[(16 * rt + (lane >> 4) * 4 + e) * 64 + 16 * j + (lane & 15)] = f2bf(acc[j][e]); }
}
__device__ __forceinline__ void retA4_unit(PRM p, LAS unsigned char* lds, int l, int u) {
    const int tid = tidx(), lane = tid & 63, wave = tid >> 6;
    const int c = u & 31, b = u >> 5, row0 = b * 2048 + c * 64;
    const bf16_t* U = (const bf16_t*)(p.ws + OFF_U);
    const float* RC = (const float*)(p.ws + OFF_ROPE); const float* RS = RC + 2052 * 32;
    LAS bf16_t* KWT = (LAS bf16_t*)lds; LAS bf16_t* VT = (LAS bf16_t*)(lds + 36864);
    const int t = tid >> 3, c8 = (tid & 7) * 8, tt = (tid & 255) >> 2, j0 = (tid & 3) * 8;
    u32x4 vraw[4], x1[2], x2[2]; float cs[8], sn[8];
#pragma unroll
    for (int hh = 0; hh < 4; ++hh) vraw[hh] = ldg8(U + (size_t)(row0 + t) * NU + URV + hh * 64 + c8);
#pragma unroll
    for (int it = 0; it < 2; ++it) { const int hh = it * 2 + (tid >> 8); const bf16_t* ur = U + (size_t)(row0 + tt) * NU + URK + hh * 64 + j0; x1[it] = ldg8(ur); x2[it] = ldg8(ur + 32); }
    ld8f(RC + (size_t)(c * 64 + tt) * 32 + j0, cs); ld8f(RS + (size_t)(c * 64 + tt) * 32 + j0, sn);
#pragma unroll
    for (int hh = 0; hh < 4; ++hh)
#pragma unroll
        for (int i = 0; i < 8; ++i) VT[(hh * 64 + c8 + i) * 72 + t] = elem8(vraw[hh], i);
#pragma unroll
    for (int it = 0; it < 2; ++it) { const int hh = it * 2 + (tid >> 8);
        const float lg = logf(1.0f - exp2f(-5.0f - (float)hh)); const float w = __expf((float)(63 - tt) * lg) * 0.125f;
        float a[8], bb[8]; unpack8(x1[it], a); unpack8(x2[it], bb);
#pragma unroll
        for (int i = 0; i < 8; ++i) { KWT[(hh * 64 + j0 + i) * 72 + tt] = f2bf((a[i] * cs[i] - bb[i] * sn[i]) * w); KWT[(hh * 64 + j0 + 32 + i) * 72 + tt] = f2bf((bb[i] * cs[i] + a[i] * sn[i]) * w); } }
    __syncthreads();
    engineA4(KWT, VT, (bf16_t*)(p.ws + OFF_DSR) + ((size_t)(b * 4) * 32 + c) * 4096, wave, lane);
    __syncthreads();
}
__device__ __forceinline__ void hgA4_unit(PRM p, LAS unsigned char* lds, int l, int u) {
    const int tid = tidx(), lane = tid & 63, wave = tid >> 6;
    const int c = u & 31, b = u >> 5, row0 = b * 2048 + c * 64;
    const bf16_t* U = (const bf16_t*)(p.ws + OFF_U);
    LAS float* CUM = (LAS float*)lds; LAS bf16_t* KWT = (LAS bf16_t*)(lds + 65792); LAS bf16_t* VT = (LAS bf16_t*)(lds + 102656);
    const int t = tid >> 3, c8 = (tid & 7) * 8;
    u32x4 hfraw[4], viraw[4];
#pragma unroll
    for (int hh = 0; hh < 4; ++hh) { const bf16_t* ur = U + (size_t)(row0 + t) * NU + hh * 64 + c8; hfraw[hh] = ldg8(ur + UHF); viraw[hh] = ldg8(ur + UHI); }
#pragma unroll
    for (int hh = 0; hh < 4; ++hh) { float lb[8], hf[8]; ld8f((const float*)(p.ws + OFF_LB) + l * 256 + hh * 64 + c8, lb); unpack8(hfraw[hh], hf);
#pragma unroll
        for (int i = 0; i < 8; ++i) { VT[(hh * 64 + c8 + i) * 72 + t] = elem8(viraw[hh], i); CUM[t * 257 + hh * 64 + c8 + i] = __logf(lb[i] + (1.0f - lb[i]) * sigmoidf_(hf[i])); } }
    __syncthreads();
#pragma unroll 8
    for (int kk = 0; kk < 32; ++kk) { const int k = wave * 32 + kk; const float v = scan64_add(CUM[lane * 257 + k], lane); CUM[lane * 257 + k] = v; }
    __syncthreads();
#pragma unroll
    for (int hh = 0; hh < 4; ++hh) { float lb[8], hf[8]; ld8f((const float*)(p.ws + OFF_LB) + l * 256 + hh * 64 + c8, lb); unpack8(hfraw[hh], hf);
#pragma unroll
        for (int i = 0; i < 8; ++i) { const int ch = hh * 64 + c8 + i; const float kk_ = (1.0f - lb[i]) * sigmoidf_(-hf[i]);
            KWT[ch * 72 + t] = f2bf(kk_ * __expf(CUM[63 * 257 + ch] - CUM[t * 257 + ch])); } }
    if (tid < 256) ((float*)(p.ws + OFF_DECH))[((size_t)(b * 4 + (tid >> 6)) * 32 + c) * 64 + (tid & 63)] = __expf(CUM[63 * 257 + tid]);
    __syncthreads();
    engineA4(KWT, VT, (bf16_t*)(p.ws + OFF_DSH) + ((size_t)(b * 4) * 32 + c) * 4096, wave, lane);
    __syncthreads();
}

__device__ __forceinline__ void mixA_unit(PRM p, LAS unsigned char* lds, int l, int u) {
    RetRegs rr; HgRegs hr; RgRegs gr;
    ret_load<false>(p, l, u, rr); hg_load<false>(p, l, u, hr); rg_load<false>(p, l, u, gr);
    ret_body<false>(p, lds, l, u, rr); hg_body<false>(p, lds, l, u, hr); rg_body<false>(p, lds, l, u, gr);
}

__device__ __forceinline__ void mixC_unit(PRM p, LAS unsigned char* lds, int l, int u) {
    RetRegs rr; HgRegs hr; RgRegs gr;
    ret_load<true>(p, l, u, rr); hg_load<true>(p, l, u, hr); rg_load<true>(p, l, u, gr);
    ret_body<true>(p, lds, l, u, rr); hg_body<true>(p, lds, l, u, hr); rg_body<true>(p, lds, l, u, gr);
}

__device__ __forceinline__ void carry_phase(PRM p, int l) {
    const int gt = blockIdx.x * NTHR + tidx(), NG = gridDim.x * NTHR;
    constexpr int N_SSD = 8 * 4 * 4096, N_RET = 8 * 4 * 2048, N_HG = N_RET, N_RG = 8 * 256;
    for (int i = gt; i < N_SSD + N_RET + N_HG + N_RG; i += NG) {
        if (i < N_SSD + N_RET + N_HG) {
            unsigned* base; float dec[32]; size_t stride, oo;
            if (i < N_SSD) { const int bh = i >> 12, e2 = i & 4095; base = (unsigned*)(p.ws + OFF_DSS) + (size_t)bh * 32 * 4096 + e2; stride = 4096;
                const float* dc = (const float*)(p.ws + OFF_DECS) + bh * 32;
#pragma unroll
                for (int c = 0; c < 32; ++c) dec[c] = dc[c];
                oo = O_PSSD + (size_t)l * 8 * 32768 + (size_t)bh * 8192 + 2 * e2;
            } else if (i < N_SSD + N_RET) { const int j = i - N_SSD, bh = j >> 11, e2 = j & 2047; base = (unsigned*)(p.ws + OFF_DSR) + (size_t)bh * 32 * 2048 + e2; stride = 2048;
                const float d = expf(64.0f * logf(1.0f - exp2f(-5.0f - (float)(bh & 3))));
#pragma unroll
                for (int c = 0; c < 32; ++c) dec[c] = d;
                oo = O_PRET + (size_t)l * 8 * 16384 + (size_t)bh * 4096 + 2 * e2;
            } else { const int j = i - N_SSD - N_RET, bh = j >> 11, e2 = j & 2047; base = (unsigned*)(p.ws + OFF_DSH) + (size_t)bh * 32 * 2048 + e2; stride = 2048;
                const float* dc = (const float*)(p.ws + OFF_DECH) + (size_t)bh * 32 * 64 + (e2 >> 5);
#pragma unroll
                for (int c = 0; c < 32; ++c) dec[c] = dc[c * 64];
                oo = O_PHG + (size_t)l * 8 * 16384 + (size_t)bh * 4096 + 2 * e2;
            }
            unsigned tmp[32];
#pragma unroll
            for (int c = 0; c < 32; ++c) tmp[c] = base[(size_t)c * stride];
            float s0 = 0.f, s1 = 0.f;
#pragma unroll
            for (int c = 0; c < 32; ++c) { base[(size_t)c * stride] = pk2(s0, s1);
                s0 = dec[c] * s0 + __uint_as_float(tmp[c] << 16); s1 = dec[c] * s1 + __uint_as_float(tmp[c] & 0xffff0000u); }
            *(f32x2*)(p.out + oo) = (f32x2){s0, s1};
        } else {
            const int j = i - N_SSD - N_RET - N_HG, b = j >> 8, ch = j & 255;
            const float* hl = (const float*)(p.ws + OFF_RGH) + (size_t)b * 32 * 256 + ch; const float* at = (const float*)(p.ws + OFF_RGA) + (size_t)b * 32 * 256 + ch;
            float* cr = (float*)(p.ws + OFF_RGC) + (size_t)b * 32 * 256 + ch;
            float tmp[32], dec[32];
#pragma unroll
            for (int c = 0; c < 32; ++c) { tmp[c] = hl[c * 256]; dec[c] = at[c * 256]; }
            float sacc = 0.f;
#pragma unroll
            for (int c = 0; c < 32; ++c) { cr[c * 256] = sacc; sacc = dec[c] * sacc + tmp[c]; }
            p.out[O_PRG + (size_t)l * 8 * 256 + b * 256 + ch] = sacc;
        }
    }
}

constexpr int S_QD = 0, S_KW = 8192, S_V = 16384, S_DEC = 20480, S_P = 22528, S_Y = 22784, S_RED = 26880, S_SCR = 59648;
template <int KD>
__device__ __forceinline__ void dec_engine(const float* S0, float* S1, LAS unsigned char* lds) {
    const int tid = tidx(), p_ = tid & 63, kq = tid >> 6; constexpr int KPER = KD / 8;
    const LAS float* QDs = (const LAS float*)(lds + S_QD); const LAS float* KWs = (const LAS float*)(lds + S_KW); const LAS float* Vs = (const LAS float*)(lds + S_V);
    const LAS float* DECs = (const LAS float*)(lds + S_DEC); const LAS float* Ps = (const LAS float*)(lds + S_P); LAS float* Ys = (LAS float*)(lds + S_Y); LAS float* RED = (LAS float*)(lds + S_RED);
    float v[4][4], yp[4][4];
#pragma unroll
    for (int h = 0; h < 4; ++h)
#pragma unroll
        for (int s = 0; s < 4; ++s) { v[h][s] = Vs[s * 256 + h * 64 + p_]; yp[h][s] = 0.f; }
#pragma unroll
    for (int h = 0; h < 4; ++h) {
#pragma unroll
        for (int kk = 0; kk < KPER; ++kk) { const int k = kq * KPER + kk;
            const float s0 = S0[(size_t)(h * KD + k) * 64 + p_];
            const f32x4 kw = *(const LAS f32x4*)(KWs + (h * 128 + k) * 4), qd = *(const LAS f32x4*)(QDs + (h * 128 + k) * 4);
            const float acc = DECs[h * 128 + k] * s0 + kw.x * v[h][0] + kw.y * v[h][1] + kw.z * v[h][2] + kw.w * v[h][3];
            S1[(size_t)(h * KD + k) * 64 + p_] = acc;
            yp[h][0] += qd.x * s0; yp[h][1] += qd.y * s0; yp[h][2] += qd.z * s0; yp[h][3] += qd.w * s0;
        }
    }
#pragma unroll
    for (int h = 0; h < 4; ++h)
#pragma unroll
        for (int t = 0; t < 4; ++t) RED[(kq * 16 + h * 4 + t) * 64 + p_] = yp[h][t];
    __syncthreads();
    for (int idx = tid; idx < 1024; idx += NTHR) { const int p2 = idx & 63, ht = idx >> 6, h = ht >> 2, t = ht & 3;
        float sum = 0.f;
#pragma unroll
        for (int q = 0; q < 8; ++q) sum += RED[(q * 16 + ht) * 64 + p2];
        for (int s = 0; s <= t; ++s) sum += Ps[ht * 4 + s] * Vs[s * 256 + h * 64 + p2];
        Ys[t * 256 + h * 64 + p2] = sum; }
    __syncthreads();
}

__device__ __forceinline__ void sample_ssd(PRM p, LAS unsigned char* lds, int l, int b) {
    const int tid = tidx(), lane = tid & 63, wave = tid >> 6, R0 = TP + b * 4;
    const bf16_t* U = (const bf16_t*)(p.ws + OFF_U); const float* SDT = (const float*)(p.ws + OFF_SDT);
    LAS float* QDs = (LAS float*)(lds + S_QD); LAS float* KWs = (LAS float*)(lds + S_KW); LAS float* Vs = (LAS float*)(lds + S_V);
    LAS float* DECs = (LAS float*)(lds + S_DEC); LAS float* Ps = (LAS float*)(lds + S_P); LAS float* Ys = (LAS float*)(lds + S_Y);
    LAS float* XB = (LAS float*)(lds + S_SCR); LAS float* DTs = (LAS float*)(lds + S_SCR + 12288); LAS float* CUs = DTs + 16;
    for (int ch = tid; ch < 768; ch += NTHR) {
        float xx[7];
#pragma unroll
        for (int r = 0; r < 3; ++r) xx[r] = p.in[3][((size_t)(l * 128 + b) * 3 + r) * 768 + ch];
#pragma unroll
        for (int t = 0; t < 4; ++t) xx[3 + t] = bf2f(U[(size_t)(R0 + t) * NU + UXBC + ch]);
        const float* cw = p.in[18] + (size_t)l * 4 * 768 + ch; const float w0 = cw[0], w1 = cw[768], w2 = cw[1536], w3 = cw[2304], bias = p.in[19][l * 768 + ch];
#pragma unroll
        for (int t = 0; t < 4; ++t) XB[t * 768 + ch] = siluf_(bias + w0 * xx[t] + w1 * xx[t + 1] + w2 * xx[t + 2] + w3 * xx[t + 3]);
#pragma unroll
        for (int r = 0; r < 3; ++r) p.out[O_SSSDC + ((size_t)(l * 128 + b) * 3 + r) * 768 + ch] = xx[4 + r];
    }
    if (tid < 4) { const int h = tid; float cum = 0.f; const float bias = p.in[20][l * 4 + h], A = -expf(p.in[21][l * 4 + h]);
        for (int t = 0; t < 4; ++t) { const float dt = softplusf_(SDT[(size_t)(R0 + t) * 4 + h] + bias); cum += A * dt; DTs[h * 4 + t] = dt; CUs[h * 4 + t] = cum; } }
    __syncthreads();
    for (int idx = tid; idx < 2048; idx += NTHR) { const int h = idx >> 9, t = (idx >> 7) & 3, n = idx & 127, g = h >> 1;
        QDs[(h * 128 + n) * 4 + t] = XB[t * 768 + 512 + g * 128 + n] * __expf(CUs[h * 4 + t]);
        KWs[(h * 128 + n) * 4 + t] = XB[t * 768 + 256 + g * 128 + n] * __expf(CUs[h * 4 + 3] - CUs[h * 4 + t]) * DTs[h * 4 + t]; }
    for (int idx = tid; idx < 1024; idx += NTHR) Vs[idx] = XB[(idx >> 8) * 768 + (idx & 255)];
    DECs[(tid >> 7) * 128 + (tid & 127)] = __expf(CUs[(tid >> 7) * 4 + 3]);
    if (tid < 64) { const int h = tid >> 4, t = (tid >> 2) & 3, s = tid & 3, g = h >> 1; float val = 0.f;
        if (s <= t) { float dot = 0.f;
#pragma unroll 32
            for (int n = 0; n < 128; ++n) dot += XB[t * 768 + 512 + g * 128 + n] * XB[s * 768 + 256 + g * 128 + n];
            val = dot * __expf(CUs[h * 4 + t] - CUs[h * 4 + s]) * DTs[h * 4 + s]; }
        Ps[tid] = val; }
    __syncthreads();
    dec_engine<128>(p.in[2] + (size_t)(l * 128 + b) * 32768, p.out + O_SSSD + (size_t)(l * 128 + b) * 32768, lds);
    for (int idx = tid; idx < 1024; idx += NTHR) { const int t = idx >> 8, ch = idx & 255, h = ch >> 6;
        const float y = Ys[idx] + p.in[22][l * 4 + h] * XB[t * 768 + ch];
        Ys[idx] = y * siluf_(bf2f(U[(size_t)(R0 + t) * NU + UZ + ch])); }
    __syncthreads();
    if (wave < 4) { const int t = wave; float v[4], ss = 0.f;
#pragma unroll
        for (int i = 0; i < 4; ++i) { v[i] = Ys[t * 256 + lane + 64 * i]; ss += v[i] * v[i]; }
        const float rstd = 1.0f / sqrtf(wave_sum(ss) * (1.0f / 256.0f) + EPS);
#pragma unroll
        for (int i = 0; i < 4; ++i) ((bf16_t*)(p.ws + OFF_YC))[(size_t)(R0 + t) * D + lane + 64 * i] = f2bf(v[i] * rstd * p.in[23][l * 256 + lane + 64 * i]); }
    __syncthreads();
}

template <bool CENTER>
__device__ __forceinline__ void sample_headnorm(PRM p, LAS unsigned char* lds, int R0, const float* gain, int gcol, int ocol) {
    const int tid = tidx(), lane = tid & 63, wave = tid >> 6;
    const bf16_t* U = (const bf16_t*)(p.ws + OFF_U); const LAS float* Ys = (const LAS float*)(lds + S_Y);
#pragma unroll
    for (int q = 0; q < 2; ++q) { const int gi = wave * 2 + q, t = gi >> 2, h = gi & 3;
        const float y = Ys[t * 256 + h * 64 + lane];
        const float mean = CENTER ? wave_sum(y) * (1.0f / 64.0f) : 0.f; const float d = y - mean;
        const float var = wave_sum(d * d) * (1.0f / 64.0f);
        const float o = d / sqrtf(var + EPS) * gain[h * 64 + lane] * siluf_(bf2f(U[(size_t)(R0 + t) * NU + gcol + h * 64 + lane]));
        ((bf16_t*)(p.ws + OFF_YC))[(size_t)(R0 + t) * D + ocol + h * 64 + lane] = f2bf(o); }
}

__device__ __forceinline__ void sample_ret(PRM p, LAS unsigned char* lds, int l, int b) {
    const int tid = tidx(), R0 = TP + b * 4;
    const bf16_t* U = (const bf16_t*)(p.ws + OFF_U);
    const float* RC = (const float*)(p.ws + OFF_ROPE); const float* RS = RC + 2052 * 32;
    LAS float* QDs = (LAS float*)(lds + S_QD); LAS float* KWs = (LAS float*)(lds + S_KW); LAS float* Vs = (LAS float*)(lds + S_V);
    LAS float* DECs = (LAS float*)(lds + S_DEC); LAS float* Ps = (LAS float*)(lds + S_P);
    LAS float* Qr = (LAS float*)(lds + S_SCR); LAS float* Kr = Qr + 1024;
    { const int h = tid >> 7, t = (tid >> 5) & 3, j = tid & 31; const bf16_t* ur = U + (size_t)(R0 + t) * NU;
        const float cs = RC[(2048 + t) * 32 + j], sn = RS[(2048 + t) * 32 + j];
        const float q1 = bf2f(ur[URQ + h * 64 + j]), q2 = bf2f(ur[URQ + h * 64 + j + 32]), k1 = bf2f(ur[URK + h * 64 + j]), k2 = bf2f(ur[URK + h * 64 + j + 32]);
        Qr[(h * 4 + t) * 64 + j] = q1 * cs - q2 * sn; Qr[(h * 4 + t) * 64 + j + 32] = q2 * cs + q1 * sn;
        Kr[(h * 4 + t) * 64 + j] = (k1 * cs - k2 * sn) * 0.125f; Kr[(h * 4 + t) * 64 + j + 32] = (k2 * cs + k1 * sn) * 0.125f; }
    for (int idx = tid; idx < 1024; idx += NTHR) Vs[idx] = bf2f(U[(size_t)(R0 + (idx >> 8)) * NU + URV + (idx & 255)]);
    __syncthreads();
    for (int idx = tid; idx < 1024; idx += NTHR) { const int h = idx >> 8, t = (idx >> 6) & 3, k = idx & 63; const float lg = logf(1.0f - exp2f(-5.0f - (float)h));
        QDs[(h * 128 + k) * 4 + t] = Qr[(h * 4 + t) * 64 + k] * __expf((float)(t + 1) * lg);
        KWs[(h * 128 + k) * 4 + t] = Kr[(h * 4 + t) * 64 + k] * __expf((float)(3 - t) * lg); }
    if (tid < 256) { const int h = tid >> 6; DECs[h * 128 + (tid & 63)] = __expf(4.0f * logf(1.0f - exp2f(-5.0f - (float)h))); }
    if (tid < 64) { const int h = tid >> 4, t = (tid >> 2) & 3, s = tid & 3; float val = 0.f;
        if (s <= t) { float dot = 0.f;
#pragma unroll 32
            for (int k = 0; k < 64; ++k) dot += Qr[(h * 4 + t) * 64 + k] * Kr[(h * 4 + s) * 64 + k];
            val = dot * __expf((float)(t - s) * logf(1.0f - exp2f(-5.0f - (float)h))); }
        Ps[tid] = val; }
    __syncthreads();
    dec_engine<64>(p.in[4] + (size_t)(l * 128 + b) * 16384, p.out + O_SRET + (size_t)(l * 128 + b) * 16384, lds);
    sample_headnorm<true>(p, lds, R0, p.in[24] + l * 256, URG, 256);
    __syncthreads();
}

__device__ __forceinline__ void sample_hg(PRM p, LAS unsigned char* lds, int l, int b) {
    const int tid = tidx(), R0 = TP + b * 4;
    const bf16_t* U = (const bf16_t*)(p.ws + OFF_U);
    LAS float* QDs = (LAS float*)(lds + S_QD); LAS float* KWs = (LAS float*)(lds + S_KW); LAS float* Vs = (LAS float*)(lds + S_V);
    LAS float* DECs = (LAS float*)(lds + S_DEC); LAS float* Ps = (LAS float*)(lds + S_P);
    LAS float* LF = (LAS float*)(lds + S_SCR); LAS float* KK = LF + 1024; LAS float* QH = KK + 1024;
    for (int idx = tid; idx < 1024; idx += NTHR) { const int t = idx >> 8, ch = idx & 255; const bf16_t* ur = U + (size_t)(R0 + t) * NU;
        float lbk = 0.f;
        if (l > 0) { const float a0 = p.in[32][ch], a1 = p.in[32][256 + ch]; const float mx = fmaxf(a0, a1), e0 = expf(a0 - mx), e1 = expf(a1 - mx); lbk = e1 / (e0 + e1); }
        const float hf = bf2f(ur[UHF + ch]);
        LF[idx] = logf(lbk + (1.0f - lbk) * sigmoidf_(hf)); KK[idx] = (1.0f - lbk) * sigmoidf_(-hf); QH[idx] = siluf_(bf2f(ur[UHQ + ch])); Vs[idx] = bf2f(ur[UHI + ch]); }
    __syncthreads();
    if (tid < 256) { float c = 0.f; for (int t = 0; t < 4; ++t) { c += LF[t * 256 + tid]; LF[t * 256 + tid] = c; } }
    __syncthreads();
    for (int idx = tid; idx < 1024; idx += NTHR) { const int h = idx >> 8, t = (idx >> 6) & 3, k = idx & 63, ch = h * 64 + k;
        const float cum = LF[t * 256 + ch], last = LF[3 * 256 + ch];
        QDs[(h * 128 + k) * 4 + t] = QH[t * 256 + ch] * __expf(cum); KWs[(h * 128 + k) * 4 + t] = KK[t * 256 + ch] * __expf(last - cum); }
    if (tid < 256) DECs[(tid >> 6) * 128 + (tid & 63)] = __expf(LF[3 * 256 + tid]);
    if (tid < 64) { const int h = tid >> 4, t = (tid >> 2) & 3, s = tid & 3; float val = 0.f;
        if (s <= t)
#pragma unroll 16
            for (int k = 0; k < 64; ++k) { const int ch = h * 64 + k; val += QH[t * 256 + ch] * KK[s * 256 + ch] * __expf(LF[t * 256 + ch] - LF[s * 256 + ch]); }
        Ps[tid] = val; }
    __syncthreads();
    dec_engine<64>(p.in[7] + (size_t)(l * 128 + b) * 16384, p.out + O_SHG + (size_t)(l * 128 + b) * 16384, lds);
    sample_headnorm<false>(p, lds, R0, p.in[33] + l * 256, UHG, 768);
    __syncthreads();
}

__device__ __forceinline__ void sample_rg(PRM p, LAS unsigned char* lds, int l, int b) {
    const int tid = tidx(), R0 = TP + b * 4;
    const bf16_t* U = (const bf16_t*)(p.ws + OFF_U);
    LAS float* XRs = (LAS float*)(lds + S_SCR); LAS float* GA = XRs + 1024;
    if (tid < 256) { const int ch = tid; float xx[7];
#pragma unroll
        for (int r = 0; r < 3; ++r) xx[r] = p.in[6][((size_t)(l * 128 + b) * 3 + r) * 256 + ch];
#pragma unroll
        for (int t = 0; t < 4; ++t) xx[3 + t] = bf2f(U[(size_t)(R0 + t) * NU + UGX + ch]);
        const float* cw = p.in[25] + (size_t)l * 4 * 256 + ch; const float w0 = cw[0], w1 = cw[256], w2 = cw[512], w3 = cw[768], bias = p.in[26][l * 256 + ch];
#pragma unroll
        for (int t = 0; t < 4; ++t) XRs[t * 256 + ch] = bias + w0 * xx[t] + w1 * xx[t + 1] + w2 * xx[t + 2] + w3 * xx[t + 3];
#pragma unroll
        for (int r = 0; r < 3; ++r) p.out[O_SRGC + ((size_t)(l * 128 + b) * 3 + r) * 256 + ch] = xx[4 + r]; }
    __syncthreads();
    { const int ch = tid & 255, gate = tid >> 8, blk = ch >> 6, j = ch & 63; const float* W = p.in[gate ? 29 : 27] + (size_t)(l * 4 + blk) * 4096;
        float a0 = 0.f, a1 = 0.f, a2 = 0.f, a3 = 0.f, wv[64];
#pragma unroll
        for (int i = 0; i < 64; ++i) wv[i] = W[i * 64 + j];
#pragma unroll
        for (int i = 0; i < 64; ++i) { const float w = wv[i];
            a0 += XRs[blk * 64 + i] * w; a1 += XRs[256 + blk * 64 + i] * w; a2 += XRs[512 + blk * 64 + i] * w; a3 += XRs[768 + blk * 64 + i] * w; }
        GA[(gate * 4 + 0) * 256 + ch] = a0; GA[(gate * 4 + 1) * 256 + ch] = a1; GA[(gate * 4 + 2) * 256 + ch] = a2; GA[(gate * 4 + 3) * 256 + ch] = a3; }
    __syncthreads();
    if (tid < 256) { const int ch = tid; float h = p.in[5][(size_t)(l * 128 + b) * 256 + ch];
        const float ba = p.in[28][l * 256 + ch], bx = p.in[30][l * 256 + ch], sp = -8.0f * softplusf_(-p.in[31][l * 256 + ch]);
        for (int t = 0; t < 4; ++t) { const float r = sigmoidf_(GA[t * 256 + ch] + ba), ig = sigmoidf_(GA[(4 + t) * 256 + ch] + bx);
            const float la = sp * r; h = __expf(la) * h + sqrtf(-expm1f(2.0f * la)) * ig * XRs[t * 256 + ch];
            ((bf16_t*)(p.ws + OFF_YC))[(size_t)(R0 + t) * D + 512 + ch] = f2bf(geluf_(bf2f(U[(size_t)(R0 + t) * NU + UGY + ch])) * h); }
        p.out[O_SRG + (size_t)(l * 128 + b) * 256 + ch] = h; }
    __syncthreads();
}

__device__ __forceinline__ void attn_prompt(PRM p, LAS unsigned char* lds, int u) {
    const int tid = tidx(), lane = tid & 63, wave = tid >> 6, fr = lane & 15, fq = lane >> 4;
    const int qt = u & 15, h = (u >> 4) & 3, b = u >> 6, r0 = b * 2048 + qt * 128;
    const bf16_t* Q = (const bf16_t*)(p.ws + OFF_Q); const bf16_t* KBp = (const bf16_t*)(p.ws + OFF_KB) + (size_t)(b * 4 + h) * 65536;
    const bf16_t* VTp = (const bf16_t*)(p.ws + OFF_VTB) + (size_t)(b * 4 + h) * 65536; bf16_t* OB = (bf16_t*)(p.ws + OFF_YC);
    LAS bf16_t* KC = (LAS bf16_t*)lds; LAS bf16_t* PS = (LAS bf16_t*)(lds + 36864);
    bf16x8 qf[8];
#pragma unroll
    for (int ks = 0; ks < 8; ++ks) qf[ks] = *(const bf16x8*)(Q + (size_t)(r0 + 16 * wave + fr) * D + h * 256 + ks * 32 + fq * 8);
    u32x4 kr[4];
    const int sr = tid >> 3, sc8 = (tid & 7) * 8;
#pragma unroll
    for (int i = 0; i < 4; ++i) kr[i] = *(const u32x4*)(KBp + (size_t)(sr + 64 * i) * 256 + sc8);
    f32x4 S[16];
#pragma unroll
    for (int j = 0; j < 16; ++j) S[j] = (f32x4){0.f, 0.f, 0.f, 0.f};
#pragma unroll
    for (int dc = 0; dc < 4; ++dc) {
#pragma unroll
        for (int i = 0; i < 4; ++i) *(LAS u32x4*)(KC + (sr + 64 * i) * 72 + sc8) = kr[i];
        __syncthreads();
        if (dc < 3) {
#pragma unroll
            for (int i = 0; i < 4; ++i) kr[i] = *(const u32x4*)(KBp + (size_t)(sr + 64 * i) * 256 + (dc + 1) * 64 + sc8);
        } else {
#pragma unroll
            for (int i = 0; i < 4; ++i) kr[i] = *(const u32x4*)(VTp + (size_t)(sr + 64 * i) * 256 + sc8);
        }
#pragma unroll
        for (int k2 = 0; k2 < 2; ++k2)
#pragma unroll
            for (int j = 0; j < 16; ++j) { const bf16x8 kf = *(const LAS bf16x8*)(KC + (16 * j + fr) * 72 + k2 * 32 + fq * 8);
                S[j] = __builtin_amdgcn_mfma_f32_16x16x32_bf16(kf, qf[dc * 2 + k2], S[j], 0, 0, 0); }
        __syncthreads();
    }
    {
        float m = -3.0e38f;
#pragma unroll
        for (int j = 0; j < 16; ++j) m = fmaxf(fmaxf(m, fmaxf(S[j][0], S[j][1])), fmaxf(S[j][2], S[j][3]));
        m = fmaxf(m, __shfl_xor(m, 16)); m = fmaxf(m, __shfl_xor(m, 32));
        float sm = 0.f;
#pragma unroll
        for (int j = 0; j < 16; ++j)
#pragma unroll
            for (int e = 0; e < 4; ++e) { const float ev = __expf((S[j][e] - m) * 0.0625f); S[j][e] = ev; sm += ev; }
        sm += __shfl_xor(sm, 16); sm += __shfl_xor(sm, 32);
        const float inv = 1.0f / sm;
#pragma unroll
        for (int j = 0; j < 16; ++j) { u32x2 w; w.x = pk2(S[j][0] * inv, S[j][1] * inv); w.y = pk2(S[j][2] * inv, S[j][3] * inv);
            *(LAS u32x2*)(PS + (16 * wave + fr) * 264 + 16 * j + 4 * fq) = w; }
    }
    f32x4 O[16];
#pragma unroll
    for (int j = 0; j < 16; ++j) O[j] = (f32x4){0.f, 0.f, 0.f, 0.f};
#pragma unroll
    for (int kc = 0; kc < 4; ++kc) {
#pragma unroll
        for (int i = 0; i < 4; ++i) *(LAS u32x4*)(KC + (sr + 64 * i) * 72 + sc8) = kr[i];
        __syncthreads();
        if (kc < 3) {
#pragma unroll
            for (int i = 0; i < 4; ++i) kr[i] = *(const u32x4*)(VTp + (size_t)(sr + 64 * i) * 256 + (kc + 1) * 64 + sc8);
        }
#pragma unroll
        for (int k2 = 0; k2 < 2; ++k2) { const bf16x8 pf = *(const LAS bf16x8*)(PS + (16 * wave + fr) * 264 + kc * 64 + k2 * 32 + fq * 8);
#pragma unroll
            for (int j = 0; j < 16; ++j) { const bf16x8 vf = *(const LAS bf16x8*)(KC + (16 * j + fr) * 72 + k2 * 32 + fq * 8);
                O[j] = __builtin_amdgcn_mfma_f32_16x16x32_bf16(vf, pf, O[j], 0, 0, 0); } }
        __syncthreads();
    }
#pragma unroll
    for (int j = 0; j < 16; ++j) { u32x2 w; w.x = pk2(O[j][0], O[j][1]); w.y = pk2(O[j][2], O[j][3]);
        *(u32x2*)(OB + (size_t)(r0 + 16 * wave + fr) * D + h * 256 + 16 * j + 4 * fq) = w; }
}

__device__ __forceinline__ void attn_sample(PRM p, LAS unsigned char* lds, int l, int u) {
    const int tid = tidx(), lane = tid & 63, wave = tid >> 6;
    const int h = u & 3, b = u >> 2, R0 = TP + b * 4;
    const bf16_t* Q = (const bf16_t*)(p.ws + OFF_Q); bf16_t* OB = (bf16_t*)(p.ws + OFF_YC);
    LAS float* QSs = (LAS float*)lds; LAS float* SCT = QSs + 1024; LAS float* OP = SCT + 1024;
    const float* Kp = p.in[8] + ((size_t)(l * 128 + b) * 256) * 1024 + h * 256 + lane * 4;
    f32x4 kvn[8];
#pragma unroll
    for (int i = 0; i < 8; ++i) kvn[i] = *(const f32x4*)(Kp + (size_t)(wave * 32 + i) * 1024);
    for (int idx = tid; idx < 1024; idx += NTHR) QSs[idx] = bf2f(Q[(size_t)(R0 + (idx >> 8)) * D + h * 256 + (idx & 255)]) * 0.0625f;
    __syncthreads();
    f32x4 q[4];
#pragma unroll
    for (int t = 0; t < 4; ++t) q[t] = *(const LAS f32x4*)(QSs + t * 256 + lane * 4);
#pragma unroll 1
    for (int i0 = 0; i0 < 32; i0 += 8) {
        f32x4 kv[8];
#pragma unroll
        for (int i = 0; i < 8; ++i) kv[i] = kvn[i];
        if (i0 + 8 < 32) {
#pragma unroll
            for (int i = 0; i < 8; ++i) kvn[i] = *(const f32x4*)(Kp + (size_t)(wave * 32 + i0 + 8 + i) * 1024);
        }
        float vals[32];
#pragma unroll
        for (int i = 0; i < 8; ++i)
#pragma unroll
            for (int t = 0; t < 4; ++t) vals[i * 4 + t] = kv[i].x * q[t].x + kv[i].y * q[t].y + kv[i].z * q[t].z + kv[i].w * q[t].w;
#pragma unroll
        for (int n = 16, mask = 32; n >= 1; n >>= 1, mask >>= 1) { const bool up = (lane & mask) != 0;
#pragma unroll
            for (int i = 0; i < n; ++i) { const float send = up ? vals[i] : vals[i + n]; const float keep = up ? vals[i + n] : vals[i]; vals[i] = keep + __shfl_xor(send, mask); } }
        const float tot = vals[0] + __shfl_xor(vals[0], 1);
        if ((lane & 1) == 0) { const int vi = lane >> 1; SCT[(wave * 32 + i0 + (vi >> 2)) * 4 + (vi & 3)] = tot; }
    }
    const float* Vp = p.in[9] + ((size_t)(l * 128 + b) * 256) * 1024 + h * 256 + lane * 4;
    f32x4 vvn[8];
#pragma unroll
    for (int i = 0; i < 8; ++i) vvn[i] = *(const f32x4*)(Vp + (size_t)(wave * 32 + i) * 1024);
    __syncthreads();
    if (wave < 4) { const int t = wave; float v[4], m = -3.0e38f;
#pragma unroll
        for (int i = 0; i < 4; ++i) { v[i] = SCT[(lane + 64 * i) * 4 + t]; m = fmaxf(m, v[i]); }
        m = wave_max(m); float sm = 0.f;
#pragma unroll
        for (int i = 0; i < 4; ++i) { v[i] = __expf(v[i] - m); sm += v[i]; }
        sm = 1.0f / wave_sum(sm);
#pragma unroll
        for (int i = 0; i < 4; ++i) SCT[(lane + 64 * i) * 4 + t] = v[i] * sm; }
    __syncthreads();
    {
        f32x4 acc[4];
#pragma unroll
        for (int t = 0; t < 4; ++t) acc[t] = (f32x4){0.f, 0.f, 0.f, 0.f};
#pragma unroll 1
        for (int i0 = 0; i0 < 32; i0 += 8) {
            f32x4 vv[8];
#pragma unroll
            for (int i = 0; i < 8; ++i) vv[i] = vvn[i];
            if (i0 + 8 < 32) {
#pragma unroll
                for (int i = 0; i < 8; ++i) vvn[i] = *(const f32x4*)(Vp + (size_t)(wave * 32 + i0 + 8 + i) * 1024);
            }
#pragma unroll
            for (int i = 0; i < 8; ++i) { const f32x4 pr = *(const LAS f32x4*)(SCT + (wave * 32 + i0 + i) * 4);
                acc[0] = acc[0] + vv[i] * pr.x; acc[1] = acc[1] + vv[i] * pr.y; acc[2] = acc[2] + vv[i] * pr.z; acc[3] = acc[3] + vv[i] * pr.w; }
        }
#pragma unroll
        for (int t = 0; t < 4; ++t) *(LAS f32x4*)(OP + (wave * 4 + t) * 256 + lane * 4) = acc[t];
    }
    __syncthreads();
    for (int idx = tid; idx < 1024; idx += NTHR) { float o = 0.f;
#pragma unroll
        for (int w = 0; w < 8; ++w) o += OP[w * 1024 + idx];
        OB[(size_t)(R0 + (idx >> 8)) * D + h * 256 + (idx & 255)] = f2bf(o); }
    __syncthreads();
}

template <int MODE, int K, int KC>
__device__ __forceinline__ void sgemm(LAS unsigned char* lds, const bf16_t* A, const bf16_t* Bt, float* Cf, bf16_t* Cb) {
    const int tid = tidx(), lane = tid & 63, wave = tid >> 6, fr = lane & 15, fq = lane >> 4;
    constexpr int NCH = KC / 8, NI = (32 * NCH + NTHR - 1) / NTHR, LD = KC + 8, NSLAB = K / KC;
    LAS bf16_t* AS = (LAS bf16_t*)lds; LAS bf16_t* BS = (LAS bf16_t*)(lds + 32 * LD * 2);
    const int rt = (wave >> 1) & 1, ct = wave & 1;
    const int ntile = (512 - (int)blockIdx.x + (int)gridDim.x - 1) / (int)gridDim.x, nstep = ntile * NSLAB;
    u32x4 ra[NI], rb[NI];
    auto issue = [&](int step) { const int tile = blockIdx.x + (step / NSLAB) * gridDim.x, k0 = (step % NSLAB) * KC, tm = tile >> 5, tn = tile & 31;
#pragma unroll
        for (int i = 0; i < NI; ++i) { const int idx = tid + i * NTHR; const int r = idx / NCH, cc = idx % NCH;
            if (idx < 32 * NCH) { ra[i] = ldg8(A + (size_t)(tm * 32 + r) * K + k0 + cc * 8); rb[i] = ldg8(Bt + (size_t)(tn * 32 + r) * K + k0 + cc * 8); } } };
    if (nstep > 0) issue(0);
    f32x4 acc = (f32x4){0.f, 0.f, 0.f, 0.f};
#pragma unroll 1
    for (int step = 0; step < nstep; ++step) {
#pragma unroll
        for (int i = 0; i < NI; ++i) { const int idx = tid + i * NTHR; const int r = idx / NCH, cc = idx % NCH;
            if (idx < 32 * NCH) { *(LAS u32x4*)(AS + r * LD + cc * 8) = ra[i]; *(LAS u32x4*)(BS + r * LD + cc * 8) = rb[i]; } }
        __syncthreads();
        if (step + 1 < nstep) issue(step + 1);
        if (wave < 4) {
#pragma unroll 4
            for (int ks = 0; ks < KC / 32; ++ks) { const bf16x8 a = *(const LAS bf16x8*)(AS + (16 * rt + fr) * LD + ks * 32 + fq * 8);
                const bf16x8 b = *(const LAS bf16x8*)(BS + (16 * ct + fr) * LD + ks * 32 + fq * 8);
                acc = __builtin_amdgcn_mfma_f32_16x16x32_bf16(a, b, acc, 0, 0, 0); }
            if ((step % NSLAB) == NSLAB - 1) { const int tile = blockIdx.x + (step / NSLAB) * gridDim.x, tm = tile >> 5, tn = tile & 31;
#pragma unroll
                for (int e = 0; e < 4; ++e) { const size_t o = (size_t)(tm * 32 + 16 * rt + fq * 4 + e) * 1024 + tn * 32 + 16 * ct + fr;
                    if (MODE == 0) Cf[o] = acc[e]; else Cb[o] = f2bf(acc[e]); }
                acc = (f32x4){0.f, 0.f, 0.f, 0.f}; }
        }
        __syncthreads();
    }
}

#ifndef REP_SYNC
#define REP_SYNC 1
#endif
#define GSYNC() do { _Pragma("unroll 1") for (int _r = 0; _r < REP_SYNC; ++_r) xcd_barrier(xb); } while (0)
#ifndef REP_SAMP
#define REP_SAMP 1
#endif
#ifndef REP_SSD
#define REP_SSD 1
#endif
#ifndef REP_ROWS
#define REP_ROWS 1
#endif
#ifndef REP_P0
#define REP_P0 1
#endif
#ifndef REP_GEMM
#define REP_GEMM 1
#endif
#ifndef REP_MIX
#define REP_MIX 1
#endif
#ifndef REP_ATT
#define REP_ATT 1
#endif
__global__ void __launch_bounds__(512) mega(Params p_unused) {
    const KPRM kp = (KPRM)__builtin_amdgcn_kernarg_segment_ptr();
#define PP (*kp_launder(kp))
    extern __shared__ __attribute__((aligned(16))) unsigned char shm[];
    LAS unsigned char* lds = (LAS unsigned char*)shm;
    cg::grid_group grid = cg::this_grid();
    unsigned char* ws = PP.ws;
    bf16_t* H = (bf16_t*)(ws + OFF_H); bf16_t* UB = (bf16_t*)(ws + OFF_U); bf16_t* YC = (bf16_t*)(ws + OFF_YC); bf16_t* M = (bf16_t*)(ws + OFF_M);
    bf16_t* QB = (bf16_t*)(ws + OFF_Q); bf16_t* ACT = (bf16_t*)(ws + OFF_ACT); float* X = PP.out; float* SDT = (float*)(ws + OFF_SDT);
    volatile LAS unsigned* xst = (volatile LAS unsigned*)(lds + 163824);
    unsigned* bar = (unsigned*)(ws + OFF_BAR);
    { const int t0 = tidx(); if (t0 == 0) { xst[0] = 0u; xst[1] = 0u; } if (blockIdx.x == 0) for (int i = t0; i < XCD_BAR_WORDS; i += NTHR) bar[i] = 0u; }
    __syncthreads();
    phase0(PP, lds);
    grid.sync();
    XcdBarrier xb = xcd_barrier_post(bar, xst);
#pragma unroll 1
    for (int rep = 1; rep < REP_P0; ++rep) { phase0(PP, lds); GSYNC(); }
#pragma unroll 1
    for (int l = 0; l < NL; ++l) {
#pragma unroll 1
        for (int rep = 0; rep < REP_GEMM; ++rep) {
            { EpiBf16 e{UB, NU}; run_gemm(lds, H, (const bf16_t*)(ws + OFF_WIN) + (size_t)l * NU * D, TT, NU, D, e, 0); }
            { EpiMemKV e{PP.out + O_PMK + (size_t)l * 8 * 256 * 1024, PP.out + O_PMV + (size_t)l * 8 * 256 * 1024, (bf16_t*)(ws + OFF_KB), (bf16_t*)(ws + OFF_VTB)};
              run_gemm(lds, (const bf16_t*)(ws + OFF_HM) + (size_t)l * 2048 * D, (const bf16_t*)(ws + OFF_WXKV) + (size_t)l * 2048 * D, 2048, 2048, D, e, 64); }
            GSYNC();
        }
#pragma unroll 1
        for (int rep = 0; rep < REP_MIX; ++rep) {
#pragma unroll 1
            for (int grp = 0; grp < 3; ++grp) { const int gsel = (blockIdx.x & 1) ? 2 - grp : grp;
                if (gsel == 0) {
#pragma unroll 1
                    for (int r2 = 0; r2 < REP_SAMP; ++r2)
                    for (int u = blockIdx.x; u < 512; u += gridDim.x) {
                        if (u < 128) sample_ssd(PP, lds, l, u);
                        else if (u < 256) sample_ret(PP, lds, l, u - 128);
                        else if (u < 384) sample_hg(PP, lds, l, u - 256);
                        else sample_rg(PP, lds, l, u - 384);
                    }
                } else if (gsel == 1) {
#pragma unroll 1
                    for (int r2 = 0; r2 < REP_SSD; ++r2)
                    for (int u = blockIdx.x; u < 512; u += gridDim.x) ssd_passA(PP, lds, l, u);
                } else {
#ifdef MIXA_PERHEAD
#pragma unroll 1
                    for (int u = blockIdx.x; u < 1024; u += gridDim.x) mixA_unit(PP, lds, l, u);
#else
#pragma unroll 1
                    for (int u = blockIdx.x; u < 256; u += gridDim.x) { retA4_unit(PP, lds, l, u); hgA4_unit(PP, lds, l, u); }
                    rg_loop<false>(PP, lds, l);
#endif
                }
            }
            GSYNC();
            carry_phase(PP, l);
            GSYNC();
            if ((blockIdx.x & 1) == 0) {
#pragma unroll 1
                for (int r2 = 0; r2 < REP_SSD; ++r2)
                for (int u = blockIdx.x; u < 256; u += gridDim.x) ssd_passC(PP, lds, l, u);
            }
#if 1
#if 1
            ret_loop<true>(PP, lds, l);
#else
#pragma unroll 1
            for (int u = blockIdx.x; u < 512; u += gridDim.x) retC2_unit(PP, lds, l, u);
#endif
            hg_loop<true>(PP, lds, l); rg_loop<true>(PP, lds, l);
            if (blockIdx.x & 1) {
#pragma unroll 1
                for (int r2 = 0; r2 < REP_SSD; ++r2)
                for (int u = blockIdx.x; u < 256; u += gridDim.x) ssd_passC(PP, lds, l, u);
            }
#else
#pragma unroll 1
            for (int u = blockIdx.x; u < 1024; u += gridDim.x) mixC_unit(PP, lds, l, u);
#endif
            GSYNC();
        }
#pragma unroll 1
        for (int rep = 0; rep < REP_GEMM; ++rep) { EpiBf16 e{M, D}; run_gemm(lds, YC, (const bf16_t*)(ws + OFF_WOUT) + (size_t)l * D * D, TP, D, D, e, 0);
            sgemm<1, 1024, 1024>(lds, YC + (size_t)TP * D, (const bf16_t*)(ws + OFF_WOUT) + (size_t)l * D * D, nullptr, M + (size_t)TP * D); GSYNC(); }
        rows_phase(lds, TT, l == 0 ? PP.in[0] : nullptr, l == 0 ? PP.in[1] : nullptr, X, M, PP.in[12] + l * D, PP.in[13] + l * D, H, nullptr, nullptr);
#if REP_ROWS > 1
        rows_phase(lds, TT, nullptr, nullptr, (float*)(ws + OFF_XS), M, PP.in[12] + l * D, PP.in[13] + l * D, (bf16_t*)(ws + OFF_HS), nullptr, nullptr);
#endif
        GSYNC();
#pragma unroll 1
        for (int rep = 0; rep < REP_GEMM; ++rep) { EpiBf16 e{QB, D}; run_gemm(lds, H, (const bf16_t*)(ws + OFF_WXQ) + (size_t)l * D * D, TP, D, D, e, 0);
            sgemm<1, 1024, 1024>(lds, H + (size_t)TP * D, (const bf16_t*)(ws + OFF_WXQ) + (size_t)l * D * D, nullptr, QB + (size_t)TP * D); GSYNC(); }
#pragma unroll 1
        for (int rep = 0; rep < REP_ATT; ++rep) {
            for (int k = 0; k < 1024; k += gridDim.x) { const int u = (gridDim.x == 256 && (blockIdx.x & 1)) ? (int)((blockIdx.x + k + 512) & 1023) : (int)(blockIdx.x + k);
                if (u < 512) attn_prompt(PP, lds, u); else if (u < 1024) attn_sample(PP, lds, l, u - 512); }
            GSYNC();
        }
#pragma unroll 1
        for (int rep = 0; rep < REP_GEMM; ++rep) { EpiBf16 e{M, D}; run_gemm(lds, YC, (const bf16_t*)(ws + OFF_WXO) + (size_t)l * D * D, TP, D, D, e, 0);
            sgemm<1, 1024, 1024>(lds, YC + (size_t)TP * D, (const bf16_t*)(ws + OFF_WXO) + (size_t)l * D * D, nullptr, M + (size_t)TP * D); GSYNC(); }
        rows_phase(lds, TT, nullptr, nullptr, X, M, PP.in[14] + l * D, PP.in[15] + l * D, H, nullptr, nullptr);
#if REP_ROWS > 1
        rows_phase(lds, TT, nullptr, nullptr, (float*)(ws + OFF_XS), M, PP.in[14] + l * D, PP.in[15] + l * D, (bf16_t*)(ws + OFF_HS), nullptr, nullptr);
#endif
        GSYNC();
#pragma unroll 1
        for (int rep = 0; rep < REP_GEMM; ++rep) { EpiSwiGLU e{ACT}; run_gemm(lds, H, (const bf16_t*)(ws + OFF_WGU) + (size_t)l * 5632 * D, TT, 5632, D, e, 0); GSYNC(); }
#pragma unroll 1
        for (int rep = 0; rep < REP_GEMM; ++rep) { EpiBf16 e{M, D}; run_gemm(lds, ACT, (const bf16_t*)(ws + OFF_WDN) + (size_t)l * D * DFF, TP, D, DFF, e, 0);
            sgemm<1, 2816, 704>(lds, ACT + (size_t)TP * DFF, (const bf16_t*)(ws + OFF_WDN) + (size_t)l * D * DFF, nullptr, M + (size_t)TP * D); GSYNC(); }
        rows_phase(lds, TT, nullptr, nullptr, X, M, PP.in[16] + l * D, l + 1 < NL ? PP.in[11] + (l + 1) * D : nullptr, H, l + 1 < NL ? PP.in[17] + (size_t)(l + 1) * D * DIN : nullptr, SDT);
#if REP_ROWS > 1
        rows_phase(lds, TT, nullptr, nullptr, (float*)(ws + OFF_XS), M, PP.in[16] + l * D, l + 1 < NL ? PP.in[11] + (l + 1) * D : nullptr, (bf16_t*)(ws + OFF_HS), l + 1 < NL ? PP.in[17] + (size_t)(l + 1) * D * DIN : nullptr, (float*)(ws + OFF_HS));
#endif
        GSYNC();
    }
}

#undef PP
extern "C" void kernel_launch(void* const* d_in, const int* in_sizes, int n_in, void* d_out, int out_size, void* d_ws, size_t ws_size, hipStream_t stream) {
    constexpr int LDS_BYTES = 160 * 1024;
    static int grid = 0;
    if (grid == 0) {
        if (n_in != 41 || (size_t)out_size != O_END || ws_size < WS_END) { fprintf(stderr, "kernel_launch: unexpected shapes (n_in %d out %d ws %zu need %zu)\n", n_in, out_size, ws_size, (size_t)WS_END); grid = -1; return; }
        int dev = 0, cus = 0, per_cu = 0;
        (void)hipGetDevice(&dev);
        (void)hipDeviceGetAttribute(&cus, hipDeviceAttributeMultiprocessorCount, dev);
        (void)hipFuncSetAttribute((const void*)mega, hipFuncAttributeMaxDynamicSharedMemorySize, LDS_BYTES);
        (void)hipOccupancyMaxActiveBlocksPerMultiprocessor(&per_cu, (const void*)mega, 512, LDS_BYTES);
        if (per_cu < 1) { fprintf(stderr, "kernel_launch: occupancy query reports %d blocks per CU\n", per_cu); per_cu = 1; }
        grid = cus < 256 ? cus : 256;
    }
    if (grid < 0) return;
    Params p{};
    for (int i = 0; i < 41; ++i) p.in[i] = (const float*)d_in[i];
    p.out = (float*)d_out; p.ws = (unsigned char*)d_ws;
    void* args[] = {&p};
    hipError_t e = hipLaunchCooperativeKernel((void*)mega, dim3(grid), dim3(512), args, LDS_BYTES, stream);
    if (e != hipSuccess) fprintf(stderr, "cooperative launch failed: %s (grid %d)\n", hipGetErrorString(e), grid);
}
```

```cpp
#include <hip/hip_runtime.h>
#include <hip/hip_cooperative_groups.h>
#include <cstdio>
#include <cstdint>
namespace cg = cooperative_groups;
__device__ __forceinline__ int tidx() { int t = threadIdx.x; asm volatile("" : "+v"(t)); return t; }
namespace pg8 {
#define PG8_LAS __attribute__((address_space(3)))
typedef unsigned short bf16_t;
typedef short bf16x8 __attribute__((ext_vector_type(8)));
typedef float f32x4 __attribute__((ext_vector_type(4)));
typedef unsigned u32x4 __attribute__((ext_vector_type(4)));
constexpr int BM = 256, BK = 64, HALF = 128, HTB = HALF * BK * 2  , STAGE_BYTES = 8 * HTB, NXCD = 8, WGM = 8;

__host__ __device__ __forceinline__ int lds_byte(int r, int c) { const int st = (r >> 4) * 2 + (c >> 5), rr = r & 15, cc = c & 31, ob = rr * 64 + cc * 2; return st * 1024 + (ob ^ (((ob >> 9) & 1) << 5)); }
__host__ __device__ __forceinline__ void stage_rc(int b, int& R, int& C) { const int st = b / 1024, sb = b % 1024, swz = sb ^ (((sb >> 9) & 1) << 5); R = (st >> 1) * 16 + swz / 64; C = (st & 1) * 32 + (swz % 64) / 2; }
__host__ __device__ __forceinline__ int perm32(int rho) { const int n = rho >> 4, i = rho & 15; return 8 * (i >> 2) + 4 * n + (i & 3); }

struct Unit { int pm, pn; };
struct Gemm { const bf16_t* A; const bf16_t* Bt; int M, N, K; };

struct StaticOrder {
    int nM, nN, nwg, G, c;
    __host__ __device__ void init(int M, int N, int G_, int c_) { nM = M / BM; nN = N / BM; nwg = nM * nN; G = G_; c = c_; }
    __host__ __device__ bool next(int i, Unit& u) const {
        const long L = (long)i * G + c; if (L >= nwg) return false;
        int wgid = (int)L; { const int q = nwg / NXCD, r = nwg % NXCD, xcd = wgid % NXCD, off = wgid / NXCD; wgid = (xcd < r ? xcd * (q + 1) : r * (q + 1) + (xcd - r) * q) + off; }
        const int nig = WGM * nN, gid = wgid / nig, fm = gid * WGM, gsz = (nM - fm) < WGM ? (nM - fm) : WGM;
        u.pm = fm + ((wgid % nig) % gsz); u.pn = (wgid % nig) / gsz; return true;
    }
    __device__ __forceinline__ void a_ready(const Unit&) const {}
    __device__ __forceinline__ void done(const Unit&) const {}
};
}
namespace pg8 {
template <class Epi, class Sched, bool STAMP = false>
__device__ __forceinline__ void gemm_phase(PG8_LAS unsigned char* lds, const Gemm g, const Sched& S, const Epi& E, unsigned long long* stamps) {
    const int tid = tidx(), wid = __builtin_amdgcn_readfirstlane(tid >> 6), lane = tid & 63, wr = wid >> 2, wc = wid & 3, fr = lane & 15, fq = lane >> 4;
    const int K = g.K, nt = K / BK;
    int ts_lo = 0, ts_hi = 0, nts = 0; const unsigned long long rt_entry = STAMP ? (unsigned long long)wall_clock64() : 0ull;
#define PG8_STAMP() do { if (STAMP && wid == 0 && nts < 64) { const unsigned long long _c = (unsigned long long)clock64(); \
        ts_lo = (lane == nts) ? (int)(unsigned)_c : ts_lo; ts_hi = (lane == nts) ? (int)(unsigned)(_c >> 32) : ts_hi; ++nts; } } while (0)
    PG8_STAMP();
    unsigned voffA[2], voffB[2];
#pragma unroll
    for (int i = 0; i < 2; ++i) { int R, C; stage_rc(tid * 16 + i * 8192, R, C); const int Rb = Epi::PERM ? ((R & ~31) + perm32(R & 31)) : R;
        voffA[i] = (unsigned)(R * K + C) * 2u; voffB[i] = (unsigned)(Rb * K + C) * 2u; }
    const size_t kstep = (size_t)(BK * 2);
    const size_t hstep = (size_t)HALF * K * 2;
    const size_t tstep = 2 * hstep;
    const unsigned ldsw = (unsigned)wid * 1024u;
    const int aoff = lds_byte(wr * 64 + fr, fq * 8), boff = lds_byte(wc * 32 + fr, fq * 8);
#define PG8_SA(b, h) (((b) * 2 + (h)) * HTB)
#define PG8_SB(b, h) ((4 + (b) * 2 + (h)) * HTB)
#define PG8_STAGE(bufoff, gbase, voff) do { _Pragma("unroll") for (int _i = 0; _i < 2; ++_i) \
        __builtin_amdgcn_global_load_lds((const unsigned*)((const char*)(gbase) + (voff)[_i]), (PG8_LAS unsigned*)(lds + (bufoff) + ldsw + _i * 8192), 16, 0, 0); } while (0)
#define PG8_LDA(dst, b, h) do { _Pragma("unroll") for (int m = 0; m < 4; ++m) _Pragma("unroll") for (int k = 0; k < 2; ++k) dst[m][k] = *(const PG8_LAS bf16x8*)(lds + PG8_SA(b, h) + aoff + m * 2048 + k * 1024); } while (0)
#define PG8_LDB(dst, b, h) do { _Pragma("unroll") for (int n = 0; n < 2; ++n) _Pragma("unroll") for (int k = 0; k < 2; ++k) dst[n][k] = *(const PG8_LAS bf16x8*)(lds + PG8_SB(b, h) + boff + n * 2048 + k * 1024); } while (0)
#define PG8_MMA(ai, bj, At, Bt) do { __builtin_amdgcn_s_setprio(1); _Pragma("unroll") for (int m = 0; m < 4; ++m) _Pragma("unroll") for (int n = 0; n < 2; ++n) _Pragma("unroll") for (int k = 0; k < 2; ++k) \
        acc[ai][bj][m][n] = __builtin_amdgcn_mfma_f32_16x16x32_bf16(Bt[n][k], At[m][k], acc[ai][bj][m][n], 0, 0, 0); __builtin_amdgcn_s_setprio(0); } while (0)
#define PG8_WAIT_V(n) asm volatile("s_waitcnt vmcnt(" #n ")" ::: "memory")
#define PG8_WAIT_L(n) asm volatile("s_waitcnt lgkmcnt(" #n ")" ::: "memory")
#define PG8_BAR __builtin_amdgcn_s_barrier()
#define PG8_SCHED __builtin_amdgcn_sched_barrier(0)
    Unit cur, nxt; int ui = 0;
    if (!S.next(0, cur)) return;
    f32x4 acc[2][2][4][2];
#pragma unroll
    for (int a = 0; a < 2; ++a)
#pragma unroll
        for (int b = 0; b < 2; ++b)
#pragma unroll
            for (int m = 0; m < 4; ++m)
#pragma unroll
                for (int n = 0; n < 2; ++n) acc[a][b][m][n] = (f32x4){0.f, 0.f, 0.f, 0.f};
    bf16x8 At[4][2], B0[2][2], B1[2][2];
    const char* cA = (const char*)g.A + (size_t)cur.pm * tstep; const char* cB = (const char*)g.Bt + (size_t)cur.pn * tstep;
    S.a_ready(cur);
    PG8_STAGE(PG8_SB(0, 0), cB, voffB); PG8_STAGE(PG8_SA(0, 0), cA, voffA); PG8_STAGE(PG8_SB(0, 1), cB + hstep, voffB); PG8_STAGE(PG8_SA(0, 1), cA + hstep, voffA);
    if (wr == 1) PG8_BAR;
    PG8_WAIT_V(4); PG8_BAR;
    PG8_STAGE(PG8_SB(1, 0), cB + kstep, voffB); PG8_STAGE(PG8_SA(1, 0), cA + kstep, voffA); PG8_STAGE(PG8_SB(1, 1), cB + hstep + kstep, voffB);
    PG8_WAIT_V(6); PG8_BAR;
    PG8_STAMP();
    for (;;) {
        const bool has_next = S.next(ui + 1, nxt);
        const char* nA = has_next ? (const char*)g.A + (size_t)nxt.pm * tstep : cA; const char* nB = has_next ? (const char*)g.Bt + (size_t)nxt.pn * tstep : cB;
        for (int t = 0; t < nt; t += 2) {
            const bool last = (t == nt - 2);
            const char* a1 = cA + (size_t)(t + 1) * kstep;
            const char* a2 = last ? nA : cA + (size_t)(t + 2) * kstep; const char* b2 = last ? nB : cB + (size_t)(t + 2) * kstep;
            const char* a3 = a2 + kstep; const char* b3 = b2 + kstep;
            if (last && has_next) S.a_ready(nxt);
            PG8_LDB(B0, 0, 0); PG8_SCHED; PG8_LDA(At, 0, 0); PG8_STAGE(PG8_SA(1, 1), a1 + hstep, voffA);
            PG8_WAIT_L(8); PG8_BAR; PG8_WAIT_L(0); PG8_MMA(0, 0, At, B0); PG8_BAR; PG8_SCHED;
            PG8_LDB(B1, 0, 1); PG8_STAGE(PG8_SB(0, 0), b2, voffB);
            PG8_BAR; PG8_WAIT_L(0); PG8_MMA(0, 1, At, B1); PG8_BAR;
            PG8_LDA(At, 0, 1); PG8_STAGE(PG8_SA(0, 0), a2, voffA);
            PG8_BAR; PG8_WAIT_L(0); PG8_MMA(1, 0, At, B0); PG8_BAR; PG8_SCHED;
            PG8_STAGE(PG8_SB(0, 1), b2 + hstep, voffB);
            PG8_WAIT_V(6); PG8_BAR; PG8_MMA(1, 1, At, B1); PG8_BAR;
            PG8_LDB(B0, 1, 0); PG8_SCHED; PG8_LDA(At, 1, 0); PG8_STAGE(PG8_SA(0, 1), a2 + hstep, voffA);
            PG8_WAIT_L(8); PG8_BAR; PG8_WAIT_L(0); PG8_MMA(0, 0, At, B0); PG8_BAR; PG8_SCHED;
            PG8_LDB(B1, 1, 1); PG8_STAGE(PG8_SB(1, 0), b3, voffB);
            PG8_BAR; PG8_WAIT_L(0); PG8_MMA(0, 1, At, B1); PG8_BAR;
            PG8_LDA(At, 1, 1); PG8_STAGE(PG8_SA(1, 0), a3, voffA);
            PG8_BAR; PG8_WAIT_L(0); PG8_MMA(1, 0, At, B0); PG8_BAR; PG8_SCHED;
            PG8_STAGE(PG8_SB(1, 1), b3 + hstep, voffB);
            PG8_WAIT_V(6); PG8_BAR; PG8_MMA(1, 1, At, B1); PG8_BAR;
        }
        PG8_STAMP();
        if constexpr (!Epi::AFTER_DRAIN) { E(acc, cur, wr, wc, fr, fq); S.done(cur); }
        PG8_STAMP();
        if (!has_next) break;
#pragma unroll
        for (int a = 0; a < 2; ++a)
#pragma unroll
            for (int b = 0; b < 2; ++b)
#pragma unroll
                for (int m = 0; m < 4; ++m)
#pragma unroll
                    for (int n = 0; n < 2; ++n) acc[a][b][m][n] = (f32x4){0.f, 0.f, 0.f, 0.f};
        cur = nxt; cA = nA; cB = nB; ++ui;
    }
    PG8_WAIT_V(0);
    if (wr == 0) PG8_BAR;
    PG8_BAR;
    if constexpr (Epi::AFTER_DRAIN) { E.fused(acc, cur, wr, wc, fr, fq, lds, wid, lane); S.done(cur); }
    PG8_STAMP();
    if (STAMP && wid == 0) { stamps[lane] = lane < nts ? (((unsigned long long)(unsigned)ts_hi << 32) | (unsigned)ts_lo) : 0ull;
        if (lane == 62) stamps[62] = rt_entry; if (lane == 63) stamps[63] = (unsigned long long)wall_clock64(); }
#undef PG8_STAMP
#undef PG8_SA
#undef PG8_SB
#undef PG8_STAGE
#undef PG8_LDA
#undef PG8_LDB
#undef PG8_MMA
#undef PG8_WAIT_V
#undef PG8_WAIT_L
#undef PG8_BAR
#undef PG8_SCHED
}
}

#define LAS __attribute__((address_space(3)))
using pg8::bf16_t; using pg8::bf16x8; using pg8::f32x4; using pg8::u32x4;
typedef unsigned u32x2 __attribute__((ext_vector_type(2)));
typedef float f32x2 __attribute__((ext_vector_type(2)));

constexpr int D = 1024, TP = 16384, TS = 512, TT = TP + TS, NU = 3584, DIN = 3588, DFF = 2816, NL = 2;
constexpr int NTHR = 512;
constexpr float EPS = 1e-6f;
constexpr int UZ = 0, UXBC = 256, URQ = 1024, URK = 1280, URV = 1536, URG = 1792, UGX = 2048, UGY = 2304, UHQ = 2560, UHF = 2816, UHI = 3072, UHG = 3328;
constexpr size_t O_YP = 0, O_YS = O_YP + (size_t)8 * 2048 * 1024, O_PSSD = O_YS + (size_t)128 * 4 * 1024, O_PSSDC = O_PSSD + (size_t)2 * 8 * 4 * 128 * 64,
    O_PRET = O_PSSDC + (size_t)2 * 8 * 3 * 768, O_PRG = O_PRET + (size_t)2 * 8 * 4 * 64 * 64, O_PRGC = O_PRG + (size_t)2 * 8 * 256, O_PHG = O_PRGC + (size_t)2 * 8 * 3 * 256,
    O_PMK = O_PHG + (size_t)2 * 8 * 4 * 64 * 64, O_PMV = O_PMK + (size_t)2 * 8 * 256 * 1024, O_SSSD = O_PMV + (size_t)2 * 8 * 256 * 1024, O_SSSDC = O_SSSD + (size_t)2 * 128 * 4 * 128 * 64,
    O_SRET = O_SSSDC + (size_t)2 * 128 * 3 * 768, O_SRG = O_SRET + (size_t)2 * 128 * 4 * 64 * 64, O_SRGC = O_SRG + (size_t)2 * 128 * 256, O_SHG = O_SRGC + (size_t)2 * 128 * 3 * 256,
    O_END = O_SHG + (size_t)2 * 128 * 4 * 64 * 64;
constexpr size_t OFF_WIN = 0, OFF_WOUT = OFF_WIN + (size_t)NL * NU * D * 2, OFF_WXQ = OFF_WOUT + (size_t)NL * D * D * 2, OFF_WXO = OFF_WXQ + (size_t)NL * D * D * 2,
    OFF_WXKV = OFF_WXO + (size_t)NL * D * D * 2, OFF_WGU = OFF_WXKV + (size_t)NL * 2048 * D * 2, OFF_WDN = OFF_WGU + (size_t)NL * 5632 * D * 2, OFF_WRG = OFF_WDN + (size_t)NL * D * DFF * 2,
    OFF_ROPE = OFF_WRG + (size_t)NL * 2 * 4 * 64 * 64 * 2, OFF_H = OFF_ROPE + (size_t)2052 * 32 * 2 * 4, OFF_HM = OFF_H + (size_t)TT * D * 2, OFF_U = OFF_HM + (size_t)NL * 2048 * D * 2,
    OFF_SDT = OFF_U + (size_t)TT * NU * 2, OFF_YC = OFF_SDT + (size_t)TT * 4 * 4, OFF_M = OFF_YC + (size_t)TT * D * 2, OFF_Q = OFF_M + (size_t)TT * D * 4, OFF_ACT = OFF_Q + (size_t)TT * D * 2,
    OFF_KB = OFF_ACT + (size_t)TT * DFF * 2, OFF_VTB = OFF_KB + (size_t)8 * 4 * 256 * 256 * 2, OFF_DSS = OFF_VTB + (size_t)8 * 4 * 256 * 256 * 2, OFF_DECS = OFF_DSS + (size_t)8 * 4 * 32 * 8192 * 4,
    OFF_DSR = OFF_DECS + 4096, OFF_DSH = OFF_DSR + (size_t)8 * 4 * 32 * 4096 * 4, OFF_DECH = OFF_DSH + (size_t)8 * 4 * 32 * 4096 * 4, OFF_RGH = OFF_DECH + (size_t)8 * 4 * 32 * 64 * 4,
    OFF_RGA = OFF_RGH + (size_t)8 * 32 * 256 * 4, OFF_RGC = OFF_RGA + (size_t)8 * 32 * 256 * 4, OFF_BAR = OFF_RGC + (size_t)8 * 32 * 256 * 4, OFF_LB = OFF_BAR + 16384, OFF_XS = OFF_LB + 4096, OFF_HS = OFF_XS + (size_t)TT * D * 4, WS_END = OFF_HS + (size_t)TT * D * 2;

struct Params { const float* in[41]; float* out; unsigned char* ws; };
typedef const __attribute__((address_space(4))) Params* KPRM;
typedef const __attribute__((address_space(4))) Params& PRM;
__device__ __forceinline__ KPRM kp_launder(KPRM k) { asm volatile("" : "+s"(k)); return k; }

__device__ __forceinline__ float bf2f(bf16_t b) { return __uint_as_float(((unsigned)b) << 16); }
__device__ __forceinline__ unsigned pk2(float lo, float hi) { unsigned r; asm volatile("v_cvt_pk_bf16_f32 %0, %1, %2" : "=v"(r) : "v"(lo), "v"(hi)); return r; }
__device__ __forceinline__ bf16_t f2bf(float f) { return (bf16_t)(pk2(f, f) & 0xffffu); }
__device__ __forceinline__ float sigmoidf_(float x) { return __builtin_amdgcn_rcpf(1.0f + __expf(-x)); }
__device__ __forceinline__ float siluf_(float x) { return x * __builtin_amdgcn_rcpf(1.0f + __expf(-x)); }
__device__ __forceinline__ float siluf_div(float x) { return x / (1.0f + __expf(-x)); }
__device__ __forceinline__ float softplusf_(float x) { const float e = __expf(-fabsf(x)); const float l1p = e < 1.0e-3f ? e * (1.0f - e * (0.5f - e * 0.33333333f)) : __logf(1.0f + e); return fmaxf(x, 0.0f) + l1p; }
__device__ __forceinline__ float geluf_(float x) { const float u = 0.7978845608028654f * (x + 0.044715f * x * x * x); return x * __builtin_amdgcn_rcpf(1.0f + __expf(-2.0f * u)); }
#define DPP_F(old, src, ctrl, rmask) __int_as_float(__builtin_amdgcn_update_dpp(__float_as_int(old), __float_as_int(src), (ctrl), (rmask), 0xf, false))
#define DPP_ROR(v, n) DPP_F(0.f, v, 0x120 + (n), 0xf)
__device__ __forceinline__ float row16_sum(float v) { v += DPP_ROR(v, 8); v += DPP_ROR(v, 4); v += DPP_ROR(v, 2); v += DPP_ROR(v, 1); return v; }
__device__ __forceinline__ float row16_max(float v) { v = fmaxf(v, DPP_ROR(v, 8)); v = fmaxf(v, DPP_ROR(v, 4)); v = fmaxf(v, DPP_ROR(v, 2)); v = fmaxf(v, DPP_ROR(v, 1)); return v; }
__device__ __forceinline__ float rl_(float v, int lane) { return __int_as_float(__builtin_amdgcn_readlane(__float_as_int(v), lane)); }
__device__ __forceinline__ float wave_sum(float v) { v = row16_sum(v); return (rl_(v, 0) + rl_(v, 16)) + (rl_(v, 32) + rl_(v, 48)); }
__device__ __forceinline__ float wave_max(float v) { v = row16_max(v); return fmaxf(fmaxf(rl_(v, 0), rl_(v, 16)), fmaxf(rl_(v, 32), rl_(v, 48))); }
template <int NT, int KS>
__device__ __forceinline__ void mm_nt(f32x4 (&acc)[NT], const LAS bf16_t* A, int lda, const LAS bf16_t* B, int ldb, int lane) {
    const int r = lane & 15, q = (lane >> 4) * 8;
#pragma unroll
    for (int ks = 0; ks < KS; ++ks) {
        const bf16x8 a = *(const LAS bf16x8*)(A + r * lda + ks * 32 + q);
#pragma unroll
        for (int j = 0; j < NT; ++j) {
            const bf16x8 b = *(const LAS bf16x8*)(B + (16 * j + r) * ldb + ks * 32 + q);
            acc[j] = __builtin_amdgcn_mfma_f32_16x16x32_bf16(a, b, acc[j], 0, 0, 0);
        }
    }
}

struct EpiBf16 {
    static constexpr bool PERM = true, AFTER_DRAIN = false;
    bf16_t* O; int ldc;
    __device__ __forceinline__ void operator()(const f32x4 (&acc)[2][2][4][2], const pg8::Unit& u, int wr, int wc, int fr, int fq) const {
        const int row0 = u.pm * 256 + wr * 64 + fr, col0 = u.pn * 256 + wc * 32 + 8 * fq;
#pragma unroll
        for (int ai = 0; ai < 2; ++ai)
#pragma unroll
            for (int m = 0; m < 4; ++m) {
                bf16_t* rowp = O + (size_t)(row0 + ai * 128 + m * 16) * ldc + col0;
#pragma unroll
                for (int bj = 0; bj < 2; ++bj) {
                    const f32x4 v0 = acc[ai][bj][m][0], v1 = acc[ai][bj][m][1];
                    u32x4 w; w.x = pk2(v0[0], v0[1]); w.y = pk2(v0[2], v0[3]); w.z = pk2(v1[0], v1[1]); w.w = pk2(v1[2], v1[3]);
                    *(u32x4*)(rowp + bj * 128) = w;
                }
            }
    }
};
struct EpiF32 {
    static constexpr bool PERM = false, AFTER_DRAIN = false;
    float* C; int ldc;
    __device__ __forceinline__ void operator()(const f32x4 (&acc)[2][2][4][2], const pg8::Unit& u, int wr, int wc, int fr, int fq) const {
        const int row0 = u.pm * 256 + wr * 64 + fr, col0 = u.pn * 256 + wc * 32 + 4 * fq;
#pragma unroll
        for (int ai = 0; ai < 2; ++ai)
#pragma unroll
            for (int m = 0; m < 4; ++m) {
                float* rowp = C + (size_t)(row0 + ai * 128 + m * 16) * ldc + col0;
#pragma unroll
                for (int bj = 0; bj < 2; ++bj)
#pragma unroll
                    for (int n = 0; n < 2; ++n) *(f32x4*)(rowp + bj * 128 + n * 16) = acc[ai][bj][m][n];
            }
    }
};
struct EpiSwiGLU {
    static constexpr bool PERM = true, AFTER_DRAIN = false;
    bf16_t* O;
    __device__ __forceinline__ void operator()(const f32x4 (&acc)[2][2][4][2], const pg8::Unit& u, int wr, int wc, int fr, int fq) const {
        const int row0 = u.pm * 256 + wr * 64 + fr, col0 = u.pn * 128 + wc * 32 + 8 * fq;
#pragma unroll
        for (int ai = 0; ai < 2; ++ai)
#pragma unroll
            for (int m = 0; m < 4; ++m) {
                bf16_t* rowp = O + (size_t)(row0 + ai * 128 + m * 16) * DFF + col0;
                const f32x4 g0 = acc[ai][0][m][0], g1 = acc[ai][0][m][1], u0 = acc[ai][1][m][0], u1 = acc[ai][1][m][1];
                u32x4 w;
                w.x = pk2(siluf_(g0[0]) * u0[0], siluf_(g0[1]) * u0[1]); w.y = pk2(siluf_(g0[2]) * u0[2], siluf_(g0[3]) * u0[3]);
                w.z = pk2(siluf_(g1[0]) * u1[0], siluf_(g1[1]) * u1[1]); w.w = pk2(siluf_(g1[2]) * u1[2], siluf_(g1[3]) * u1[3]);
                *(u32x4*)rowp = w;
            }
    }
};
struct EpiMemKV {
    static constexpr bool PERM = false, AFTER_DRAIN = false;
    float* kout; float* vout; bf16_t* KB; bf16_t* VTB;
    __device__ __forceinline__ void operator()(const f32x4 (&acc)[2][2][4][2], const pg8::Unit& u, int wr, int wc, int fr, int fq) const {
        const int row0 = u.pm * 256 + wr * 64 + fr, col0 = u.pn * 256 + wc * 32 + 4 * fq;
#pragma unroll
        for (int ai = 0; ai < 2; ++ai)
#pragma unroll
            for (int m = 0; m < 4; ++m) {
                const int row = row0 + ai * 128 + m * 16, b = row >> 8, key = row & 255;
#pragma unroll
                for (int bj = 0; bj < 2; ++bj)
#pragma unroll
                    for (int n = 0; n < 2; ++n) {
                        const int col = col0 + bj * 128 + n * 16; const f32x4 v = acc[ai][bj][m][n];
                        if (col < 1024) {
                            *(f32x4*)(kout + (size_t)row * 1024 + col) = v;
                            u32x2 w; w.x = pk2(v[0], v[1]); w.y = pk2(v[2], v[3]);
                            *(u32x2*)(KB + ((size_t)(b * 4 + (col >> 8)) * 256 + key) * 256 + (col & 255)) = w;
                        } else {
                            const int c2 = col - 1024;
                            *(f32x4*)(vout + (size_t)row * 1024 + c2) = v;
                            bf16_t* vp = VTB + ((size_t)(b * 4 + (c2 >> 8)) * 256 + (c2 & 255)) * 256 + key;
                            vp[0] = f2bf(v[0]); vp[256] = f2bf(v[1]); vp[512] = f2bf(v[2]); vp[768] = f2bf(v[3]);
                        }
                    }
            }
    }
};
template <class Epi>
__device__ __forceinline__ void run_gemm(LAS unsigned char* lds, const bf16_t* A, const bf16_t* Bt, int M, int N, int K, const Epi& E, int cshift) {
    asm volatile("" : "+s"(M), "+s"(N), "+s"(K));
    pg8::Gemm g{A, Bt, M, N, K};
    pg8::StaticOrder S; S.init(M, N, (int)gridDim.x, (int)((blockIdx.x + cshift) % gridDim.x));
    pg8::gemm_phase<Epi, pg8::StaticOrder, false>(lds, g, S, E, nullptr);
}

struct TItem { const float* src; bf16_t* dst; int ldw, K, k0, srcc, dstr; };
constexpr int I_IN = 16 * 112, I_SQ = 16 * 32, I_KV = 16 * 64, I_GU = 16 * 176, I_DN = 44 * 32, I_RG = 16;
constexpr int I_PER = I_IN + 3 * I_SQ + I_KV + I_GU + I_DN + I_RG;
__device__ __forceinline__ bool titem(PRM p, int it, TItem& T) {
    if (it >= NL * I_PER) return false;
    const int l = it / I_PER; int r = it % I_PER;
    unsigned char* ws = p.ws;
    if (r < I_IN) { const int kb = r / 112, n0 = (r % 112) * 32; T.src = p.in[17] + (size_t)l * D * DIN; T.ldw = DIN; T.K = D; T.k0 = kb * 64; T.srcc = n0 < 1024 ? n0 : n0 + 4;
        T.dst = (bf16_t*)(ws + OFF_WIN) + (size_t)l * NU * D; T.dstr = n0; return true; }
    r -= I_IN;
    if (r < 3 * I_SQ) { const int which = r / I_SQ; r %= I_SQ; const int kb = r / 32, n0 = (r % 32) * 32;
        T.src = p.in[which == 0 ? 34 : (which == 1 ? 36 : 38)] + (size_t)l * D * D; T.ldw = D; T.K = D; T.k0 = kb * 64; T.srcc = n0;
        T.dst = (bf16_t*)(ws + (which == 0 ? OFF_WOUT : (which == 1 ? OFF_WXQ : OFF_WXO))) + (size_t)l * D * D; T.dstr = n0; return true; }
    r -= 3 * I_SQ;
    if (r < I_KV) { const int kb = r / 64, n0 = (r % 64) * 32; T.src = p.in[37] + (size_t)l * D * 2048; T.ldw = 2048; T.K = D; T.k0 = kb * 64; T.srcc = n0;
        T.dst = (bf16_t*)(ws + OFF_WXKV) + (size_t)l * 2048 * D; T.dstr = n0; return true; }
    r -= I_KV;
    if (r < I_GU) { const int kb = r / 176, n0 = (r % 176) * 32; const int pn = n0 >> 8, bj = (n0 & 255) >> 7, j = n0 & 127;
        T.src = p.in[39] + (size_t)l * D * 5632; T.ldw = 5632; T.K = D; T.k0 = kb * 64; T.srcc = bj * DFF + pn * 128 + j;
        T.dst = (bf16_t*)(ws + OFF_WGU) + (size_t)l * 5632 * D; T.dstr = n0; return true; }
    r -= I_GU;
    if (r < I_DN) { const int kb = r / 32, n0 = (r % 32) * 32; T.src = p.in[40] + (size_t)l * DFF * D; T.ldw = D; T.K = DFF; T.k0 = kb * 64; T.srcc = n0;
        T.dst = (bf16_t*)(ws + OFF_WDN) + (size_t)l * D * DFF; T.dstr = n0; return true; }
    r -= I_DN;
    { const int gate = r >> 3, blk = (r & 7) >> 1, nb = r & 1;
        T.src = p.in[gate ? 29 : 27] + (size_t)(l * 4 + blk) * 4096; T.ldw = 64; T.K = 64; T.k0 = 0; T.srcc = nb * 32;
        T.dst = (bf16_t*)(ws + OFF_WRG) + (size_t)((l * 2 + gate) * 4 + blk) * 4096; T.dstr = nb * 32; return true; }
}

__device__ __forceinline__ void rows_phase(LAS unsigned char* lds, int nrows, const float* xp, const float* xs, float* X, const bf16_t* M, const float* gpost,
                                           const float* gpre, bf16_t* H, const float* wdt, float* SDT) {
    const int tid = tidx(), lane = tid & 63, wave = tid >> 6;
    const int gw = blockIdx.x * 8 + wave, NGW = gridDim.x * 8;
    LAS float* wl = (LAS float*)lds;
    if (wdt) { for (int i = tid; i < 4096; i += NTHR) wl[i] = wdt[(size_t)(i >> 2) * DIN + 1024 + (i & 3)]; __syncthreads(); }
    constexpr int NR = 4;
    for (int rowb = gw; rowb < nrows; rowb += NR * NGW) {
        f32x4 v[NR][4], m[NR][4];
        bool ok[NR];
#pragma unroll
        for (int q = 0; q < NR; ++q) { const int row = rowb + q * NGW; ok[q] = row < nrows;
            if (ok[q]) {
                const float* xr = xp ? (row < TP ? xp + (size_t)row * D : xs + (size_t)(row - TP) * D) : X + (size_t)row * D;
#pragma unroll
                for (int j = 0; j < 4; ++j) v[q][j] = ((const f32x4*)xr)[lane + 64 * j];
                if (M) {
#pragma unroll
                    for (int j = 0; j < 4; ++j) { const u32x2 w = ((const u32x2*)(M + (size_t)row * D))[lane + 64 * j];
                        m[q][j] = (f32x4){__uint_as_float(w.x << 16), __uint_as_float(w.x & 0xffff0000u), __uint_as_float(w.y << 16), __uint_as_float(w.y & 0xffff0000u)}; }
                }
            } }
#pragma unroll
        for (int q = 0; q < NR; ++q) { const int row = rowb + q * NGW;
            if (!ok[q]) continue;
            if (M) {
                float ss = 0.f;
#pragma unroll
                for (int j = 0; j < 4; ++j) ss += m[q][j].x * m[q][j].x + m[q][j].y * m[q][j].y + m[q][j].z * m[q][j].z + m[q][j].w * m[q][j].w;
                const float rstd = 1.0f / sqrtf(wave_sum(ss) * (1.0f / D) + EPS);
#pragma unroll
                for (int j = 0; j < 4; ++j) { const f32x4 g = ((const f32x4*)gpost)[lane + 64 * j]; v[q][j] = v[q][j] + m[q][j] * rstd * g; }
            }
            if (X && (M || xp)) {
#pragma unroll
                for (int j = 0; j < 4; ++j) ((f32x4*)(X + (size_t)row * D))[lane + 64 * j] = v[q][j];
            }
            if (gpre) {
                float ss = 0.f;
#pragma unroll
                for (int j = 0; j < 4; ++j) ss += v[q][j].x * v[q][j].x + v[q][j].y * v[q][j].y + v[q][j].z * v[q][j].z + v[q][j].w * v[q][j].w;
                const float rstd = 1.0f / sqrtf(wave_sum(ss) * (1.0f / D) + EPS);
                float d0 = 0.f, d1 = 0.f, d2 = 0.f, d3 = 0.f;
#pragma unroll
                for (int j = 0; j < 4; ++j) {
                    const f32x4 g = ((const f32x4*)gpre)[lane + 64 * j]; const f32x4 h = v[q][j] * rstd * g;
                    u32x2 w; w.x = pk2(h.x, h.y); w.y = pk2(h.z, h.w);
                    ((u32x2*)(H + (size_t)row * D))[lane + 64 * j] = w;
                    if (wdt) {
#pragma unroll
                        for (int e = 0; e < 4; ++e) { const f32x4 wv = *(const LAS f32x4*)(wl + 4 * (4 * (lane + 64 * j) + e)); const float he = h[e];
                            d0 += he * wv.x; d1 += he * wv.y; d2 += he * wv.z; d3 += he * wv.w; }
                    }
                }
                if (wdt) { d0 = wave_sum(d0); d1 = wave_sum(d1); d2 = wave_sum(d2); d3 = wave_sum(d3);
                    if (lane == 0) { f32x4 o; o.x = d0; o.y = d1; o.z = d2; o.w = d3; *(f32x4*)(SDT + (size_t)row * 4) = o; } }
            }
        }
    }
    if (wdt) __syncthreads();
}

__device__ __forceinline__ void transposes(PRM p, LAS unsigned char* lds, int it_lo, int it_hi, int gwv, int ngw) {
    const int tid = tidx(), lane = tid & 63, wave = tid >> 6;
    LAS float* scr = (LAS float*)lds + wave * (64 * 33);
    for (int base = it_lo; base < it_hi; base += ngw) {
        TItem T; const bool ok = (base + gwv < it_hi) && titem(p, base + gwv, T);
        if (ok) {
            float tv[32];
#pragma unroll
            for (int i = 0; i < 32; ++i) tv[i] = T.src[(size_t)(T.k0 + 2 * i + (lane >> 5)) * T.ldw + T.srcc + (lane & 31)];
#pragma unroll
            for (int i = 0; i < 32; ++i) scr[(2 * i + (lane >> 5)) * 33 + (lane & 31)] = tv[i];
        }
        __syncthreads();
        if (ok) {
            const int c = lane & 7;
#pragma unroll
            for (int j = 0; j < 4; ++j) { const int n = (lane >> 3) + 8 * j; const LAS float* s = scr + (8 * c) * 33 + n;
                u32x4 o; o.x = pk2(s[0 * 33], s[1 * 33]); o.y = pk2(s[2 * 33], s[3 * 33]); o.z = pk2(s[4 * 33], s[5 * 33]); o.w = pk2(s[6 * 33], s[7 * 33]);
                *(u32x4*)(T.dst + (size_t)(T.dstr + n) * T.K + T.k0 + 8 * c) = o; }
        }
        __syncthreads();
    }
}

__device__ __forceinline__ void phase0(PRM p, LAS unsigned char* lds) {
    const int tid = tidx(), lane = tid & 63, wave = tid >> 6;
    const int gw = blockIdx.x * 8 + wave, NGW = gridDim.x * 8;
    transposes(p, lds, 0, NL * I_PER, gw, NGW);
    float* RC = (float*)(p.ws + OFF_ROPE); float* RS = RC + 2052 * 32;
    for (int i = blockIdx.x * NTHR + tid; i < 2052 * 32; i += gridDim.x * NTHR) {
        const int pi = i >> 5, j = i & 31;
        const double pos = pi < 2048 ? (double)pi : (double)(16384 + pi - 2048);
        const double inv = exp2(-(double)j * (13.287712379549449 / 32.0));
        const double ang = pos * inv;
        const double r = ang - 6.283185307179586 * rint(ang * 0.15915494309189535);
        const float rf = (float)r;
        RC[i] = cosf(rf); RS[i] = sinf(rf);
    }
    if (blockIdx.x == 0 && tid < 256) { const float a0 = p.in[32][tid], a1 = p.in[32][256 + tid]; const float mx = fmaxf(a0, a1), e0 = expf(a0 - mx), e1 = expf(a1 - mx);
        ((float*)(p.ws + OFF_LB))[tid] = 0.f; ((float*)(p.ws + OFF_LB))[256 + tid] = e1 / (e0 + e1); }
    rows_phase(lds, TT, p.in[0], p.in[1], nullptr, nullptr, nullptr, p.in[11], (bf16_t*)(p.ws + OFF_H), p.in[17], (float*)(p.ws + OFF_SDT));
    for (int l = 0; l < NL; ++l)
        rows_phase(lds, 2048, p.in[10], nullptr, nullptr, nullptr, nullptr, p.in[35] + l * D, (bf16_t*)(p.ws + OFF_HM) + (size_t)l * 2048 * D, nullptr, nullptr);
}
#define XB_TMO      128
#define XB_XCNT(j)  (256  + 64 * (j))
#define XB_XSUB(j)  (1280 + 64 * (j))
#define XB_XGEN(j)  (2304 + 64 * (j))
#define XB_TOP      3328
#define XB_TOPGEN   3392
#define XCD_BAR_WORDS 3456
#define XB_SPIN_CAP (1u << 18)

__device__ __forceinline__ unsigned xb_ld(unsigned* p)              { return __hip_atomic_load(p, __ATOMIC_RELAXED, __HIP_MEMORY_SCOPE_AGENT); }
__device__ __forceinline__ unsigned xb_add(unsigned* p, unsigned v) { return __hip_atomic_fetch_add(p, v, __ATOMIC_RELAXED, __HIP_MEMORY_SCOPE_AGENT); }
__device__ __forceinline__ unsigned xb_xcc_id() { return (unsigned)__builtin_amdgcn_s_getreg((3 << 11) | 20) & 0xFu; }
#define XB_SPIN(cond, bar) do { unsigned _sp = 0; while (cond) { __builtin_amdgcn_s_sleep(1); \
    if ((++_sp & 255u) == 0u) { if (xb_ld(&(bar)[XB_TMO])) break; if (_sp > XB_SPIN_CAP) { atomicAdd(&(bar)[XB_TMO], 1u); break; } } } } while (0)

struct XcdBarrier {
    unsigned* bar; unsigned x;
    volatile LAS unsigned* st;
};

__device__ __forceinline__ XcdBarrier xcd_barrier_post(unsigned* bar, volatile LAS unsigned* st) {
    XcdBarrier b; b.bar = bar; b.x = xb_xcc_id(); b.st = st;
    if (tidx() == 0) (void)xb_add(&bar[XB_XCNT(b.x)], 1u);
    return b;
}
__device__ __forceinline__ void xcd_barrier_complete(unsigned* bar, unsigned x, unsigned& nloc, unsigned& nx) {
    const unsigned G = gridDim.x * gridDim.y * gridDim.z;
    unsigned sum, cnt, mine, sp = 0u;
    for (;;) {
        sum = 0u; cnt = 0u; mine = 0u;
#pragma unroll
        for (unsigned j = 0; j < 16; ++j) { const unsigned c = xb_ld(&bar[XB_XCNT(j)]); sum += c; cnt += (c > 0u) ? 1u : 0u; mine = (j == x) ? c : mine; }
        if (sum == G) break;
        __builtin_amdgcn_s_sleep(1);
        if ((++sp & 255u) == 0u) { if (xb_ld(&bar[XB_TMO])) break; if (sp > XB_SPIN_CAP) { atomicAdd(&bar[XB_TMO], 1u); break; } }
    }
    nloc = mine > 0u ? mine : 1u; nx = cnt > 0u ? cnt : 1u;
}

__device__ __forceinline__ void xcd_barrier(const XcdBarrier& b) {
    asm volatile("s_waitcnt vmcnt(0)" ::: "memory");
    __syncthreads();
    if (tidx() == 0) {
        unsigned* bar = b.bar;
        __builtin_amdgcn_s_waitcnt(0);
        unsigned nloc = b.st[0], nx = b.st[1];
        if (nloc == 0u) { xcd_barrier_complete(bar, b.x, nloc, nx); b.st[0] = nloc; b.st[1] = nx; }
        const unsigned old = xb_add(&bar[XB_XSUB(b.x)], 1u);
        const unsigned gen = old / nloc;
        if (old + 1u == (gen + 1u) * nloc) {
            __builtin_amdgcn_fence(__ATOMIC_RELEASE, "agent");
            asm volatile("s_waitcnt vmcnt(0)" ::: "memory");
            const unsigned og = xb_add(&bar[XB_TOP], 1u);
            const unsigned tg = og / nx;
            if (og + 1u == (tg + 1u) * nx) xb_add(&bar[XB_TOPGEN], 1u);
            else XB_SPIN(xb_ld(&bar[XB_TOPGEN]) == tg, bar);
            __builtin_amdgcn_fence(__ATOMIC_ACQUIRE, "agent");
            xb_add(&bar[XB_XGEN(b.x)], 1u);
            asm volatile("s_waitcnt vmcnt(0)" ::: "memory");
        } else {
            XB_SPIN(xb_ld(&bar[XB_XGEN(b.x)]) == gen, bar);
            __builtin_amdgcn_fence(__ATOMIC_ACQUIRE, "agent");
            asm volatile("s_waitcnt vmcnt(0)" ::: "memory");
        }
    }
    __syncthreads();
}


template <int NTOK>
__device__ __forceinline__ void conv_run(const bf16_t* Ucol, bool hist_ok, float w0, float w1, float w2, float w3, float bias, float (&out)[NTOK]) {
    float x3 = 0.f, x2 = 0.f, x1 = 0.f;
    if (hist_ok) { x3 = bf2f(Ucol[-3 * NU]); x2 = bf2f(Ucol[-2 * NU]); x1 = bf2f(Ucol[-NU]); }
#pragma unroll
    for (int i = 0; i < NTOK; ++i) { const float x0 = bf2f(Ucol[i * NU]); out[i] = bias + w0 * x3 + w1 * x2 + w2 * x1 + w3 * x0; x3 = x2; x2 = x1; x1 = x0; }
}
__device__ __forceinline__ float scan64_add(float v, int lane) {
    (void)lane;
    v += DPP_F(0.f, v, 0x111, 0xf); v += DPP_F(0.f, v, 0x112, 0xf); v += DPP_F(0.f, v, 0x114, 0xf); v += DPP_F(0.f, v, 0x118, 0xf);
    v += DPP_F(0.f, v, 0x142, 0xa); v += DPP_F(0.f, v, 0x143, 0xc);
    return v;
}
__device__ __forceinline__ void scan64_lin(float& A, float& B) {
#define LIN_STEP(ctrl, rmask) { const float Ap = DPP_F(1.f, A, ctrl, rmask), Bp = DPP_F(0.f, B, ctrl, rmask); B = A * Bp + B; A = A * Ap; }
    LIN_STEP(0x111, 0xf) LIN_STEP(0x112, 0xf) LIN_STEP(0x114, 0xf) LIN_STEP(0x118, 0xf) LIN_STEP(0x142, 0xa) LIN_STEP(0x143, 0xc)
#undef LIN_STEP
}


__device__ __forceinline__ void unpack8(const u32x4 w, float (&f)[8]) {
    f[0] = __uint_as_float(w.x << 16); f[1] = __uint_as_float(w.x & 0xffff0000u); f[2] = __uint_as_float(w.y << 16); f[3] = __uint_as_float(w.y & 0xffff0000u);
    f[4] = __uint_as_float(w.z << 16); f[5] = __uint_as_float(w.z & 0xffff0000u); f[6] = __uint_as_float(w.w << 16); f[7] = __uint_as_float(w.w & 0xffff0000u);
}
__device__ __forceinline__ u32x4 pack8(const float (&f)[8]) { u32x4 w; w.x = pk2(f[0], f[1]); w.y = pk2(f[2], f[3]); w.z = pk2(f[4], f[5]); w.w = pk2(f[6], f[7]); return w; }
__device__ __forceinline__ u32x4 ldg8(const bf16_t* p) { return *(const u32x4*)p; }
__device__ __forceinline__ bf16_t elem8(const u32x4 w, int i) { const unsigned x = (i >> 1) == 0 ? w.x : ((i >> 1) == 1 ? w.y : ((i >> 1) == 2 ? w.z : w.w)); return (bf16_t)((i & 1) ? (x >> 16) : (x & 0xffffu)); }
__device__ __forceinline__ void ld8f(const float* p, float (&f)[8]) { const f32x4 a = *(const f32x4*)p, b = *(const f32x4*)(p + 4); f[0] = a.x; f[1] = a.y; f[2] = a.z; f[3] = a.w; f[4] = b.x; f[5] = b.y; f[6] = b.z; f[7] = b.w; }
template <int NT>
__device__ __forceinline__ void conv8(const u32x4 (&rows)[NT + 3], const float (&w)[4][8], const float (&bias)[8], float (&o)[NT][8]) {
    float x[NT + 3][8];
#pragma unroll
    for (int r = 0; r < NT + 3; ++r) unpack8(rows[r], x[r]);
#pragma unroll
    for (int t = 0; t < NT; ++t)
#pragma unroll
        for (int i = 0; i < 8; ++i) o[t][i] = bias[i] + w[0][i] * x[t][i] + w[1][i] * x[t + 1][i] + w[2][i] * x[t + 2][i] + w[3][i] * x[t + 3][i];
}

__device__ __forceinline__ void ssd_passA(PRM p, LAS unsigned char* lds, int l, int u) {
    const int tid = tidx(), lane = tid & 63, wave = tid >> 6;
    const int c = u & 31, g = (u >> 5) & 1, b = u >> 6, row0 = b * 2048 + c * 64;
    const bf16_t* U = (const bf16_t*)(p.ws + OFF_U); const float* SDT = (const float*)(p.ws + OFF_SDT);
    LAS float* DT = (LAS float*)lds; LAS float* CU = DT + 128;
    LAS bf16_t* BT = (LAS bf16_t*)(lds + 1024); LAS bf16_t* VT = (LAS bf16_t*)(lds + 1024 + 18432);
    const int chl0 = (tid & 31) * 8, t0 = (tid >> 5) * 4;
    const int xc0 = chl0 < 128 ? g * 128 + chl0 : 256 + g * 128 + (chl0 - 128);
    u32x4 rows[7];
#pragma unroll
    for (int r = 0; r < 7; ++r) { const int t = t0 - 3 + r; rows[r] = (c > 0 || t >= 0) ? ldg8(U + (size_t)(row0 + t) * NU + UXBC + xc0) : (u32x4){0u, 0u, 0u, 0u}; }
    float w[4][8], bias[8];
#pragma unroll
    for (int j = 0; j < 4; ++j) ld8f(p.in[18] + (size_t)(l * 4 + j) * 768 + xc0, w[j]);
    ld8f(p.in[19] + l * 768 + xc0, bias);
    if (wave < 2) {
        const int h = 2 * g + wave;
        const float dt = softplusf_(SDT[(size_t)(row0 + lane) * 4 + h] + p.in[20][l * 4 + h]);
        const float cum = scan64_add(-expf(p.in[21][l * 4 + h]) * dt, lane);
        DT[wave * 64 + lane] = dt; CU[wave * 64 + lane] = cum;
    }
    float o[4][8]; conv8<4>(rows, w, bias, o);
    __syncthreads();
    if (chl0 < 128) { const int hh = chl0 >> 6; const float last = CU[hh * 64 + 63];
#pragma unroll
        for (int tt = 0; tt < 4; ++tt) { const int t = t0 + tt; const float sc = DT[hh * 64 + t] * __expf(last - CU[hh * 64 + t]);
#pragma unroll
            for (int i = 0; i < 8; ++i) VT[(chl0 + i) * 72 + t] = f2bf(siluf_(o[tt][i]) * sc); }
    } else { const int n0 = chl0 - 128;
#pragma unroll
        for (int tt = 0; tt < 4; ++tt)
#pragma unroll
            for (int i = 0; i < 8; ++i) BT[(n0 + i) * 72 + t0 + tt] = f2bf(siluf_(o[tt][i]));
    }
    __syncthreads();
    f32x4 acc[8];
#pragma unroll
    for (int j = 0; j < 8; ++j) acc[j] = (f32x4){0.f, 0.f, 0.f, 0.f};
    mm_nt<8, 2>(acc, BT + 16 * wave * 72, 72, VT, 72, lane);
    bf16_t* DS = (bf16_t*)(p.ws + OFF_DSS);
#pragma unroll
    for (int jj = 0; jj < 8; ++jj) { const int h = 2 * g + (jj >> 2), pc = (jj & 3) * 16 + (lane & 15);
#pragma unroll
        for (int e = 0; e < 4; ++e) { const int n = 16 * wave + (lane >> 4) * 4 + e; DS[(((size_t)(b * 4 + h) * 32 + c) * 128 + n) * 64 + pc] = f2bf(acc[jj][e]); } }
    if (tid < 2) ((float*)(p.ws + OFF_DECS))[(b * 4 + 2 * g + tid) * 32 + c] = __expf(CU[tid * 64 + 63]);
    __syncthreads();
}

__device__ __forceinline__ void ssd_passC(PRM p, LAS unsigned char* lds, int l, int u) {
    const int tid = tidx(), lane = tid & 63, wave = tid >> 6;
    const int c = u & 31, b = u >> 5, row0 = b * 2048 + c * 64;
    const bf16_t* U = (const bf16_t*)(p.ws + OFF_U); const float* SDT = (const float*)(p.ws + OFF_SDT);
    const bf16_t* DS = (const bf16_t*)(p.ws + OFF_DSS);
    bf16_t* YC = (bf16_t*)(p.ws + OFF_YC);
    LAS float* DT = (LAS float*)lds; LAS float* CU = (LAS float*)(lds + 1024); LAS float* SSQ = (LAS float*)(lds + 2048);
    LAS bf16_t* CM = (LAS bf16_t*)(lds + 3072); LAS bf16_t* BM = (LAS bf16_t*)(lds + 20480); LAS bf16_t* VT = (LAS bf16_t*)(lds + 37888);
    LAS bf16_t* PP = (LAS bf16_t*)(lds + 56320); LAS bf16_t* SINT = (LAS bf16_t*)(lds + 74752);
    if (wave < 4) {
        const int h = wave;
        const float dt = softplusf_(SDT[(size_t)(row0 + lane) * 4 + h] + p.in[20][l * 4 + h]);
        const float cum = scan64_add(-expf(p.in[21][l * 4 + h]) * dt, lane);
        DT[h * 64 + lane] = dt; CU[h * 64 + lane] = cum;
    }
    f32x4 yv[2][4];
#pragma unroll
    for (int g = 0; g < 2; ++g) {
        {
            u32x4 sv[4];
#pragma unroll
            for (int i = 0; i < 4; ++i) { const int idx8 = tid + i * NTHR, hh = idx8 >> 10, rem = idx8 & 1023, n = rem >> 3, p0 = (rem & 7) * 8;
                sv[i] = ldg8(DS + (((size_t)(b * 4 + 2 * g + hh) * 32 + c) * 128 + n) * 64 + p0); }
#pragma unroll
            for (int it = 0; it < 2; ++it) { const int item = tid + it * NTHR;
                if (item < 768) {
                    const int chl0 = (item % 48) * 8, t0 = (item / 48) * 4, which = chl0 >> 7, n0 = chl0 & 127, xc0 = which * 256 + g * 128 + n0;
                    u32x4 rows[7];
#pragma unroll
                    for (int r = 0; r < 7; ++r) { const int t = t0 - 3 + r; rows[r] = (c > 0 || t >= 0) ? ldg8(U + (size_t)(row0 + t) * NU + UXBC + xc0) : (u32x4){0u, 0u, 0u, 0u}; }
                    float w[4][8], bias[8];
#pragma unroll
                    for (int j = 0; j < 4; ++j) ld8f(p.in[18] + (size_t)(l * 4 + j) * 768 + xc0, w[j]);
                    ld8f(p.in[19] + l * 768 + xc0, bias);
                    float o[4][8]; conv8<4>(rows, w, bias, o);
                    if (which == 0) {
#pragma unroll
                        for (int tt = 0; tt < 4; ++tt)
#pragma unroll
                            for (int i = 0; i < 8; ++i) VT[(n0 + i) * 72 + t0 + tt] = f2bf(siluf_(o[tt][i]));
                    } else { LAS bf16_t* dstp = which == 1 ? BM : CM;
#pragma unroll
                        for (int tt = 0; tt < 4; ++tt) { float sv8[8];
#pragma unroll
                            for (int i = 0; i < 8; ++i) sv8[i] = siluf_(o[tt][i]);
                            *(LAS u32x4*)(dstp + (t0 + tt) * 136 + n0) = pack8(sv8); }
                    }
                } }
#pragma unroll
            for (int i = 0; i < 4; ++i) { const int idx8 = tid + i * NTHR, hh = idx8 >> 10, rem = idx8 & 1023, n = rem >> 3, p0 = (rem & 7) * 8;
#pragma unroll
                for (int e = 0; e < 8; ++e) SINT[(hh * 64 + p0 + e) * 136 + n] = elem8(sv[i], e); }
        }
        __syncthreads();
        {
            const int rt = wave & 3, ct0 = (wave >> 2) * 2;
            f32x4 sc[2]; sc[0] = (f32x4){0.f, 0.f, 0.f, 0.f}; sc[1] = sc[0];
            mm_nt<2, 4>(sc, CM + 16 * rt * 136, 136, BM + 16 * ct0 * 136, 136, lane);
#pragma unroll
            for (int hh = 0; hh < 2; ++hh) { const int h = 2 * g + hh;
#pragma unroll
                for (int jj = 0; jj < 2; ++jj)
#pragma unroll
                    for (int e = 0; e < 4; ++e) { const int t = 16 * rt + (lane >> 4) * 4 + e, s = 16 * (ct0 + jj) + (lane & 15);
                        const float val = s <= t ? sc[jj][e] * __expf(CU[h * 64 + t] - CU[h * 64 + s]) * DT[h * 64 + s] : 0.f;
                        PP[(hh * 64 + t) * 72 + s] = f2bf(val); } }
        }
        __syncthreads();
        {
            const int hh = wave >> 2, rt = wave & 3, h = 2 * g + hh;
            float zv[4][4];
#pragma unroll
            for (int e = 0; e < 4; ++e)
#pragma unroll
                for (int j = 0; j < 4; ++j) zv[e][j] = bf2f(U[(size_t)(row0 + 16 * rt + (lane >> 4) * 4 + e) * NU + UZ + h * 64 + 16 * j + (lane & 15)]);
#pragma unroll
            for (int j = 0; j < 4; ++j) yv[g][j] = (f32x4){0.f, 0.f, 0.f, 0.f};
            mm_nt<4, 4>(yv[g], CM + 16 * rt * 136, 136, SINT + hh * 64 * 136, 136, lane);
#pragma unroll
            for (int e = 0; e < 4; ++e) { const float sc = __expf(CU[h * 64 + 16 * rt + (lane >> 4) * 4 + e]);
#pragma unroll
                for (int j = 0; j < 4; ++j) yv[g][j][e] *= sc; }
            mm_nt<4, 2>(yv[g], PP + (hh * 64 + 16 * rt) * 72, 72, VT + hh * 64 * 72, 72, lane);
            const float Dh = p.in[22][l * 4 + h];
#pragma unroll
            for (int e = 0; e < 4; ++e) { const int t = 16 * rt + (lane >> 4) * 4 + e; float s2 = 0.f;
#pragma unroll
                for (int j = 0; j < 4; ++j) { const int pc = 16 * j + (lane & 15);
                    const float xs = bf2f(VT[(hh * 64 + pc) * 72 + t]);
                    const float v = (yv[g][j][e] + Dh * xs) * siluf_(zv[e][j]); yv[g][j][e] = v; s2 += v * v; }
                s2 = row16_sum(s2);
                if ((lane & 15) == 0) SSQ[t * 4 + h] = s2; }
        }
        __syncthreads();
    }
#pragma unroll
    for (int g = 0; g < 2; ++g) { const int hh = wave >> 2, rt = wave & 3, h = 2 * g + hh;
#pragma unroll
        for (int e = 0; e < 4; ++e) { const int t = 16 * rt + (lane >> 4) * 4 + e;
            const float tot = SSQ[t * 4 + 0] + SSQ[t * 4 + 1] + SSQ[t * 4 + 2] + SSQ[t * 4 + 3];
            const float rstd = 1.0f / sqrtf(tot * (1.0f / 256.0f) + EPS);
#pragma unroll
            for (int j = 0; j < 4; ++j) { const int pc = 16 * j + (lane & 15);
                YC[(size_t)(row0 + t) * D + h * 64 + pc] = f2bf(yv[g][j][e] * rstd * p.in[23][l * 256 + h * 64 + pc]); } } }
    if (c == 31) for (int idx = tid; idx < 2304; idx += NTHR) { const int r = idx / 768, ch = idx % 768;
        p.out[O_PSSDC + ((size_t)(l * 8 + b) * 3 + r) * 768 + ch] = bf2f(U[(size_t)(b * 2048 + 2045 + r) * NU + UXBC + ch]); }
    __syncthreads();
}

constexpr int E_CUM = 0, E_QS = 16640, E_QD = 25856, E_KV = 35072, E_VT = 71936, E_SINT = 81152, E_PP = 90368, E_KWT = 99584, E_RSC = 108800, E_SSQ = 109056;
__device__ __forceinline__ void engineA(LAS unsigned char* lds, bf16_t* DS, int wave, int lane) {
    const LAS bf16_t* KWT = (const LAS bf16_t*)(lds + E_KWT); const LAS bf16_t* VT = (const LAS bf16_t*)(lds + E_VT);
    const int rt = wave >> 1, ct0 = (wave & 1) * 2;
    f32x4 acc[2]; acc[0] = (f32x4){0.f, 0.f, 0.f, 0.f}; acc[1] = acc[0];
    mm_nt<2, 2>(acc, KWT + 16 * rt * 72, 72, VT + 16 * ct0 * 72, 72, lane);
#pragma unroll
    for (int jj = 0; jj < 2; ++jj)
#pragma unroll
        for (int e = 0; e < 4; ++e) DS[(16 * rt + (lane >> 4) * 4 + e) * 64 + 16 * (ct0 + jj) + (lane & 15)] = f2bf(acc[jj][e]);
}
template <bool RET>
__device__ __forceinline__ void engineC(LAS unsigned char* lds, int qd_off, int kvstride, float lg, f32x4 (&y)[2], int wave, int lane) {
    const LAS bf16_t* QS = (const LAS bf16_t*)(lds + E_QS); const LAS bf16_t* QD = (const LAS bf16_t*)(lds + qd_off);
    const LAS bf16_t* KV = (const LAS bf16_t*)(lds + E_KV); const LAS bf16_t* VT = (const LAS bf16_t*)(lds + E_VT);
    const LAS bf16_t* SINT = (const LAS bf16_t*)(lds + E_SINT); LAS bf16_t* PP = (LAS bf16_t*)(lds + E_PP); const LAS float* RSC = (const LAS float*)(lds + E_RSC);
    const int rt = wave >> 1, ct0 = (wave & 1) * 2;
    f32x4 sc[2]; sc[0] = (f32x4){0.f, 0.f, 0.f, 0.f}; sc[1] = sc[0];
    mm_nt<2, 2>(sc, QS + 16 * rt * 72, 72, KV + kvstride * rt + 16 * ct0 * 72, 72, lane);
#pragma unroll
    for (int jj = 0; jj < 2; ++jj)
#pragma unroll
        for (int e = 0; e < 4; ++e) { const int t = 16 * rt + (lane >> 4) * 4 + e, s = 16 * (ct0 + jj) + (lane & 15);
            float val = 0.f; if (s <= t) val = RET ? sc[jj][e] * __expf((float)(t - s) * lg) : sc[jj][e];
            PP[t * 72 + s] = f2bf(val); }
    __syncthreads();
    y[0] = (f32x4){0.f, 0.f, 0.f, 0.f}; y[1] = y[0];
    mm_nt<2, 2>(y, QD + 16 * rt * 72, 72, SINT + 16 * ct0 * 72, 72, lane);
#pragma unroll
    for (int e = 0; e < 4; ++e) { const float r = RSC[16 * rt + (lane >> 4) * 4 + e]; y[0][e] *= r; y[1][e] *= r; }
    mm_nt<2, 2>(y, PP + 16 * rt * 72, 72, VT + 16 * ct0 * 72, 72, lane);
}
template <bool CENTER>
__device__ __forceinline__ void headnorm_store(LAS unsigned char* lds, const f32x4 (&y)[2], int wave, int lane, const float (&gate)[8], const float (&gain)[2], bf16_t* outp) {
    LAS f32x2* SSQ = (LAS f32x2*)(lds + E_SSQ);
    const int rt = wave >> 1, half = wave & 1, ct0 = half * 2;
#pragma unroll
    for (int e = 0; e < 4; ++e) { float s1 = y[0][e] + y[1][e], s2 = y[0][e] * y[0][e] + y[1][e] * y[1][e];
        s1 = row16_sum(s1); s2 = row16_sum(s2);
        if ((lane & 15) == 0) SSQ[(16 * rt + (lane >> 4) * 4 + e) * 2 + half] = (f32x2){s1, s2}; }
    __syncthreads();
#pragma unroll
    for (int e = 0; e < 4; ++e) { const int t = 16 * rt + (lane >> 4) * 4 + e;
        const f32x2 a = SSQ[t * 2], b2 = SSQ[t * 2 + 1];
        const float mean = CENTER ? (a.x + b2.x) * (1.0f / 64.0f) : 0.f;
        const float var = (a.y + b2.y) * (1.0f / 64.0f) - mean * mean;
        const float rstd = 1.0f / sqrtf(fmaxf(var, 0.f) + EPS);
#pragma unroll
        for (int jj = 0; jj < 2; ++jj) { const int pc = 16 * (ct0 + jj) + (lane & 15);
            outp[(size_t)t * D + pc] = f2bf((y[jj][e] - mean) * rstd * gain[jj] * siluf_(gate[e * 2 + jj])); } }
}
__device__ __forceinline__ void headnorm_prefetch(int wave, int lane, const bf16_t* Ugate, const float* gainp, float (&gate)[8], float (&gain)[2]) {
    const int rt = wave >> 1, ct0 = (wave & 1) * 2;
#pragma unroll
    for (int jj = 0; jj < 2; ++jj) { const int pc = 16 * (ct0 + jj) + (lane & 15); gain[jj] = gainp[pc];
#pragma unroll
        for (int e = 0; e < 4; ++e) gate[e * 2 + jj] = bf2f(Ugate[(size_t)(16 * rt + (lane >> 4) * 4 + e) * NU + pc]); }
}

struct RetRegs { u32x4 vraw, x1, x2, dsraw; float cs[8], sn[8], gate[8], gain[2]; };
template <bool PASSC>
__device__ __forceinline__ void ret_load(PRM p, int l, int u, RetRegs& r) {
    const int tid = tidx(), lane = tid & 63, wave = tid >> 6;
    const int h = u & 3, c = (u >> 2) & 31, b = u >> 7, row0 = b * 2048 + c * 64;
    const bf16_t* U = (const bf16_t*)(p.ws + OFF_U);
    const float* RC = (const float*)(p.ws + OFF_ROPE); const float* RS = RC + 2052 * 32;
    const bf16_t* DS = (const bf16_t*)(p.ws + OFF_DSR) + ((size_t)(b * 4 + h) * 32 + c) * 4096;
    const int t = tid >> 3, c8 = (tid & 7) * 8, isq = tid >> 8, tt = (tid & 255) >> 2, j0 = (tid & 3) * 8;
    r.vraw = ldg8(U + (size_t)(row0 + t) * NU + URV + h * 64 + c8); r.dsraw = (u32x4){0u, 0u, 0u, 0u};
    if (PASSC) { r.dsraw = ldg8(DS + t * 64 + c8); headnorm_prefetch(wave, lane, U + (size_t)row0 * NU + URG + h * 64, p.in[24] + l * 256 + h * 64, r.gate, r.gain); }
    r.x1 = (u32x4){0u, 0u, 0u, 0u}; r.x2 = r.x1;
    if (PASSC || isq == 0) { const bf16_t* ur = U + (size_t)(row0 + tt) * NU + (isq ? URQ : URK) + h * 64 + j0; r.x1 = ldg8(ur); r.x2 = ldg8(ur + 32);
        ld8f(RC + (size_t)(c * 64 + tt) * 32 + j0, r.cs); ld8f(RS + (size_t)(c * 64 + tt) * 32 + j0, r.sn); }
}
template <bool PASSC>
__device__ __forceinline__ void ret_body(PRM p, LAS unsigned char* lds, int l, int u, const RetRegs& r) {
    const int tid = tidx(), lane = tid & 63, wave = tid >> 6;
    const int h = u & 3, c = (u >> 2) & 31, b = u >> 7, row0 = b * 2048 + c * 64;
    const float lg = logf(1.0f - exp2f(-5.0f - (float)h));
    LAS bf16_t* QS = (LAS bf16_t*)(lds + E_QS); LAS bf16_t* KV = (LAS bf16_t*)(lds + E_KV); LAS bf16_t* VT = (LAS bf16_t*)(lds + E_VT);
    LAS bf16_t* SINT = (LAS bf16_t*)(lds + E_SINT); LAS bf16_t* KWT = (LAS bf16_t*)(lds + E_KWT); LAS float* RSC = (LAS float*)(lds + E_RSC);
    bf16_t* DS = (bf16_t*)(p.ws + OFF_DSR) + ((size_t)(b * 4 + h) * 32 + c) * 4096;
    const int t = tid >> 3, c8 = (tid & 7) * 8, isq = tid >> 8, tt = (tid & 255) >> 2, j0 = (tid & 3) * 8;
#pragma unroll
    for (int i = 0; i < 8; ++i) VT[(c8 + i) * 72 + t] = elem8(r.vraw, i);
    if (PASSC) {
#pragma unroll
        for (int i = 0; i < 8; ++i) SINT[(c8 + i) * 72 + t] = elem8(r.dsraw, i);
        if (tid < 64) RSC[tid] = __expf((float)(tid + 1) * lg);
    }
    if (PASSC || isq == 0) {
        float a[8], bb[8], ra[8], rb[8]; unpack8(r.x1, a); unpack8(r.x2, bb);
        const float scl = isq ? 1.0f : 0.125f;
#pragma unroll
        for (int i = 0; i < 8; ++i) { ra[i] = (a[i] * r.cs[i] - bb[i] * r.sn[i]) * scl; rb[i] = (bb[i] * r.cs[i] + a[i] * r.sn[i]) * scl; }
        if (PASSC) { LAS bf16_t* dst = isq ? QS : KV;
            *(LAS u32x4*)(dst + tt * 72 + j0) = pack8(ra); *(LAS u32x4*)(dst + tt * 72 + j0 + 32) = pack8(rb);
        } else { const float w = __expf((float)(63 - tt) * lg);
#pragma unroll
            for (int i = 0; i < 8; ++i) { KWT[(j0 + i) * 72 + tt] = f2bf(ra[i] * w); KWT[(j0 + 32 + i) * 72 + tt] = f2bf(rb[i] * w); } }
    }
    __syncthreads();
    if (PASSC) {
        f32x4 y[2]; engineC<true>(lds, E_QS, 0, lg, y, wave, lane);
        headnorm_store<true>(lds, y, wave, lane, r.gate, r.gain, (bf16_t*)(p.ws + OFF_YC) + (size_t)row0 * D + 256 + h * 64);
    } else engineA(lds, DS, wave, lane);
    __syncthreads();
}

struct HgRegs { u32x4 hfraw, viraw, hqraw, dsraw; float lb[8], gate[8], gain[2]; };
template <bool PASSC>
__device__ __forceinline__ void hg_load(PRM p, int l, int u, HgRegs& r) {
    const int tid = tidx(), lane = tid & 63, wave = tid >> 6;
    const int h = u & 3, c = (u >> 2) & 31, b = u >> 7, row0 = b * 2048 + c * 64;
    const bf16_t* U = (const bf16_t*)(p.ws + OFF_U);
    const bf16_t* DS = (const bf16_t*)(p.ws + OFF_DSH) + ((size_t)(b * 4 + h) * 32 + c) * 4096;
    const int t = tid >> 3, c8 = (tid & 7) * 8;
    const bf16_t* ur = U + (size_t)(row0 + t) * NU + h * 64 + c8;
    r.hfraw = ldg8(ur + UHF); r.viraw = ldg8(ur + UHI); r.hqraw = (u32x4){0u, 0u, 0u, 0u}; r.dsraw = r.hqraw;
    if (PASSC) { r.hqraw = ldg8(ur + UHQ); r.dsraw = ldg8(DS + t * 64 + c8); headnorm_prefetch(wave, lane, U + (size_t)row0 * NU + UHG + h * 64, p.in[33] + l * 256 + h * 64, r.gate, r.gain); }
    ld8f((const float*)(p.ws + OFF_LB) + l * 256 + h * 64 + c8, r.lb);
}
template <bool PASSC>
__device__ __forceinline__ void hg_body(PRM p, LAS unsigned char* lds, int l, int u, const HgRegs& r) {
    const int tid = tidx(), lane = tid & 63, wave = tid >> 6;
    const int h = u & 3, c = (u >> 2) & 31, b = u >> 7, row0 = b * 2048 + c * 64;
    LAS float* CUM = (LAS float*)(lds + E_CUM);
    LAS bf16_t* QS = (LAS bf16_t*)(lds + E_QS); LAS bf16_t* QD = (LAS bf16_t*)(lds + E_QD); LAS bf16_t* KV = (LAS bf16_t*)(lds + E_KV); LAS bf16_t* VT = (LAS bf16_t*)(lds + E_VT);
    LAS bf16_t* SINT = (LAS bf16_t*)(lds + E_SINT); LAS bf16_t* KWT = (LAS bf16_t*)(lds + E_KWT); LAS float* RSC = (LAS float*)(lds + E_RSC);
    bf16_t* DS = (bf16_t*)(p.ws + OFF_DSH) + ((size_t)(b * 4 + h) * 32 + c) * 4096;
    const int t = tid >> 3, c8 = (tid & 7) * 8;
#pragma unroll
    for (int i = 0; i < 8; ++i) VT[(c8 + i) * 72 + t] = elem8(r.viraw, i);
    if (PASSC) {
#pragma unroll
        for (int i = 0; i < 8; ++i) SINT[(c8 + i) * 72 + t] = elem8(r.dsraw, i);
        if (tid < 64) RSC[tid] = 1.0f;
    }
    float hf[8]; unpack8(r.hfraw, hf);
#pragma unroll
    for (int i = 0; i < 8; ++i) CUM[t * 65 + c8 + i] = __logf(r.lb[i] + (1.0f - r.lb[i]) * sigmoidf_(hf[i]));
    __syncthreads();
#pragma unroll
    for (int kk = 0; kk < 8; ++kk) { const int k = wave * 8 + kk; const float v = scan64_add(CUM[lane * 65 + k], lane); CUM[lane * 65 + k] = v; }
    __syncthreads();
    {
        float cum[8], kk_[8];
#pragma unroll
        for (int i = 0; i < 8; ++i) { cum[i] = CUM[t * 65 + c8 + i]; kk_[i] = (1.0f - r.lb[i]) * sigmoidf_(-hf[i]); }
        if (PASSC) {
            float q[8], qd[8], qs[8]; unpack8(r.hqraw, q); const int i_ = t >> 4;
#pragma unroll
            for (int i = 0; i < 8; ++i) { q[i] = siluf_(q[i]); const float ci0 = i_ ? CUM[(16 * i_ - 1) * 65 + c8 + i] : 0.f; qd[i] = q[i] * __expf(cum[i]); qs[i] = q[i] * __expf(cum[i] - ci0); }
            *(LAS u32x4*)(QD + t * 72 + c8) = pack8(qd); *(LAS u32x4*)(QS + t * 72 + c8) = pack8(qs);
#pragma unroll
            for (int i2 = 0; i2 < 4; ++i2) { float kv[8];
#pragma unroll
                for (int i = 0; i < 8; ++i) { float val = 0.f;
                    if (i2 >= i_) { const float c0 = i2 ? CUM[(16 * i2 - 1) * 65 + c8 + i] : 0.f; val = kk_[i] * __expf(fminf(c0 - cum[i], 60.f)); }
                    kv[i] = val; }
                *(LAS u32x4*)(KV + i2 * 4608 + t * 72 + c8) = pack8(kv); }
        } else {
#pragma unroll
            for (int i = 0; i < 8; ++i) KWT[(c8 + i) * 72 + t] = f2bf(kk_[i] * __expf(CUM[63 * 65 + c8 + i] - cum[i]));
            if (tid < 64) ((float*)(p.ws + OFF_DECH))[((size_t)(b * 4 + h) * 32 + c) * 64 + tid] = __expf(CUM[63 * 65 + tid]);
        }
    }
    __syncthreads();
    if (PASSC) {
        f32x4 y[2]; engineC<false>(lds, E_QD, 4608, 0.f, y, wave, lane);
        headnorm_store<false>(lds, y, wave, lane, r.gate, r.gain, (bf16_t*)(p.ws + OFF_YC) + (size_t)row0 * D + 768 + h * 64);
    } else engineA(lds, DS, wave, lane);
    __syncthreads();
}

struct RgRegs { u32x4 rows[4], wt[2], gyraw; float w[4][8], bias[8], hin[8], ba[2], bx[2], lam[2]; };
template <bool PASSC>
__device__ __forceinline__ void rg_load(PRM p, int l, int u, RgRegs& r) {
    const int tid = tidx(), lane = tid & 63, wave = tid >> 6;
    const int blk = u & 3, c = (u >> 2) & 31, b = u >> 7, row0 = b * 2048 + c * 64;
    const bf16_t* U = (const bf16_t*)(p.ws + OFF_U);
    const int t = tid >> 3, c8 = (tid & 7) * 8, ch0 = blk * 64 + c8;
#pragma unroll
    for (int q = 0; q < 4; ++q) { const int tr = t - 3 + q; r.rows[q] = (c > 0 || tr >= 0) ? ldg8(U + (size_t)(row0 + tr) * NU + UGX + ch0) : (u32x4){0u, 0u, 0u, 0u}; }
#pragma unroll
    for (int j = 0; j < 4; ++j) ld8f(p.in[25] + (size_t)(l * 4 + j) * 256 + ch0, r.w[j]);
    ld8f(p.in[26] + l * 256 + ch0, r.bias);
    const bf16_t* WRG = (const bf16_t*)(p.ws + OFF_WRG);
#pragma unroll
    for (int i = 0; i < 2; ++i) { const int idx = tid + i * NTHR, gate = idx >> 9, rem = idx & 511; r.wt[i] = *(const u32x4*)(WRG + (size_t)((l * 2 + gate) * 4 + blk) * 4096 + (rem >> 3) * 64 + (rem & 7) * 8); }
    r.gyraw = (u32x4){0u, 0u, 0u, 0u};
    if (PASSC) { r.gyraw = ldg8(U + (size_t)(row0 + t) * NU + UGY + ch0);
#pragma unroll
        for (int kk = 0; kk < 8; ++kk) r.hin[kk] = ((const float*)(p.ws + OFF_RGC))[(size_t)(b * 32 + c) * 256 + blk * 64 + wave * 8 + kk]; }
#pragma unroll
    for (int jj = 0; jj < 2; ++jj) { const int ch = blk * 64 + 16 * ((wave >> 2) * 2 + jj) + (lane & 15);
        r.ba[jj] = p.in[28][l * 256 + ch]; r.bx[jj] = p.in[30][l * 256 + ch]; r.lam[jj] = p.in[31][l * 256 + ch]; }
}
template <bool PASSC>
__device__ __forceinline__ void rg_body(PRM p, LAS unsigned char* lds, int l, int u, const RgRegs& r) {
    const int tid = tidx(), lane = tid & 63, wave = tid >> 6;
    const int blk = u & 3, c = (u >> 2) & 31, b = u >> 7, row0 = b * 2048 + c * 64;
    const bf16_t* U = (const bf16_t*)(p.ws + OFF_U);
    LAS float* XR = (LAS float*)lds; LAS bf16_t* XRB = (LAS bf16_t*)(lds + 16640); LAS bf16_t* WT = (LAS bf16_t*)(lds + 25856);
    LAS float* AA = (LAS float*)(lds + 44288); LAS float* BB = (LAS float*)(lds + 60928); LAS float* HL = (LAS float*)(lds + 77568);
    const int t = tid >> 3, c8 = (tid & 7) * 8, ch0 = blk * 64 + c8;
    {
        float o[1][8]; conv8<1>(r.rows, r.w, r.bias, o);
#pragma unroll
        for (int i = 0; i < 8; ++i) XR[t * 65 + c8 + i] = o[0][i];
        *(LAS u32x4*)(XRB + t * 72 + c8) = pack8(o[0]);
#pragma unroll
        for (int i = 0; i < 2; ++i) { const int idx = tid + i * NTHR, gate = idx >> 9, rem = idx & 511; *(LAS u32x4*)(WT + gate * 4608 + (rem >> 3) * 72 + (rem & 7) * 8) = r.wt[i]; }
    }
    __syncthreads();
    {
        const int rt = wave & 3, ct0 = (wave >> 2) * 2;
        f32x4 aA[2], aX[2]; aA[0] = (f32x4){0.f, 0.f, 0.f, 0.f}; aA[1] = aA[0]; aX[0] = aA[0]; aX[1] = aA[0];
        mm_nt<2, 2>(aA, XRB + 16 * rt * 72, 72, WT + 16 * ct0 * 72, 72, lane);
        mm_nt<2, 2>(aX, XRB + 16 * rt * 72, 72, WT + 4608 + 16 * ct0 * 72, 72, lane);
#pragma unroll
        for (int jj = 0; jj < 2; ++jj) { const int j = 16 * (ct0 + jj) + (lane & 15);
            const float sp = -8.0f * softplusf_(-r.lam[jj]);
#pragma unroll
            for (int e = 0; e < 4; ++e) { const int tq = 16 * rt + (lane >> 4) * 4 + e;
                const float rr = sigmoidf_(aA[jj][e] + r.ba[jj]), ig = sigmoidf_(aX[jj][e] + r.bx[jj]);
                const float la = sp * rr; AA[tq * 65 + j] = __expf(la); BB[tq * 65 + j] = sqrtf(fmaxf(1.0f - __expf(2.0f * la), 0.f)) * ig * XR[tq * 65 + j]; } }
    }
    __syncthreads();
#pragma unroll
    for (int kk = 0; kk < 8; ++kk) { const int j = wave * 8 + kk, ch = blk * 64 + j;
        float A = AA[lane * 65 + j], B = BB[lane * 65 + j];
        scan64_lin(A, B);
        if (PASSC) HL[lane * 65 + j] = B + A * r.hin[kk];
        else if (lane == 63) { ((float*)(p.ws + OFF_RGH))[(size_t)(b * 32 + c) * 256 + ch] = B; ((float*)(p.ws + OFF_RGA))[(size_t)(b * 32 + c) * 256 + ch] = A; }
    }
    if (PASSC) {
        __syncthreads();
        float gy[8], y[8]; unpack8(r.gyraw, gy);
#pragma unroll
        for (int i = 0; i < 8; ++i) y[i] = geluf_(gy[i]) * HL[t * 65 + c8 + i];
        *(u32x4*)((bf16_t*)(p.ws + OFF_YC) + (size_t)(row0 + t) * D + 512 + ch0) = pack8(y);
        if (c == 31 && tid < 192) { const int rr = tid >> 6, j = tid & 63;
            p.out[O_PRGC + ((size_t)(l * 8 + b) * 3 + rr) * 256 + blk * 64 + j] = bf2f(U[(size_t)(b * 2048 + 2045 + rr) * NU + UGX + blk * 64 + j]); }
    }
    __syncthreads();
}

#define UNIT_LOOP(NAME, REGS, LOADF, BODYF)                                                                             \
template <bool PASSC> __device__ __forceinline__ void NAME(PRM p, LAS unsigned char* lds, int l) {            \
    int u = blockIdx.x; if (u >= 1024) return;                                                                          \
    REGS cur; LOADF<PASSC>(p, l, u, cur);                                                                               \
    _Pragma("unroll 1") for (; u < 1024; u += gridDim.x) { REGS nx; const int un = u + gridDim.x;                        \
        if (un < 1024) LOADF<PASSC>(p, l, un, nx);                                                                      \
        BODYF<PASSC>(p, lds, l, u, cur);                                                                                \
        if (un < 1024) cur = nx; } }
UNIT_LOOP(ret_loop, RetRegs, ret_load, ret_body)
UNIT_LOOP(hg_loop, HgRegs, hg_load, hg_body)
template <bool PASSC> __device__ __forceinline__ void rg_loop(PRM p, LAS unsigned char* lds, int l) {
    _Pragma("unroll 1") for (int u = blockIdx.x; u < 1024; u += gridDim.x) { RgRegs r; rg_load<PASSC>(p, l, u, r); rg_body<PASSC>(p, lds, l, u, r); } }

__device__ __forceinline__ void retC2_unit(PRM p, LAS unsigned char* lds, int l, int u) {
    const int tid = tidx(), lane = tid & 63, wave = tid >> 6;
    const int hp = u & 1, c = (u >> 1) & 31, b = u >> 6, row0 = b * 2048 + c * 64;
    const bf16_t* U = (const bf16_t*)(p.ws + OFF_U);
    const float* RC = (const float*)(p.ws + OFF_ROPE); const float* RS = RC + 2052 * 32;
    LAS bf16_t* QS = (LAS bf16_t*)lds; LAS bf16_t* KV = (LAS bf16_t*)(lds + 18432); LAS bf16_t* VT = (LAS bf16_t*)(lds + 36864);
    LAS bf16_t* SINT = (LAS bf16_t*)(lds + 55296); LAS bf16_t* PP = (LAS bf16_t*)(lds + 73728);
    const int t = tid >> 3, c8 = (tid & 7) * 8, isq = tid >> 8, tt = (tid & 255) >> 2, j0 = (tid & 3) * 8;
    const int hw = wave >> 2, rt = wave & 3, hme = 2 * hp + hw;
    u32x4 vraw[2], dsraw[2], x1[2], x2[2]; float cs[8], sn[8], gate[16], gain[4];
#pragma unroll
    for (int hh = 0; hh < 2; ++hh) { const int h = 2 * hp + hh;
        vraw[hh] = ldg8(U + (size_t)(row0 + t) * NU + URV + h * 64 + c8);
        dsraw[hh] = ldg8((const bf16_t*)(p.ws + OFF_DSR) + ((size_t)(b * 4 + h) * 32 + c) * 4096 + t * 64 + c8);
        const bf16_t* ur = U + (size_t)(row0 + tt) * NU + (isq ? URQ : URK) + h * 64 + j0; x1[hh] = ldg8(ur); x2[hh] = ldg8(ur + 32); }
    ld8f(RC + (size_t)(c * 64 + tt) * 32 + j0, cs); ld8f(RS + (size_t)(c * 64 + tt) * 32 + j0, sn);
#pragma unroll
    for (int j = 0; j < 4; ++j) { const int pc = 16 * j + (lane & 15); gain[j] = p.in[24][l * 256 + hme * 64 + pc];
#pragma unroll
        for (int e = 0; e < 4; ++e) gate[e * 4 + j] = bf2f(U[(size_t)(row0 + 16 * rt + (lane >> 4) * 4 + e) * NU + URG + hme * 64 + pc]); }
#pragma unroll
    for (int hh = 0; hh < 2; ++hh) {
#pragma unroll
        for (int i = 0; i < 8; ++i) { VT[hh * 4608 + (c8 + i) * 72 + t] = elem8(vraw[hh], i); SINT[hh * 4608 + (c8 + i) * 72 + t] = elem8(dsraw[hh], i); }
        float a[8], bb[8], ra[8], rb[8]; unpack8(x1[hh], a); unpack8(x2[hh], bb);
        const float scl = isq ? 1.0f : 0.125f;
#pragma unroll
        for (int i = 0; i < 8; ++i) { ra[i] = (a[i] * cs[i] - bb[i] * sn[i]) * scl; rb[i] = (bb[i] * cs[i] + a[i] * sn[i]) * scl; }
        LAS bf16_t* dst = (isq ? QS : KV) + hh * 4608;
        *(LAS u32x4*)(dst + tt * 72 + j0) = pack8(ra); *(LAS u32x4*)(dst + tt * 72 + j0 + 32) = pack8(rb);
    }
    __syncthreads();
    const float lg = logf(1.0f - exp2f(-5.0f - (float)hme));
    {
        f32x4 sc[4];
#pragma unroll
        for (int j = 0; j < 4; ++j) sc[j] = (f32x4){0.f, 0.f, 0.f, 0.f};
        mm_nt<4, 2>(sc, QS + hw * 4608 + 16 * rt * 72, 72, KV + hw * 4608, 72, lane);
#pragma unroll
        for (int j = 0; j < 4; ++j)
#pragma unroll
            for (int e = 0; e < 4; ++e) { const int tq = 16 * rt + (lane >> 4) * 4 + e, sq = 16 * j + (lane & 15);
                PP[hw * 4608 + tq * 72 + sq] = f2bf(sq <= tq ? sc[j][e] * __expf((float)(tq - sq) * lg) : 0.f); }
    }
    __syncthreads();
    f32x4 y[4];
#pragma unroll
    for (int j = 0; j < 4; ++j) y[j] = (f32x4){0.f, 0.f, 0.f, 0.f};
    mm_nt<4, 2>(y, QS + hw * 4608 + 16 * rt * 72, 72, SINT + hw * 4608, 72, lane);
#pragma unroll
    for (int e = 0; e < 4; ++e) { const float r = __expf((float)(16 * rt + (lane >> 4) * 4 + e + 1) * lg);
#pragma unroll
        for (int j = 0; j < 4; ++j) y[j][e] *= r; }
    mm_nt<4, 2>(y, PP + hw * 4608 + 16 * rt * 72, 72, VT + hw * 4608, 72, lane);
    bf16_t* outp = (bf16_t*)(p.ws + OFF_YC) + (size_t)row0 * D + 256 + hme * 64;
#pragma unroll
    for (int e = 0; e < 4; ++e) { const int tq = 16 * rt + (lane >> 4) * 4 + e;
        float s1 = (y[0][e] + y[1][e]) + (y[2][e] + y[3][e]);
#pragma unroll
        for (int o = 1; o < 16; o <<= 1) s1 += __shfl_xor(s1, o);
        const float mean = s1 * (1.0f / 64.0f);
        float s2 = 0.f;
#pragma unroll
        for (int j = 0; j < 4; ++j) { const float d = y[j][e] - mean; s2 += d * d; }
#pragma unroll
        for (int o = 1; o < 16; o <<= 1) s2 += __shfl_xor(s2, o);
        const float rstd = 1.0f / sqrtf(s2 * (1.0f / 64.0f) + EPS);
#pragma unroll
        for (int j = 0; j < 4; ++j) outp[(size_t)tq * D + 16 * j + (lane & 15)] = f2bf((y[j][e] - mean) * rstd * gain[j] * siluf_(gate[e * 4 + j])); }
    __syncthreads();
}

__device__ __forceinline__ void engineA4(const LAS bf16_t* KWT, const LAS bf16_t* VT, bf16_t* DSbase  , int wave, int lane) {
    const int hh = wave >> 1, rt0 = (wave & 1) * 2;
#pragma unroll
    for (int q = 0; q < 2; ++q) { const int rt = rt0 + q;
        f32x4 acc[4];
#pragma unroll
        for (int j = 0; j < 4; ++j) acc[j] = (f32x4){0.f, 0.f, 0.f, 0.f};
        mm_nt<4, 2>(acc, KWT + (hh * 64 + 16 * rt) * 72, 72, VT + hh * 64 * 72, 72, lane);
        bf16_t* DS = DSbase + (size_t)hh * 32 * 4096;
#pragma unroll
        for (int j = 0; j < 4; ++j)
#pragma unroll
            for (int e = 0; e < 4; ++e) DS[(16 * rt + (lane >> 4) * 4 + e) * 64 + 16 * j + (lane & 15)] = f2bf(acc[j][e]); }
}
__device__ __forceinline__ void retA4_unit(PRM p, LAS unsigned char* lds, int l, int u) {
    const int tid = tidx(), lane = tid & 63, wave = tid >> 6;
    const int c = u & 31, b = u >> 5, row0 = b * 2048 + c * 64;
    const bf16_t* U = (const bf16_t*)(p.ws + OFF_U);
    const float* RC = (const float*)(p.ws + OFF_ROPE); const float* RS = RC + 2052 * 32;
    LAS bf16_t* KWT = (LAS bf16_t*)lds; LAS bf16_t* VT = (LAS bf16_t*)(lds + 36864);
    const int t = tid >> 3, c8 = (tid & 7) * 8, tt = (tid & 255) >> 2, j0 = (tid & 3) * 8;
    u32x4 vraw[4], x1[2], x2[2]; float cs[8], sn[8];
#pragma unroll
    for (int hh = 0; hh < 4; ++hh) vraw[hh] = ldg8(U + (size_t)(row0 + t) * NU + URV + hh * 64 + c8);
#pragma unroll
    for (int it = 0; it < 2; ++it) { const int hh = it * 2 + (tid >> 8); const bf16_t* ur = U + (size_t)(row0 + tt) * NU + URK + hh * 64 + j0; x1[it] = ldg8(ur); x2[it] = ldg8(ur + 32); }
    ld8f(RC + (size_t)(c * 64 + tt) * 32 + j0, cs); ld8f(RS + (size_t)(c * 64 + tt) * 32 + j0, sn);
#pragma unroll
    for (int hh = 0; hh < 4; ++hh)
#pragma unroll
        for (int i = 0; i < 8; ++i) VT[(hh * 64 + c8 + i) * 72 + t] = elem8(vraw[hh], i);
#pragma unroll
    for (int it = 0; it < 2; ++it) { const int hh = it * 2 + (tid >> 8);
        const float lg = logf(1.0f - exp2f(-5.0f - (float)hh)); const float w = __expf((float)(63 - tt) * lg) * 0.125f;
        float a[8], bb[8]; unpack8(x1[it], a); unpack8(x2[it], bb);
#pragma unroll
        for (int i = 0; i < 8; ++i) { KWT[(hh * 64 + j0 + i) * 72 + tt] = f2bf((a[i] * cs[i] - bb[i] * sn[i]) * w); KWT[(hh * 64 + j0 + 32 + i) * 72 + tt] = f2bf((bb[i] * cs[i] + a[i] * sn[i]) * w); } }
    __syncthreads();
    engineA4(KWT, VT, (bf16_t*)(p.ws + OFF_DSR) + ((size_t)(b * 4) * 32 + c) * 4096, wave, lane);
    __syncthreads();
}
__device__ __forceinline__ void hgA4_unit(PRM p, LAS unsigned char* lds, int l, int u) {
    const int tid = tidx(), lane = tid & 63, wave = tid >> 6;
    const int c = u & 31, b = u >> 5, row0 = b * 2048 + c * 64;
    const bf16_t* U = (const bf16_t*)(p.ws + OFF_U);
    LAS float* CUM = (LAS float*)lds; LAS bf16_t* KWT = (LAS bf16_t*)(lds + 65792); LAS bf16_t* VT = (LAS bf16_t*)(lds + 102656);
    const int t = tid >> 3, c8 = (tid & 7) * 8;
    u32x4 hfraw[4], viraw[4];
#pragma unroll
    for (int hh = 0; hh < 4; ++hh) { const bf16_t* ur = U + (size_t)(row0 + t) * NU + hh * 64 + c8; hfraw[hh] = ldg8(ur + UHF); viraw[hh] = ldg8(ur + UHI); }
#pragma unroll
    for (int hh = 0; hh < 4; ++hh) { float lb[8], hf[8]; ld8f((const float*)(p.ws + OFF_LB) + l * 256 + hh * 64 + c8, lb); unpack8(hfraw[hh], hf);
#pragma unroll
        for (int i = 0; i < 8; ++i) { VT[(hh * 64 + c8 + i) * 72 + t] = elem8(viraw[hh], i); CUM[t * 257 + hh * 64 + c8 + i] = __logf(lb[i] + (1.0f - lb[i]) * sigmoidf_(hf[i])); } }
    __syncthreads();
#pragma unroll 8
    for (int kk = 0; kk < 32; ++kk) { const int k = wave * 32 + kk; const float v = scan64_add(CUM[lane * 257 + k], lane); CUM[lane * 257 + k] = v; }
    __syncthreads();
#pragma unroll
    for (int hh = 0; hh < 4; ++hh) { float lb[8], hf[8]; ld8f((const float*)(p.ws + OFF_LB) + l * 256 + hh * 64 + c8, lb); unpack8(hfraw[hh], hf);
#pragma unroll
        for (int i = 0; i < 8; ++i) { const int ch = hh * 64 + c8 + i; const float kk_ = (1.0f - lb[i]) * sigmoidf_(-hf[i]);
            KWT[ch * 72 + t] = f2bf(kk_ * __expf(CUM[63 * 257 + ch] - CUM[t * 257 + ch])); } }
    if (tid < 256) ((float*)(p.ws + OFF_DECH))[((size_t)(b * 4 + (tid >> 6)) * 32 + c) * 64 + (tid & 63)] = __expf(CUM[63 * 257 + tid]);
    __syncthreads();
    engineA4(KWT, VT, (bf16_t*)(p.ws + OFF_DSH) + ((size_t)(b * 4) * 32 + c) * 4096, wave, lane);
    __syncthreads();
}

__device__ __forceinline__ void mixA_unit(PRM p, LAS unsigned char* lds, int l, int u) {
    RetRegs rr; HgRegs hr; RgRegs gr;
    ret_load<false>(p, l, u, rr); hg_load<false>(p, l, u, hr); rg_load<false>(p, l, u, gr);
    ret_body<false>(p, lds, l, u, rr); hg_body<false>(p, lds, l, u, hr); rg_body<false>(p, lds, l, u, gr);
}

__device__ __forceinline__ void mixC_unit(PRM p, LAS unsigned char* lds, int l, int u) {
    RetRegs rr; HgRegs hr; RgRegs gr;
    ret_load<true>(p, l, u, rr); hg_load<true>(p, l, u, hr); rg_load<true>(p, l, u, gr);
    ret_body<true>(p, lds, l, u, rr); hg_body<true>(p, lds, l, u, hr); rg_body<true>(p, lds, l, u, gr);
}

__device__ __forceinline__ void carry_phase(PRM p, int l) {
    const int gt = blockIdx.x * NTHR + tidx(), NG = gridDim.x * NTHR;
    constexpr int N_SSD = 8 * 4 * 4096, N_RET = 8 * 4 * 2048, N_HG = N_RET, N_RG = 8 * 256;
    for (int i = gt; i < N_SSD + N_RET + N_HG + N_RG; i += NG) {
        if (i < N_SSD + N_RET + N_HG) {
            unsigned* base; float dec[32]; size_t stride, oo;
            if (i < N_SSD) { const int bh = i >> 12, e2 = i & 4095; base = (unsigned*)(p.ws + OFF_DSS) + (size_t)bh * 32 * 4096 + e2; stride = 4096;
                const float* dc = (const float*)(p.ws + OFF_DECS) + bh * 32;
#pragma unroll
                for (int c = 0; c < 32; ++c) dec[c] = dc[c];
                oo = O_PSSD + (size_t)l * 8 * 32768 + (size_t)bh * 8192 + 2 * e2;
            } else if (i < N_SSD + N_RET) { const int j = i - N_SSD, bh = j >> 11, e2 = j & 2047; base = (unsigned*)(p.ws + OFF_DSR) + (size_t)bh * 32 * 2048 + e2; stride = 2048;
                const float d = expf(64.0f * logf(1.0f - exp2f(-5.0f - (float)(bh & 3))));
#pragma unroll
                for (int c = 0; c < 32; ++c) dec[c] = d;
                oo = O_PRET + (size_t)l * 8 * 16384 + (size_t)bh * 4096 + 2 * e2;
            } else { const int j = i - N_SSD - N_RET, bh = j >> 11, e2 = j & 2047; base = (unsigned*)(p.ws + OFF_DSH) + (size_t)bh * 32 * 2048 + e2; stride = 2048;
                const float* dc = (const float*)(p.ws + OFF_DECH) + (size_t)bh * 32 * 64 + (e2 >> 5);
#pragma unroll
                for (int c = 0; c < 32; ++c) dec[c] = dc[c * 64];
                oo = O_PHG + (size_t)l * 8 * 16384 + (size_t)bh * 4096 + 2 * e2;
            }
            unsigned tmp[32];
#pragma unroll
            for (int c = 0; c < 32; ++c) tmp[c] = base[(size_t)c * stride];
            float s0 = 0.f, s1 = 0.f;
#pragma unroll
            for (int c = 0; c < 32; ++c) { base[(size_t)c * stride] = pk2(s0, s1);
                s0 = dec[c] * s0 + __uint_as_float(tmp[c] << 16); s1 = dec[c] * s1 + __uint_as_float(tmp[c] & 0xffff0000u); }
            *(f32x2*)(p.out + oo) = (f32x2){s0, s1};
        } else {
            const int j = i - N_SSD - N_RET - N_HG, b = j >> 8, ch = j & 255;
            const float* hl = (const float*)(p.ws + OFF_RGH) + (size_t)b * 32 * 256 + ch; const float* at = (const float*)(p.ws + OFF_RGA) + (size_t)b * 32 * 256 + ch;
            float* cr = (float*)(p.ws + OFF_RGC) + (size_t)b * 32 * 256 + ch;
            float tmp[32], dec[32];
#pragma unroll
            for (int c = 0; c < 32; ++c) { tmp[c] = hl[c * 256]; dec[c] = at[c * 256]; }
            float sacc = 0.f;
#pragma unroll
            for (int c = 0; c < 32; ++c) { cr[c * 256] = sacc; sacc = dec[c] * sacc + tmp[c]; }
            p.out[O_PRG + (size_t)l * 8 * 256 + b * 256 + ch] = sacc;
        }
    }
}

constexpr int S_QD = 0, S_KW = 8192, S_V = 16384, S_DEC = 20480, S_P = 22528, S_Y = 22784, S_RED = 26880, S_SCR = 59648;
template <int KD>
__device__ __forceinline__ void dec_engine(const float* S0, float* S1, LAS unsigned char* lds) {
    const int tid = tidx(), p_ = tid & 63, kq = tid >> 6; constexpr int KPER = KD / 8;
    const LAS float* QDs = (const LAS float*)(lds + S_QD); const LAS float* KWs = (const LAS float*)(lds + S_KW); const LAS float* Vs = (const LAS float*)(lds + S_V);
    const LAS float* DECs = (const LAS float*)(lds + S_DEC); const LAS float* Ps = (const LAS float*)(lds + S_P); LAS float* Ys = (LAS float*)(lds + S_Y); LAS float* RED = (LAS float*)(lds + S_RED);
    float v[4][4], yp[4][4];
#pragma unroll
    for (int h = 0; h < 4; ++h)
#pragma unroll
        for (int s = 0; s < 4; ++s) { v[h][s] = Vs[s * 256 + h * 64 + p_]; yp[h][s] = 0.f; }
#pragma unroll
    for (int h = 0; h < 4; ++h) {
#pragma unroll
        for (int kk = 0; kk < KPER; ++kk) { const int k = kq * KPER + kk;
            const float s0 = S0[(size_t)(h * KD + k) * 64 + p_];
            const f32x4 kw = *(const LAS f32x4*)(KWs + (h * 128 + k) * 4), qd = *(const LAS f32x4*)(QDs + (h * 128 + k) * 4);
            const float acc = DECs[h * 128 + k] * s0 + kw.x * v[h][0] + kw.y * v[h][1] + kw.z * v[h][2] + kw.w * v[h][3];
            S1[(size_t)(h * KD + k) * 64 + p_] = acc;
            yp[h][0] += qd.x * s0; yp[h][1] += qd.y * s0; yp[h][2] += qd.z * s0; yp[h][3] += qd.w * s0;
        }
    }
#pragma unroll
    for (int h = 0; h < 4; ++h)
#pragma unroll
        for (int t = 0; t < 4; ++t) RED[(kq * 16 + h * 4 + t) * 64 + p_] = yp[h][t];
    __syncthreads();
    for (int idx = tid; idx < 1024; idx += NTHR) { const int p2 = idx & 63, ht = idx >> 6, h = ht >> 2, t = ht & 3;
        float sum = 0.f;
#pragma unroll
        for (int q = 0; q < 8; ++q) sum += RED[(q * 16 + ht) * 64 + p2];
        for (int s = 0; s <= t; ++s) sum += Ps[ht * 4 + s] * Vs[s * 256 + h * 64 + p2];
        Ys[t * 256 + h * 64 + p2] = sum; }
    __syncthreads();
}

__device__ __forceinline__ void sample_ssd(PRM p, LAS unsigned char* lds, int l, int b) {
    const int tid = tidx(), lane = tid & 63, wave = tid >> 6, R0 = TP + b * 4;
    const bf16_t* U = (const bf16_t*)(p.ws + OFF_U); const float* SDT = (const float*)(p.ws + OFF_SDT);
    LAS float* QDs = (LAS float*)(lds + S_QD); LAS float* KWs = (LAS float*)(lds + S_KW); LAS float* Vs = (LAS float*)(lds + S_V);
    LAS float* DECs = (LAS float*)(lds + S_DEC); LAS float* Ps = (LAS float*)(lds + S_P); LAS float* Ys = (LAS float*)(lds + S_Y);
    LAS float* XB = (LAS float*)(lds + S_SCR); LAS float* DTs = (LAS float*)(lds + S_SCR + 12288); LAS float* CUs = DTs + 16;
    for (int ch = tid; ch < 768; ch += NTHR) {
        float xx[7];
#pragma unroll
        for (int r = 0; r < 3; ++r) xx[r] = p.in[3][((size_t)(l * 128 + b) * 3 + r) * 768 + ch];
#pragma unroll
        for (int t = 0; t < 4; ++t) xx[3 + t] = bf2f(U[(size_t)(R0 + t) * NU + UXBC + ch]);
        const float* cw = p.in[18] + (size_t)l * 4 * 768 + ch; const float w0 = cw[0], w1 = cw[768], w2 = cw[1536], w3 = cw[2304], bias = p.in[19][l * 768 + ch];
#pragma unroll
        for (int t = 0; t < 4; ++t) XB[t * 768 + ch] = siluf_(bias + w0 * xx[t] + w1 * xx[t + 1] + w2 * xx[t + 2] + w3 * xx[t + 3]);
#pragma unroll
        for (int r = 0; r < 3; ++r) p.out[O_SSSDC + ((size_t)(l * 128 + b) * 3 + r) * 768 + ch] = xx[4 + r];
    }
    if (tid < 4) { const int h = tid; float cum = 0.f; const float bias = p.in[20][l * 4 + h], A = -expf(p.in[21][l * 4 + h]);
        for (int t = 0; t < 4; ++t) { const float dt = softplusf_(SDT[(size_t)(R0 + t) * 4 + h] + bias); cum += A * dt; DTs[h * 4 + t] = dt; CUs[h * 4 + t] = cum; } }
    __syncthreads();
    for (int idx = tid; idx < 2048; idx += NTHR) { const int h = idx >> 9, t = (idx >> 7) & 3, n = idx & 127, g = h >> 1;
        QDs[(h * 128 + n) * 4 + t] = XB[t * 768 + 512 + g * 128 + n] * __expf(CUs[h * 4 + t]);
        KWs[(h * 128 + n) * 4 + t] = XB[t * 768 + 256 + g * 128 + n] * __expf(CUs[h * 4 + 3] - CUs[h * 4 + t]) * DTs[h * 4 + t]; }
    for (int idx = tid; idx < 1024; idx += NTHR) Vs[idx] = XB[(idx >> 8) * 768 + (idx & 255)];
    DECs[(tid >> 7) * 128 + (tid & 127)] = __expf(CUs[(tid >> 7) * 4 + 3]);
    if (tid < 64) { const int h = tid >> 4, t = (tid >> 2) & 3, s = tid & 3, g = h >> 1; float val = 0.f;
        if (s <= t) { float dot = 0.f;
#pragma unroll 32
            for (int n = 0; n < 128; ++n) dot += XB[t * 768 + 512 + g * 128 + n] * XB[s * 768 + 256 + g * 128 + n];
            val = dot * __expf(CUs[h * 4 + t] - CUs[h * 4 + s]) * DTs[h * 4 + s]; }
        Ps[tid] = val; }
    __syncthreads();
    dec_engine<128>(p.in[2] + (size_t)(l * 128 + b) * 32768, p.out + O_SSSD + (size_t)(l * 128 + b) * 32768, lds);
    for (int idx = tid; idx < 1024; idx += NTHR) { const int t = idx >> 8, ch = idx & 255, h = ch >> 6;
        const float y = Ys[idx] + p.in[22][l * 4 + h] * XB[t * 768 + ch];
        Ys[idx] = y * siluf_(bf2f(U[(size_t)(R0 + t) * NU + UZ + ch])); }
    __syncthreads();
    if (wave < 4) { const int t = wave; float v[4], ss = 0.f;
#pragma unroll
        for (int i = 0; i < 4; ++i) { v[i] = Ys[t * 256 + lane + 64 * i]; ss += v[i] * v[i]; }
        const float rstd = 1.0f / sqrtf(wave_sum(ss) * (1.0f / 256.0f) + EPS);
#pragma unroll
        for (int i = 0; i < 4; ++i) ((bf16_t*)(p.ws + OFF_YC))[(size_t)(R0 + t) * D + lane + 64 * i] = f2bf(v[i] * rstd * p.in[23][l * 256 + lane + 64 * i]); }
    __syncthreads();
}

template <bool CENTER>
__device__ __forceinline__ void sample_headnorm(PRM p, LAS unsigned char* lds, int R0, const float* gain, int gcol, int ocol) {
    const int tid = tidx(), lane = tid & 63, wave = tid >> 6;
    const bf16_t* U = (const bf16_t*)(p.ws + OFF_U); const LAS float* Ys = (const LAS float*)(lds + S_Y);
#pragma unroll
    for (int q = 0; q < 2; ++q) { const int gi = wave * 2 + q, t = gi >> 2, h = gi & 3;
        const float y = Ys[t * 256 + h * 64 + lane];
        const float mean = CENTER ? wave_sum(y) * (1.0f / 64.0f) : 0.f; const float d = y - mean;
        const float var = wave_sum(d * d) * (1.0f / 64.0f);
        const float o = d / sqrtf(var + EPS) * gain[h * 64 + lane] * siluf_(bf2f(U[(size_t)(R0 + t) * NU + gcol + h * 64 + lane]));
        ((bf16_t*)(p.ws + OFF_YC))[(size_t)(R0 + t) * D + ocol + h * 64 + lane] = f2bf(o); }
}

__device__ __forceinline__ void sample_ret(PRM p, LAS unsigned char* lds, int l, int b) {
    const int tid = tidx(), R0 = TP + b * 4;
    const bf16_t* U = (const bf16_t*)(p.ws + OFF_U);
    const float* RC = (const float*)(p.ws + OFF_ROPE); const float* RS = RC + 2052 * 32;
    LAS float* QDs = (LAS float*)(lds + S_QD); LAS float* KWs = (LAS float*)(lds + S_KW); LAS float* Vs = (LAS float*)(lds + S_V);
    LAS float* DECs = (LAS float*)(lds + S_DEC); LAS float* Ps = (LAS float*)(lds + S_P);
    LAS float* Qr = (LAS float*)(lds + S_SCR); LAS float* Kr = Qr + 1024;
    { const int h = tid >> 7, t = (tid >> 5) & 3, j = tid & 31; const bf16_t* ur = U + (size_t)(R0 + t) * NU;
        const float cs = RC[(2048 + t) * 32 + j], sn = RS[(2048 + t) * 32 + j];
        const float q1 = bf2f(ur[URQ + h * 64 + j]), q2 = bf2f(ur[URQ + h * 64 + j + 32]), k1 = bf2f(ur[URK + h * 64 + j]), k2 = bf2f(ur[URK + h * 64 + j + 32]);
        Qr[(h * 4 + t) * 64 + j] = q1 * cs - q2 * sn; Qr[(h * 4 + t) * 64 + j + 32] = q2 * cs + q1 * sn;
        Kr[(h * 4 + t) * 64 + j] = (k1 * cs - k2 * sn) * 0.125f; Kr[(h * 4 + t) * 64 + j + 32] = (k2 * cs + k1 * sn) * 0.125f; }
    for (int idx = tid; idx < 1024; idx += NTHR) Vs[idx] = bf2f(U[(size_t)(R0 + (idx >> 8)) * NU + URV + (idx & 255)]);
    __syncthreads();
    for (int idx = tid; idx < 1024; idx += NTHR) { const int h = idx >> 8, t = (idx >> 6) & 3, k = idx & 63; const float lg = logf(1.0f - exp2f(-5.0f - (float)h));
        QDs[(h * 128 + k) * 4 + t] = Qr[(h * 4 + t) * 64 + k] * __expf((float)(t + 1) * lg);
        KWs[(h * 128 + k) * 4 + t] = Kr[(h * 4 + t) * 64 + k] * __expf((float)(3 - t) * lg); }
    if (tid < 256) { const int h = tid >> 6; DECs[h * 128 + (tid & 63)] = __expf(4.0f * logf(1.0f - exp2f(-5.0f - (float)h))); }
    if (tid < 64) { const int h = tid >> 4, t = (tid >> 2) & 3, s = tid & 3; float val = 0.f;
        if (s <= t) { float dot = 0.f;
#pragma unroll 32
            for (int k = 0; k < 64; ++k) dot += Qr[(h * 4 + t) * 64 + k] * Kr[(h * 4 + s) * 64 + k];
            val = dot * __expf((float)(t - s) * logf(1.0f - exp2f(-5.0f - (float)h))); }
        Ps[tid] = val; }
    __syncthreads();
    dec_engine<64>(p.in[4] + (size_t)(l * 128 + b) * 16384, p.out + O_SRET + (size_t)(l * 128 + b) * 16384, lds);
    sample_headnorm<true>(p, lds, R0, p.in[24] + l * 256, URG, 256);
    __syncthreads();
}

__device__ __forceinline__ void sample_hg(PRM p, LAS unsigned char* lds, int l, int b) {
    const int tid = tidx(), R0 = TP + b * 4;
    const bf16_t* U = (const bf16_t*)(p.ws + OFF_U);
    LAS float* QDs = (LAS float*)(lds + S_QD); LAS float* KWs = (LAS float*)(lds + S_KW); LAS float* Vs = (LAS float*)(lds + S_V);
    LAS float* DECs = (LAS float*)(lds + S_DEC); LAS float* Ps = (LAS float*)(lds + S_P);
    LAS float* LF = (LAS float*)(lds + S_SCR); LAS float* KK = LF + 1024; LAS float* QH = KK + 1024;
    for (int idx = tid; idx < 1024; idx += NTHR) { const int t = idx >> 8, ch = idx & 255; const bf16_t* ur = U + (size_t)(R0 + t) * NU;
        float lbk = 0.f;
        if (l > 0) { const float a0 = p.in[32][ch], a1 = p.in[32][256 + ch]; const float mx = fmaxf(a0, a1), e0 = expf(a0 - mx), e1 = expf(a1 - mx); lbk = e1 / (e0 + e1); }
        const float hf = bf2f(ur[UHF + ch]);
        LF[idx] = logf(lbk + (1.0f - lbk) * sigmoidf_(hf)); KK[idx] = (1.0f - lbk) * sigmoidf_(-hf); QH[idx] = siluf_(bf2f(ur[UHQ + ch])); Vs[idx] = bf2f(ur[UHI + ch]); }
    __syncthreads();
    if (tid < 256) { float c = 0.f; for (int t = 0; t < 4; ++t) { c += LF[t * 256 + tid]; LF[t * 256 + tid] = c; } }
    __syncthreads();
    for (int idx = tid; idx < 1024; idx += NTHR) { const int h = idx >> 8, t = (idx >> 6) & 3, k = idx & 63, ch = h * 64 + k;
        const float cum = LF[t * 256 + ch], last = LF[3 * 256 + ch];
        QDs[(h * 128 + k) * 4 + t] = QH[t * 256 + ch] * __expf(cum); KWs[(h * 128 + k) * 4 + t] = KK[t * 256 + ch] * __expf(last - cum); }
    if (tid < 256) DECs[(tid >> 6) * 128 + (tid & 63)] = __expf(LF[3 * 256 + tid]);
    if (tid < 64) { const int h = tid >> 4, t = (tid >> 2) & 3, s = tid & 3; float val = 0.f;
        if (s <= t)
#pragma unroll 16
            for (int k = 0; k < 64; ++k) { const int ch = h * 64 + k; val += QH[t * 256 + ch] * KK[s * 256 + ch] * __expf(LF[t * 256 + ch] - LF[s * 256 + ch]); }
        Ps[tid] = val; }
    __syncthreads();
    dec_engine<64>(p.in[7] + (size_t)(l * 128 + b) * 16384, p.out + O_SHG + (size_t)(l * 128 + b) * 16384, lds);
    sample_headnorm<false>(p, lds, R0, p.in[33] + l * 256, UHG, 768);
    __syncthreads();
}

__device__ __forceinline__ void sample_rg(PRM p, LAS unsigned char* lds, int l, int b) {
    const int tid = tidx(), R0 = TP + b * 4;
    const bf16_t* U = (const bf16_t*)(p.ws + OFF_U);
    LAS float* XRs = (LAS float*)(lds + S_SCR); LAS float* GA = XRs + 1024;
    if (tid < 256) { const int ch = tid; float xx[7];
#pragma unroll
        for (int r = 0; r < 3; ++r) xx[r] = p.in[6][((size_t)(l * 128 + b) * 3 + r) * 256 + ch];
#pragma unroll
        for (int t = 0; t < 4; ++t) xx[3 + t] = bf2f(U[(size_t)(R0 + t) * NU + UGX + ch]);
        const float* cw = p.in[25] + (size_t)l * 4 * 256 + ch; const float w0 = cw[0], w1 = cw[256], w2 = cw[512], w3 = cw[768], bias = p.in[26][l * 256 + ch];
#pragma unroll
        for (int t = 0; t < 4; ++t) XRs[t * 256 + ch] = bias + w0 * xx[t] + w1 * xx[t + 1] + w2 * xx[t + 2] + w3 * xx[t + 3];
#pragma unroll
        for (int r = 0; r < 3; ++r) p.out[O_SRGC + ((size_t)(l * 128 + b) * 3 + r) * 256 + ch] = xx[4 + r]; }
    __syncthreads();
    { const int ch = tid & 255, gate = tid >> 8, blk = ch >> 6, j = ch & 63; const float* W = p.in[gate ? 29 : 27] + (size_t)(l * 4 + blk) * 4096;
        float a0 = 0.f, a1 = 0.f, a2 = 0.f, a3 = 0.f, wv[64];
#pragma unroll
        for (int i = 0; i < 64; ++i) wv[i] = W[i * 64 + j];
#pragma unroll
        for (int i = 0; i < 64; ++i) { const float w = wv[i];
            a0 += XRs[blk * 64 + i] * w; a1 += XRs[256 + blk * 64 + i] * w; a2 += XRs[512 + blk * 64 + i] * w; a3 += XRs[768 + blk * 64 + i] * w; }
        GA[(gate * 4 + 0) * 256 + ch] = a0; GA[(gate * 4 + 1) * 256 + ch] = a1; GA[(gate * 4 + 2) * 256 + ch] = a2; GA[(gate * 4 + 3) * 256 + ch] = a3; }
    __syncthreads();
    if (tid < 256) { const int ch = tid; float h = p.in[5][(size_t)(l * 128 + b) * 256 + ch];
        const float ba = p.in[28][l * 256 + ch], bx = p.in[30][l * 256 + ch], sp = -8.0f * softplusf_(-p.in[31][l * 256 + ch]);
        for (int t = 0; t < 4; ++t) { const float r = sigmoidf_(GA[t * 256 + ch] + ba), ig = sigmoidf_(GA[(4 + t) * 256 + ch] + bx);
            const float la = sp * r; h = __expf(la) * h + sqrtf(-expm1f(2.0f * la)) * ig * XRs[t * 256 + ch];
            ((bf16_t*)(p.ws + OFF_YC))[(size_t)(R0 + t) * D + 512 + ch] = f2bf(geluf_(bf2f(U[(size_t)(R0 + t) * NU + UGY + ch])) * h); }
        p.out[O_SRG + (size_t)(l * 128 + b) * 256 + ch] = h; }
    __syncthreads();
}

__device__ __forceinline__ void attn_prompt(PRM p, LAS unsigned char* lds, int u) {
    const int tid = tidx(), lane = tid & 63, wave = tid >> 6, fr = lane & 15, fq = lane >> 4;
    const int qt = u & 15, h = (u >> 4) & 3, b = u >> 6, r0 = b * 2048 + qt * 128;
    const bf16_t* Q = (const bf16_t*)(p.ws + OFF_Q); const bf16_t* KBp = (const bf16_t*)(p.ws + OFF_KB) + (size_t)(b * 4 + h) * 65536;
    const bf16_t* VTp = (const bf16_t*)(p.ws + OFF_VTB) + (size_t)(b * 4 + h) * 65536; bf16_t* OB = (bf16_t*)(p.ws + OFF_YC);
    LAS bf16_t* KC = (LAS bf16_t*)lds; LAS bf16_t* PS = (LAS bf16_t*)(lds + 36864);
    bf16x8 qf[8];
#pragma unroll
    for (int ks = 0; ks < 8; ++ks) qf[ks] = *(const bf16x8*)(Q + (size_t)(r0 + 16 * wave + fr) * D + h * 256 + ks * 32 + fq * 8);
    u32x4 kr[4];
    const int sr = tid >> 3, sc8 = (tid & 7) * 8;
#pragma unroll
    for (int i = 0; i < 4; ++i) kr[i] = *(const u32x4*)(KBp + (size_t)(sr + 64 * i) * 256 + sc8);
    f32x4 S[16];
#pragma unroll
    for (int j = 0; j < 16; ++j) S[j] = (f32x4){0.f, 0.f, 0.f, 0.f};
#pragma unroll
    for (int dc = 0; dc < 4; ++dc) {
#pragma unroll
        for (int i = 0; i < 4; ++i) *(LAS u32x4*)(KC + (sr + 64 * i) * 72 + sc8) = kr[i];
        __syncthreads();
        if (dc < 3) {
#pragma unroll
            for (int i = 0; i < 4; ++i) kr[i] = *(const u32x4*)(KBp + (size_t)(sr + 64 * i) * 256 + (dc + 1) * 64 + sc8);
        } else {
#pragma unroll
            for (int i = 0; i < 4; ++i) kr[i] = *(const u32x4*)(VTp + (size_t)(sr + 64 * i) * 256 + sc8);
        }
#pragma unroll
        for (int k2 = 0; k2 < 2; ++k2)
#pragma unroll
            for (int j = 0; j < 16; ++j) { const bf16x8 kf = *(const LAS bf16x8*)(KC + (16 * j + fr) * 72 + k2 * 32 + fq * 8);
                S[j] = __builtin_amdgcn_mfma_f32_16x16x32_bf16(kf, qf[dc * 2 + k2], S[j], 0, 0, 0); }
        __syncthreads();
    }
    {
        float m = -3.0e38f;
#pragma unroll
        for (int j = 0; j < 16; ++j) m = fmaxf(fmaxf(m, fmaxf(S[j][0], S[j][1])), fmaxf(S[j][2], S[j][3]));
        m = fmaxf(m, __shfl_xor(m, 16)); m = fmaxf(m, __shfl_xor(m, 32));
        float sm = 0.f;
#pragma unroll
        for (int j = 0; j < 16; ++j)
#pragma unroll
            for (int e = 0; e < 4; ++e) { const float ev = __expf((S[j][e] - m) * 0.0625f); S[j][e] = ev; sm += ev; }
        sm += __shfl_xor(sm, 16); sm += __shfl_xor(sm, 32);
        const float inv = 1.0f / sm;
#pragma unroll
        for (int j = 0; j < 16; ++j) { u32x2 w; w.x = pk2(S[j][0] * inv, S[j][1] * inv); w.y = pk2(S[j][2] * inv, S[j][3] * inv);
            *(LAS u32x2*)(PS + (16 * wave + fr) * 264 + 16 * j + 4 * fq) = w; }
    }
    f32x4 O[16];
#pragma unroll
    for (int j = 0; j < 16; ++j) O[j] = (f32x4){0.f, 0.f, 0.f, 0.f};
#pragma unroll
    for (int kc = 0; kc < 4; ++kc) {
#pragma unroll
        for (int i = 0; i < 4; ++i) *(LAS u32x4*)(KC + (sr + 64 * i) * 72 + sc8) = kr[i];
        __syncthreads();
        if (kc < 3) {
#pragma unroll
            for (int i = 0; i < 4; ++i) kr[i] = *(const u32x4*)(VTp + (size_t)(sr + 64 * i) * 256 + (kc + 1) * 64 + sc8);
        }
#pragma unroll
        for (int k2 = 0; k2 < 2; ++k2) { const bf16x8 pf = *(const LAS bf16x8*)(PS + (16 * wave + fr) * 264 + kc * 64 + k2 * 32 + fq * 8);
#pragma unroll
            for (int j = 0; j < 16; ++j) { const bf16x8 vf = *(const LAS bf16x8*)(KC + (16 * j + fr) * 72 + k2 * 32 + fq * 8);
                O[j] = __builtin_amdgcn_mfma_f32_16x16x32_bf16(vf, pf, O[j], 0, 0, 0); } }
        __syncthreads();
    }
#pragma unroll
    for (int j = 0; j < 16; ++j) { u32x2 w; w.x = pk2(O[j][0], O[j][1]); w.y = pk2(O[j][2], O[j][3]);
        *(u32x2*)(OB + (size_t)(r0 + 16 * wave + fr) * D + h * 256 + 16 * j + 4 * fq) = w; }
}

__device__ __forceinline__ void attn_sample(PRM p, LAS unsigned char* lds, int l, int u) {
    const int tid = tidx(), lane = tid & 63, wave = tid >> 6;
    const int h = u & 3, b = u >> 2, R0 = TP + b * 4;
    const bf16_t* Q = (const bf16_t*)(p.ws + OFF_Q); bf16_t* OB = (bf16_t*)(p.ws + OFF_YC);
    LAS float* QSs = (LAS float*)lds; LAS float* SCT = QSs + 1024; LAS float* OP = SCT + 1024;
    const float* Kp = p.in[8] + ((size_t)(l * 128 + b) * 256) * 1024 + h * 256 + lane * 4;
    f32x4 kvn[8];
#pragma unroll
    for (int i = 0; i < 8; ++i) kvn[i] = *(const f32x4*)(Kp + (size_t)(wave * 32 + i) * 1024);
    for (int idx = tid; idx < 1024; idx += NTHR) QSs[idx] = bf2f(Q[(size_t)(R0 + (idx >> 8)) * D + h * 256 + (idx & 255)]) * 0.0625f;
    __syncthreads();
    f32x4 q[4];
#pragma unroll
    for (int t = 0; t < 4; ++t) q[t] = *(const LAS f32x4*)(QSs + t * 256 + lane * 4);
#pragma unroll 1
    for (int i0 = 0; i0 < 32; i0 += 8) {
        f32x4 kv[8];
#pragma unroll
        for (int i = 0; i < 8; ++i) kv[i] = kvn[i];
        if (i0 + 8 < 32) {
#pragma unroll
            for (int i = 0; i < 8; ++i) kvn[i] = *(const f32x4*)(Kp + (size_t)(wave * 32 + i0 + 8 + i) * 1024);
        }
        float vals[32];
#pragma unroll
        for (int i = 0; i < 8; ++i)
#pragma unroll
            for (int t = 0; t < 4; ++t) vals[i * 4 + t] = kv[i].x * q[t].x + kv[i].y * q[t].y + kv[i].z * q[t].z + kv[i].w * q[t].w;
#define TR_STEP(N, BIT, XCHG) { const bool up = (lane & (BIT)) != 0; _Pragma("unroll") for (int i = 0; i < (N); ++i) { \
            const float send = up ? vals[i] : vals[i + (N)]; const float keep = up ? vals[i + (N)] : vals[i]; vals[i] = keep + XCHG(send); } }
#define X_ROR8(v) DPP_F(0.f, v, 0x128, 0xf)
#define X_QP1(v) DPP_F(0.f, v, 0xB1, 0xf)
#define X_QP2(v) DPP_F(0.f, v, 0x4E, 0xf)
#define X_B4(v) __shfl_xor(v, 4)
#define X_B16(v) __shfl_xor(v, 16)
        TR_STEP(16, 8, X_ROR8) TR_STEP(8, 1, X_QP1) TR_STEP(4, 2, X_QP2) TR_STEP(2, 4, X_B4) TR_STEP(1, 16, X_B16)
#undef TR_STEP
        const float tot = vals[0] + __shfl_xor(vals[0], 32);
        if (lane < 32) { const int vi = (((lane >> 3) & 1) << 4) | ((lane & 1) << 3) | (((lane >> 1) & 1) << 2) | (((lane >> 2) & 1) << 1) | ((lane >> 4) & 1);
            SCT[(wave * 32 + i0 + (vi >> 2)) * 4 + (vi & 3)] = tot; }
    }
    const float* Vp = p.in[9] + ((size_t)(l * 128 + b) * 256) * 1024 + h * 256 + lane * 4;
    f32x4 vvn[8];
#pragma unroll
    for (int i = 0; i < 8; ++i) vvn[i] = *(const f32x4*)(Vp + (size_t)(wave * 32 + i) * 1024);
    __syncthreads();
    if (wave < 4) { const int t = wave; float v[4], m = -3.0e38f;
#pragma unroll
        for (int i = 0; i < 4; ++i) { v[i] = SCT[(lane + 64 * i) * 4 + t]; m = fmaxf(m, v[i]); }
        m = wave_max(m); float sm = 0.f;
#pragma unroll
        for (int i = 0; i < 4; ++i) { v[i] = __expf(v[i] - m); sm += v[i]; }
        sm = 1.0f / wave_sum(sm);
#pragma unroll
        for (int i = 0; i < 4; ++i) SCT[(lane + 64 * i) * 4 + t] = v[i] * sm; }
    __syncthreads();
    {
        f32x4 acc[4];
#pragma unroll
        for (int t = 0; t < 4; ++t) acc[t] = (f32x4){0.f, 0.f, 0.f, 0.f};
#pragma unroll 1
        for (int i0 = 0; i0 < 32; i0 += 8) {
            f32x4 vv[8];
#pragma unroll
            for (int i = 0; i < 8; ++i) vv[i] = vvn[i];
            if (i0 + 8 < 32) {
#pragma unroll
                for (int i = 0; i < 8; ++i) vvn[i] = *(const f32x4*)(Vp + (size_t)(wave * 32 + i0 + 8 + i) * 1024);
            }
#pragma unroll
            for (int i = 0; i < 8; ++i) { const f32x4 pr = *(const LAS f32x4*)(SCT + (wave * 32 + i0 + i) * 4);
                acc[0] = acc[0] + vv[i] * pr.x; acc[1] = acc[1] + vv[i] * pr.y; acc[2] = acc[2] + vv[i] * pr.z; acc[3] = acc[3] + vv[i] * pr.w; }
        }
#pragma unroll
        for (int t = 0; t < 4; ++t) *(LAS f32x4*)(OP + (wave * 4 + t) * 256 + lane * 4) = acc[t];
    }
    __syncthreads();
    for (int idx = tid; idx < 1024; idx += NTHR) { float o = 0.f;
#pragma unroll
        for (int w = 0; w < 8; ++w) o += OP[w * 1024 + idx];
        OB[(size_t)(R0 + (idx >> 8)) * D + h * 256 + (idx & 255)] = f2bf(o); }
    __syncthreads();
}

template <int MODE, int K, int KC>
__device__ __forceinline__ void sgemm(LAS unsigned char* lds, const bf16_t* A, const bf16_t* Bt, float* Cf, bf16_t* Cb) {
    const int tid = tidx(), lane = tid & 63, wave = tid >> 6, fr = lane & 15, fq = lane >> 4;
    constexpr int NCH = KC / 8, NI = (32 * NCH + NTHR - 1) / NTHR, LD = KC + 8, NSLAB = K / KC;
    LAS bf16_t* AS = (LAS bf16_t*)lds; LAS bf16_t* BS = (LAS bf16_t*)(lds + 32 * LD * 2);
    const int rt = (wave >> 1) & 1, ct = wave & 1;
    const int ntile = (512 - (int)blockIdx.x + (int)gridDim.x - 1) / (int)gridDim.x, nstep = ntile * NSLAB;
    u32x4 ra[NI], rb[NI];
    auto issue = [&](int step) { const int tile = blockIdx.x + (step / NSLAB) * gridDim.x, k0 = (step % NSLAB) * KC, tm = tile >> 5, tn = tile & 31;
#pragma unroll
        for (int i = 0; i < NI; ++i) { const int idx = tid + i * NTHR; const int r = idx / NCH, cc = idx % NCH;
            if (idx < 32 * NCH) { ra[i] = ldg8(A + (size_t)(tm * 32 + r) * K + k0 + cc * 8); rb[i] = ldg8(Bt + (size_t)(tn * 32 + r) * K + k0 + cc * 8); } } };
    if (nstep > 0) issue(0);
    f32x4 acc = (f32x4){0.f, 0.f, 0.f, 0.f};
#pragma unroll 1
    for (int step = 0; step < nstep; ++step) {
#pragma unroll
        for (int i = 0; i < NI; ++i) { const int idx = tid + i * NTHR; const int r = idx / NCH, cc = idx % NCH;
            if (idx < 32 * NCH) { *(LAS u32x4*)(AS + r * LD + cc * 8) = ra[i]; *(LAS u32x4*)(BS + r * LD + cc * 8) = rb[i]; } }
        __syncthreads();
        if (step + 1 < nstep) issue(step + 1);
        if (wave < 4) {
#pragma unroll 4
            for (int ks = 0; ks < KC / 32; ++ks) { const bf16x8 a = *(const LAS bf16x8*)(AS + (16 * rt + fr) * LD + ks * 32 + fq * 8);
                const bf16x8 b = *(const LAS bf16x8*)(BS + (16 * ct + fr) * LD + ks * 32 + fq * 8);
                acc = __builtin_amdgcn_mfma_f32_16x16x32_bf16(a, b, acc, 0, 0, 0); }
            if ((step % NSLAB) == NSLAB - 1) { const int tile = blockIdx.x + (step / NSLAB) * gridDim.x, tm = tile >> 5, tn = tile & 31;
#pragma unroll
                for (int e = 0; e < 4; ++e) { const size_t o = (size_t)(tm * 32 + 16 * rt + fq * 4 + e) * 1024 + tn * 32 + 16 * ct + fr;
                    if (MODE == 0) Cf[o] = acc[e]; else Cb[o] = f2bf(acc[e]); }
                acc = (f32x4){0.f, 0.f, 0.f, 0.f}; }
        }
        __syncthreads();
    }
}

#ifndef REP_SYNC
#define REP_SYNC 1
#endif
#define GSYNC() do { _Pragma("unroll 1") for (int _r = 0; _r < REP_SYNC; ++_r) xcd_barrier(xb); } while (0)
#ifndef REP_SAMP
#define REP_SAMP 1
#endif
#ifndef REP_SSD
#define REP_SSD 1
#endif
#ifndef REP_ROWS
#define REP_ROWS 1
#endif
#ifndef REP_P0
#define REP_P0 1
#endif
#ifndef REP_GEMM
#define REP_GEMM 1
#endif
#ifndef REP_MIX
#define REP_MIX 1
#endif
#ifndef REP_ATT
#define REP_ATT 1
#endif
__global__ void __launch_bounds__(512) mega(Params p_unused) {
    const KPRM kp = (KPRM)__builtin_amdgcn_kernarg_segment_ptr();
#define PP (*kp_launder(kp))
    extern __shared__ __attribute__((aligned(16))) unsigned char shm[];
    LAS unsigned char* lds = (LAS unsigned char*)shm;
    cg::grid_group grid = cg::this_grid();
    unsigned char* ws = PP.ws;
    bf16_t* H = (bf16_t*)(ws + OFF_H); bf16_t* UB = (bf16_t*)(ws + OFF_U); bf16_t* YC = (bf16_t*)(ws + OFF_YC); bf16_t* M = (bf16_t*)(ws + OFF_M);
    bf16_t* QB = (bf16_t*)(ws + OFF_Q); bf16_t* ACT = (bf16_t*)(ws + OFF_ACT); float* X = PP.out; float* SDT = (float*)(ws + OFF_SDT);
    volatile LAS unsigned* xst = (volatile LAS unsigned*)(lds + 163824);
    unsigned* bar = (unsigned*)(ws + OFF_BAR);
    { const int t0 = tidx(); if (t0 == 0) { xst[0] = 0u; xst[1] = 0u; } if (blockIdx.x == 0) for (int i = t0; i < XCD_BAR_WORDS; i += NTHR) bar[i] = 0u; }
    __syncthreads();
    phase0(PP, lds);
    grid.sync();
    XcdBarrier xb = xcd_barrier_post(bar, xst);
#pragma unroll 1
    for (int rep = 1; rep < REP_P0; ++rep) { phase0(PP, lds); GSYNC(); }
#pragma unroll 1
    for (int l = 0; l < NL; ++l) {
#pragma unroll 1
        for (int rep = 0; rep < REP_GEMM; ++rep) {
            { EpiBf16 e{UB, NU}; run_gemm(lds, H, (const bf16_t*)(ws + OFF_WIN) + (size_t)l * NU * D, TT, NU, D, e, 0); }
            { EpiMemKV e{PP.out + O_PMK + (size_t)l * 8 * 256 * 1024, PP.out + O_PMV + (size_t)l * 8 * 256 * 1024, (bf16_t*)(ws + OFF_KB), (bf16_t*)(ws + OFF_VTB)};
              run_gemm(lds, (const bf16_t*)(ws + OFF_HM) + (size_t)l * 2048 * D, (const bf16_t*)(ws + OFF_WXKV) + (size_t)l * 2048 * D, 2048, 2048, D, e, 64); }
            GSYNC();
        }
#pragma unroll 1
        for (int rep = 0; rep < REP_MIX; ++rep) {
#pragma unroll 1
            for (int grp = 0; grp < 3; ++grp) { const int gsel = (blockIdx.x & 1) ? 2 - grp : grp;
                if (gsel == 0) {
#pragma unroll 1
                    for (int r2 = 0; r2 < REP_SAMP; ++r2)
                    for (int u = blockIdx.x; u < 512; u += gridDim.x) {
                        if (u < 128) sample_ssd(PP, lds, l, u);
                        else if (u < 256) sample_ret(PP, lds, l, u - 128);
                        else if (u < 384) sample_hg(PP, lds, l, u - 256);
                        else sample_rg(PP, lds, l, u - 384);
                    }
                } else if (gsel == 1) {
#pragma unroll 1
                    for (int r2 = 0; r2 < REP_SSD; ++r2)
                    for (int u = blockIdx.x; u < 512; u += gridDim.x) ssd_passA(PP, lds, l, u);
                } else {
#ifdef MIXA_PERHEAD
#pragma unroll 1
                    for (int u = blockIdx.x; u < 1024; u += gridDim.x) mixA_unit(PP, lds, l, u);
#else
#pragma unroll 1
                    for (int u = blockIdx.x; u < 256; u += gridDim.x) { retA4_unit(PP, lds, l, u); hgA4_unit(PP, lds, l, u); }
                    rg_loop<false>(PP, lds, l);
#endif
                }
            }
            GSYNC();
            carry_phase(PP, l);
            GSYNC();
            if ((blockIdx.x & 1) == 0) {
#pragma unroll 1
                for (int r2 = 0; r2 < REP_SSD; ++r2)
                for (int u = blockIdx.x; u < 256; u += gridDim.x) ssd_passC(PP, lds, l, u);
            }
#if 1
#if 1
            ret_loop<true>(PP, lds, l);
#else
#pragma unroll 1
            for (int u = blockIdx.x; u < 512; u += gridDim.x) retC2_unit(PP, lds, l, u);
#endif
            hg_loop<true>(PP, lds, l); rg_loop<true>(PP, lds, l);
            if (blockIdx.x & 1) {
#pragma unroll 1
                for (int r2 = 0; r2 < REP_SSD; ++r2)
                for (int u = blockIdx.x; u < 256; u += gridDim.x) ssd_passC(PP, lds, l, u);
            }
#else
#pragma unroll 1
            for (int u = blockIdx.x; u < 1024; u += gridDim.x) mixC_unit(PP, lds, l, u);
#endif
            GSYNC();
        }
#pragma unroll 1
        for (int rep = 0; rep < REP_GEMM; ++rep) { EpiBf16 e{M, D}; run_gemm(lds, YC, (const bf16_t*)(ws + OFF_WOUT) + (size_t)l * D * D, TP, D, D, e, 0);
            sgemm<1, 1024, 1024>(lds, YC + (size_t)TP * D, (const bf16_t*)(ws + OFF_WOUT) + (size_t)l * D * D, nullptr, M + (size_t)TP * D); GSYNC(); }
        rows_phase(lds, TT, l == 0 ? PP.in[0] : nullptr, l == 0 ? PP.in[1] : nullptr, X, M, PP.in[12] + l * D, PP.in[13] + l * D, H, nullptr, nullptr);
#if REP_ROWS > 1
        rows_phase(lds, TT, nullptr, nullptr, (float*)(ws + OFF_XS), M, PP.in[12] + l * D, PP.in[13] + l * D, (bf16_t*)(ws + OFF_HS), nullptr, nullptr);
#endif
        GSYNC();
#pragma unroll 1
        for (int rep = 0; rep < REP_GEMM; ++rep) { EpiBf16 e{QB, D}; run_gemm(lds, H, (const bf16_t*)(ws + OFF_WXQ) + (size_t)l * D * D, TP, D, D, e, 0);
            sgemm<1, 1024, 1024>(lds, H + (size_t)TP * D, (const bf16_t*)(ws + OFF_WXQ) + (size_t)l * D * D, nullptr, QB + (size_t)TP * D); GSYNC(); }
#pragma unroll 1
        for (int rep = 0; rep < REP_ATT; ++rep) {
            for (int k = 0; k < 1024; k += gridDim.x) { const int u = (gridDim.x == 256 && (blockIdx.x & 1)) ? (int)((blockIdx.x + k + 512) & 1023) : (int)(blockIdx.x + k);
                if (u < 512) attn_prompt(PP, lds, u); else if (u < 1024) attn_sample(PP, lds, l, u - 512); }
            GSYNC();
        }
#pragma unroll 1
        for (int rep = 0; rep < REP_GEMM; ++rep) { EpiBf16 e{M, D}; run_gemm(lds, YC, (const bf16_t*)(ws + OFF_WXO) + (size_t)l * D * D, TP, D, D, e, 0);
            sgemm<1, 1024, 1024>(lds, YC + (size_t)TP * D, (const bf16_t*)(ws + OFF_WXO) + (size_t)l * D * D, nullptr, M + (size_t)TP * D); GSYNC(); }
        rows_phase(lds, TT, nullptr, nullptr, X, M, PP.in[14] + l * D, PP.in[15] + l * D, H, nullptr, nullptr);
#if REP_ROWS > 1
        rows_phase(lds, TT, nullptr, nullptr, (float*)(ws + OFF_XS), M, PP.in[14] + l * D, PP.in[15] + l * D, (bf16_t*)(ws + OFF_HS), nullptr, nullptr);
#endif
        GSYNC();
#pragma unroll 1
        for (int rep = 0; rep < REP_GEMM; ++rep) { EpiSwiGLU e{ACT}; run_gemm(lds, H, (const bf16_t*)(ws + OFF_WGU) + (size_t)l * 5632 * D, TT, 5632, D, e, 0); GSYNC(); }
#pragma unroll 1
        for (int rep = 0; rep < REP_GEMM; ++rep) { EpiBf16 e{M, D}; run_gemm(lds, ACT, (const bf16_t*)(ws + OFF_WDN) + (size_t)l * D * DFF, TP, D, DFF, e, 0);
            sgemm<1, 2816, 704>(lds, ACT + (size_t)TP * DFF, (const bf16_t*)(ws + OFF_WDN) + (size_t)l * D * DFF, nullptr, M + (size_t)TP * D); GSYNC(); }
        rows_phase(lds, TT, nullptr, nullptr, X, M, PP.in[16] + l * D, l + 1 < NL ? PP.in[11] + (l + 1) * D : nullptr, H, l + 1 < NL ? PP.in[17] + (size_t)(l + 1) * D * DIN : nullptr, SDT);
#if REP_ROWS > 1
        rows_phase(lds, TT, nullptr, nullptr, (float*)(ws + OFF_XS), M, PP.in[16] + l * D, l + 1 < NL ? PP.in[11] + (l + 1) * D : nullptr, (bf16_t*)(ws + OFF_HS), l + 1 < NL ? PP.in[17] + (size_t)(l + 1) * D * DIN : nullptr, (float*)(ws + OFF_HS));
#endif
        GSYNC();
    }
}

#undef PP
extern "C" void kernel_launch(void* const* d_in, const int* in_sizes, int n_in, void* d_out, int out_size, void* d_ws, size_t ws_size, hipStream_t stream) {
    constexpr int LDS_BYTES = 160 * 1024;
    static int grid = 0;
    if (grid == 0) {
        if (n_in != 41 || (size_t)out_size != O_END || ws_size < WS_END) { fprintf(stderr, "kernel_launch: unexpected shapes (n_in %d out %d ws %zu need %zu)\n", n_in, out_size, ws_size, (size_t)WS_END); grid = -1; return; }
        int dev = 0, cus = 0, per_cu = 0;
        (void)hipGetDevice(&dev);
        (void)hipDeviceGetAttribute(&cus, hipDeviceAttributeMultiprocessorCount, dev);
        (void)hipFuncSetAttribute((const void*)mega, hipFuncAttributeMaxDynamicSharedMemorySize, LDS_BYTES);
        (void)hipOccupancyMaxActiveBlocksPerMultiprocessor(&per_cu, (const void*)mega, 512, LDS_BYTES);
        if (per_cu < 1) { fprintf(stderr, "kernel_launch: occupancy query reports %d blocks per CU\n", per_cu); per_cu = 1; }
        grid = cus < 256 ? cus : 256;
    }
    if (grid < 0) return;
    Params p{};
    for (int i = 0; i < 41; ++i) p.in[i] = (const float*)d_in[i];
    p.out = (float*)d_out; p.ws = (unsigned char*)d_ws;
    void* args[] = {&p};
    hipError_t e = hipLaunchCooperativeKernel((void*)mega, dim3(grid), dim3(512), args, LDS_BYTES, stream);
    if (e != hipSuccess) fprintf(stderr, "cooperative launch failed: %s (grid %d)\n", hipGetErrorString(e), grid);
}
```

```cpp
#include <hip/hip_runtime.h>
#include <hip/hip_cooperative_groups.h>
#include <cstdio>
#include <cstdint>
namespace cg = cooperative_groups;
__device__ __forceinline__ int tidx() { int t = threadIdx.x; asm volatile("" : "+v"(t)); return t; }
namespace pg8 {
#define PG8_LAS __attribute__((address_space(3)))
typedef unsigned short bf16_t;
typedef short bf16x8 __attribute__((ext_vector_type(8)));
typedef float f32x4 __attribute__((ext_vector_type(4)));
typedef unsigned u32x4 __attribute__((ext_vector_type(4)));
constexpr int BM = 256, BK = 64, HALF = 128, HTB = HALF * BK * 2  , STAGE_BYTES = 8 * HTB, NXCD = 8, WGM = 8;

__host__ __device__ __forceinline__ int lds_byte(int r, int c) { const int st = (r >> 4) * 2 + (c >> 5), rr = r & 15, cc = c & 31, ob = rr * 64 + cc * 2; return st * 1024 + (ob ^ (((ob >> 9) & 1) << 5)); }
__host__ __device__ __forceinline__ void stage_rc(int b, int& R, int& C) { const int st = b / 1024, sb = b % 1024, swz = sb ^ (((sb >> 9) & 1) << 5); R = (st >> 1) * 16 + swz / 64; C = (st & 1) * 32 + (swz % 64) / 2; }
__host__ __device__ __forceinline__ int perm32(int rho) { const int n = rho >> 4, i = rho & 15; return 8 * (i >> 2) + 4 * n + (i & 3); }

struct Unit { int pm, pn; };
struct Gemm { const bf16_t* A; const bf16_t* Bt; int M, N, K; };

struct StaticOrder {
    int nM, nN, nwg, G, c;
    __host__ __device__ void init(int M, int N, int G_, int c_) { nM = M / BM; nN = N / BM; nwg = nM * nN; G = G_; c = c_; }
    __host__ __device__ bool next(int i, Unit& u) const {
        const long L = (long)i * G + c; if (L >= nwg) return false;
        int wgid = (int)L; { const int q = nwg / NXCD, r = nwg % NXCD, xcd = wgid % NXCD, off = wgid / NXCD; wgid = (xcd < r ? xcd * (q + 1) : r * (q + 1) + (xcd - r) * q) + off; }
        const int nig = WGM * nN, gid = wgid / nig, fm = gid * WGM, gsz = (nM - fm) < WGM ? (nM - fm) : WGM;
        u.pm = fm + ((wgid % nig) % gsz); u.pn = (wgid % nig) / gsz; return true;
    }
    __device__ __forceinline__ void a_ready(const Unit&) const {}
    __device__ __forceinline__ void done(const Unit&) const {}
};
}
namespace pg8 {
template <class Epi, class Sched, bool STAMP = false>
__device__ __forceinline__ void gemm_phase(PG8_LAS unsigned char* lds, const Gemm g, const Sched& S, const Epi& E, unsigned long long* stamps) {
    const int tid = tidx(), wid = __builtin_amdgcn_readfirstlane(tid >> 6), lane = tid & 63, wr = wid >> 2, wc = wid & 3, fr = lane & 15, fq = lane >> 4;
    const int K = g.K, nt = K / BK;
    int ts_lo = 0, ts_hi = 0, nts = 0; const unsigned long long rt_entry = STAMP ? (unsigned long long)wall_clock64() : 0ull;
#define PG8_STAMP() do { if (STAMP && wid == 0 && nts < 64) { const unsigned long long _c = (unsigned long long)clock64(); \
        ts_lo = (lane == nts) ? (int)(unsigned)_c : ts_lo; ts_hi = (lane == nts) ? (int)(unsigned)(_c >> 32) : ts_hi; ++nts; } } while (0)
    PG8_STAMP();
    unsigned voffA[2], voffB[2];
#pragma unroll
    for (int i = 0; i < 2; ++i) { int R, C; stage_rc(tid * 16 + i * 8192, R, C); const int Rb = Epi::PERM ? ((R & ~31) + perm32(R & 31)) : R;
        voffA[i] = (unsigned)(R * K + C) * 2u; voffB[i] = (unsigned)(Rb * K + C) * 2u; }
    const size_t kstep = (size_t)(BK * 2);
    const size_t hstep = (size_t)HALF * K * 2;
    const size_t tstep = 2 * hstep;
    const unsigned ldsw = (unsigned)wid * 1024u;
    const int aoff = lds_byte(wr * 64 + fr, fq * 8), boff = lds_byte(wc * 32 + fr, fq * 8);
#define PG8_SA(b, h) (((b) * 2 + (h)) * HTB)
#define PG8_SB(b, h) ((4 + (b) * 2 + (h)) * HTB)
#define PG8_STAGE(bufoff, gbase, voff) do { _Pragma("unroll") for (int _i = 0; _i < 2; ++_i) \
        __builtin_amdgcn_global_load_lds((const unsigned*)((const char*)(gbase) + (voff)[_i]), (PG8_LAS unsigned*)(lds + (bufoff) + ldsw + _i * 8192), 16, 0, 0); } while (0)
#define PG8_LDA(dst, b, h) do { _Pragma("unroll") for (int m = 0; m < 4; ++m) _Pragma("unroll") for (int k = 0; k < 2; ++k) dst[m][k] = *(const PG8_LAS bf16x8*)(lds + PG8_SA(b, h) + aoff + m * 2048 + k * 1024); } while (0)
#define PG8_LDB(dst, b, h) do { _Pragma("unroll") for (int n = 0; n < 2; ++n) _Pragma("unroll") for (int k = 0; k < 2; ++k) dst[n][k] = *(const PG8_LAS bf16x8*)(lds + PG8_SB(b, h) + boff + n * 2048 + k * 1024); } while (0)
#define PG8_MMA(ai, bj, At, Bt) do { __builtin_amdgcn_s_setprio(1); _Pragma("unroll") for (int m = 0; m < 4; ++m) _Pragma("unroll") for (int n = 0; n < 2; ++n) _Pragma("unroll") for (int k = 0; k < 2; ++k) \
        acc[ai][bj][m][n] = __builtin_amdgcn_mfma_f32_16x16x32_bf16(Bt[n][k], At[m][k], acc[ai][bj][m][n], 0, 0, 0); __builtin_amdgcn_s_setprio(0); } while (0)
#define PG8_WAIT_V(n) asm volatile("s_waitcnt vmcnt(" #n ")" ::: "memory")
#define PG8_WAIT_L(n) asm volatile("s_waitcnt lgkmcnt(" #n ")" ::: "memory")
#define PG8_BAR __builtin_amdgcn_s_barrier()
#define PG8_SCHED __builtin_amdgcn_sched_barrier(0)
    Unit cur, nxt; int ui = 0;
    if (!S.next(0, cur)) return;
    f32x4 acc[2][2][4][2];
#pragma unroll
    for (int a = 0; a < 2; ++a)
#pragma unroll
        for (int b = 0; b < 2; ++b)
#pragma unroll
            for (int m = 0; m < 4; ++m)
#pragma unroll
                for (int n = 0; n < 2; ++n) acc[a][b][m][n] = (f32x4){0.f, 0.f, 0.f, 0.f};
    bf16x8 At[4][2], B0[2][2], B1[2][2];
    const char* cA = (const char*)g.A + (size_t)cur.pm * tstep; const char* cB = (const char*)g.Bt + (size_t)cur.pn * tstep;
    S.a_ready(cur);
    PG8_STAGE(PG8_SB(0, 0), cB, voffB); PG8_STAGE(PG8_SA(0, 0), cA, voffA); PG8_STAGE(PG8_SB(0, 1), cB + hstep, voffB); PG8_STAGE(PG8_SA(0, 1), cA + hstep, voffA);
    if (wr == 1) PG8_BAR;
    PG8_WAIT_V(4); PG8_BAR;
    PG8_STAGE(PG8_SB(1, 0), cB + kstep, voffB); PG8_STAGE(PG8_SA(1, 0), cA + kstep, voffA); PG8_STAGE(PG8_SB(1, 1), cB + hstep + kstep, voffB);
    PG8_WAIT_V(6); PG8_BAR;
    PG8_STAMP();
    for (;;) {
        const bool has_next = S.next(ui + 1, nxt);
        const char* nA = has_next ? (const char*)g.A + (size_t)nxt.pm * tstep : cA; const char* nB = has_next ? (const char*)g.Bt + (size_t)nxt.pn * tstep : cB;
        for (int t = 0; t < nt; t += 2) {
            const bool last = (t == nt - 2);
            const char* a1 = cA + (size_t)(t + 1) * kstep;
            const char* a2 = last ? nA : cA + (size_t)(t + 2) * kstep; const char* b2 = last ? nB : cB + (size_t)(t + 2) * kstep;
            const char* a3 = a2 + kstep; const char* b3 = b2 + kstep;
            if (last && has_next) S.a_ready(nxt);
            PG8_LDB(B0, 0, 0); PG8_SCHED; PG8_LDA(At, 0, 0); PG8_STAGE(PG8_SA(1, 1), a1 + hstep, voffA);
            PG8_WAIT_L(8); PG8_BAR; PG8_WAIT_L(0); PG8_MMA(0, 0, At, B0); PG8_BAR; PG8_SCHED;
            PG8_LDB(B1, 0, 1); PG8_STAGE(PG8_SB(0, 0), b2, voffB);
            PG8_BAR; PG8_WAIT_L(0); PG8_MMA(0, 1, At, B1); PG8_BAR;
            PG8_LDA(At, 0, 1); PG8_STAGE(PG8_SA(0, 0), a2, voffA);
            PG8_BAR; PG8_WAIT_L(0); PG8_MMA(1, 0, At, B0); PG8_BAR; PG8_SCHED;
            PG8_STAGE(PG8_SB(0, 1), b2 + hstep, voffB);
            PG8_WAIT_V(6); PG8_BAR; PG8_MMA(1, 1, At, B1); PG8_BAR;
            PG8_LDB(B0, 1, 0); PG8_SCHED; PG8_LDA(At, 1, 0); PG8_STAGE(PG8_SA(0, 1), a2 + hstep, voffA);
            PG8_WAIT_L(8); PG8_BAR; PG8_WAIT_L(0); PG8_MMA(0, 0, At, B0); PG8_BAR; PG8_SCHED;
            PG8_LDB(B1, 1, 1); PG8_STAGE(PG8_SB(1, 0), b3, voffB);
            PG8_BAR; PG8_WAIT_L(0); PG8_MMA(0, 1, At, B1); PG8_BAR;
            PG8_LDA(At, 1, 1); PG8_STAGE(PG8_SA(1, 0), a3, voffA);
            PG8_BAR; PG8_WAIT_L(0); PG8_MMA(1, 0, At, B0); PG8_BAR; PG8_SCHED;
            PG8_STAGE(PG8_SB(1, 1), b3 + hstep, voffB);
            PG8_WAIT_V(6); PG8_BAR; PG8_MMA(1, 1, At, B1); PG8_BAR;
        }
        PG8_STAMP();
        if constexpr (!Epi::AFTER_DRAIN) { E(acc, cur, wr, wc, fr, fq); S.done(cur); }
        PG8_STAMP();
        if (!has_next) break;
#pragma unroll
        for (int a = 0; a < 2; ++a)
#pragma unroll
            for (int b = 0; b < 2; ++b)
#pragma unroll
                for (int m = 0; m < 4; ++m)
#pragma unroll
                    for (int n = 0; n < 2; ++n) acc[a][b][m][n] = (f32x4){0.f, 0.f, 0.f, 0.f};
        cur = nxt; cA = nA; cB = nB; ++ui;
    }
    PG8_WAIT_V(0);
    if (wr == 0) PG8_BAR;
    PG8_BAR;
    if constexpr (Epi::AFTER_DRAIN) { E.fused(acc, cur, wr, wc, fr, fq, lds, wid, lane); S.done(cur); }
    PG8_STAMP();
    if (STAMP && wid == 0) { stamps[lane] = lane < nts ? (((unsigned long long)(unsigned)ts_hi << 32) | (unsigned)ts_lo) : 0ull;
        if (lane == 62) stamps[62] = rt_entry; if (lane == 63) stamps[63] = (unsigned long long)wall_clock64(); }
#undef PG8_STAMP
#undef PG8_SA
#undef PG8_SB
#undef PG8_STAGE
#undef PG8_LDA
#undef PG8_LDB
#undef PG8_MMA
#undef PG8_WAIT_V
#undef PG8_WAIT_L
#undef PG8_BAR
#undef PG8_SCHED
}
}

#define LAS __attribute__((address_space(3)))
using pg8::bf16_t; using pg8::bf16x8; using pg8::f32x4; using pg8::u32x4;
typedef unsigned u32x2 __attribute__((ext_vector_type(2)));
typedef float f32x2 __attribute__((ext_vector_type(2)));

constexpr int D = 1024, TP = 16384, TS = 512, TT = TP + TS, NU = 3584, DIN = 3588, DFF = 2816, NL = 2;
constexpr int NTHR = 512;
constexpr float EPS = 1e-6f;
constexpr int UZ = 0, UXBC = 256, URQ = 1024, URK = 1280, URV = 1536, URG = 1792, UGX = 2048, UGY = 2304, UHQ = 2560, UHF = 2816, UHI = 3072, UHG = 3328;
constexpr size_t O_YP = 0, O_YS = O_YP + (size_t)8 * 2048 * 1024, O_PSSD = O_YS + (size_t)128 * 4 * 1024, O_PSSDC = O_PSSD + (size_t)2 * 8 * 4 * 128 * 64,
    O_PRET = O_PSSDC + (size_t)2 * 8 * 3 * 768, O_PRG = O_PRET + (size_t)2 * 8 * 4 * 64 * 64, O_PRGC = O_PRG + (size_t)2 * 8 * 256, O_PHG = O_PRGC + (size_t)2 * 8 * 3 * 256,
    O_PMK = O_PHG + (size_t)2 * 8 * 4 * 64 * 64, O_PMV = O_PMK + (size_t)2 * 8 * 256 * 1024, O_SSSD = O_PMV + (size_t)2 * 8 * 256 * 1024, O_SSSDC = O_SSSD + (size_t)2 * 128 * 4 * 128 * 64,
    O_SRET = O_SSSDC + (size_t)2 * 128 * 3 * 768, O_SRG = O_SRET + (size_t)2 * 128 * 4 * 64 * 64, O_SRGC = O_SRG + (size_t)2 * 128 * 256, O_SHG = O_SRGC + (size_t)2 * 128 * 3 * 256,
    O_END = O_SHG + (size_t)2 * 128 * 4 * 64 * 64;
constexpr size_t OFF_WIN = 0, OFF_WOUT = OFF_WIN + (size_t)NL * NU * D * 2, OFF_WXQ = OFF_WOUT + (size_t)NL * D * D * 2, OFF_WXO = OFF_WXQ + (size_t)NL * D * D * 2,
    OFF_WXKV = OFF_WXO + (size_t)NL * D * D * 2, OFF_WGU = OFF_WXKV + (size_t)NL * 2048 * D * 2, OFF_WDN = OFF_WGU + (size_t)NL * 5632 * D * 2, OFF_WRG = OFF_WDN + (size_t)NL * D * DFF * 2,
    OFF_ROPE = OFF_WRG + (size_t)NL * 2 * 4 * 64 * 64 * 2, OFF_H = OFF_ROPE + (size_t)2052 * 32 * 2 * 4, OFF_HM = OFF_H + (size_t)TT * D * 2, OFF_U = OFF_HM + (size_t)NL * 2048 * D * 2,
    OFF_SDT = OFF_U + (size_t)TT * NU * 2, OFF_YC = OFF_SDT + (size_t)TT * 4 * 4, OFF_M = OFF_YC + (size_t)TT * D * 2, OFF_Q = OFF_M + (size_t)TT * D * 4, OFF_ACT = OFF_Q + (size_t)TT * D * 2,
    OFF_KB = OFF_ACT + (size_t)TT * DFF * 2, OFF_VTB = OFF_KB + (size_t)8 * 4 * 256 * 256 * 2, OFF_DSS = OFF_VTB + (size_t)8 * 4 * 256 * 256 * 2, OFF_DECS = OFF_DSS + (size_t)8 * 4 * 32 * 8192 * 4,
    OFF_DSR = OFF_DECS + 4096, OFF_DSH = OFF_DSR + (size_t)8 * 4 * 32 * 4096 * 4, OFF_DECH = OFF_DSH + (size_t)8 * 4 * 32 * 4096 * 4, OFF_RGH = OFF_DECH + (size_t)8 * 4 * 32 * 64 * 4,
    OFF_RGA = OFF_RGH + (size_t)8 * 32 * 256 * 4, OFF_RGC = OFF_RGA + (size_t)8 * 32 * 256 * 4, OFF_BAR = OFF_RGC + (size_t)8 * 32 * 256 * 4, OFF_LB = OFF_BAR + 16384, OFF_XS = OFF_LB + 4096, OFF_HS = OFF_XS + (size_t)TT * D * 4, WS_END = OFF_HS + (size_t)TT * D * 2;

struct Params { const float* in[41]; float* out; unsigned char* ws; };
typedef const __attribute__((address_space(4))) Params* KPRM;
typedef const __attribute__((address_space(4))) Params& PRM;
__device__ __forceinline__ KPRM kp_launder(KPRM k) { asm volatile("" : "+s"(k)); return k; }

__device__ __forceinline__ float bf2f(bf16_t b) { return __uint_as_float(((unsigned)b) << 16); }
__device__ __forceinline__ unsigned pk2(float lo, float hi) { unsigned r; asm volatile("v_cvt_pk_bf16_f32 %0, %1, %2" : "=v"(r) : "v"(lo), "v"(hi)); return r; }
__device__ __forceinline__ bf16_t f2bf(float f) { return (bf16_t)(pk2(f, f) & 0xffffu); }
__device__ __forceinline__ float sigmoidf_(float x) { return __builtin_amdgcn_rcpf(1.0f + __expf(-x)); }
__device__ __forceinline__ float siluf_(float x) { return x * __builtin_amdgcn_rcpf(1.0f + __expf(-x)); }
__device__ __forceinline__ float siluf_div(float x) { return x / (1.0f + __expf(-x)); }
__device__ __forceinline__ float softplusf_(float x) { const float e = __expf(-fabsf(x)); const float l1p = e < 1.0e-3f ? e * (1.0f - e * (0.5f - e * 0.33333333f)) : __logf(1.0f + e); return fmaxf(x, 0.0f) + l1p; }
__device__ __forceinline__ float geluf_(float x) { const float u = 0.7978845608028654f * (x + 0.044715f * x * x * x); return x * __builtin_amdgcn_rcpf(1.0f + __expf(-2.0f * u)); }
#define DPP_F(old, src, ctrl, rmask) __int_as_float(__builtin_amdgcn_update_dpp(__float_as_int(old), __float_as_int(src), (ctrl), (rmask), 0xf, false))
#define DPP_ROR(v, n) DPP_F(0.f, v, 0x120 + (n), 0xf)
__device__ __forceinline__ float row16_sum(float v) { v += DPP_ROR(v, 8); v += DPP_ROR(v, 4); v += DPP_ROR(v, 2); v += DPP_ROR(v, 1); return v; }
__device__ __forceinline__ float row16_max(float v) { v = fmaxf(v, DPP_ROR(v, 8)); v = fmaxf(v, DPP_ROR(v, 4)); v = fmaxf(v, DPP_ROR(v, 2)); v = fmaxf(v, DPP_ROR(v, 1)); return v; }
__device__ __forceinline__ float rl_(float v, int lane) { return __int_as_float(__builtin_amdgcn_readlane(__float_as_int(v), lane)); }
__device__ __forceinline__ float wave_sum(float v) { v = row16_sum(v); return (rl_(v, 0) + rl_(v, 16)) + (rl_(v, 32) + rl_(v, 48)); }
__device__ __forceinline__ float wave_max(float v) { v = row16_max(v); return fmaxf(fmaxf(rl_(v, 0), rl_(v, 16)), fmaxf(rl_(v, 32), rl_(v, 48))); }
template <int NT, int KS>
__device__ __forceinline__ void mm_nt(f32x4 (&acc)[NT], const LAS bf16_t* A, int lda, const LAS bf16_t* B, int ldb, int lane) {
    const int r = lane & 15, q = (lane >> 4) * 8;
#pragma unroll
    for (int ks = 0; ks < KS; ++ks) {
        const bf16x8 a = *(const LAS bf16x8*)(A + r * lda + ks * 32 + q);
#pragma unroll
        for (int j = 0; j < NT; ++j) {
            const bf16x8 b = *(const LAS bf16x8*)(B + (16 * j + r) * ldb + ks * 32 + q);
            acc[j] = __builtin_amdgcn_mfma_f32_16x16x32_bf16(a, b, acc[j], 0, 0, 0);
        }
    }
}

struct EpiBf16 {
    static constexpr bool PERM = true, AFTER_DRAIN = false;
    bf16_t* O; int ldc;
    __device__ __forceinline__ void operator()(const f32x4 (&acc)[2][2][4][2], const pg8::Unit& u, int wr, int wc, int fr, int fq) const {
        const int row0 = u.pm * 256 + wr * 64 + fr, col0 = u.pn * 256 + wc * 32 + 8 * fq;
#pragma unroll
        for (int ai = 0; ai < 2; ++ai)
#pragma unroll
            for (int m = 0; m < 4; ++m) {
                bf16_t* rowp = O + (size_t)(row0 + ai * 128 + m * 16) * ldc + col0;
#pragma unroll
                for (int bj = 0; bj < 2; ++bj) {
                    const f32x4 v0 = acc[ai][bj][m][0], v1 = acc[ai][bj][m][1];
                    u32x4 w; w.x = pk2(v0[0], v0[1]); w.y = pk2(v0[2], v0[3]); w.z = pk2(v1[0], v1[1]); w.w = pk2(v1[2], v1[3]);
                    *(u32x4*)(rowp + bj * 128) = w;
                }
            }
    }
};
struct EpiF32 {
    static constexpr bool PERM = false, AFTER_DRAIN = false;
    float* C; int ldc;
    __device__ __forceinline__ void operator()(const f32x4 (&acc)[2][2][4][2], const pg8::Unit& u, int wr, int wc, int fr, int fq) const {
        const int row0 = u.pm * 256 + wr * 64 + fr, col0 = u.pn * 256 + wc * 32 + 4 * fq;
#pragma unroll
        for (int ai = 0; ai < 2; ++ai)
#pragma unroll
            for (int m = 0; m < 4; ++m) {
                float* rowp = C + (size_t)(row0 + ai * 128 + m * 16) * ldc + col0;
#pragma unroll
                for (int bj = 0; bj < 2; ++bj)
#pragma unroll
                    for (int n = 0; n < 2; ++n) *(f32x4*)(rowp + bj * 128 + n * 16) = acc[ai][bj][m][n];
            }
    }
};
struct EpiSwiGLU {
    static constexpr bool PERM = true, AFTER_DRAIN = false;
    bf16_t* O;
    __device__ __forceinline__ void operator()(const f32x4 (&acc)[2][2][4][2], const pg8::Unit& u, int wr, int wc, int fr, int fq) const {
        const int row0 = u.pm * 256 + wr * 64 + fr, col0 = u.pn * 128 + wc * 32 + 8 * fq;
#pragma unroll
        for (int ai = 0; ai < 2; ++ai)
#pragma unroll
            for (int m = 0; m < 4; ++m) {
                bf16_t* rowp = O + (size_t)(row0 + ai * 128 + m * 16) * DFF + col0;
                const f32x4 g0 = acc[ai][0][m][0], g1 = acc[ai][0][m][1], u0 = acc[ai][1][m][0], u1 = acc[ai][1][m][1];
                u32x4 w;
                w.x = pk2(siluf_(g0[0]) * u0[0], siluf_(g0[1]) * u0[1]); w.y = pk2(siluf_(g0[2]) * u0[2], siluf_(g0[3]) * u0[3]);
                w.z = pk2(siluf_(g1[0]) * u1[0], siluf_(g1[1]) * u1[1]); w.w = pk2(siluf_(g1[2]) * u1[2], siluf_(g1[3]) * u1[3]);
                *(u32x4*)rowp = w;
            }
    }
};
struct EpiMemKV {
    static constexpr bool PERM = false, AFTER_DRAIN = false;
    float* kout; float* vout; bf16_t* KB; bf16_t* VTB;
    __device__ __forceinline__ void operator()(const f32x4 (&acc)[2][2][4][2], const pg8::Unit& u, int wr, int wc, int fr, int fq) const {
        const int row0 = u.pm * 256 + wr * 64 + fr, col0 = u.pn * 256 + wc * 32 + 4 * fq;
#pragma unroll
        for (int ai = 0; ai < 2; ++ai)
#pragma unroll
            for (int m = 0; m < 4; ++m) {
                const int row = row0 + ai * 128 + m * 16, b = row >> 8, key = row & 255;
#pragma unroll
                for (int bj = 0; bj < 2; ++bj)
#pragma unroll
                    for (int n = 0; n < 2; ++n) {
                        const int col = col0 + bj * 128 + n * 16; const f32x4 v = acc[ai][bj][m][n];
                        if (col < 1024) {
                            *(f32x4*)(kout + (size_t)row * 1024 + col) = v;
                            u32x2 w; w.x = pk2(v[0], v[1]); w.y = pk2(v[2], v[3]);
                            *(u32x2*)(KB + ((size_t)(b * 4 + (col >> 8)) * 256 + key) * 256 + (col & 255)) = w;
                        } else {
                            const int c2 = col - 1024;
                            *(f32x4*)(vout + (size_t)row * 1024 + c2) = v;
                            bf16_t* vp = VTB + ((size_t)(b * 4 + (c2 >> 8)) * 256 + (c2 & 255)) * 256 + key;
                            vp[0] = f2bf(v[0]); vp[256] = f2bf(v[1]); vp[512] = f2bf(v[2]); vp[768] = f2bf(v[3]);
                        }
                    }
            }
    }
};
template <class Epi>
__device__ __forceinline__ void run_gemm(LAS unsigned char* lds, const bf16_t* A, const bf16_t* Bt, int M, int N, int K, const Epi& E, int cshift) {
    asm volatile("" : "+s"(M), "+s"(N), "+s"(K));
    pg8::Gemm g{A, Bt, M, N, K};
    pg8::StaticOrder S; S.init(M, N, (int)gridDim.x, (int)((blockIdx.x + cshift) % gridDim.x));
    pg8::gemm_phase<Epi, pg8::StaticOrder, false>(lds, g, S, E, nullptr);
}

struct TItem { const float* src; bf16_t* dst; int ldw, K, k0, srcc, dstr; };
constexpr int I_IN = 16 * 112, I_SQ = 16 * 32, I_KV = 16 * 64, I_GU = 16 * 176, I_DN = 44 * 32, I_RG = 16;
constexpr int I_PER = I_IN + 3 * I_SQ + I_KV + I_GU + I_DN + I_RG;
__device__ __forceinline__ bool titem(PRM p, int it, TItem& T) {
    if (it >= NL * I_PER) return false;
    const int l = it / I_PER; int r = it % I_PER;
    unsigned char* ws = p.ws;
    if (r < I_IN) { const int kb = r / 112, n0 = (r % 112) * 32; T.src = p.in[17] + (size_t)l * D * DIN; T.ldw = DIN; T.K = D; T.k0 = kb * 64; T.srcc = n0 < 1024 ? n0 : n0 + 4;
        T.dst = (bf16_t*)(ws + OFF_WIN) + (size_t)l * NU * D; T.dstr = n0; return true; }
    r -= I_IN;
    if (r < 3 * I_SQ) { const int which = r / I_SQ; r %= I_SQ; const int kb = r / 32, n0 = (r % 32) * 32;
        T.src = p.in[which == 0 ? 34 : (which == 1 ? 36 : 38)] + (size_t)l * D * D; T.ldw = D; T.K = D; T.k0 = kb * 64; T.srcc = n0;
        T.dst = (bf16_t*)(ws + (which == 0 ? OFF_WOUT : (which == 1 ? OFF_WXQ : OFF_WXO))) + (size_t)l * D * D; T.dstr = n0; return true; }
    r -= 3 * I_SQ;
    if (r < I_KV) { const int kb = r / 64, n0 = (r % 64) * 32; T.src = p.in[37] + (size_t)l * D * 2048; T.ldw = 2048; T.K = D; T.k0 = kb * 64; T.srcc = n0;
        T.dst = (bf16_t*)(ws + OFF_WXKV) + (size_t)l * 2048 * D; T.dstr = n0; return true; }
    r -= I_KV;
    if (r < I_GU) { const int kb = r / 176, n0 = (r % 176) * 32; const int pn = n0 >> 8, bj = (n0 & 255) >> 7, j = n0 & 127;
        T.src = p.in[39] + (size_t)l * D * 5632; T.ldw = 5632; T.K = D; T.k0 = kb * 64; T.srcc = bj * DFF + pn * 128 + j;
        T.dst = (bf16_t*)(ws + OFF_WGU) + (size_t)l * 5632 * D; T.dstr = n0; return true; }
    r -= I_GU;
    if (r < I_DN) { const int kb = r / 32, n0 = (r % 32) * 32; T.src = p.in[40] + (size_t)l * DFF * D; T.ldw = D; T.K = DFF; T.k0 = kb * 64; T.srcc = n0;
        T.dst = (bf16_t*)(ws + OFF_WDN) + (size_t)l * D * DFF; T.dstr = n0; return true; }
    r -= I_DN;
    { const int gate = r >> 3, blk = (r & 7) >> 1, nb = r & 1;
        T.src = p.in[gate ? 29 : 27] + (size_t)(l * 4 + blk) * 4096; T.ldw = 64; T.K = 64; T.k0 = 0; T.srcc = nb * 32;
        T.dst = (bf16_t*)(ws + OFF_WRG) + (size_t)((l * 2 + gate) * 4 + blk) * 4096; T.dstr = nb * 32; return true; }
}

__device__ __forceinline__ void rows_phase(LAS unsigned char* lds, int nrows, const float* xp, const float* xs, float* X, const bf16_t* M, const float* gpost,
                                           const float* gpre, bf16_t* H, const float* wdt, float* SDT) {
    const int tid = tidx(), lane = tid & 63, wave = tid >> 6;
    const int gw = blockIdx.x * 8 + wave, NGW = gridDim.x * 8;
    LAS float* wl = (LAS float*)lds;
    if (wdt) { for (int i = tid; i < 4096; i += NTHR) wl[i] = wdt[(size_t)(i >> 2) * DIN + 1024 + (i & 3)]; __syncthreads(); }
    constexpr int NR = 4;
    for (int rowb = gw; rowb < nrows; rowb += NR * NGW) {
        f32x4 v[NR][4], m[NR][4];
        bool ok[NR];
#pragma unroll
        for (int q = 0; q < NR; ++q) { const int row = rowb + q * NGW; ok[q] = row < nrows;
            if (ok[q]) {
                const float* xr = xp ? (row < TP ? xp + (size_t)row * D : xs + (size_t)(row - TP) * D) : X + (size_t)row * D;
#pragma unroll
                for (int j = 0; j < 4; ++j) v[q][j] = ((const f32x4*)xr)[lane + 64 * j];
                if (M) {
#pragma unroll
                    for (int j = 0; j < 4; ++j) { const u32x2 w = ((const u32x2*)(M + (size_t)row * D))[lane + 64 * j];
                        m[q][j] = (f32x4){__uint_as_float(w.x << 16), __uint_as_float(w.x & 0xffff0000u), __uint_as_float(w.y << 16), __uint_as_float(w.y & 0xffff0000u)}; }
                }
            } }
#pragma unroll
        for (int q = 0; q < NR; ++q) { const int row = rowb + q * NGW;
            if (!ok[q]) continue;
            if (M) {
                float ss = 0.f;
#pragma unroll
                for (int j = 0; j < 4; ++j) ss += m[q][j].x * m[q][j].x + m[q][j].y * m[q][j].y + m[q][j].z * m[q][j].z + m[q][j].w * m[q][j].w;
                const float rstd = 1.0f / sqrtf(wave_sum(ss) * (1.0f / D) + EPS);
#pragma unroll
                for (int j = 0; j < 4; ++j) { const f32x4 g = ((const f32x4*)gpost)[lane + 64 * j]; v[q][j] = v[q][j] + m[q][j] * rstd * g; }
            }
            if (X && (M || xp)) {
#pragma unroll
                for (int j = 0; j < 4; ++j) ((f32x4*)(X + (size_t)row * D))[lane + 64 * j] = v[q][j];
            }
            if (gpre) {
                float ss = 0.f;
#pragma unroll
                for (int j = 0; j < 4; ++j) ss += v[q][j].x * v[q][j].x + v[q][j].y * v[q][j].y + v[q][j].z * v[q][j].z + v[q][j].w * v[q][j].w;
                const float rstd = 1.0f / sqrtf(wave_sum(ss) * (1.0f / D) + EPS);
                float d0 = 0.f, d1 = 0.f, d2 = 0.f, d3 = 0.f;
#pragma unroll
                for (int j = 0; j < 4; ++j) {
                    const f32x4 g = ((const f32x4*)gpre)[lane + 64 * j]; const f32x4 h = v[q][j] * rstd * g;
                    u32x2 w; w.x = pk2(h.x, h.y); w.y = pk2(h.z, h.w);
                    ((u32x2*)(H + (size_t)row * D))[lane + 64 * j] = w;
                    if (wdt) {
#pragma unroll
                        for (int e = 0; e < 4; ++e) { const f32x4 wv = *(const LAS f32x4*)(wl + 4 * (4 * (lane + 64 * j) + e)); const float he = h[e];
                            d0 += he * wv.x; d1 += he * wv.y; d2 += he * wv.z; d3 += he * wv.w; }
                    }
                }
                if (wdt) { d0 = wave_sum(d0); d1 = wave_sum(d1); d2 = wave_sum(d2); d3 = wave_sum(d3);
                    if (lane == 0) { f32x4 o; o.x = d0; o.y = d1; o.z = d2; o.w = d3; *(f32x4*)(SDT + (size_t)row * 4) = o; } }
            }
        }
    }
    if (wdt) __syncthreads();
}

__device__ __forceinline__ void transposes(PRM p, LAS unsigned char* lds, int it_lo, int it_hi, int gwv, int ngw) {
    const int tid = tidx(), lane = tid & 63, wave = tid >> 6;
    LAS float* scr = (LAS float*)lds + wave * (64 * 33);
    for (int base = it_lo; base < it_hi; base += ngw) {
        TItem T; const bool ok = (base + gwv < it_hi) && titem(p, base + gwv, T);
        if (ok) {
            float tv[32];
#pragma unroll
            for (int i = 0; i < 32; ++i) tv[i] = T.src[(size_t)(T.k0 + 2 * i + (lane >> 5)) * T.ldw + T.srcc + (lane & 31)];
#pragma unroll
            for (int i = 0; i < 32; ++i) scr[(2 * i + (lane >> 5)) * 33 + (lane & 31)] = tv[i];
        }
        __syncthreads();
        if (ok) {
            const int c = lane & 7;
#pragma unroll
            for (int j = 0; j < 4; ++j) { const int n = (lane >> 3) + 8 * j; const LAS float* s = scr + (8 * c) * 33 + n;
                u32x4 o; o.x = pk2(s[0 * 33], s[1 * 33]); o.y = pk2(s[2 * 33], s[3 * 33]); o.z = pk2(s[4 * 33], s[5 * 33]); o.w = pk2(s[6 * 33], s[7 * 33]);
                *(u32x4*)(T.dst + (size_t)(T.dstr + n) * T.K + T.k0 + 8 * c) = o; }
        }
        __syncthreads();
    }
}

__device__ __forceinline__ void phase0(PRM p, LAS unsigned char* lds) {
    const int tid = tidx(), lane = tid & 63, wave = tid >> 6;
    const int gw = blockIdx.x * 8 + wave, NGW = gridDim.x * 8;
    transposes(p, lds, 0, NL * I_PER, gw, NGW);
    float* RC = (float*)(p.ws + OFF_ROPE); float* RS = RC + 2052 * 32;
    for (int i = blockIdx.x * NTHR + tid; i < 2052 * 32; i += gridDim.x * NTHR) {
        const int pi = i >> 5, j = i & 31;
        const double pos = pi < 2048 ? (double)pi : (double)(16384 + pi - 2048);
        const double inv = exp2(-(double)j * (13.287712379549449 / 32.0));
        const double ang = pos * inv;
        const double r = ang - 6.283185307179586 * rint(ang * 0.15915494309189535);
        const float rf = (float)r;
        RC[i] = cosf(rf); RS[i] = sinf(rf);
    }
    if (blockIdx.x == 0 && tid < 256) { const float a0 = p.in[32][tid], a1 = p.in[32][256 + tid]; const float mx = fmaxf(a0, a1), e0 = expf(a0 - mx), e1 = expf(a1 - mx);
        ((float*)(p.ws + OFF_LB))[tid] = 0.f; ((float*)(p.ws + OFF_LB))[256 + tid] = e1 / (e0 + e1); }
    rows_phase(lds, TT, p.in[0], p.in[1], nullptr, nullptr, nullptr, p.in[11], (bf16_t*)(p.ws + OFF_H), p.in[17], (float*)(p.ws + OFF_SDT));
    for (int l = 0; l < NL; ++l)
        rows_phase(lds, 2048, p.in[10], nullptr, nullptr, nullptr, nullptr, p.in[35] + l * D, (bf16_t*)(p.ws + OFF_HM) + (size_t)l * 2048 * D, nullptr, nullptr);
}
#define XB_TMO      128
#define XB_XCNT(j)  (256  + 64 * (j))
#define XB_XSUB(j)  (1280 + 64 * (j))
#define XB_XGEN(j)  (2304 + 64 * (j))
#define XB_TOP      3328
#define XB_TOPGEN   3392
#define XCD_BAR_WORDS 3456
#define XB_SPIN_CAP (1u << 18)

__device__ __forceinline__ unsigned xb_ld(unsigned* p)              { return __hip_atomic_load(p, __ATOMIC_RELAXED, __HIP_MEMORY_SCOPE_AGENT); }
__device__ __forceinline__ unsigned xb_add(unsigned* p, unsigned v) { return __hip_atomic_fetch_add(p, v, __ATOMIC_RELAXED, __HIP_MEMORY_SCOPE_AGENT); }
__device__ __forceinline__ unsigned xb_xcc_id() { return (unsigned)__builtin_amdgcn_s_getreg((3 << 11) | 20) & 0xFu; }
#define XB_SPIN(cond, bar) do { unsigned _sp = 0; while (cond) { __builtin_amdgcn_s_sleep(1); \
    if ((++_sp & 255u) == 0u) { if (xb_ld(&(bar)[XB_TMO])) break; if (_sp > XB_SPIN_CAP) { atomicAdd(&(bar)[XB_TMO], 1u); break; } } } } while (0)

struct XcdBarrier {
    unsigned* bar; unsigned x;
    volatile LAS unsigned* st;
};

__device__ __forceinline__ XcdBarrier xcd_barrier_post(unsigned* bar, volatile LAS unsigned* st) {
    XcdBarrier b; b.bar = bar; b.x = xb_xcc_id(); b.st = st;
    if (tidx() == 0) (void)xb_add(&bar[XB_XCNT(b.x)], 1u);
    return b;
}
__device__ __forceinline__ void xcd_barrier_complete(unsigned* bar, unsigned x, unsigned& nloc, unsigned& nx) {
    const unsigned G = gridDim.x * gridDim.y * gridDim.z;
    unsigned sum, cnt, mine, sp = 0u;
    for (;;) {
        sum = 0u; cnt = 0u; mine = 0u;
#pragma unroll
        for (unsigned j = 0; j < 16; ++j) { const unsigned c = xb_ld(&bar[XB_XCNT(j)]); sum += c; cnt += (c > 0u) ? 1u : 0u; mine = (j == x) ? c : mine; }
        if (sum == G) break;
        __builtin_amdgcn_s_sleep(1);
        if ((++sp & 255u) == 0u) { if (xb_ld(&bar[XB_TMO])) break; if (sp > XB_SPIN_CAP) { atomicAdd(&bar[XB_TMO], 1u); break; } }
    }
    nloc = mine > 0u ? mine : 1u; nx = cnt > 0u ? cnt : 1u;
}

__device__ __forceinline__ void xcd_barrier(const XcdBarrier& b) {
    asm volatile("s_waitcnt vmcnt(0)" ::: "memory");
    __syncthreads();
    if (tidx() == 0) {
        unsigned* bar = b.bar;
        __builtin_amdgcn_s_waitcnt(0);
        unsigned nloc = b.st[0], nx = b.st[1];
        if (nloc == 0u) { xcd_barrier_complete(bar, b.x, nloc, nx); b.st[0] = nloc; b.st[1] = nx; }
        const unsigned old = xb_add(&bar[XB_XSUB(b.x)], 1u);
        const unsigned gen = old / nloc;
        if (old + 1u == (gen + 1u) * nloc) {
            __builtin_amdgcn_fence(__ATOMIC_RELEASE, "agent");
            asm volatile("s_waitcnt vmcnt(0)" ::: "memory");
            const unsigned og = xb_add(&bar[XB_TOP], 1u);
            const unsigned tg = og / nx;
            if (og + 1u == (tg + 1u) * nx) xb_add(&bar[XB_TOPGEN], 1u);
            else XB_SPIN(xb_ld(&bar[XB_TOPGEN]) == tg, bar);
            __builtin_amdgcn_fence(__ATOMIC_ACQUIRE, "agent");
            xb_add(&bar[XB_XGEN(b.x)], 1u);
            asm volatile("s_waitcnt vmcnt(0)" ::: "memory");
        } else {
            XB_SPIN(xb_ld(&bar[XB_XGEN(b.x)]) == gen, bar);
            __builtin_amdgcn_fence(__ATOMIC_ACQUIRE, "agent");
            asm volatile("s_waitcnt vmcnt(0)" ::: "memory");
        }
    }
    __syncthreads();
}


template <int NTOK>
__device__ __forceinline__ void conv_run(const bf16_t* Ucol, bool hist_ok, float w0, float w1, float w2, float w3, float bias, float (&out)[NTOK]) {
    float x3 = 0.f, x2 = 0.f, x1 = 0.f;
    if (hist_ok) { x3 = bf2f(Ucol[-3 * NU]); x2 = bf2f(Ucol[-2 * NU]); x1 = bf2f(Ucol[-NU]); }
#pragma unroll
    for (int i = 0; i < NTOK; ++i) { const float x0 = bf2f(Ucol[i * NU]); out[i] = bias + w0 * x3 + w1 * x2 + w2 * x1 + w3 * x0; x3 = x2; x2 = x1; x1 = x0; }
}
__device__ __forceinline__ float scan64_add(float v, int lane) {
    (void)lane;
    v += DPP_F(0.f, v, 0x111, 0xf); v += DPP_F(0.f, v, 0x112, 0xf); v += DPP_F(0.f, v, 0x114, 0xf); v += DPP_F(0.f, v, 0x118, 0xf);
    v += DPP_F(0.f, v, 0x142, 0xa); v += DPP_F(0.f, v, 0x143, 0xc);
    return v;
}
__device__ __forceinline__ void scan64_lin(float& A, float& B) {
#define LIN_STEP(ctrl, rmask) { const float Ap = DPP_F(1.f, A, ctrl, rmask), Bp = DPP_F(0.f, B, ctrl, rmask); B = A * Bp + B; A = A * Ap; }
    LIN_STEP(0x111, 0xf) LIN_STEP(0x112, 0xf) LIN_STEP(0x114, 0xf) LIN_STEP(0x118, 0xf) LIN_STEP(0x142, 0xa) LIN_STEP(0x143, 0xc)
#undef LIN_STEP
}


__device__ __forceinline__ void unpack8(const u32x4 w, float (&f)[8]) {
    f[0] = __uint_as_float(w.x << 16); f[1] = __uint_as_float(w.x & 0xffff0000u); f[2] = __uint_as_float(w.y << 16); f[3] = __uint_as_float(w.y & 0xffff0000u);
    f[4] = __uint_as_float(w.z << 16); f[5] = __uint_as_float(w.z & 0xffff0000u); f[6] = __uint_as_float(w.w << 16); f[7] = __uint_as_float(w.w & 0xffff0000u);
}
__device__ __forceinline__ u32x4 pack8(const float (&f)[8]) { u32x4 w; w.x = pk2(f[0], f[1]); w.y = pk2(f[2], f[3]); w.z = pk2(f[4], f[5]); w.w = pk2(f[6], f[7]); return w; }
__device__ __forceinline__ u32x4 ldg8(const bf16_t* p) { return *(const u32x4*)p; }
__device__ __forceinline__ bf16_t elem8(const u32x4 w, int i) { const unsigned x = (i >> 1) == 0 ? w.x : ((i >> 1) == 1 ? w.y : ((i >> 1) == 2 ? w.z : w.w)); return (bf16_t)((i & 1) ? (x >> 16) : (x & 0xffffu)); }
__device__ __forceinline__ void ld8f(const float* p, float (&f)[8]) { const f32x4 a = *(const f32x4*)p, b = *(const f32x4*)(p + 4); f[0] = a.x; f[1] = a.y; f[2] = a.z; f[3] = a.w; f[4] = b.x; f[5] = b.y; f[6] = b.z; f[7] = b.w; }
template <int NT>
__device__ __forceinline__ void conv8(const u32x4 (&rows)[NT + 3], const float (&w)[4][8], const float (&bias)[8], float (&o)[NT][8]) {
    float x[NT + 3][8];
#pragma unroll
    for (int r = 0; r < NT + 3; ++r) unpack8(rows[r], x[r]);
#pragma unroll
    for (int t = 0; t < NT; ++t)
#pragma unroll
        for (int i = 0; i < 8; ++i) o[t][i] = bias[i] + w[0][i] * x[t][i] + w[1][i] * x[t + 1][i] + w[2][i] * x[t + 2][i] + w[3][i] * x[t + 3][i];
}

__device__ __forceinline__ void ssd_passA(PRM p, LAS unsigned char* lds, int l, int u) {
    const int tid = tidx(), lane = tid & 63, wave = tid >> 6;
    const int c = u & 31, g = (u >> 5) & 1, b = u >> 6, row0 = b * 2048 + c * 64;
    const bf16_t* U = (const bf16_t*)(p.ws + OFF_U); const float* SDT = (const float*)(p.ws + OFF_SDT);
    LAS float* DT = (LAS float*)lds; LAS float* CU = DT + 128;
    LAS bf16_t* BT = (LAS bf16_t*)(lds + 1024); LAS bf16_t* VT = (LAS bf16_t*)(lds + 1024 + 18432);
    const int t0 = (tid & 15) * 4, chl0 = (tid >> 4) * 8;
    const int xc0 = chl0 < 128 ? g * 128 + chl0 : 256 + g * 128 + (chl0 - 128);
    u32x4 rows[7];
#pragma unroll
    for (int r = 0; r < 7; ++r) { const int t = t0 - 3 + r; rows[r] = (c > 0 || t >= 0) ? ldg8(U + (size_t)(row0 + t) * NU + UXBC + xc0) : (u32x4){0u, 0u, 0u, 0u}; }
    float w[4][8], bias[8];
#pragma unroll
    for (int j = 0; j < 4; ++j) ld8f(p.in[18] + (size_t)(l * 4 + j) * 768 + xc0, w[j]);
    ld8f(p.in[19] + l * 768 + xc0, bias);
    if (wave < 2) {
        const int h = 2 * g + wave;
        const float dt = softplusf_(SDT[(size_t)(row0 + lane) * 4 + h] + p.in[20][l * 4 + h]);
        const float cum = scan64_add(-expf(p.in[21][l * 4 + h]) * dt, lane);
        DT[wave * 64 + lane] = dt; CU[wave * 64 + lane] = cum;
    }
    float o[4][8]; conv8<4>(rows, w, bias, o);
    __syncthreads();
    if (chl0 < 128) { const int hh = chl0 >> 6; const float last = CU[hh * 64 + 63];
#pragma unroll
        for (int tt = 0; tt < 4; ++tt) { const int t = t0 + tt; const float sc = DT[hh * 64 + t] * __expf(last - CU[hh * 64 + t]);
#pragma unroll
            for (int i = 0; i < 8; ++i) VT[(chl0 + i) * 72 + t] = f2bf(siluf_(o[tt][i]) * sc); }
    } else { const int n0 = chl0 - 128;
#pragma unroll
        for (int tt = 0; tt < 4; ++tt)
#pragma unroll
            for (int i = 0; i < 8; ++i) BT[(n0 + i) * 72 + t0 + tt] = f2bf(siluf_(o[tt][i]));
    }
    __syncthreads();
    f32x4 acc[8];
#pragma unroll
    for (int j = 0; j < 8; ++j) acc[j] = (f32x4){0.f, 0.f, 0.f, 0.f};
    mm_nt<8, 2>(acc, BT + 16 * wave * 72, 72, VT, 72, lane);
    bf16_t* DS = (bf16_t*)(p.ws + OFF_DSS);
#pragma unroll
    for (int jj = 0; jj < 8; ++jj) { const int h = 2 * g + (jj >> 2), pc = (jj & 3) * 16 + (lane & 15);
#pragma unroll
        for (int e = 0; e < 4; ++e) { const int n = 16 * wave + (lane >> 4) * 4 + e; DS[(((size_t)(b * 4 + h) * 32 + c) * 128 + n) * 64 + pc] = f2bf(acc[jj][e]); } }
    if (tid < 2) ((float*)(p.ws + OFF_DECS))[(b * 4 + 2 * g + tid) * 32 + c] = __expf(CU[tid * 64 + 63]);
    __syncthreads();
}

__device__ __forceinline__ void ssd_passC(PRM p, LAS unsigned char* lds, int l, int u) {
    const int tid = tidx(), lane = tid & 63, wave = tid >> 6;
    const int c = u & 31, b = u >> 5, row0 = b * 2048 + c * 64;
    const bf16_t* U = (const bf16_t*)(p.ws + OFF_U); const float* SDT = (const float*)(p.ws + OFF_SDT);
    const bf16_t* DS = (const bf16_t*)(p.ws + OFF_DSS);
    bf16_t* YC = (bf16_t*)(p.ws + OFF_YC);
    LAS float* DT = (LAS float*)lds; LAS float* CU = (LAS float*)(lds + 1024); LAS float* SSQ = (LAS float*)(lds + 2048);
    LAS bf16_t* CM = (LAS bf16_t*)(lds + 3072); LAS bf16_t* BM = (LAS bf16_t*)(lds + 20480); LAS bf16_t* VT = (LAS bf16_t*)(lds + 37888);
    LAS bf16_t* PP = (LAS bf16_t*)(lds + 56320); LAS bf16_t* SINT = (LAS bf16_t*)(lds + 74752);
    if (wave < 4) {
        const int h = wave;
        const float dt = softplusf_(SDT[(size_t)(row0 + lane) * 4 + h] + p.in[20][l * 4 + h]);
        const float cum = scan64_add(-expf(p.in[21][l * 4 + h]) * dt, lane);
        DT[h * 64 + lane] = dt; CU[h * 64 + lane] = cum;
    }
    f32x4 yv[2][4];
#pragma unroll
    for (int g = 0; g < 2; ++g) {
        {
            u32x4 sv[4];
#pragma unroll
            for (int i = 0; i < 4; ++i) { const int idx8 = tid + i * NTHR, hh = idx8 >> 10, rem = idx8 & 1023, n = rem >> 3, p0 = (rem & 7) * 8;
                sv[i] = ldg8(DS + (((size_t)(b * 4 + 2 * g + hh) * 32 + c) * 128 + n) * 64 + p0); }
#pragma unroll
            for (int it = 0; it < 2; ++it) { const int item = tid + it * NTHR;
                if (item < 768) {
                    const int t0 = (item & 15) * 4, chl0 = (item >> 4) * 8, which = chl0 >> 7, n0 = chl0 & 127, xc0 = which * 256 + g * 128 + n0;
                    u32x4 rows[7];
#pragma unroll
                    for (int r = 0; r < 7; ++r) { const int t = t0 - 3 + r; rows[r] = (c > 0 || t >= 0) ? ldg8(U + (size_t)(row0 + t) * NU + UXBC + xc0) : (u32x4){0u, 0u, 0u, 0u}; }
                    float w[4][8], bias[8];
#pragma unroll
                    for (int j = 0; j < 4; ++j) ld8f(p.in[18] + (size_t)(l * 4 + j) * 768 + xc0, w[j]);
                    ld8f(p.in[19] + l * 768 + xc0, bias);
                    float o[4][8]; conv8<4>(rows, w, bias, o);
                    if (which == 0) {
#pragma unroll
                        for (int tt = 0; tt < 4; ++tt)
#pragma unroll
                            for (int i = 0; i < 8; ++i) VT[(n0 + i) * 72 + t0 + tt] = f2bf(siluf_(o[tt][i]));
                    } else { LAS bf16_t* dstp = which == 1 ? BM : CM;
#pragma unroll
                        for (int tt = 0; tt < 4; ++tt) { float sv8[8];
#pragma unroll
                            for (int i = 0; i < 8; ++i) sv8[i] = siluf_(o[tt][i]);
                            *(LAS u32x4*)(dstp + (t0 + tt) * 136 + n0) = pack8(sv8); }
                    }
                } }
#pragma unroll
            for (int i = 0; i < 4; ++i) { const int idx8 = tid + i * NTHR, hh = idx8 >> 10, rem = idx8 & 1023, n = rem >> 3, p0 = (rem & 7) * 8;
#pragma unroll
                for (int e = 0; e < 8; ++e) SINT[(hh * 64 + p0 + e) * 136 + n] = elem8(sv[i], e); }
        }
        __syncthreads();
        {
            const int rt = wave & 3, ct0 = (wave >> 2) * 2;
            f32x4 sc[2]; sc[0] = (f32x4){0.f, 0.f, 0.f, 0.f}; sc[1] = sc[0];
            mm_nt<2, 4>(sc, CM + 16 * rt * 136, 136, BM + 16 * ct0 * 136, 136, lane);
#pragma unroll
            for (int hh = 0; hh < 2; ++hh) { const int h = 2 * g + hh;
#pragma unroll
                for (int jj = 0; jj < 2; ++jj)
#pragma unroll
                    for (int e = 0; e < 4; ++e) { const int t = 16 * rt + (lane >> 4) * 4 + e, s = 16 * (ct0 + jj) + (lane & 15);
                        const float val = s <= t ? sc[jj][e] * __expf(CU[h * 64 + t] - CU[h * 64 + s]) * DT[h * 64 + s] : 0.f;
                        PP[(hh * 64 + t) * 72 + s] = f2bf(val); } }
        }
        __syncthreads();
        {
            const int hh = wave >> 2, rt = wave & 3, h = 2 * g + hh;
            float zv[4][4];
#pragma unroll
            for (int e = 0; e < 4; ++e)
#pragma unroll
                for (int j = 0; j < 4; ++j) zv[e][j] = bf2f(U[(size_t)(row0 + 16 * rt + (lane >> 4) * 4 + e) * NU + UZ + h * 64 + 16 * j + (lane & 15)]);
#pragma unroll
            for (int j = 0; j < 4; ++j) yv[g][j] = (f32x4){0.f, 0.f, 0.f, 0.f};
            mm_nt<4, 4>(yv[g], CM + 16 * rt * 136, 136, SINT + hh * 64 * 136, 136, lane);
#pragma unroll
            for (int e = 0; e < 4; ++e) { const float sc = __expf(CU[h * 64 + 16 * rt + (lane >> 4) * 4 + e]);
#pragma unroll
                for (int j = 0; j < 4; ++j) yv[g][j][e] *= sc; }
            mm_nt<4, 2>(yv[g], PP + (hh * 64 + 16 * rt) * 72, 72, VT + hh * 64 * 72, 72, lane);
            const float Dh = p.in[22][l * 4 + h];
#pragma unroll
            for (int e = 0; e < 4; ++e) { const int t = 16 * rt + (lane >> 4) * 4 + e; float s2 = 0.f;
#pragma unroll
                for (int j = 0; j < 4; ++j) { const int pc = 16 * j + (lane & 15);
                    const float xs = bf2f(VT[(hh * 64 + pc) * 72 + t]);
                    const float v = (yv[g][j][e] + Dh * xs) * siluf_(zv[e][j]); yv[g][j][e] = v; s2 += v * v; }
                s2 = row16_sum(s2);
                if ((lane & 15) == 0) SSQ[t * 4 + h] = s2; }
        }
        __syncthreads();
    }
#pragma unroll
    for (int g = 0; g < 2; ++g) { const int hh = wave >> 2, rt = wave & 3, h = 2 * g + hh;
#pragma unroll
        for (int e = 0; e < 4; ++e) { const int t = 16 * rt + (lane >> 4) * 4 + e;
            const float tot = SSQ[t * 4 + 0] + SSQ[t * 4 + 1] + SSQ[t * 4 + 2] + SSQ[t * 4 + 3];
            const float rstd = 1.0f / sqrtf(tot * (1.0f / 256.0f) + EPS);
#pragma unroll
            for (int j = 0; j < 4; ++j) { const int pc = 16 * j + (lane & 15);
                YC[(size_t)(row0 + t) * D + h * 64 + pc] = f2bf(yv[g][j][e] * rstd * p.in[23][l * 256 + h * 64 + pc]); } } }
    if (c == 31) for (int idx = tid; idx < 2304; idx += NTHR) { const int r = idx / 768, ch = idx % 768;
        p.out[O_PSSDC + ((size_t)(l * 8 + b) * 3 + r) * 768 + ch] = bf2f(U[(size_t)(b * 2048 + 2045 + r) * NU + UXBC + ch]); }
    __syncthreads();
}

constexpr int E_CUM = 0, E_QS = 16640, E_QD = 25856, E_KV = 35072, E_VT = 71936, E_SINT = 81152, E_PP = 90368, E_KWT = 99584, E_RSC = 108800, E_SSQ = 109056;
__device__ __forceinline__ void engineA(LAS unsigned char* lds, bf16_t* DS, int wave, int lane) {
    const LAS bf16_t* KWT = (const LAS bf16_t*)(lds + E_KWT); const LAS bf16_t* VT = (const LAS bf16_t*)(lds + E_VT);
    const int rt = wave >> 1, ct0 = (wave & 1) * 2;
    f32x4 acc[2]; acc[0] = (f32x4){0.f, 0.f, 0.f, 0.f}; acc[1] = acc[0];
    mm_nt<2, 2>(acc, KWT + 16 * rt * 72, 72, VT + 16 * ct0 * 72, 72, lane);
#pragma unroll
    for (int jj = 0; jj < 2; ++jj)
#pragma unroll
        for (int e = 0; e < 4; ++e) DS[(16 * rt + (lane >> 4) * 4 + e) * 64 + 16 * (ct0 + jj) + (lane & 15)] = f2bf(acc[jj][e]);
}
template <bool RET>
__device__ __forceinline__ void engineC(LAS unsigned char* lds, int qd_off, int kvstride, float lg, f32x4 (&y)[2], int wave, int lane) {
    const LAS bf16_t* QS = (const LAS bf16_t*)(lds + E_QS); const LAS bf16_t* QD = (const LAS bf16_t*)(lds + qd_off);
    const LAS bf16_t* KV = (const LAS bf16_t*)(lds + E_KV); const LAS bf16_t* VT = (const LAS bf16_t*)(lds + E_VT);
    const LAS bf16_t* SINT = (const LAS bf16_t*)(lds + E_SINT); LAS bf16_t* PP = (LAS bf16_t*)(lds + E_PP); const LAS float* RSC = (const LAS float*)(lds + E_RSC);
    const int rt = wave >> 1, ct0 = (wave & 1) * 2;
    f32x4 sc[2]; sc[0] = (f32x4){0.f, 0.f, 0.f, 0.f}; sc[1] = sc[0];
    mm_nt<2, 2>(sc, QS + 16 * rt * 72, 72, KV + kvstride * rt + 16 * ct0 * 72, 72, lane);
#pragma unroll
    for (int jj = 0; jj < 2; ++jj)
#pragma unroll
        for (int e = 0; e < 4; ++e) { const int t = 16 * rt + (lane >> 4) * 4 + e, s = 16 * (ct0 + jj) + (lane & 15);
            float val = 0.f; if (s <= t) val = RET ? sc[jj][e] * __expf((float)(t - s) * lg) : sc[jj][e];
            PP[t * 72 + s] = f2bf(val); }
    __syncthreads();
    y[0] = (f32x4){0.f, 0.f, 0.f, 0.f}; y[1] = y[0];
    mm_nt<2, 2>(y, QD + 16 * rt * 72, 72, SINT + 16 * ct0 * 72, 72, lane);
#pragma unroll
    for (int e = 0; e < 4; ++e) { const float r = RSC[16 * rt + (lane >> 4) * 4 + e]; y[0][e] *= r; y[1][e] *= r; }
    mm_nt<2, 2>(y, PP + 16 * rt * 72, 72, VT + 16 * ct0 * 72, 72, lane);
}
template <bool CENTER>
__device__ __forceinline__ void headnorm_store(LAS unsigned char* lds, const f32x4 (&y)[2], int wave, int lane, const float (&gate)[8], const float (&gain)[2], bf16_t* outp) {
    LAS f32x2* SSQ = (LAS f32x2*)(lds + E_SSQ);
    const int rt = wave >> 1, half = wave & 1, ct0 = half * 2;
#pragma unroll
    for (int e = 0; e < 4; ++e) { float s1 = y[0][e] + y[1][e], s2 = y[0][e] * y[0][e] + y[1][e] * y[1][e];
        s1 = row16_sum(s1); s2 = row16_sum(s2);
        if ((lane & 15) == 0) SSQ[(16 * rt + (lane >> 4) * 4 + e) * 2 + half] = (f32x2){s1, s2}; }
    __syncthreads();
#pragma unroll
    for (int e = 0; e < 4; ++e) { const int t = 16 * rt + (lane >> 4) * 4 + e;
        const f32x2 a = SSQ[t * 2], b2 = SSQ[t * 2 + 1];
        const float mean = CENTER ? (a.x + b2.x) * (1.0f / 64.0f) : 0.f;
        const float var = (a.y + b2.y) * (1.0f / 64.0f) - mean * mean;
        const float rstd = 1.0f / sqrtf(fmaxf(var, 0.f) + EPS);
#pragma unroll
        for (int jj = 0; jj < 2; ++jj) { const int pc = 16 * (ct0 + jj) + (lane & 15);
            outp[(size_t)t * D + pc] = f2bf((y[jj][e] - mean) * rstd * gain[jj] * siluf_(gate[e * 2 + jj])); } }
}
__device__ __forceinline__ void headnorm_prefetch(int wave, int lane, const bf16_t* Ugate, const float* gainp, float (&gate)[8], float (&gain)[2]) {
    const int rt = wave >> 1, ct0 = (wave & 1) * 2;
#pragma unroll
    for (int jj = 0; jj < 2; ++jj) { const int pc = 16 * (ct0 + jj) + (lane & 15); gain[jj] = gainp[pc];
#pragma unroll
        for (int e = 0; e < 4; ++e) gate[e * 2 + jj] = bf2f(Ugate[(size_t)(16 * rt + (lane >> 4) * 4 + e) * NU + pc]); }
}

struct RetRegs { u32x4 vraw, x1, x2, dsraw; float cs[8], sn[8], gate[8], gain[2]; };
template <bool PASSC>
__device__ __forceinline__ void ret_load(PRM p, int l, int u, RetRegs& r) {
    const int tid = tidx(), lane = tid & 63, wave = tid >> 6;
    const int h = u & 3, c = (u >> 2) & 31, b = u >> 7, row0 = b * 2048 + c * 64;
    const bf16_t* U = (const bf16_t*)(p.ws + OFF_U);
    const float* RC = (const float*)(p.ws + OFF_ROPE); const float* RS = RC + 2052 * 32;
    const bf16_t* DS = (const bf16_t*)(p.ws + OFF_DSR) + ((size_t)(b * 4 + h) * 32 + c) * 4096;
    const int t = tid >> 3, c8 = (tid & 7) * 8, isq = tid >> 8, tt = (tid & 255) >> 2, j0 = (tid & 3) * 8;
    r.vraw = ldg8(U + (size_t)(row0 + t) * NU + URV + h * 64 + c8); r.dsraw = (u32x4){0u, 0u, 0u, 0u};
    if (PASSC) { r.dsraw = ldg8(DS + t * 64 + c8); headnorm_prefetch(wave, lane, U + (size_t)row0 * NU + URG + h * 64, p.in[24] + l * 256 + h * 64, r.gate, r.gain); }
    r.x1 = (u32x4){0u, 0u, 0u, 0u}; r.x2 = r.x1;
    if (PASSC || isq == 0) { const bf16_t* ur = U + (size_t)(row0 + tt) * NU + (isq ? URQ : URK) + h * 64 + j0; r.x1 = ldg8(ur); r.x2 = ldg8(ur + 32);
        ld8f(RC + (size_t)(c * 64 + tt) * 32 + j0, r.cs); ld8f(RS + (size_t)(c * 64 + tt) * 32 + j0, r.sn); }
}
template <bool PASSC>
__device__ __forceinline__ void ret_body(PRM p, LAS unsigned char* lds, int l, int u, const RetRegs& r) {
    const int tid = tidx(), lane = tid & 63, wave = tid >> 6;
    const int h = u & 3, c = (u >> 2) & 31, b = u >> 7, row0 = b * 2048 + c * 64;
    const float lg = logf(1.0f - exp2f(-5.0f - (float)h));
    LAS bf16_t* QS = (LAS bf16_t*)(lds + E_QS); LAS bf16_t* KV = (LAS bf16_t*)(lds + E_KV); LAS bf16_t* VT = (LAS bf16_t*)(lds + E_VT);
    LAS bf16_t* SINT = (LAS bf16_t*)(lds + E_SINT); LAS bf16_t* KWT = (LAS bf16_t*)(lds + E_KWT); LAS float* RSC = (LAS float*)(lds + E_RSC);
    bf16_t* DS = (bf16_t*)(p.ws + OFF_DSR) + ((size_t)(b * 4 + h) * 32 + c) * 4096;
    const int t = tid >> 3, c8 = (tid & 7) * 8, isq = tid >> 8, tt = (tid & 255) >> 2, j0 = (tid & 3) * 8;
#pragma unroll
    for (int i = 0; i < 8; ++i) VT[(c8 + i) * 72 + t] = elem8(r.vraw, i);
    if (PASSC) {
#pragma unroll
        for (int i = 0; i < 8; ++i) SINT[(c8 + i) * 72 + t] = elem8(r.dsraw, i);
        if (tid < 64) RSC[tid] = __expf((float)(tid + 1) * lg);
    }
    if (PASSC || isq == 0) {
        float a[8], bb[8], ra[8], rb[8]; unpack8(r.x1, a); unpack8(r.x2, bb);
        const float scl = isq ? 1.0f : 0.125f;
#pragma unroll
        for (int i = 0; i < 8; ++i) { ra[i] = (a[i] * r.cs[i] - bb[i] * r.sn[i]) * scl; rb[i] = (bb[i] * r.cs[i] + a[i] * r.sn[i]) * scl; }
        if (PASSC) { LAS bf16_t* dst = isq ? QS : KV;
            *(LAS u32x4*)(dst + tt * 72 + j0) = pack8(ra); *(LAS u32x4*)(dst + tt * 72 + j0 + 32) = pack8(rb);
        } else { const float w = __expf((float)(63 - tt) * lg);
#pragma unroll
            for (int i = 0; i < 8; ++i) { KWT[(j0 + i) * 72 + tt] = f2bf(ra[i] * w); KWT[(j0 + 32 + i) * 72 + tt] = f2bf(rb[i] * w); } }
    }
    __syncthreads();
    if (PASSC) {
        f32x4 y[2]; engineC<true>(lds, E_QS, 0, lg, y, wave, lane);
        headnorm_store<true>(lds, y, wave, lane, r.gate, r.gain, (bf16_t*)(p.ws + OFF_YC) + (size_t)row0 * D + 256 + h * 64);
    } else engineA(lds, DS, wave, lane);
    __syncthreads();
}

struct HgRegs { u32x4 hfraw, viraw, hqraw, dsraw; float lb[8], gate[8], gain[2]; };
template <bool PASSC>
__device__ __forceinline__ void hg_load(PRM p, int l, int u, HgRegs& r) {
    const int tid = tidx(), lane = tid & 63, wave = tid >> 6;
    const int h = u & 3, c = (u >> 2) & 31, b = u >> 7, row0 = b * 2048 + c * 64;
    const bf16_t* U = (const bf16_t*)(p.ws + OFF_U);
    const bf16_t* DS = (const bf16_t*)(p.ws + OFF_DSH) + ((size_t)(b * 4 + h) * 32 + c) * 4096;
    const int t = tid >> 3, c8 = (tid & 7) * 8;
    const bf16_t* ur = U + (size_t)(row0 + t) * NU + h * 64 + c8;
    r.hfraw = ldg8(ur + UHF); r.viraw = ldg8(ur + UHI); r.hqraw = (u32x4){0u, 0u, 0u, 0u}; r.dsraw = r.hqraw;
    if (PASSC) { r.hqraw = ldg8(ur + UHQ); r.dsraw = ldg8(DS + t * 64 + c8); headnorm_prefetch(wave, lane, U + (size_t)row0 * NU + UHG + h * 64, p.in[33] + l * 256 + h * 64, r.gate, r.gain); }
    ld8f((const float*)(p.ws + OFF_LB) + l * 256 + h * 64 + c8, r.lb);
}
template <bool PASSC>
__device__ __forceinline__ void hg_body(PRM p, LAS unsigned char* lds, int l, int u, const HgRegs& r) {
    const int tid = tidx(), lane = tid & 63, wave = tid >> 6;
    const int h = u & 3, c = (u >> 2) & 31, b = u >> 7, row0 = b * 2048 + c * 64;
    LAS float* CUM = (LAS float*)(lds + E_CUM);
    LAS bf16_t* QS = (LAS bf16_t*)(lds + E_QS); LAS bf16_t* QD = (LAS bf16_t*)(lds + E_QD); LAS bf16_t* KV = (LAS bf16_t*)(lds + E_KV); LAS bf16_t* VT = (LAS bf16_t*)(lds + E_VT);
    LAS bf16_t* SINT = (LAS bf16_t*)(lds + E_SINT); LAS bf16_t* KWT = (LAS bf16_t*)(lds + E_KWT); LAS float* RSC = (LAS float*)(lds + E_RSC);
    bf16_t* DS = (bf16_t*)(p.ws + OFF_DSH) + ((size_t)(b * 4 + h) * 32 + c) * 4096;
    const int t = tid >> 3, c8 = (tid & 7) * 8;
#pragma unroll
    for (int i = 0; i < 8; ++i) VT[(c8 + i) * 72 + t] = elem8(r.viraw, i);
    if (PASSC) {
#pragma unroll
        for (int i = 0; i < 8; ++i) SINT[(c8 + i) * 72 + t] = elem8(r.dsraw, i);
        if (tid < 64) RSC[tid] = 1.0f;
    }
    float hf[8]; unpack8(r.hfraw, hf);
#pragma unroll
    for (int i = 0; i < 8; ++i) CUM[t * 65 + c8 + i] = __logf(r.lb[i] + (1.0f - r.lb[i]) * sigmoidf_(hf[i]));
    __syncthreads();
#pragma unroll
    for (int kk = 0; kk < 8; ++kk) { const int k = wave * 8 + kk; const float v = scan64_add(CUM[lane * 65 + k], lane); CUM[lane * 65 + k] = v; }
    __syncthreads();
    {
        float cum[8], kk_[8];
#pragma unroll
        for (int i = 0; i < 8; ++i) { cum[i] = CUM[t * 65 + c8 + i]; kk_[i] = (1.0f - r.lb[i]) * sigmoidf_(-hf[i]); }
        if (PASSC) {
            float q[8], qd[8], qs[8]; unpack8(r.hqraw, q); const int i_ = t >> 4;
#pragma unroll
            for (int i = 0; i < 8; ++i) { q[i] = siluf_(q[i]); const float ci0 = i_ ? CUM[(16 * i_ - 1) * 65 + c8 + i] : 0.f; qd[i] = q[i] * __expf(cum[i]); qs[i] = q[i] * __expf(cum[i] - ci0); }
            *(LAS u32x4*)(QD + t * 72 + c8) = pack8(qd); *(LAS u32x4*)(QS + t * 72 + c8) = pack8(qs);
#pragma unroll
            for (int i2 = 0; i2 < 4; ++i2) { float kv[8];
#pragma unroll
                for (int i = 0; i < 8; ++i) { float val = 0.f;
                    if (i2 >= i_) { const float c0 = i2 ? CUM[(16 * i2 - 1) * 65 + c8 + i] : 0.f; val = kk_[i] * __expf(fminf(c0 - cum[i], 60.f)); }
                    kv[i] = val; }
                *(LAS u32x4*)(KV + i2 * 4608 + t * 72 + c8) = pack8(kv); }
        } else {
#pragma unroll
            for (int i = 0; i < 8; ++i) KWT[(c8 + i) * 72 + t] = f2bf(kk_[i] * __expf(CUM[63 * 65 + c8 + i] - cum[i]));
            if (tid < 64) ((float*)(p.ws + OFF_DECH))[((size_t)(b * 4 + h) * 32 + c) * 64 + tid] = __expf(CUM[63 * 65 + tid]);
        }
    }
    __syncthreads();
    if (PASSC) {
        f32x4 y[2]; engineC<false>(lds, E_QD, 4608, 0.f, y, wave, lane);
        headnorm_store<false>(lds, y, wave, lane, r.gate, r.gain, (bf16_t*)(p.ws + OFF_YC) + (size_t)row0 * D + 768 + h * 64);
    } else engineA(lds, DS, wave, lane);
    __syncthreads();
}

struct RgRegs { u32x4 rows[4], wt[2], gyraw; float w[4][8], bias[8], hin[8], ba[2], bx[2], lam[2]; };
template <bool PASSC>
__device__ __forceinline__ void rg_load(PRM p, int l, int u, RgRegs& r) {
    const int tid = tidx(), lane = tid & 63, wave = tid >> 6;
    const int blk = u & 3, c = (u >> 2) & 31, b = u >> 7, row0 = b * 2048 + c * 64;
    const bf16_t* U = (const bf16_t*)(p.ws + OFF_U);
    const int t = tid >> 3, c8 = (tid & 7) * 8, ch0 = blk * 64 + c8;
#pragma unroll
    for (int q = 0; q < 4; ++q) { const int tr = t - 3 + q; r.rows[q] = (c > 0 || tr >= 0) ? ldg8(U + (size_t)(row0 + tr) * NU + UGX + ch0) : (u32x4){0u, 0u, 0u, 0u}; }
#pragma unroll
    for (int j = 0; j < 4; ++j) ld8f(p.in[25] + (size_t)(l * 4 + j) * 256 + ch0, r.w[j]);
    ld8f(p.in[26] + l * 256 + ch0, r.bias);
    const bf16_t* WRG = (const bf16_t*)(p.ws + OFF_WRG);
#pragma unroll
    for (int i = 0; i < 2; ++i) { const int idx = tid + i * NTHR, gate = idx >> 9, rem = idx & 511; r.wt[i] = *(const u32x4*)(WRG + (size_t)((l * 2 + gate) * 4 + blk) * 4096 + (rem >> 3) * 64 + (rem & 7) * 8); }
    r.gyraw = (u32x4){0u, 0u, 0u, 0u};
    if (PASSC) { r.gyraw = ldg8(U + (size_t)(row0 + t) * NU + UGY + ch0);
#pragma unroll
        for (int kk = 0; kk < 8; ++kk) r.hin[kk] = ((const float*)(p.ws + OFF_RGC))[(size_t)(b * 32 + c) * 256 + blk * 64 + wave * 8 + kk]; }
#pragma unroll
    for (int jj = 0; jj < 2; ++jj) { const int ch = blk * 64 + 16 * ((wave >> 2) * 2 + jj) + (lane & 15);
        r.ba[jj] = p.in[28][l * 256 + ch]; r.bx[jj] = p.in[30][l * 256 + ch]; r.lam[jj] = p.in[31][l * 256 + ch]; }
}
template <bool PASSC>
__device__ __forceinline__ void rg_body(PRM p, LAS unsigned char* lds, int l, int u, const RgRegs& r) {
    const int tid = tidx(), lane = tid & 63, wave = tid >> 6;
    const int blk = u & 3, c = (u >> 2) & 31, b = u >> 7, row0 = b * 2048 + c * 64;
    const bf16_t* U = (const bf16_t*)(p.ws + OFF_U);
    LAS float* XR = (LAS float*)lds; LAS bf16_t* XRB = (LAS bf16_t*)(lds + 16640); LAS bf16_t* WT = (LAS bf16_t*)(lds + 25856);
    LAS float* AA = (LAS float*)(lds + 44288); LAS float* BB = (LAS float*)(lds + 60928); LAS float* HL = (LAS float*)(lds + 77568);
    const int t = tid >> 3, c8 = (tid & 7) * 8, ch0 = blk * 64 + c8;
    {
        float o[1][8]; conv8<1>(r.rows, r.w, r.bias, o);
#pragma unroll
        for (int i = 0; i < 8; ++i) XR[t * 65 + c8 + i] = o[0][i];
        *(LAS u32x4*)(XRB + t * 72 + c8) = pack8(o[0]);
#pragma unroll
        for (int i = 0; i < 2; ++i) { const int idx = tid + i * NTHR, gate = idx >> 9, rem = idx & 511; *(LAS u32x4*)(WT + gate * 4608 + (rem >> 3) * 72 + (rem & 7) * 8) = r.wt[i]; }
    }
    __syncthreads();
    {
        const int rt = wave & 3, ct0 = (wave >> 2) * 2;
        f32x4 aA[2], aX[2]; aA[0] = (f32x4){0.f, 0.f, 0.f, 0.f}; aA[1] = aA[0]; aX[0] = aA[0]; aX[1] = aA[0];
        mm_nt<2, 2>(aA, XRB + 16 * rt * 72, 72, WT + 16 * ct0 * 72, 72, lane);
        mm_nt<2, 2>(aX, XRB + 16 * rt * 72, 72, WT + 4608 + 16 * ct0 * 72, 72, lane);
#pragma unroll
        for (int jj = 0; jj < 2; ++jj) { const int j = 16 * (ct0 + jj) + (lane & 15);
            const float sp = -8.0f * softplusf_(-r.lam[jj]);
#pragma unroll
            for (int e = 0; e < 4; ++e) { const int tq = 16 * rt + (lane >> 4) * 4 + e;
                const float rr = sigmoidf_(aA[jj][e] + r.ba[jj]), ig = sigmoidf_(aX[jj][e] + r.bx[jj]);
                const float la = sp * rr; AA[tq * 65 + j] = __expf(la); BB[tq * 65 + j] = sqrtf(fmaxf(1.0f - __expf(2.0f * la), 0.f)) * ig * XR[tq * 65 + j]; } }
    }
    __syncthreads();
#pragma unroll
    for (int kk = 0; kk < 8; ++kk) { const int j = wave * 8 + kk, ch = blk * 64 + j;
        float A = AA[lane * 65 + j], B = BB[lane * 65 + j];
        scan64_lin(A, B);
        if (PASSC) HL[lane * 65 + j] = B + A * r.hin[kk];
        else if (lane == 63) { ((float*)(p.ws + OFF_RGH))[(size_t)(b * 32 + c) * 256 + ch] = B; ((float*)(p.ws + OFF_RGA))[(size_t)(b * 32 + c) * 256 + ch] = A; }
    }
    if (PASSC) {
        __syncthreads();
        float gy[8], y[8]; unpack8(r.gyraw, gy);
#pragma unroll
        for (int i = 0; i < 8; ++i) y[i] = geluf_(gy[i]) * HL[t * 65 + c8 + i];
        *(u32x4*)((bf16_t*)(p.ws + OFF_YC) + (size_t)(row0 + t) * D + 512 + ch0) = pack8(y);
        if (c == 31 && tid < 192) { const int rr = tid >> 6, j = tid & 63;
            p.out[O_PRGC + ((size_t)(l * 8 + b) * 3 + rr) * 256 + blk * 64 + j] = bf2f(U[(size_t)(b * 2048 + 2045 + rr) * NU + UGX + blk * 64 + j]); }
    }
    __syncthreads();
}

#define UNIT_LOOP(NAME, REGS, LOADF, BODYF)                                                                             \
template <bool PASSC> __device__ __forceinline__ void NAME(PRM p, LAS unsigned char* lds, int l) {            \
    int u = blockIdx.x; if (u >= 1024) return;                                                                          \
    REGS cur; LOADF<PASSC>(p, l, u, cur);                                                                               \
    _Pragma("unroll 1") for (; u < 1024; u += gridDim.x) { REGS nx; const int un = u + gridDim.x;                        \
        if (un < 1024) LOADF<PASSC>(p, l, un, nx);                                                                      \
        BODYF<PASSC>(p, lds, l, u, cur);                                                                                \
        if (un < 1024) cur = nx; } }
UNIT_LOOP(ret_loop, RetRegs, ret_load, ret_body)
UNIT_LOOP(hg_loop, HgRegs, hg_load, hg_body)
template <bool PASSC> __device__ __forceinline__ void rg_loop(PRM p, LAS unsigned char* lds, int l) {
    _Pragma("unroll 1") for (int u = blockIdx.x; u < 1024; u += gridDim.x) { RgRegs r; rg_load<PASSC>(p, l, u, r); rg_body<PASSC>(p, lds, l, u, r); } }

__device__ __forceinline__ void retC2_unit(PRM p, LAS unsigned char* lds, int l, int u) {
    const int tid = tidx(), lane = tid & 63, wave = tid >> 6;
    const int hp = u & 1, c = (u >> 1) & 31, b = u >> 6, row0 = b * 2048 + c * 64;
    const bf16_t* U = (const bf16_t*)(p.ws + OFF_U);
    const float* RC = (const float*)(p.ws + OFF_ROPE); const float* RS = RC + 2052 * 32;
    LAS bf16_t* QS = (LAS bf16_t*)lds; LAS bf16_t* KV = (LAS bf16_t*)(lds + 18432); LAS bf16_t* VT = (LAS bf16_t*)(lds + 36864);
    LAS bf16_t* SINT = (LAS bf16_t*)(lds + 55296); LAS bf16_t* PP = (LAS bf16_t*)(lds + 73728);
    const int t = tid >> 3, c8 = (tid & 7) * 8, isq = tid >> 8, tt = (tid & 255) >> 2, j0 = (tid & 3) * 8;
    const int hw = wave >> 2, rt = wave & 3, hme = 2 * hp + hw;
    u32x4 vraw[2], dsraw[2], x1[2], x2[2]; float cs[8], sn[8], gate[16], gain[4];
#pragma unroll
    for (int hh = 0; hh < 2; ++hh) { const int h = 2 * hp + hh;
        vraw[hh] = ldg8(U + (size_t)(row0 + t) * NU + URV + h * 64 + c8);
        dsraw[hh] = ldg8((const bf16_t*)(p.ws + OFF_DSR) + ((size_t)(b * 4 + h) * 32 + c) * 4096 + t * 64 + c8);
        const bf16_t* ur = U + (size_t)(row0 + tt) * NU + (isq ? URQ : URK) + h * 64 + j0; x1[hh] = ldg8(ur); x2[hh] = ldg8(ur + 32); }
    ld8f(RC + (size_t)(c * 64 + tt) * 32 + j0, cs); ld8f(RS + (size_t)(c * 64 + tt) * 32 + j0, sn);
#pragma unroll
    for (int j = 0; j < 4; ++j) { const int pc = 16 * j + (lane & 15); gain[j] = p.in[24][l * 256 + hme * 64 + pc];
#pragma unroll
        for (int e = 0; e < 4; ++e) gate[e * 4 + j] = bf2f(U[(size_t)(row0 + 16 * rt + (lane >> 4) * 4 + e) * NU + URG + hme * 64 + pc]); }
#pragma unroll
    for (int hh = 0; hh < 2; ++hh) {
#pragma unroll
        for (int i = 0; i < 8; ++i) { VT[hh * 4608 + (c8 + i) * 72 + t] = elem8(vraw[hh], i); SINT[hh * 4608 + (c8 + i) * 72 + t] = elem8(dsraw[hh], i); }
        float a[8], bb[8], ra[8], rb[8]; unpack8(x1[hh], a); unpack8(x2[hh], bb);
        const float scl = isq ? 1.0f : 0.125f;
#pragma unroll
        for (int i = 0; i < 8; ++i) { ra[i] = (a[i] * cs[i] - bb[i] * sn[i]) * scl; rb[i] = (bb[i] * cs[i] + a[i] * sn[i]) * scl; }
        LAS bf16_t* dst = (isq ? QS : KV) + hh * 4608;
        *(LAS u32x4*)(dst + tt * 72 + j0) = pack8(ra); *(LAS u32x4*)(dst + tt * 72 + j0 + 32) = pack8(rb);
    }
    __syncthreads();
    const float lg = logf(1.0f - exp2f(-5.0f - (float)hme));
    {
        f32x4 sc[4];
#pragma unroll
        for (int j = 0; j < 4; ++j) sc[j] = (f32x4){0.f, 0.f, 0.f, 0.f};
        mm_nt<4, 2>(sc, QS + hw * 4608 + 16 * rt * 72, 72, KV + hw * 4608, 72, lane);
#pragma unroll
        for (int j = 0; j < 4; ++j)
#pragma unroll
            for (int e = 0; e < 4; ++e) { const int tq = 16 * rt + (lane >> 4) * 4 + e, sq = 16 * j + (lane & 15);
                PP[hw * 4608 + tq * 72 + sq] = f2bf(sq <= tq ? sc[j][e] * __expf((float)(tq - sq) * lg) : 0.f); }
    }
    __syncthreads();
    f32x4 y[4];
#pragma unroll
    for (int j = 0; j < 4; ++j) y[j] = (f32x4){0.f, 0.f, 0.f, 0.f};
    mm_nt<4, 2>(y, QS + hw * 4608 + 16 * rt * 72, 72, SINT + hw * 4608, 72, lane);
#pragma unroll
    for (int e = 0; e < 4; ++e) { const float r = __expf((float)(16 * rt + (lane >> 4) * 4 + e + 1) * lg);
#pragma unroll
        for (int j = 0; j < 4; ++j) y[j][e] *= r; }
    mm_nt<4, 2>(y, PP + hw * 4608 + 16 * rt * 72, 72, VT + hw * 4608, 72, lane);
    bf16_t* outp = (bf16_t*)(p.ws + OFF_YC) + (size_t)row0 * D + 256 + hme * 64;
#pragma unroll
    for (int e = 0; e < 4; ++e) { const int tq = 16 * rt + (lane >> 4) * 4 + e;
        float s1 = (y[0][e] + y[1][e]) + (y[2][e] + y[3][e]);
#pragma unroll
        for (int o = 1; o < 16; o <<= 1) s1 += __shfl_xor(s1, o);
        const float mean = s1 * (1.0f / 64.0f);
        float s2 = 0.f;
#pragma unroll
        for (int j = 0; j < 4; ++j) { const float d = y[j][e] - mean; s2 += d * d; }
#pragma unroll
        for (int o = 1; o < 16; o <<= 1) s2 += __shfl_xor(s2, o);
        const float rstd = 1.0f / sqrtf(s2 * (1.0f / 64.0f) + EPS);
#pragma unroll
        for (int j = 0; j < 4; ++j) outp[(size_t)tq * D + 16 * j + (lane & 15)] = f2bf((y[j][e] - mean) * rstd * gain[j] * siluf_(gate[e * 4 + j])); }
    __syncthreads();
}

__device__ __forceinline__ void engineA4(const LAS bf16_t* KWT, const LAS bf16_t* VT, bf16_t* DSbase  , int wave, int lane) {
    const int hh = wave >> 1, rt0 = (wave & 1) * 2;
#pragma unroll
    for (int q = 0; q < 2; ++q) { const int rt = rt0 + q;
        f32x4 acc[4];
#pragma unroll
        for (int j = 0; j < 4; ++j) acc[j] = (f32x4){0.f, 0.f, 0.f, 0.f};
        mm_nt<4, 2>(acc, KWT + (hh * 64 + 16 * rt) * 72, 72, VT + hh * 64 * 72, 72, lane);
        bf16_t* DS = DSbase + (size_t)hh * 32 * 4096;
#pragma unroll
        for (int j = 0; j < 4; ++j)
#pragma unroll
            for (int e = 0; e < 4; ++e) DS[(16 * rt + (lane >> 4) * 4 + e) * 64 + 16 * j + (lane & 15)] = f2bf(acc[j][e]); }
}
__device__ __forceinline__ void retA4_unit(PRM p, LAS unsigned char* lds, int l, int u) {
    const int tid = tidx(), lane = tid & 63, wave = tid >> 6;
    const int c = u & 31, b = u >> 5, row0 = b * 2048 + c * 64;
    const bf16_t* U = (const bf16_t*)(p.ws + OFF_U);
    const float* RC = (const float*)(p.ws + OFF_ROPE); const float* RS = RC + 2052 * 32;
    LAS bf16_t* KWT = (LAS bf16_t*)lds; LAS bf16_t* VT = (LAS bf16_t*)(lds + 36864);
    const int t = tid >> 3, c8 = (tid & 7) * 8, tt = (tid & 255) >> 2, j0 = (tid & 3) * 8;
    u32x4 vraw[4], x1[2], x2[2]; float cs[8], sn[8];
#pragma unroll
    for (int hh = 0; hh < 4; ++hh) vraw[hh] = ldg8(U + (size_t)(row0 + t) * NU + URV + hh * 64 + c8);
#pragma unroll
    for (int it = 0; it < 2; ++it) { const int hh = it * 2 + (tid >> 8); const bf16_t* ur = U + (size_t)(row0 + tt) * NU + URK + hh * 64 + j0; x1[it] = ldg8(ur); x2[it] = ldg8(ur + 32); }
    ld8f(RC + (size_t)(c * 64 + tt) * 32 + j0, cs); ld8f(RS + (size_t)(c * 64 + tt) * 32 + j0, sn);
#pragma unroll
    for (int hh = 0; hh < 4; ++hh)
#pragma unroll
        for (int i = 0; i < 8; ++i) VT[(hh * 64 + c8 + i) * 72 + t] = elem8(vraw[hh], i);
#pragma unroll
    for (int it = 0; it < 2; ++it) { const int hh = it * 2 + (tid >> 8);
        const float lg = logf(1.0f - exp2f(-5.0f - (float)hh)); const float w = __expf((float)(63 - tt) * lg) * 0.125f;
        float a[8], bb[8]; unpack8(x1[it], a); unpack8(x2[it], bb);
#pragma unroll
        for (int i = 0; i < 8; ++i) { KWT[(hh * 64 + j0 + i) * 72 + tt] = f2bf((a[i] * cs[i] - bb[i] * sn[i]) * w); KWT[(hh * 64 + j0 + 32 + i) * 72 + tt] = f2bf((bb[i] * cs[i] + a[i] * sn[i]) * w); } }
    __syncthreads();
    engineA4(KWT, VT, (bf16_t*)(p.ws + OFF_DSR) + ((size_t)(b * 4) * 32 + c) * 4096, wave, lane);
    __syncthreads();
}
__device__ __forceinline__ void hgA4_unit(PRM p, LAS unsigned char* lds, int l, int u) {
    const int tid = tidx(), lane = tid & 63, wave = tid >> 6;
    const int c = u & 31, b = u >> 5, row0 = b * 2048 + c * 64;
    const bf16_t* U = (const bf16_t*)(p.ws + OFF_U);
    LAS float* CUM = (LAS float*)lds; LAS bf16_t* KWT = (LAS bf16_t*)(lds + 65792); LAS bf16_t* VT = (LAS bf16_t*)(lds + 102656);
    const int t = tid >> 3, c8 = (tid & 7) * 8;
    u32x4 hfraw[4], viraw[4];
#pragma unroll
    for (int hh = 0; hh < 4; ++hh) { const bf16_t* ur = U + (size_t)(row0 + t) * NU + hh * 64 + c8; hfraw[hh] = ldg8(ur + UHF); viraw[hh] = ldg8(ur + UHI); }
#pragma unroll
    for (int hh = 0; hh < 4; ++hh) { float lb[8], hf[8]; ld8f((const float*)(p.ws + OFF_LB) + l * 256 + hh * 64 + c8, lb); unpack8(hfraw[hh], hf);
#pragma unroll
        for (int i = 0; i < 8; ++i) { VT[(hh * 64 + c8 + i) * 72 + t] = elem8(viraw[hh], i); CUM[t * 257 + hh * 64 + c8 + i] = __logf(lb[i] + (1.0f - lb[i]) * sigmoidf_(hf[i])); } }
    __syncthreads();
#pragma unroll 8
    for (int kk = 0; kk < 32; ++kk) { const int k = wave * 32 + kk; const float v = scan64_add(CUM[lane * 257 + k], lane); CUM[lane * 257 + k] = v; }
    __syncthreads();
#pragma unroll
    for (int hh = 0; hh < 4; ++hh) { float lb[8], hf[8]; ld8f((const float*)(p.ws + OFF_LB) + l * 256 + hh * 64 + c8, lb); unpack8(hfraw[hh], hf);
#pragma unroll
        for (int i = 0; i < 8; ++i) { const int ch = hh * 64 + c8 + i; const float kk_ = (1.0f - lb[i]) * sigmoidf_(-hf[i]);
            KWT[ch * 72 + t] = f2bf(kk_ * __expf(CUM[63 * 257 + ch] - CUM[t * 257 + ch])); } }
    if (tid < 256) ((float*)(p.ws + OFF_DECH))[((size_t)(b * 4 + (tid >> 6)) * 32 + c) * 64 + (tid & 63)] = __expf(CUM[63 * 257 + tid]);
    __syncthreads();
    engineA4(KWT, VT, (bf16_t*)(p.ws + OFF_DSH) + ((size_t)(b * 4) * 32 + c) * 4096, wave, lane);
    __syncthreads();
}

__device__ __forceinline__ void mixA_unit(PRM p, LAS unsigned char* lds, int l, int u) {
    RetRegs rr; HgRegs hr; RgRegs gr;
    ret_load<false>(p, l, u, rr); hg_load<false>(p, l, u, hr); rg_load<false>(p, l, u, gr);
    ret_body<false>(p, lds, l, u, rr); hg_body<false>(p, lds, l, u, hr); rg_body<false>(p, lds, l, u, gr);
}

__device__ __forceinline__ void mixC_unit(PRM p, LAS unsigned char* lds, int l, int u) {
    RetRegs rr; HgRegs hr; RgRegs gr;
    ret_load<true>(p, l, u, rr); hg_load<true>(p, l, u, hr); rg_load<true>(p, l, u, gr);
    ret_body<true>(p, lds, l, u, rr); hg_body<true>(p, lds, l, u, hr); rg_body<true>(p, lds, l, u, gr);
}

__device__ __forceinline__ void carry_phase(PRM p, int l) {
    const int gt = blockIdx.x * NTHR + tidx(), NG = gridDim.x * NTHR;
    constexpr int N_SSD = 8 * 4 * 4096, N_RET = 8 * 4 * 2048, N_HG = N_RET, N_RG = 8 * 256;
    for (int i = gt; i < N_SSD + N_RET + N_HG + N_RG; i += NG) {
        if (i < N_SSD + N_RET + N_HG) {
            unsigned* base; float dec[32]; size_t stride, oo;
            if (i < N_SSD) { const int bh = i >> 12, e2 = i & 4095; base = (unsigned*)(p.ws + OFF_DSS) + (size_t)bh * 32 * 4096 + e2; stride = 4096;
                const float* dc = (const float*)(p.ws + OFF_DECS) + bh * 32;
#pragma unroll
                for (int c = 0; c < 32; ++c) dec[c] = dc[c];
                oo = O_PSSD + (size_t)l * 8 * 32768 + (size_t)bh * 8192 + 2 * e2;
            } else if (i < N_SSD + N_RET) { const int j = i - N_SSD, bh = j >> 11, e2 = j & 2047; base = (unsigned*)(p.ws + OFF_DSR) + (size_t)bh * 32 * 2048 + e2; stride = 2048;
                const float d = expf(64.0f * logf(1.0f - exp2f(-5.0f - (float)(bh & 3))));
#pragma unroll
                for (int c = 0; c < 32; ++c) dec[c] = d;
                oo = O_PRET + (size_t)l * 8 * 16384 + (size_t)bh * 4096 + 2 * e2;
            } else { const int j = i - N_SSD - N_RET, bh = j >> 11, e2 = j & 2047; base = (unsigned*)(p.ws + OFF_DSH) + (size_t)bh * 32 * 2048 + e2; stride = 2048;
                const float* dc = (const float*)(p.ws + OFF_DECH) + (size_t)bh * 32 * 64 + (e2 >> 5);
#pragma unroll
                for (int c = 0; c < 32; ++c) dec[c] = dc[c * 64];
                oo = O_PHG + (size_t)l * 8 * 16384 + (size_t)bh * 4096 + 2 * e2;
            }
            unsigned tmp[32];
#pragma unroll
            for (int c = 0; c < 32; ++c) tmp[c] = base[(size_t)c * stride];
            float s0 = 0.f, s1 = 0.f;
#pragma unroll
            for (int c = 0; c < 32; ++c) { base[(size_t)c * stride] = pk2(s0, s1);
                s0 = dec[c] * s0 + __uint_as_float(tmp[c] << 16); s1 = dec[c] * s1 + __uint_as_float(tmp[c] & 0xffff0000u); }
            *(f32x2*)(p.out + oo) = (f32x2){s0, s1};
        } else {
            const int j = i - N_SSD - N_RET - N_HG, b = j >> 8, ch = j & 255;
            const float* hl = (const float*)(p.ws + OFF_RGH) + (size_t)b * 32 * 256 + ch; const float* at = (const float*)(p.ws + OFF_RGA) + (size_t)b * 32 * 256 + ch;
            float* cr = (float*)(p.ws + OFF_RGC) + (size_t)b * 32 * 256 + ch;
            float tmp[32], dec[32];
#pragma unroll
            for (int c = 0; c < 32; ++c) { tmp[c] = hl[c * 256]; dec[c] = at[c * 256]; }
            float sacc = 0.f;
#pragma unroll
            for (int c = 0; c < 32; ++c) { cr[c * 256] = sacc; sacc = dec[c] * sacc + tmp[c]; }
            p.out[O_PRG + (size_t)l * 8 * 256 + b * 256 + ch] = sacc;
        }
    }
}

constexpr int S_QD = 0, S_KW = 8192, S_V = 16384, S_DEC = 20480, S_P = 22528, S_Y = 22784, S_RED = 26880, S_SCR = 59648;
template <int KD>
__device__ __forceinline__ void dec_engine(const float* S0, float* S1, LAS unsigned char* lds) {
    const int tid = tidx(), p_ = tid & 63, kq = tid >> 6; constexpr int KPER = KD / 8;
    const LAS float* QDs = (const LAS float*)(lds + S_QD); const LAS float* KWs = (const LAS float*)(lds + S_KW); const LAS float* Vs = (const LAS float*)(lds + S_V);
    const LAS float* DECs = (const LAS float*)(lds + S_DEC); const LAS float* Ps = (const LAS float*)(lds + S_P); LAS float* Ys = (LAS float*)(lds + S_Y); LAS float* RED = (LAS float*)(lds + S_RED);
    float v[4][4], yp[4][4];
#pragma unroll
    for (int h = 0; h < 4; ++h)
#pragma unroll
        for (int s = 0; s < 4; ++s) { v[h][s] = Vs[s * 256 + h * 64 + p_]; yp[h][s] = 0.f; }
#pragma unroll
    for (int h = 0; h < 4; ++h) {
#pragma unroll
        for (int kk = 0; kk < KPER; ++kk) { const int k = kq * KPER + kk;
            const float s0 = S0[(size_t)(h * KD + k) * 64 + p_];
            const f32x4 kw = *(const LAS f32x4*)(KWs + (h * 128 + k) * 4), qd = *(const LAS f32x4*)(QDs + (h * 128 + k) * 4);
            const float acc = DECs[h * 128 + k] * s0 + kw.x * v[h][0] + kw.y * v[h][1] + kw.z * v[h][2] + kw.w * v[h][3];
            S1[(size_t)(h * KD + k) * 64 + p_] = acc;
            yp[h][0] += qd.x * s0; yp[h][1] += qd.y * s0; yp[h][2] += qd.z * s0; yp[h][3] += qd.w * s0;
        }
    }
#pragma unroll
    for (int h = 0; h < 4; ++h)
#pragma unroll
        for (int t = 0; t < 4; ++t) RED[(kq * 16 + h * 4 + t) * 64 + p_] = yp[h][t];
    __syncthreads();
    for (int idx = tid; idx < 1024; idx += NTHR) { const int p2 = idx & 63, ht = idx >> 6, h = ht >> 2, t = ht & 3;
        float sum = 0.f;
#pragma unroll
        for (int q = 0; q < 8; ++q) sum += RED[(q * 16 + ht) * 64 + p2];
        for (int s = 0; s <= t; ++s) sum += Ps[ht * 4 + s] * Vs[s * 256 + h * 64 + p2];
        Ys[t * 256 + h * 64 + p2] = sum; }
    __syncthreads();
}

__device__ __forceinline__ void sample_ssd(PRM p, LAS unsigned char* lds, int l, int b) {
    const int tid = tidx(), lane = tid & 63, wave = tid >> 6, R0 = TP + b * 4;
    const bf16_t* U = (const bf16_t*)(p.ws + OFF_U); const float* SDT = (const float*)(p.ws + OFF_SDT);
    LAS float* QDs = (LAS float*)(lds + S_QD); LAS float* KWs = (LAS float*)(lds + S_KW); LAS float* Vs = (LAS float*)(lds + S_V);
    LAS float* DECs = (LAS float*)(lds + S_DEC); LAS float* Ps = (LAS float*)(lds + S_P); LAS float* Ys = (LAS float*)(lds + S_Y);
    LAS float* XB = (LAS float*)(lds + S_SCR); LAS float* DTs = (LAS float*)(lds + S_SCR + 12288); LAS float* CUs = DTs + 16;
    for (int ch = tid; ch < 768; ch += NTHR) {
        float xx[7];
#pragma unroll
        for (int r = 0; r < 3; ++r) xx[r] = p.in[3][((size_t)(l * 128 + b) * 3 + r) * 768 + ch];
#pragma unroll
        for (int t = 0; t < 4; ++t) xx[3 + t] = bf2f(U[(size_t)(R0 + t) * NU + UXBC + ch]);
        const float* cw = p.in[18] + (size_t)l * 4 * 768 + ch; const float w0 = cw[0], w1 = cw[768], w2 = cw[1536], w3 = cw[2304], bias = p.in[19][l * 768 + ch];
#pragma unroll
        for (int t = 0; t < 4; ++t) XB[t * 768 + ch] = siluf_(bias + w0 * xx[t] + w1 * xx[t + 1] + w2 * xx[t + 2] + w3 * xx[t + 3]);
#pragma unroll
        for (int r = 0; r < 3; ++r) p.out[O_SSSDC + ((size_t)(l * 128 + b) * 3 + r) * 768 + ch] = xx[4 + r];
    }
    if (tid < 4) { const int h = tid; float cum = 0.f; const float bias = p.in[20][l * 4 + h], A = -expf(p.in[21][l * 4 + h]);
        for (int t = 0; t < 4; ++t) { const float dt = softplusf_(SDT[(size_t)(R0 + t) * 4 + h] + bias); cum += A * dt; DTs[h * 4 + t] = dt; CUs[h * 4 + t] = cum; } }
    __syncthreads();
    for (int idx = tid; idx < 2048; idx += NTHR) { const int h = idx >> 9, t = (idx >> 7) & 3, n = idx & 127, g = h >> 1;
        QDs[(h * 128 + n) * 4 + t] = XB[t * 768 + 512 + g * 128 + n] * __expf(CUs[h * 4 + t]);
        KWs[(h * 128 + n) * 4 + t] = XB[t * 768 + 256 + g * 128 + n] * __expf(CUs[h * 4 + 3] - CUs[h * 4 + t]) * DTs[h * 4 + t]; }
    for (int idx = tid; idx < 1024; idx += NTHR) Vs[idx] = XB[(idx >> 8) * 768 + (idx & 255)];
    DECs[(tid >> 7) * 128 + (tid & 127)] = __expf(CUs[(tid >> 7) * 4 + 3]);
    if (tid < 64) { const int h = tid >> 4, t = (tid >> 2) & 3, s = tid & 3, g = h >> 1; float val = 0.f;
        if (s <= t) { float dot = 0.f;
#pragma unroll 32
            for (int n = 0; n < 128; ++n) dot += XB[t * 768 + 512 + g * 128 + n] * XB[s * 768 + 256 + g * 128 + n];
            val = dot * __expf(CUs[h * 4 + t] - CUs[h * 4 + s]) * DTs[h * 4 + s]; }
        Ps[tid] = val; }
    __syncthreads();
    dec_engine<128>(p.in[2] + (size_t)(l * 128 + b) * 32768, p.out + O_SSSD + (size_t)(l * 128 + b) * 32768, lds);
    for (int idx = tid; idx < 1024; idx += NTHR) { const int t = idx >> 8, ch = idx & 255, h = ch >> 6;
        const float y = Ys[idx] + p.in[22][l * 4 + h] * XB[t * 768 + ch];
        Ys[idx] = y * siluf_(bf2f(U[(size_t)(R0 + t) * NU + UZ + ch])); }
    __syncthreads();
    if (wave < 4) { const int t = wave; float v[4], ss = 0.f;
#pragma unroll
        for (int i = 0; i < 4; ++i) { v[i] = Ys[t * 256 + lane + 64 * i]; ss += v[i] * v[i]; }
        const float rstd = 1.0f / sqrtf(wave_sum(ss) * (1.0f / 256.0f) + EPS);
#pragma unroll
        for (int i = 0; i < 4; ++i) ((bf16_t*)(p.ws + OFF_YC))[(size_t)(R0 + t) * D + lane + 64 * i] = f2bf(v[i] * rstd * p.in[23][l * 256 + lane + 64 * i]); }
    __syncthreads();
}

template <bool CENTER>
__device__ __forceinline__ void sample_headnorm(PRM p, LAS unsigned char* lds, int R0, const float* gain, int gcol, int ocol) {
    const int tid = tidx(), lane = tid & 63, wave = tid >> 6;
    const bf16_t* U = (const bf16_t*)(p.ws + OFF_U); const LAS float* Ys = (const LAS float*)(lds + S_Y);
#pragma unroll
    for (int q = 0; q < 2; ++q) { const int gi = wave * 2 + q, t = gi >> 2, h = gi & 3;
        const float y = Ys[t * 256 + h * 64 + lane];
        const float mean = CENTER ? wave_sum(y) * (1.0f / 64.0f) : 0.f; const float d = y - mean;
        const float var = wave_sum(d * d) * (1.0f / 64.0f);
        const float o = d / sqrtf(var + EPS) * gain[h * 64 + lane] * siluf_(bf2f(U[(size_t)(R0 + t) * NU + gcol + h * 64 + lane]));
        ((bf16_t*)(p.ws + OFF_YC))[(size_t)(R0 + t) * D + ocol + h * 64 + lane] = f2bf(o); }
}

__device__ __forceinline__ void sample_ret(PRM p, LAS unsigned char* lds, int l, int b) {
    const int tid = tidx(), R0 = TP + b * 4;
    const bf16_t* U = (const bf16_t*)(p.ws + OFF_U);
    const float* RC = (const float*)(p.ws + OFF_ROPE); const float* RS = RC + 2052 * 32;
    LAS float* QDs = (LAS float*)(lds + S_QD); LAS float* KWs = (LAS float*)(lds + S_KW); LAS float* Vs = (LAS float*)(lds + S_V);
    LAS float* DECs = (LAS float*)(lds + S_DEC); LAS float* Ps = (LAS float*)(lds + S_P);
    LAS float* Qr = (LAS float*)(lds + S_SCR); LAS float* Kr = Qr + 1024;
    { const int h = tid >> 7, t = (tid >> 5) & 3, j = tid & 31; const bf16_t* ur = U + (size_t)(R0 + t) * NU;
        const float cs = RC[(2048 + t) * 32 + j], sn = RS[(2048 + t) * 32 + j];
        const float q1 = bf2f(ur[URQ + h * 64 + j]), q2 = bf2f(ur[URQ + h * 64 + j + 32]), k1 = bf2f(ur[URK + h * 64 + j]), k2 = bf2f(ur[URK + h * 64 + j + 32]);
        Qr[(h * 4 + t) * 64 + j] = q1 * cs - q2 * sn; Qr[(h * 4 + t) * 64 + j + 32] = q2 * cs + q1 * sn;
        Kr[(h * 4 + t) * 64 + j] = (k1 * cs - k2 * sn) * 0.125f; Kr[(h * 4 + t) * 64 + j + 32] = (k2 * cs + k1 * sn) * 0.125f; }
    for (int idx = tid; idx < 1024; idx += NTHR) Vs[idx] = bf2f(U[(size_t)(R0 + (idx >> 8)) * NU + URV + (idx & 255)]);
    __syncthreads();
    for (int idx = tid; idx < 1024; idx += NTHR) { const int h = idx >> 8, t = (idx >> 6) & 3, k = idx & 63; const float lg = logf(1.0f - exp2f(-5.0f - (float)h));
        QDs[(h * 128 + k) * 4 + t] = Qr[(h * 4 + t) * 64 + k] * __expf((float)(t + 1) * lg);
        KWs[(h * 128 + k) * 4 + t] = Kr[(h * 4 + t) * 64 + k] * __expf((float)(3 - t) * lg); }
    if (tid < 256) { const int h = tid >> 6; DECs[h * 128 + (tid & 63)] = __expf(4.0f * logf(1.0f - exp2f(-5.0f - (float)h))); }
    if (tid < 64) { const int h = tid >> 4, t = (tid >> 2) & 3, s = tid & 3; float val = 0.f;
        if (s <= t) { float dot = 0.f;
#pragma unroll 32
            for (int k = 0; k < 64; ++k) dot += Qr[(h * 4 + t) * 64 + k] * Kr[(h * 4 + s) * 64 + k];
            val = dot * __expf((float)(t - s) * logf(1.0f - exp2f(-5.0f - (float)h))); }
        Ps[tid] = val; }
    __syncthreads();
    dec_engine<64>(p.in[4] + (size_t)(l * 128 + b) * 16384, p.out + O_SRET + (size_t)(l * 128 + b) * 16384, lds);
    sample_headnorm<true>(p, lds, R0, p.in[24] + l * 256, URG, 256);
    __syncthreads();
}

__device__ __forceinline__ void sample_hg(PRM p, LAS unsigned char* lds, int l, int b) {
    const int tid = tidx(), R0 = TP + b * 4;
    const bf16_t* U = (const bf16_t*)(p.ws + OFF_U);
    LAS float* QDs = (LAS float*)(lds + S_QD); LAS float* KWs = (LAS float*)(lds + S_KW); LAS float* Vs = (LAS float*)(lds + S_V);
    LAS float* DECs = (LAS float*)(lds + S_DEC); LAS float* Ps = (LAS float*)(lds + S_P);
    LAS float* LF = (LAS float*)(lds + S_SCR); LAS float* KK = LF + 1024; LAS float* QH = KK + 1024;
    for (int idx = tid; idx < 1024; idx += NTHR) { const int t = idx >> 8, ch = idx & 255; const bf16_t* ur = U + (size_t)(R0 + t) * NU;
        float lbk = 0.f;
        if (l > 0) { const float a0 = p.in[32][ch], a1 = p.in[32][256 + ch]; const float mx = fmaxf(a0, a1), e0 = expf(a0 - mx), e1 = expf(a1 - mx); lbk = e1 / (e0 + e1); }
        const float hf = bf2f(ur[UHF + ch]);
        LF[idx] = logf(lbk + (1.0f - lbk) * sigmoidf_(hf)); KK[idx] = (1.0f - lbk) * sigmoidf_(-hf); QH[idx] = siluf_(bf2f(ur[UHQ + ch])); Vs[idx] = bf2f(ur[UHI + ch]); }
    __syncthreads();
    if (tid < 256) { float c = 0.f; for (int t = 0; t < 4; ++t) { c += LF[t * 256 + tid]; LF[t * 256 + tid] = c; } }
    __syncthreads();
    for (int idx = tid; idx < 1024; idx += NTHR) { const int h = idx >> 8, t = (idx >> 6) & 3, k = idx & 63, ch = h * 64 + k;
        const float cum = LF[t * 256 + ch], last = LF[3 * 256 + ch];
        QDs[(h * 128 + k) * 4 + t] = QH[t * 256 + ch] * __expf(cum); KWs[(h * 128 + k) * 4 + t] = KK[t * 256 + ch] * __expf(last - cum); }
    if (tid < 256) DECs[(tid >> 6) * 128 + (tid & 63)] = __expf(LF[3 * 256 + tid]);
    if (tid < 64) { const int h = tid >> 4, t = (tid >> 2) & 3, s = tid & 3; float val = 0.f;
        if (s <= t)
#pragma unroll 16
            for (int k = 0; k < 64; ++k) { const int ch = h * 64 + k; val += QH[t * 256 + ch] * KK[s * 256 + ch] * __expf(LF[t * 256 + ch] - LF[s * 256 + ch]); }
        Ps[tid] = val; }
    __syncthreads();
    dec_engine<64>(p.in[7] + (size_t)(l * 128 + b) * 16384, p.out + O_SHG + (size_t)(l * 128 + b) * 16384, lds);
    sample_headnorm<false>(p, lds, R0, p.in[33] + l * 256, UHG, 768);
    __syncthreads();
}

__device__ __forceinline__ void sample_rg(PRM p, LAS unsigned char* lds, int l, int b) {
    const int tid = tidx(), R0 = TP + b * 4;
    const bf16_t* U = (const bf16_t*)(p.ws + OFF_U);
    LAS float* XRs = (LAS float*)(lds + S_SCR); LAS float* GA = XRs + 1024;
    if (tid < 256) { const int ch = tid; float xx[7];
#pragma unroll
        for (int r = 0; r < 3; ++r) xx[r] = p.in[6][((size_t)(l * 128 + b) * 3 + r) * 256 + ch];
#pragma unroll
        for (int t = 0; t < 4; ++t) xx[3 + t] = bf2f(U[(size_t)(R0 + t) * NU + UGX + ch]);
        const float* cw = p.in[25] + (size_t)l * 4 * 256 + ch; const float w0 = cw[0], w1 = cw[256], w2 = cw[512], w3 = cw[768], bias = p.in[26][l * 256 + ch];
#pragma unroll
        for (int t = 0; t < 4; ++t) XRs[t * 256 + ch] = bias + w0 * xx[t] + w1 * xx[t + 1] + w2 * xx[t + 2] + w3 * xx[t + 3];
#pragma unroll
        for (int r = 0; r < 3; ++r) p.out[O_SRGC + ((size_t)(l * 128 + b) * 3 + r) * 256 + ch] = xx[4 + r]; }
    __syncthreads();
    { const int ch = tid & 255, gate = tid >> 8, blk = ch >> 6, j = ch & 63; const float* W = p.in[gate ? 29 : 27] + (size_t)(l * 4 + blk) * 4096;
        float a0 = 0.f, a1 = 0.f, a2 = 0.f, a3 = 0.f, wv[64];
#pragma unroll
        for (int i = 0; i < 64; ++i) wv[i] = W[i * 64 + j];
#pragma unroll
        for (int i = 0; i < 64; ++i) { const float w = wv[i];
            a0 += XRs[blk * 64 + i] * w; a1 += XRs[256 + blk * 64 + i] * w; a2 += XRs[512 + blk * 64 + i] * w; a3 += XRs[768 + blk * 64 + i] * w; }
        GA[(gate * 4 + 0) * 256 + ch] = a0; GA[(gate * 4 + 1) * 256 + ch] = a1; GA[(gate * 4 + 2) * 256 + ch] = a2; GA[(gate * 4 + 3) * 256 + ch] = a3; }
    __syncthreads();
    if (tid < 256) { const int ch = tid; float h = p.in[5][(size_t)(l * 128 + b) * 256 + ch];
        const float ba = p.in[28][l * 256 + ch], bx = p.in[30][l * 256 + ch], sp = -8.0f * softplusf_(-p.in[31][l * 256 + ch]);
        for (int t = 0; t < 4; ++t) { const float r = sigmoidf_(GA[t * 256 + ch] + ba), ig = sigmoidf_(GA[(4 + t) * 256 + ch] + bx);
            const float la = sp * r; h = __expf(la) * h + sqrtf(-expm1f(2.0f * la)) * ig * XRs[t * 256 + ch];
            ((bf16_t*)(p.ws + OFF_YC))[(size_t)(R0 + t) * D + 512 + ch] = f2bf(geluf_(bf2f(U[(size_t)(R0 + t) * NU + UGY + ch])) * h); }
        p.out[O_SRG + (size_t)(l * 128 + b) * 256 + ch] = h; }
    __syncthreads();
}

__device__ __forceinline__ void attn_prompt(PRM p, LAS unsigned char* lds, int u) {
    const int tid = tidx(), lane = tid & 63, wave = tid >> 6, fr = lane & 15, fq = lane >> 4;
    const int qt = u & 15, h = (u >> 4) & 3, b = u >> 6, r0 = b * 2048 + qt * 128;
    const bf16_t* Q = (const bf16_t*)(p.ws + OFF_Q); const bf16_t* KBp = (const bf16_t*)(p.ws + OFF_KB) + (size_t)(b * 4 + h) * 65536;
    const bf16_t* VTp = (const bf16_t*)(p.ws + OFF_VTB) + (size_t)(b * 4 + h) * 65536; bf16_t* OB = (bf16_t*)(p.ws + OFF_YC);
    LAS bf16_t* KC = (LAS bf16_t*)lds; LAS bf16_t* PS = (LAS bf16_t*)(lds + 36864);
    bf16x8 qf[8];
#pragma unroll
    for (int ks = 0; ks < 8; ++ks) qf[ks] = *(const bf16x8*)(Q + (size_t)(r0 + 16 * wave + fr) * D + h * 256 + ks * 32 + fq * 8);
    u32x4 kr[4];
    const int sr = tid >> 3, sc8 = (tid & 7) * 8;
#pragma unroll
    for (int i = 0; i < 4; ++i) kr[i] = *(const u32x4*)(KBp + (size_t)(sr + 64 * i) * 256 + sc8);
    f32x4 S[16];
#pragma unroll
    for (int j = 0; j < 16; ++j) S[j] = (f32x4){0.f, 0.f, 0.f, 0.f};
#pragma unroll
    for (int dc = 0; dc < 4; ++dc) {
#pragma unroll
        for (int i = 0; i < 4; ++i) *(LAS u32x4*)(KC + (sr + 64 * i) * 72 + sc8) = kr[i];
        __syncthreads();
        if (dc < 3) {
#pragma unroll
            for (int i = 0; i < 4; ++i) kr[i] = *(const u32x4*)(KBp + (size_t)(sr + 64 * i) * 256 + (dc + 1) * 64 + sc8);
        } else {
#pragma unroll
            for (int i = 0; i < 4; ++i) kr[i] = *(const u32x4*)(VTp + (size_t)(sr + 64 * i) * 256 + sc8);
        }
#pragma unroll
        for (int k2 = 0; k2 < 2; ++k2)
#pragma unroll
            for (int j = 0; j < 16; ++j) { const bf16x8 kf = *(const LAS bf16x8*)(KC + (16 * j + fr) * 72 + k2 * 32 + fq * 8);
                S[j] = __builtin_amdgcn_mfma_f32_16x16x32_bf16(kf, qf[dc * 2 + k2], S[j], 0, 0, 0); }
        __syncthreads();
    }
    {
        float m = -3.0e38f;
#pragma unroll
        for (int j = 0; j < 16; ++j) m = fmaxf(fmaxf(m, fmaxf(S[j][0], S[j][1])), fmaxf(S[j][2], S[j][3]));
        m = fmaxf(m, __shfl_xor(m, 16)); m = fmaxf(m, __shfl_xor(m, 32));
        float sm = 0.f;
#pragma unroll
        for (int j = 0; j < 16; ++j)
#pragma unroll
            for (int e = 0; e < 4; ++e) { const float ev = __expf((S[j][e] - m) * 0.0625f); S[j][e] = ev; sm += ev; }
        sm += __shfl_xor(sm, 16); sm += __shfl_xor(sm, 32);
        const float inv = 1.0f / sm;
#pragma unroll
        for (int j = 0; j < 16; ++j) { u32x2 w; w.x = pk2(S[j][0] * inv, S[j][1] * inv); w.y = pk2(S[j][2] * inv, S[j][3] * inv);
            *(LAS u32x2*)(PS + (16 * wave + fr) * 264 + 16 * j + 4 * fq) = w; }
    }
    f32x4 O[16];
#pragma unroll
    for (int j = 0; j < 16; ++j) O[j] = (f32x4){0.f, 0.f, 0.f, 0.f};
#pragma unroll
    for (int kc = 0; kc < 4; ++kc) {
#pragma unroll
        for (int i = 0; i < 4; ++i) *(LAS u32x4*)(KC + (sr + 64 * i) * 72 + sc8) = kr[i];
        __syncthreads();
        if (kc < 3) {
#pragma unroll
            for (int i = 0; i < 4; ++i) kr[i] = *(const u32x4*)(VTp + (size_t)(sr + 64 * i) * 256 + (kc + 1) * 64 + sc8);
        }
#pragma unroll
        for (int k2 = 0; k2 < 2; ++k2) { const bf16x8 pf = *(const LAS bf16x8*)(PS + (16 * wave + fr) * 264 + kc * 64 + k2 * 32 + fq * 8);
#pragma unroll
            for (int j = 0; j < 16; ++j) { const bf16x8 vf = *(const LAS bf16x8*)(KC + (16 * j + fr) * 72 + k2 * 32 + fq * 8);
                O[j] = __builtin_amdgcn_mfma_f32_16x16x32_bf16(vf, pf, O[j], 0, 0, 0); } }
        __syncthreads();
    }
#pragma unroll
    for (int j = 0; j < 16; ++j) { u32x2 w; w.x = pk2(O[j][0], O[j][1]); w.y = pk2(O[j][2], O[j][3]);
        *(u32x2*)(OB + (size_t)(r0 + 16 * wave + fr) * D + h * 256 + 16 * j + 4 * fq) = w; }
}

__device__ __forceinline__ void attn_sample(PRM p, LAS unsigned char* lds, int l, int u) {
    const int tid = tidx(), lane = tid & 63, wave = tid >> 6;
    const int h = u & 3, b = u >> 2, R0 = TP + b * 4;
    const bf16_t* Q = (const bf16_t*)(p.ws + OFF_Q); bf16_t* OB = (bf16_t*)(p.ws + OFF_YC);
    LAS float* QSs = (LAS float*)lds; LAS float* SCT = QSs + 1024; LAS float* OP = SCT + 1024;
    const float* Kp = p.in[8] + ((size_t)(l * 128 + b) * 256) * 1024 + h * 256 + lane * 4;
    f32x4 kvn[8];
#pragma unroll
    for (int i = 0; i < 8; ++i) kvn[i] = *(const f32x4*)(Kp + (size_t)(wave * 32 + i) * 1024);
    for (int idx = tid; idx < 1024; idx += NTHR) QSs[idx] = bf2f(Q[(size_t)(R0 + (idx >> 8)) * D + h * 256 + (idx & 255)]) * 0.0625f;
    __syncthreads();
    f32x4 q[4];
#pragma unroll
    for (int t = 0; t < 4; ++t) q[t] = *(const LAS f32x4*)(QSs + t * 256 + lane * 4);
#pragma unroll 1
    for (int i0 = 0; i0 < 32; i0 += 8) {
        f32x4 kv[8];
#pragma unroll
        for (int i = 0; i < 8; ++i) kv[i] = kvn[i];
        if (i0 + 8 < 32) {
#pragma unroll
            for (int i = 0; i < 8; ++i) kvn[i] = *(const f32x4*)(Kp + (size_t)(wave * 32 + i0 + 8 + i) * 1024);
        }
        float vals[32];
#pragma unroll
        for (int i = 0; i < 8; ++i)
#pragma unroll
            for (int t = 0; t < 4; ++t) vals[i * 4 + t] = kv[i].x * q[t].x + kv[i].y * q[t].y + kv[i].z * q[t].z + kv[i].w * q[t].w;
#define TR_STEP(N, BIT, XCHG) { const bool up = (lane & (BIT)) != 0; _Pragma("unroll") for (int i = 0; i < (N); ++i) { \
            const float send = up ? vals[i] : vals[i + (N)]; const float keep = up ? vals[i + (N)] : vals[i]; vals[i] = keep + XCHG(send); } }
#define X_ROR8(v) DPP_F(0.f, v, 0x128, 0xf)
#define X_QP1(v) DPP_F(0.f, v, 0xB1, 0xf)
#define X_QP2(v) DPP_F(0.f, v, 0x4E, 0xf)
#define X_B4(v) __shfl_xor(v, 4)
#define X_B16(v) __shfl_xor(v, 16)
        TR_STEP(16, 8, X_ROR8) TR_STEP(8, 1, X_QP1) TR_STEP(4, 2, X_QP2) TR_STEP(2, 4, X_B4) TR_STEP(1, 16, X_B16)
#undef TR_STEP
        const float tot = vals[0] + __shfl_xor(vals[0], 32);
        if (lane < 32) { const int vi = (((lane >> 3) & 1) << 4) | ((lane & 1) << 3) | (((lane >> 1) & 1) << 2) | (((lane >> 2) & 1) << 1) | ((lane >> 4) & 1);
            SCT[(wave * 32 + i0 + (vi >> 2)) * 4 + (vi & 3)] = tot; }
    }
    const float* Vp = p.in[9] + ((size_t)(l * 128 + b) * 256) * 1024 + h * 256 + lane * 4;
    f32x4 vvn[8];
#pragma unroll
    for (int i = 0; i < 8; ++i) vvn[i] = *(const f32x4*)(Vp + (size_t)(wave * 32 + i) * 1024);
    __syncthreads();
    if (wave < 4) { const int t = wave; float v[4], m = -3.0e38f;
#pragma unroll
        for (int i = 0; i < 4; ++i) { v[i] = SCT[(lane + 64 * i) * 4 + t]; m = fmaxf(m, v[i]); }
        m = wave_max(m); float sm = 0.f;
#pragma unroll
        for (int i = 0; i < 4; ++i) { v[i] = __expf(v[i] - m); sm += v[i]; }
        sm = 1.0f / wave_sum(sm);
#pragma unroll
        for (int i = 0; i < 4; ++i) SCT[(lane + 64 * i) * 4 + t] = v[i] * sm; }
    __syncthreads();
    {
        f32x4 acc[4];
#pragma unroll
        for (int t = 0; t < 4; ++t) acc[t] = (f32x4){0.f, 0.f, 0.f, 0.f};
#pragma unroll 1
        for (int i0 = 0; i0 < 32; i0 += 8) {
            f32x4 vv[8];
#pragma unroll
            for (int i = 0; i < 8; ++i) vv[i] = vvn[i];
            if (i0 + 8 < 32) {
#pragma unroll
                for (int i = 0; i < 8; ++i) vvn[i] = *(const f32x4*)(Vp + (size_t)(wave * 32 + i0 + 8 + i) * 1024);
            }
#pragma unroll
            for (int i = 0; i < 8; ++i) { const f32x4 pr = *(const LAS f32x4*)(SCT + (wave * 32 + i0 + i) * 4);
                acc[0] = acc[0] + vv[i] * pr.x; acc[1] = acc[1] + vv[i] * pr.y; acc[2] = acc[2] + vv[i] * pr.z; acc[3] = acc[3] + vv[i] * pr.w; }
        }
#pragma unroll
        for (int t = 0; t < 4; ++t) *(LAS f32x4*)(OP + (wave * 4 + t) * 256 + lane * 4) = acc[t];
    }
    __syncthreads();
    for (int idx = tid; idx < 1024; idx += NTHR) { float o = 0.f;
#pragma unroll
        for (int w = 0; w < 8; ++w) o += OP[w * 1024 + idx];
        OB[(size_t)(R0 + (idx >> 8)) * D + h * 256 + (idx & 255)] = f2bf(o); }
    __syncthreads();
}

template <int MODE, int K, int KC>
__device__ __forceinline__ void sgemm(LAS unsigned char* lds, const bf16_t* A, const bf16_t* Bt, float* Cf, bf16_t* Cb) {
    const int tid = tidx(), lane = tid & 63, wave = tid >> 6, fr = lane & 15, fq = lane >> 4;
    constexpr int NCH = KC / 8, NI = (32 * NCH + NTHR - 1) / NTHR, LD = KC + 8, NSLAB = K / KC;
    LAS bf16_t* AS = (LAS bf16_t*)lds; LAS bf16_t* BS = (LAS bf16_t*)(lds + 32 * LD * 2);
    const int rt = (wave >> 1) & 1, ct = wave & 1;
    const int ntile = (512 - (int)blockIdx.x + (int)gridDim.x - 1) / (int)gridDim.x, nstep = ntile * NSLAB;
    u32x4 ra[NI], rb[NI];
    auto issue = [&](int step) { const int tile = blockIdx.x + (step / NSLAB) * gridDim.x, k0 = (step % NSLAB) * KC, tm = tile >> 5, tn = tile & 31;
#pragma unroll
        for (int i = 0; i < NI; ++i) { const int idx = tid + i * NTHR; const int r = idx / NCH, cc = idx % NCH;
            if (idx < 32 * NCH) { ra[i] = ldg8(A + (size_t)(tm * 32 + r) * K + k0 + cc * 8); rb[i] = ldg8(Bt + (size_t)(tn * 32 + r) * K + k0 + cc * 8); } } };
    if (nstep > 0) issue(0);
    f32x4 acc = (f32x4){0.f, 0.f, 0.f, 0.f};
#pragma unroll 1
    for (int step = 0; step < nstep; ++step) {
#pragma unroll
        for (int i = 0; i < NI; ++i) { const int idx = tid + i * NTHR; const int r = idx / NCH, cc = idx % NCH;
            if (idx < 32 * NCH) { *(LAS u32x4*)(AS + r * LD + cc * 8) = ra[i]; *(LAS u32x4*)(BS + r * LD + cc * 8) = rb[i]; } }
        __syncthreads();
        if (step + 1 < nstep) issue(step + 1);
        if (wave < 4) {
#pragma unroll 4
            for (int ks = 0; ks < KC / 32; ++ks) { const bf16x8 a = *(const LAS bf16x8*)(AS + (16 * rt + fr) * LD + ks * 32 + fq * 8);
                const bf16x8 b = *(const LAS bf16x8*)(BS + (16 * ct + fr) * LD + ks * 32 + fq * 8);
                acc = __builtin_amdgcn_mfma_f32_16x16x32_bf16(a, b, acc, 0, 0, 0); }
            if ((step % NSLAB) == NSLAB - 1) { const int tile = blockIdx.x + (step / NSLAB) * gridDim.x, tm = tile >> 5, tn = tile & 31;
#pragma unroll
                for (int e = 0; e < 4; ++e) { const size_t o = (size_t)(tm * 32 + 16 * rt + fq * 4 + e) * 1024 + tn * 32 + 16 * ct + fr;
                    if (MODE == 0) Cf[o] = acc[e]; else Cb[o] = f2bf(acc[e]); }
                acc = (f32x4){0.f, 0.f, 0.f, 0.f}; }
        }
        __syncthreads();
    }
}

#ifndef REP_SYNC
#define REP_SYNC 1
#endif
#define GSYNC() do { _Pragma("unroll 1") for (int _r = 0; _r < REP_SYNC; ++_r) xcd_barrier(xb); } while (0)
#ifndef REP_SAMP
#define REP_SAMP 1
#endif
#ifndef REP_SSD
#define REP_SSD 1
#endif
#ifndef REP_ROWS
#define REP_ROWS 1
#endif
#ifndef REP_P0
#define REP_P0 1
#endif
#ifndef REP_GEMM
#define REP_GEMM 1
#endif
#ifndef REP_MIX
#define REP_MIX 1
#endif
#ifndef REP_ATT
#define REP_ATT 1
#endif
__global__ void __launch_bounds__(512) mega(Params p_unused) {
    const KPRM kp = (KPRM)__builtin_amdgcn_kernarg_segment_ptr();
#define PP (*kp_launder(kp))
    extern __shared__ __attribute__((aligned(16))) unsigned char shm[];
    LAS unsigned char* lds = (LAS unsigned char*)shm;
    cg::grid_group grid = cg::this_grid();
    unsigned char* ws = PP.ws;
    bf16_t* H = (bf16_t*)(ws + OFF_H); bf16_t* UB = (bf16_t*)(ws + OFF_U); bf16_t* YC = (bf16_t*)(ws + OFF_YC); bf16_t* M = (bf16_t*)(ws + OFF_M);
    bf16_t* QB = (bf16_t*)(ws + OFF_Q); bf16_t* ACT = (bf16_t*)(ws + OFF_ACT); float* X = PP.out; float* SDT = (float*)(ws + OFF_SDT);
    volatile LAS unsigned* xst = (volatile LAS unsigned*)(lds + 163824);
    unsigned* bar = (unsigned*)(ws + OFF_BAR);
    { const int t0 = tidx(); if (t0 == 0) { xst[0] = 0u; xst[1] = 0u; } if (blockIdx.x == 0) for (int i = t0; i < XCD_BAR_WORDS; i += NTHR) bar[i] = 0u; }
    __syncthreads();
    phase0(PP, lds);
    grid.sync();
    XcdBarrier xb = xcd_barrier_post(bar, xst);
#pragma unroll 1
    for (int rep = 1; rep < REP_P0; ++rep) { phase0(PP, lds); GSYNC(); }
#pragma unroll 1
    for (int l = 0; l < NL; ++l) {
#pragma unroll 1
        for (int rep = 0; rep < REP_GEMM; ++rep) {
            { EpiBf16 e{UB, NU}; run_gemm(lds, H, (const bf16_t*)(ws + OFF_WIN) + (size_t)l * NU * D, TT, NU, D, e, 0); }
            { EpiMemKV e{PP.out + O_PMK + (size_t)l * 8 * 256 * 1024, PP.out + O_PMV + (size_t)l * 8 * 256 * 1024, (bf16_t*)(ws + OFF_KB), (bf16_t*)(ws + OFF_VTB)};
              run_gemm(lds, (const bf16_t*)(ws + OFF_HM) + (size_t)l * 2048 * D, (const bf16_t*)(ws + OFF_WXKV) + (size_t)l * 2048 * D, 2048, 2048, D, e, 64); }
            GSYNC();
        }
#pragma unroll 1
        for (int rep = 0; rep < REP_MIX; ++rep) {
#pragma unroll 1
            for (int grp = 0; grp < 3; ++grp) { const int gsel = (blockIdx.x & 1) ? 2 - grp : grp;
                if (gsel == 0) {
#pragma unroll 1
                    for (int r2 = 0; r2 < REP_SAMP; ++r2)
                    for (int u = blockIdx.x; u < 512; u += gridDim.x) {
                        if (u < 128) sample_ssd(PP, lds, l, u);
                        else if (u < 256) sample_ret(PP, lds, l, u - 128);
                        else if (u < 384) sample_hg(PP, lds, l, u - 256);
                        else sample_rg(PP, lds, l, u - 384);
                    }
                } else if (gsel == 1) {
#pragma unroll 1
                    for (int r2 = 0; r2 < REP_SSD; ++r2)
                    for (int u = blockIdx.x; u < 512; u += gridDim.x) ssd_passA(PP, lds, l, u);
                } else {
#ifdef MIXA_PERHEAD
#pragma unroll 1
                    for (int u = blockIdx.x; u < 1024; u += gridDim.x) mixA_unit(PP, lds, l, u);
#else
#pragma unroll 1
                    for (int u = blockIdx.x; u < 256; u += gridDim.x) { retA4_unit(PP, lds, l, u); hgA4_unit(PP, lds, l, u); }
                    rg_loop<false>(PP, lds, l);
#endif
                }
            }
            GSYNC();
            carry_phase(PP, l);
            GSYNC();
            if ((blockIdx.x & 1) == 0) {
#pragma unroll 1
                for (int r2 = 0; r2 < REP_SSD; ++r2)
                for (int u = blockIdx.x; u < 256; u += gridDim.x) ssd_passC(PP, lds, l, u);
            }
#if 1
#if 1
            ret_loop<true>(PP, lds, l);
#else
#pragma unroll 1
            for (int u = blockIdx.x; u < 512; u += gridDim.x) retC2_unit(PP, lds, l, u);
#endif
            hg_loop<true>(PP, lds, l); rg_loop<true>(PP, lds, l);
            if (blockIdx.x & 1) {
#pragma unroll 1
                for (int r2 = 0; r2 < REP_SSD; ++r2)
                for (int u = blockIdx.x; u < 256; u += gridDim.x) ssd_passC(PP, lds, l, u);
            }
#else
#pragma unroll 1
            for (int u = blockIdx.x; u < 1024; u += gridDim.x) mixC_unit(PP, lds, l, u);
#endif
            GSYNC();
        }
#pragma unroll 1
        for (int rep = 0; rep < REP_GEMM; ++rep) { EpiBf16 e{M, D}; run_gemm(lds, YC, (const bf16_t*)(ws + OFF_WOUT) + (size_t)l * D * D, TP, D, D, e, 0);
            sgemm<1, 1024, 1024>(lds, YC + (size_t)TP * D, (const bf16_t*)(ws + OFF_WOUT) + (size_t)l * D * D, nullptr, M + (size_t)TP * D); GSYNC(); }
        rows_phase(lds, TT, l == 0 ? PP.in[0] : nullptr, l == 0 ? PP.in[1] : nullptr, X, M, PP.in[12] + l * D, PP.in[13] + l * D, H, nullptr, nullptr);
#if REP_ROWS > 1
        rows_phase(lds, TT, nullptr, nullptr, (float*)(ws + OFF_XS), M, PP.in[12] + l * D, PP.in[13] + l * D, (bf16_t*)(ws + OFF_HS), nullptr, nullptr);
#endif
        GSYNC();
#pragma unroll 1
        for (int rep = 0; rep < REP_GEMM; ++rep) { EpiBf16 e{QB, D}; run_gemm(lds, H, (const bf16_t*)(ws + OFF_WXQ) + (size_t)l * D * D, TP, D, D, e, 0);
            sgemm<1, 1024, 1024>(lds, H + (size_t)TP * D, (const bf16_t*)(ws + OFF_WXQ) + (size_t)l * D * D, nullptr, QB + (size_t)TP * D); GSYNC(); }
#pragma unroll 1
        for (int rep = 0; rep < REP_ATT; ++rep) {
            for (int k = 0; k < 1024; k += gridDim.x) { const int u = (gridDim.x == 256 && (blockIdx.x & 1)) ? (int)((blockIdx.x + k + 512) & 1023) : (int)(blockIdx.x + k);
                if (u < 512) attn_prompt(PP, lds, u); else if (u < 1024) attn_sample(PP, lds, l, u - 512); }
            GSYNC();
        }
#pragma unroll 1
        for (int rep = 0; rep < REP_GEMM; ++rep) { EpiBf16 e{M, D}; run_gemm(lds, YC, (const bf16_t*)(ws + OFF_WXO) + (size_t)l * D * D, TP, D, D, e, 0);
            sgemm<1, 1024, 1024>(lds, YC + (size_t)TP * D, (const bf16_t*)(ws + OFF_WXO) + (size_t)l * D * D, nullptr, M + (size_t)TP * D); GSYNC(); }
        rows_phase(lds, TT, nullptr, nullptr, X, M, PP.in[14] + l * D, PP.in[15] + l * D, H, nullptr, nullptr);
#if REP_ROWS > 1
        rows_phase(lds, TT, nullptr, nullptr, (float*)(ws + OFF_XS), M, PP.in[14] + l * D, PP.in[15] + l * D, (bf16_t*)(ws + OFF_HS), nullptr, nullptr);
#endif
        GSYNC();
#pragma unroll 1
        for (int rep = 0; rep < REP_GEMM; ++rep) { EpiSwiGLU e{ACT}; run_gemm(lds, H, (const bf16_t*)(ws + OFF_WGU) + (size_t)l * 5632 * D, TT, 5632, D, e, 0); GSYNC(); }
#pragma unroll 1
        for (int rep = 0; rep < REP_GEMM; ++rep) { EpiBf16 e{M, D}; run_gemm(lds, ACT, (const bf16_t*)(ws + OFF_WDN) + (size_t)l * D * DFF, TP, D, DFF, e, 0);
            sgemm<1, 2816, 704>(lds, ACT + (size_t)TP * DFF, (const bf16_t*)(ws + OFF_WDN) + (size_t)l * D * DFF, nullptr, M + (size_t)TP * D); GSYNC(); }
        rows_phase(lds, TT, nullptr, nullptr, X, M, PP.in[16] + l * D, l + 1 < NL ? PP.in[11] + (l + 1) * D : nullptr, H, l + 1 < NL ? PP.in[17] + (size_t)(l + 1) * D * DIN : nullptr, SDT);
#if REP_ROWS > 1
        rows_phase(lds, TT, nullptr, nullptr, (float*)(ws + OFF_XS), M, PP.in[16] + l * D, l + 1 < NL ? PP.in[11] + (l + 1) * D : nullptr, (bf16_t*)(ws + OFF_HS), l + 1 < NL ? PP.in[17] + (size_t)(l + 1) * D * DIN : nullptr, (float*)(ws + OFF_HS));
#endif
        GSYNC();
    }
}

#undef PP
extern "C" void kernel_launch(void* const* d_in, const int* in_sizes, int n_in, void* d_out, int out_size, void* d_ws, size_t ws_size, hipStream_t stream) {
    constexpr int LDS_BYTES = 160 * 1024;
    static int grid = 0;
    if (grid == 0) {
        if (n_in != 41 || (size_t)out_size != O_END || ws_size < WS_END) { fprintf(stderr, "kernel_launch: unexpected shapes (n_in %d out %d ws %zu need %zu)\n", n_in, out_size, ws_size, (size_t)WS_END); grid = -1; return; }
        int dev = 0, cus = 0, per_cu = 0;
        (void)hipGetDevice(&dev);
        (void)hipDeviceGetAttribute(&cus, hipDeviceAttributeMultiprocessorCount, dev);
        (void)hipFuncSetAttribute((const void*)mega, hipFuncAttributeMaxDynamicSharedMemorySize, LDS_BYTES);
        (void)hipOccupancyMaxActiveBlocksPerMultiprocessor(&per_cu, (const void*)mega, 512, LDS_BYTES);
        if (per_cu < 1) { fprintf(stderr, "kernel_launch: occupancy query reports %d blocks per CU\n", per_cu); per_cu = 1; }
        grid = cus < 256 ? cus : 256;
    }
    if (grid < 0) return;
    Params p{};
    for (int i = 0; i < 41; ++i) p.in[i] = (const float*)d_in[i];
    p.out = (float*)d_out; p.ws = (unsigned char*)d_ws;
    void* args[] = {&p};
    hipError_t e = hipLaunchCooperativeKernel((void*)mega, dim3(grid), dim3(512), args, LDS_BYTES, stream);
    if (e != hipSuccess) fprintf(stderr, "cooperative launch failed: %s (grid %d)\n", hipGetErrorString(e), grid);
}
```
